# Optimizing an MI355X kernel written in HIP

```python
import math
import jax, jax.numpy as jnp
from jax import lax
import numpy as np

D_MODEL = 1024
BATCH = 16
SEQ = 2048
DEPTH = 1

CHUNK = 64
SB_BLOCK = 128
SB_HEADS = 8
SB_HEAD_DIM = 64
SB_WIDTH = SB_HEADS * SB_HEAD_DIM
RET_HEADS = 8
RET_QK_DIM = 64
RET_V_DIM = 128
RET_QK_WIDTH = RET_HEADS * RET_QK_DIM
RET_V_WIDTH = RET_HEADS * RET_V_DIM
IN_COLS = 3 * SB_WIDTH + 2 * RET_QK_WIDTH + 2 * RET_V_WIDTH
N_BRANCHES = 2
ROPE_BASE = 10000.0
N_GROUPS = 4
EXPERTS_PER_GROUP = 4
N_EXPERTS = N_GROUPS * EXPERTS_PER_GROUP
TOP_K_IN_GROUP = 2
D_FF_EXPERT = 512
EPS = 1e-6

kernel_name = "hybrid_stickbreak_retention_hmoe"


def rms_norm(x, g):
    xf = x.astype(jnp.float32)
    y = xf * lax.rsqrt(jnp.mean(xf * xf, axis=-1, keepdims=True) + EPS)
    return (y * g.astype(jnp.float32)).astype(x.dtype)


def to_heads(t, n_heads):
    b, s, _ = t.shape
    return t.reshape(b, s, n_heads, -1).transpose(0, 2, 1, 3)


def from_heads(t):
    b, h, s, d = t.shape
    return t.transpose(0, 2, 1, 3).reshape(b, s, h * d)


def rotary(x, positions):
    half = x.shape[-1] // 2
    inv_freq = ROPE_BASE ** (-jnp.arange(half, dtype=jnp.float32) / half)
    ang = positions.astype(jnp.float32)[:, None] * inv_freq[None, :]
    cos, sin = jnp.cos(ang), jnp.sin(ang)
    x1, x2 = x[..., :half], x[..., half:]
    return jnp.concatenate([x1 * cos - x2 * sin, x2 * cos + x1 * sin], axis=-1)


def stick_breaking_attention(q, k, v):
    s_len, d = q.shape[2], q.shape[3]
    scale = 1.0 / math.sqrt(d)
    outs = []
    for blk in range(s_len // SB_BLOCK):
        q0 = blk * SB_BLOCK
        k_end = q0 + SB_BLOCK
        qb = q[:, :, q0:k_end]
        kb = k[:, :, :k_end]
        vb = v[:, :, :k_end]
        z = jnp.einsum('bhqd,bhkd->bhqk', qb, kb) * scale
        t_idx = q0 + jnp.arange(SB_BLOCK)[:, None]
        s_idx = jnp.arange(k_end)[None, :]
        mask = s_idx < t_idx
        log_keep = jnp.where(mask, jax.nn.log_sigmoid(-z), 0.0)
        suffix = lax.cumsum(log_keep, axis=3, reverse=True) - log_keep
        weights = jnp.where(mask, jnp.exp(jax.nn.log_sigmoid(z) + suffix), 0.0)
        outs.append(jnp.einsum('bhqk,bhkd->bhqd', weights, vb))
    return jnp.concatenate(outs, axis=2)


def retention_chunkwise(q, k, v):
    b, h, s_len, dk = q.shape
    dv = v.shape[-1]
    nc = s_len // CHUNK
    log_gamma = jnp.log(1.0 - 2.0 ** (-5.0 - jnp.arange(h, dtype=jnp.float32)))
    idx = jnp.arange(CHUNK, dtype=jnp.float32)
    dist = jnp.abs(idx[:, None] - idx[None, :])
    d_intra = jnp.exp(log_gamma[:, None, None] * dist)
    qc = q.reshape(b, h, nc, CHUNK, dk)
    kc = k.reshape(b, h, nc, CHUNK, dk)
    vc = v.reshape(b, h, nc, CHUNK, dv)
    scores = jnp.einsum('bhncd,bhnmd->bhncm', qc, kc) * d_intra[None, :, None]
    intra = jnp.einsum('bhncm,bhnme->bhnce', scores, vc)
    k_decay = jnp.exp(log_gamma[:, None] * (CHUNK - 1 - idx)[None, :])
    kv = jnp.einsum('bhnmd,bhnme->bhnde', kc * k_decay[None, :, None, :, None], vc)
    chunk_decay = jnp.exp(log_gamma * CHUNK)[None, :, None, None]

    def step(state, kv_n):
        return state * chunk_decay + kv_n, state

    init = jnp.zeros((b, h, dk, dv), jnp.float32)
    _, prev = lax.scan(step, init, jnp.moveaxis(kv, 2, 0))
    prev = jnp.moveaxis(prev, 0, 2)
    q_decay = jnp.exp(log_gamma[:, None] * (idx + 1.0)[None, :])
    cross = jnp.einsum('bhncd,bhnde->bhnce', qc * q_decay[None, :, None, :, None], prev)
    return (intra + cross).reshape(b, h, s_len, dv)


def hierarchical_moe(xn, w_group_router, b_group_router, w_expert_router, b_expert_router,
                     w_exp_gate, w_exp_up, w_exp_down):
    b, s_len, d = xn.shape
    xt = xn.reshape(b * s_len, d)
    n_tok = xt.shape[0]
    group_logits = (xt @ w_group_router + b_group_router).astype(jnp.float32)
    group_probs = jax.nn.softmax(group_logits, axis=-1)
    p_group, g_sel = lax.top_k(group_probs, 1)
    expert_logits = (xt @ w_expert_router + b_expert_router).astype(jnp.float32)
    expert_logits = expert_logits.reshape(n_tok, N_GROUPS, EXPERTS_PER_GROUP)
    in_group = jnp.take_along_axis(expert_logits, g_sel[:, :, None], axis=1)[:, 0]
    top_vals, top_idx = lax.top_k(in_group, TOP_K_IN_GROUP)
    gate = jax.nn.softmax(top_vals, axis=-1) * p_group
    expert_id = g_sel * EXPERTS_PER_GROUP + top_idx
    combine = jnp.sum(jax.nn.one_hot(expert_id, N_EXPERTS, dtype=jnp.float32) * gate[..., None], axis=1)
    combine = combine.astype(xt.dtype)
    y = jnp.zeros_like(xt)
    for e in range(N_EXPERTS):
        hidden = jax.nn.silu(xt @ w_exp_gate[e]) * (xt @ w_exp_up[e])
        y = y + combine[:, e:e + 1] * (hidden @ w_exp_down[e])
    return y.reshape(b, s_len, d)


def setup_inputs(seed: int = 0) -> dict:
    key = jax.random.key(seed)
    ks = jax.random.split(key, 20)
    f32 = jnp.float32

    def w(k, shape, fan_in):
        return jax.random.normal(k, shape, f32) * (fan_in ** -0.5)

    def gain(k, shape):
        return 1.0 + 0.02 * jax.random.normal(k, shape, f32)

    L = DEPTH
    return {
        "x": jax.random.normal(ks[0], (BATCH, SEQ, D_MODEL), f32),
        "norm_mix_g": gain(ks[1], (L, D_MODEL)),
        "w_in": w(ks[2], (L, D_MODEL, IN_COLS), D_MODEL),
        "w_gate": w(ks[3], (L, D_MODEL, N_BRANCHES * D_MODEL), D_MODEL),
        "b_gate": 0.02 * jax.random.normal(ks[4], (L, N_BRANCHES * D_MODEL), f32),
        "w_sb_out": w(ks[5], (L, SB_WIDTH, D_MODEL), SB_WIDTH),
        "w_ret_out": w(ks[6], (L, RET_V_WIDTH, D_MODEL), RET_V_WIDTH),
        "ret_norm_g": gain(ks[7], (L, RET_V_WIDTH)),
        "w_out": w(ks[8], (L, D_MODEL, D_MODEL), D_MODEL),
        "norm_ffn_g": gain(ks[9], (L, D_MODEL)),
        "w_group_router": w(ks[10], (L, D_MODEL, N_GROUPS), D_MODEL),
        "b_group_router": 0.01 * jax.random.normal(ks[11], (L, N_GROUPS), f32),
        "w_expert_router": w(ks[12], (L, D_MODEL, N_EXPERTS), D_MODEL),
        "b_expert_router": 0.01 * jax.random.normal(ks[13], (L, N_EXPERTS), f32),
        "w_exp_gate": w(ks[14], (L, N_EXPERTS, D_MODEL, D_FF_EXPERT), D_MODEL),
        "w_exp_up": w(ks[15], (L, N_EXPERTS, D_MODEL, D_FF_EXPERT), D_MODEL),
        "w_exp_down": w(ks[16], (L, N_EXPERTS, D_FF_EXPERT, D_MODEL), D_FF_EXPERT),
        "norm_final_g": gain(ks[17], (D_MODEL,)),
    }


def reference(x, norm_mix_g, w_in, w_gate, b_gate, w_sb_out, w_ret_out, ret_norm_g, w_out,
              norm_ffn_g, w_group_router, b_group_router, w_expert_router, b_expert_router,
              w_exp_gate, w_exp_up, w_exp_down, norm_final_g):
    h = x
    s_len = x.shape[1]
    positions = jnp.arange(s_len, dtype=jnp.int32)
    split_sizes = [SB_WIDTH, SB_WIDTH, SB_WIDTH, RET_QK_WIDTH, RET_QK_WIDTH, RET_V_WIDTH, RET_V_WIDTH]
    split_at = [int(i) for i in np.cumsum(split_sizes)[:-1]]
    for layer in range(DEPTH):
        xn = rms_norm(h, norm_mix_g[layer])
        proj = xn @ w_in[layer]
        sb_q, sb_k, sb_v, r_q, r_k, r_v, r_g = jnp.split(proj, split_at, axis=-1)
        y_sb = stick_breaking_attention(to_heads(sb_q, SB_HEADS).astype(jnp.float32),
                                        to_heads(sb_k, SB_HEADS).astype(jnp.float32),
                                        to_heads(sb_v, SB_HEADS).astype(jnp.float32))
        y_sb = from_heads(y_sb).astype(x.dtype) @ w_sb_out[layer]
        rq = rotary(to_heads(r_q, RET_HEADS).astype(jnp.float32), positions)
        rk = rotary(to_heads(r_k, RET_HEADS).astype(jnp.float32), positions) * (RET_QK_DIM ** -0.5)
        rv = to_heads(r_v, RET_HEADS).astype(jnp.float32)
        y_ret = retention_chunkwise(rq, rk, rv)
        y_ret = y_ret * lax.rsqrt(jnp.mean(y_ret * y_ret, axis=-1, keepdims=True) + EPS)
        y_ret = from_heads(y_ret) * ret_norm_g[layer].astype(jnp.float32)
        y_ret = (jax.nn.silu(r_g.astype(jnp.float32)) * y_ret).astype(x.dtype) @ w_ret_out[layer]
        gates = jax.nn.sigmoid(xn @ w_gate[layer] + b_gate[layer])
        g_sb, g_ret = jnp.split(gates, N_BRANCHES, axis=-1)
        h = h + (g_sb * y_sb + g_ret * y_ret) @ w_out[layer]
        hn = rms_norm(h, norm_ffn_g[layer])
        h = h + hierarchical_moe(hn, w_group_router[layer], b_group_router[layer],
                                 w_expert_router[layer], b_expert_router[layer],
                                 w_exp_gate[layer], w_exp_up[layer], w_exp_down[layer])
    return rms_norm(h, norm_final_g)
```

```cpp
#include <hip/hip_runtime.h>
#include <cstdio>
#include <cstdint>
namespace pg8 {
#define PG8_LAS __attribute__((address_space(3)))
typedef unsigned short bf16_t;
typedef short bf16x8 __attribute__((ext_vector_type(8)));
typedef float f32x4 __attribute__((ext_vector_type(4)));
typedef unsigned u32x4 __attribute__((ext_vector_type(4)));
constexpr int BM = 256, BK = 64, HALF = 128, HTB = HALF * BK * 2  , STAGE_BYTES = 8 * HTB, NXCD = 8, WGM = 8;
__host__ __device__ __forceinline__ int lds_byte(int r, int c) { const int st = (r >> 4) * 2 + (c >> 5), rr = r & 15, cc = c & 31, ob = rr * 64 + cc * 2; return st * 1024 + (ob ^ (((ob >> 9) & 1) << 5)); }
__host__ __device__ __forceinline__ void stage_rc(int b, int& R, int& C) { const int st = b / 1024, sb = b % 1024, swz = sb ^ (((sb >> 9) & 1) << 5); R = (st >> 1) * 16 + swz / 64; C = (st & 1) * 32 + (swz % 64) / 2; }
__host__ __device__ __forceinline__ int perm32(int rho) { const int n = rho >> 4, i = rho & 15; return 8 * (i >> 2) + 4 * n + (i & 3); }

struct Unit { const char* a; const char* b; int row0, col0, tag; };
struct StaticOrder {
    const char* A; const char* Bt; int K, nM, nN, nwg, G, c;
    __device__ void init(const void* A_, const void* Bt_, int M, int N, int K_, int G_, int c_) { A = (const char*)A_; Bt = (const char*)Bt_; K = K_; nM = M / BM; nN = N / BM; nwg = nM * nN; G = G_; c = c_; }
    __device__ bool next(int i, Unit& u) const {
        const long L = (long)i * G + c; if (L >= nwg) return false;
        int wgid = (int)L; { const int q = nwg / NXCD, r = nwg % NXCD, xcd = wgid % NXCD, off = wgid / NXCD; wgid = (xcd < r ? xcd * (q + 1) : r * (q + 1) + (xcd - r) * q) + off; }
        const int nig = WGM * nN, gid = wgid / nig, fm = gid * WGM, gsz = (nM - fm) < WGM ? (nM - fm) : WGM;
        const int pm = fm + ((wgid % nig) % gsz), pn = (wgid % nig) / gsz;
        u.a = A + (size_t)pm * BM * K * 2; u.b = Bt + (size_t)pn * BM * K * 2; u.row0 = pm * BM; u.col0 = pn * BM; u.tag = pn; return true;
    }
    __device__ __forceinline__ void a_ready(const Unit&) const {}
    __device__ __forceinline__ void done(const Unit&) const {}
};
__device__ __forceinline__ unsigned cvt_pk_bf16(float lo, float hi) { unsigned r; asm volatile("v_cvt_pk_bf16_f32 %0, %1, %2" : "=v"(r) : "v"(lo), "v"(hi)); return r; }
template <class Epi, class Sched, bool ALIGN_EPI = false, bool SP2 = false>
__device__ __forceinline__ void gemm_phase(PG8_LAS unsigned char* lds, const int K, const Sched& S, const Epi& E) {
    const int tid = threadIdx.x, wid = __builtin_amdgcn_readfirstlane(tid >> 6), lane = tid & 63, wr = wid >> 2, wc = wid & 3, fr = lane & 15, fq = lane >> 4;
    const int nt = K / BK;
    unsigned voffA[2], voffB[2];
#pragma unroll
    for (int i = 0; i < 2; ++i) { int R, C; stage_rc(tid * 16 + i * 8192, R, C); const int Rb = Epi::PERM ? ((R & ~31) + perm32(R & 31)) : R;
        voffA[i] = (unsigned)(R * K + C) * 2u; voffB[i] = (unsigned)(Rb * K + C) * 2u; }
    const size_t kstep = (size_t)(BK * 2);
    const size_t hstep = (size_t)HALF * K * 2;
    const size_t tstep = 2 * hstep;
    const unsigned ldsw = (unsigned)wid * 1024u;
    const int aoff = lds_byte(wr * 64 + fr, fq * 8), boff = lds_byte(wc * 32 + fr, fq * 8);
#define PG8_SA(b, h) (((b) * 2 + (h)) * HTB)
#define PG8_SB(b, h) ((4 + (b) * 2 + (h)) * HTB)
#define PG8_STAGE(bufoff, gbase, voff) do { _Pragma("unroll") for (int _i = 0; _i < 2; ++_i) \
        __builtin_amdgcn_global_load_lds((const unsigned*)((const char*)(gbase) + (voff)[_i]), (PG8_LAS unsigned*)(lds + (bufoff) + ldsw + _i * 8192), 16, 0, 0); } while (0)
#define PG8_LDA(dst, b, h) do { _Pragma("unroll") for (int m = 0; m < 4; ++m) _Pragma("unroll") for (int k = 0; k < 2; ++k) dst[m][k] = *(const PG8_LAS bf16x8*)(lds + PG8_SA(b, h) + aoff + m * 2048 + k * 1024); } while (0)
#define PG8_LDB(dst, b, h) do { _Pragma("unroll") for (int n = 0; n < 2; ++n) _Pragma("unroll") for (int k = 0; k < 2; ++k) dst[n][k] = *(const PG8_LAS bf16x8*)(lds + PG8_SB(b, h) + boff + n * 2048 + k * 1024); } while (0)
#define PG8_MMA(ai, bj, At, Bt) do { __builtin_amdgcn_s_setprio(1); _Pragma("unroll") for (int m = 0; m < 4; ++m) _Pragma("unroll") for (int n = 0; n < 2; ++n) _Pragma("unroll") for (int k = 0; k < 2; ++k) \
        acc[ai][bj][m][n] = __builtin_amdgcn_mfma_f32_16x16x32_bf16(Bt[n][k], At[m][k], acc[ai][bj][m][n], 0, 0, 0); __builtin_amdgcn_s_setprio(0); } while (0)
#define PG8_WAIT_V(n) asm volatile("s_waitcnt vmcnt(" #n ")" ::: "memory")
#define PG8_WAIT_L(n) asm volatile("s_waitcnt lgkmcnt(" #n ")" ::: "memory")
#define PG8_BAR __builtin_amdgcn_s_barrier()
#define PG8_SCHED __builtin_amdgcn_sched_barrier(0)
    Unit cur, nxt; int ui = 0;
    if (!S.next(0, cur)) return;
    f32x4 acc[2][2][4][2];
#pragma unroll
    for (int a = 0; a < 2; ++a)
#pragma unroll
        for (int b = 0; b < 2; ++b)
#pragma unroll
            for (int m = 0; m < 4; ++m)
#pragma unroll
                for (int n = 0; n < 2; ++n) acc[a][b][m][n] = (f32x4){0.f, 0.f, 0.f, 0.f};
    bf16x8 At[4][2], B0[2][2], B1[2][2];
    const char* cA = cur.a; const char* cB = cur.b;
    S.a_ready(cur);
    if constexpr (SP2) {
        PG8_STAGE(PG8_SB(0, 0), cB, voffB); PG8_STAGE(PG8_SB(0, 1), cB + hstep, voffB); PG8_STAGE(PG8_SA(0, 0), cA, voffA); PG8_STAGE(PG8_SA(0, 1), cA + hstep, voffA);
        if (wr == 1) PG8_BAR;
        PG8_WAIT_V(2); PG8_BAR;
        PG8_STAGE(PG8_SB(1, 0), cB + kstep, voffB); PG8_STAGE(PG8_SA(1, 0), cA + kstep, voffA); PG8_STAGE(PG8_SB(1, 1), cB + hstep + kstep, voffB);
        PG8_WAIT_V(6); PG8_BAR;
    } else {
        PG8_STAGE(PG8_SB(0, 0), cB, voffB); PG8_STAGE(PG8_SA(0, 0), cA, voffA); PG8_STAGE(PG8_SB(0, 1), cB + hstep, voffB); PG8_STAGE(PG8_SA(0, 1), cA + hstep, voffA);
        if (wr == 1) PG8_BAR;
        PG8_WAIT_V(4); PG8_BAR;
        PG8_STAGE(PG8_SB(1, 0), cB + kstep, voffB); PG8_STAGE(PG8_SA(1, 0), cA + kstep, voffA); PG8_STAGE(PG8_SB(1, 1), cB + hstep + kstep, voffB);
        PG8_WAIT_V(6); PG8_BAR;
    }
    for (;;) {
        const bool has_next = S.next(ui + 1, nxt);
        const char* nA = has_next ? nxt.a : cA; const char* nB = has_next ? nxt.b : cB;
        for (int t = 0; t < nt; t += 2) {
            const bool last = (t == nt - 2);
            const char* a1 = cA + (size_t)(t + 1) * kstep;
            const char* a2 = last ? nA : cA + (size_t)(t + 2) * kstep; const char* b2 = last ? nB : cB + (size_t)(t + 2) * kstep;
            const char* a3 = a2 + kstep; const char* b3 = b2 + kstep;
            if (last && has_next) S.a_ready(nxt);
            if constexpr (SP2) {
            PG8_LDB(B0, 0, 0); PG8_LDB(B1, 0, 1); PG8_SCHED; PG8_LDA(At, 0, 0); PG8_STAGE(PG8_SA(1, 1), a1 + hstep, voffA);
            PG8_WAIT_V(8); PG8_WAIT_L(0); PG8_BAR; PG8_MMA(0, 0, At, B0); PG8_MMA(0, 1, At, B1); PG8_BAR; PG8_SCHED;
            PG8_LDA(At, 0, 1); PG8_STAGE(PG8_SB(0, 0), b2, voffB); PG8_STAGE(PG8_SB(0, 1), b2 + hstep, voffB); PG8_STAGE(PG8_SA(0, 0), a2, voffA);
            PG8_WAIT_V(8); PG8_WAIT_L(0); PG8_BAR; PG8_MMA(1, 0, At, B0); PG8_MMA(1, 1, At, B1); PG8_BAR; PG8_SCHED;
            PG8_LDB(B0, 1, 0); PG8_LDB(B1, 1, 1); PG8_SCHED; PG8_LDA(At, 1, 0); PG8_STAGE(PG8_SA(0, 1), a2 + hstep, voffA);
            PG8_WAIT_V(8); PG8_WAIT_L(0); PG8_BAR; PG8_MMA(0, 0, At, B0); PG8_MMA(0, 1, At, B1); PG8_BAR; PG8_SCHED;
            PG8_LDA(At, 1, 1); PG8_STAGE(PG8_SB(1, 0), b3, voffB); PG8_STAGE(PG8_SB(1, 1), b3 + hstep, voffB); PG8_STAGE(PG8_SA(1, 0), a3, voffA);
            PG8_WAIT_V(8); PG8_WAIT_L(0); PG8_BAR; PG8_MMA(1, 0, At, B0); PG8_MMA(1, 1, At, B1); PG8_BAR; PG8_SCHED;
            } else {
            PG8_LDB(B0, 0, 0); PG8_SCHED; PG8_LDA(At, 0, 0); PG8_STAGE(PG8_SA(1, 1), a1 + hstep, voffA);
            PG8_WAIT_L(8); PG8_BAR; PG8_WAIT_L(0); PG8_MMA(0, 0, At, B0); PG8_BAR; PG8_SCHED;
            PG8_LDB(B1, 0, 1); PG8_STAGE(PG8_SB(0, 0), b2, voffB);
            PG8_BAR; PG8_WAIT_L(0); PG8_MMA(0, 1, At, B1); PG8_BAR;
            PG8_LDA(At, 0, 1); PG8_STAGE(PG8_SA(0, 0), a2, voffA);
            PG8_BAR; PG8_WAIT_L(0); PG8_MMA(1, 0, At, B0); PG8_BAR; PG8_SCHED;
            PG8_STAGE(PG8_SB(0, 1), b2 + hstep, voffB);
            PG8_WAIT_V(6); PG8_BAR; PG8_MMA(1, 1, At, B1); PG8_BAR;
            PG8_LDB(B0, 1, 0); PG8_SCHED; PG8_LDA(At, 1, 0); PG8_STAGE(PG8_SA(0, 1), a2 + hstep, voffA);
            PG8_WAIT_L(8); PG8_BAR; PG8_WAIT_L(0); PG8_MMA(0, 0, At, B0); PG8_BAR; PG8_SCHED;
            PG8_LDB(B1, 1, 1); PG8_STAGE(PG8_SB(1, 0), b3, voffB);
            PG8_BAR; PG8_WAIT_L(0); PG8_MMA(0, 1, At, B1); PG8_BAR;
            PG8_LDA(At, 1, 1); PG8_STAGE(PG8_SA(1, 0), a3, voffA);
            PG8_BAR; PG8_WAIT_L(0); PG8_MMA(1, 0, At, B0); PG8_BAR; PG8_SCHED;
            PG8_STAGE(PG8_SB(1, 1), b3 + hstep, voffB);
            PG8_WAIT_V(6); PG8_BAR; PG8_MMA(1, 1, At, B1); PG8_BAR;
            }
        }
        if constexpr (ALIGN_EPI) { if (wr == 0) PG8_BAR; }
        if constexpr (!Epi::AFTER_DRAIN) { E(acc, cur, wr, wc, fr, fq); S.done(cur); }
        if (!has_next) break;
#pragma unroll
        for (int a = 0; a < 2; ++a)
#pragma unroll
            for (int b = 0; b < 2; ++b)
#pragma unroll
                for (int m = 0; m < 4; ++m)
#pragma unroll
                    for (int n = 0; n < 2; ++n) acc[a][b][m][n] = (f32x4){0.f, 0.f, 0.f, 0.f};
        cur = nxt; cA = nA; cB = nB; ++ui;
        if constexpr (ALIGN_EPI) { if (wr == 1) PG8_BAR; }
    }
    PG8_WAIT_V(0);
    if constexpr (!ALIGN_EPI) { if (wr == 0) PG8_BAR; }
    PG8_BAR;
    if constexpr (Epi::AFTER_DRAIN) { E.fused(acc, cur, wr, wc, fr, fq, lds, wid, lane); S.done(cur); }
#undef PG8_SA
#undef PG8_SB
#undef PG8_STAGE
#undef PG8_LDA
#undef PG8_LDB
#undef PG8_MMA
#undef PG8_WAIT_V
#undef PG8_WAIT_L
#undef PG8_BAR
#undef PG8_SCHED
}
}
#define GAS __attribute__((address_space(1)))
#define LAS __attribute__((address_space(3)))
typedef unsigned short bf16;
typedef unsigned v4u __attribute__((ext_vector_type(4)));
typedef float f32x4 __attribute__((ext_vector_type(4)));
typedef short bf16x8 __attribute__((ext_vector_type(8)));
typedef GAS unsigned gu32;
typedef GAS unsigned long long gu64;
#define RLX_AGENT __ATOMIC_RELAXED, __HIP_MEMORY_SCOPE_AGENT
#define LDS_WAIT() asm volatile("s_waitcnt lgkmcnt(0)" ::: "memory")
#define VM_WAIT() asm volatile("s_waitcnt vmcnt(0)" ::: "memory")
__device__ __forceinline__ unsigned long long rt() { return __builtin_amdgcn_s_memrealtime(); }
__device__ __forceinline__ unsigned f2bf(float f) { unsigned u = __builtin_bit_cast(unsigned, f); return (u + 0x7fffu + ((u >> 16) & 1u)) >> 16; }
__device__ __forceinline__ unsigned pk2(float lo, float hi) { return f2bf(lo) | (f2bf(hi) << 16); }

#define XB_TMO      128
#define XB_XCNT(j)  (256  + 64 * (j))
#define XB_XSUB(j)  (1280 + 64 * (j))
#define XB_XGEN(j)  (2304 + 64 * (j))
#define XB_TOP      3328
#define XB_TOPGEN   3392
#define XCD_BAR_WORDS 3456
#define XB_SPIN_CAP (1u << 18)

__device__ __forceinline__ unsigned xb_ld(unsigned* p)              { return __hip_atomic_load(p, __ATOMIC_RELAXED, __HIP_MEMORY_SCOPE_AGENT); }
__device__ __forceinline__ unsigned xb_add(unsigned* p, unsigned v) { return __hip_atomic_fetch_add(p, v, __ATOMIC_RELAXED, __HIP_MEMORY_SCOPE_AGENT); }
__device__ __forceinline__ unsigned xb_xcc_id() { return (unsigned)__builtin_amdgcn_s_getreg((3 << 11) | 20) & 0xFu; }
#define XB_SPIN(cond, bar) do { unsigned _sp = 0; while (cond) { __builtin_amdgcn_s_sleep(1); \
    if ((++_sp & 255u) == 0u) { if (xb_ld(&(bar)[XB_TMO])) break; if (_sp > XB_SPIN_CAP) { atomicAdd(&(bar)[XB_TMO], 1u); break; } } } } while (0)

struct XcdBarrier {
    unsigned* bar; unsigned x;
    volatile LAS unsigned* st;
};

__device__ __forceinline__ XcdBarrier xcd_barrier_post(unsigned* bar, volatile LAS unsigned* st) {
    XcdBarrier b; b.bar = bar; b.x = xb_xcc_id(); b.st = st;
    if (threadIdx.x == 0) (void)xb_add(&bar[XB_XCNT(b.x)], 1u);
    return b;
}
__device__ __forceinline__ void xcd_barrier_complete(unsigned* bar, unsigned x, unsigned& nloc, unsigned& nx) {
    const unsigned G = gridDim.x * gridDim.y * gridDim.z;
    unsigned sum, cnt, mine, sp = 0u;
    for (;;) {
        sum = 0u; cnt = 0u; mine = 0u;
#pragma unroll
        for (unsigned j = 0; j < 16; ++j) { const unsigned c = xb_ld(&bar[XB_XCNT(j)]); sum += c; cnt += (c > 0u) ? 1u : 0u; mine = (j == x) ? c : mine; }
        if (sum == G) break;
        __builtin_amdgcn_s_sleep(1);
        if ((++sp & 255u) == 0u) { if (xb_ld(&bar[XB_TMO])) break; if (sp > XB_SPIN_CAP) { atomicAdd(&bar[XB_TMO], 1u); break; } }
    }
    nloc = mine > 0u ? mine : 1u; nx = cnt > 0u ? cnt : 1u;
}

__device__ __forceinline__ void xcd_barrier(const XcdBarrier& b) {
    asm volatile("s_waitcnt vmcnt(0)" ::: "memory");
    __syncthreads();
    if (threadIdx.x == 0) {
        unsigned* bar = b.bar;
        __builtin_amdgcn_s_waitcnt(0);
        unsigned nloc = b.st[0], nx = b.st[1];
        if (nloc == 0u) { xcd_barrier_complete(bar, b.x, nloc, nx); b.st[0] = nloc; b.st[1] = nx; }
        const unsigned old = xb_add(&bar[XB_XSUB(b.x)], 1u);
        const unsigned gen = old / nloc;
        if (old + 1u == (gen + 1u) * nloc) {
            __builtin_amdgcn_fence(__ATOMIC_RELEASE, "agent");
            asm volatile("s_waitcnt vmcnt(0)" ::: "memory");
            const unsigned og = xb_add(&bar[XB_TOP], 1u);
            const unsigned tg = og / nx;
            if (og + 1u == (tg + 1u) * nx) xb_add(&bar[XB_TOPGEN], 1u);
            else XB_SPIN(xb_ld(&bar[XB_TOPGEN]) == tg, bar);
            __builtin_amdgcn_fence(__ATOMIC_ACQUIRE, "agent");
            xb_add(&bar[XB_XGEN(b.x)], 1u);
            asm volatile("s_waitcnt vmcnt(0)" ::: "memory");
        } else {
            XB_SPIN(xb_ld(&bar[XB_XGEN(b.x)]) == gen, bar);
            __builtin_amdgcn_fence(__ATOMIC_ACQUIRE, "agent");
            asm volatile("s_waitcnt vmcnt(0)" ::: "memory");
        }
    }
    __syncthreads();
}


constexpr int NWAVES = 8, NTHR = NWAVES * 64;
constexpr int DM = 1024, NB = 16, SEQ = 2048, T = NB * SEQ;
constexpr int N1 = 6656;
constexpr int NCLS = 24, SROWS = T + NCLS * 256;
constexpr float EPS = 1e-6f;
constexpr size_t MiB = 1u << 20;
constexpr size_t WS_CTL = 0, CTL_ZERO_BYTES = 1 * MiB;
constexpr size_t WS_ROT = 1 * MiB;
constexpr size_t WS_TOK = 2 * MiB;
constexpr size_t WS_RSTD = 2 * MiB + 512 * 1024;
constexpr size_t WS_SINFO = 3 * MiB;
constexpr size_t WS_W1 = 4 * MiB, WS_WSB = 18 * MiB, WS_WRET = 19 * MiB, WS_WOUT = 21 * MiB, WS_WUP = 23 * MiB, WS_WDN = 55 * MiB;
constexpr size_t WS_R1 = 104 * MiB;
constexpr size_t WS_SBQ = 168 * MiB, WS_SBK = 200 * MiB, WS_SBV = 232 * MiB, WS_RQ = 264 * MiB, WS_RK = 296 * MiB, WS_RV = 328 * MiB, WS_RG = 392 * MiB, WS_YSB = 456 * MiB;
constexpr size_t WS_TMP = WS_SBQ, WS_MIX = WS_SBV, WS_HNS = WS_RV;
constexpr size_t WS_END = 488 * MiB;
constexpr int CW_BAR = 4096, CW_CNT = 8192;
constexpr int RING_BYTES = 131072, LDSCTL_OFF = RING_BYTES, MISC_OFF = LDSCTL_OFF + 320, TAB_OFF = LDSCTL_OFF + 1024;
constexpr int LDS_BYTES = 147456;

struct TokInfo { int cls, pos; float ga, gb; };
struct SInfo { int tok; float ga, gb; int pad; };

__device__ __forceinline__ float wave_sum(float v) {
#pragma unroll
    for (int o = 1; o < 64; o <<= 1) v += __shfl_xor(v, o);
    return v;
}
__device__ __forceinline__ float bf2f(unsigned short b) { return __builtin_bit_cast(float, (unsigned)b << 16); }
__device__ __forceinline__ float bflo(unsigned w) { return __builtin_bit_cast(float, w << 16); }
__device__ __forceinline__ float bfhi(unsigned w) { return __builtin_bit_cast(float, w & 0xffff0000u); }

struct Args { const float* in[18]; float* out; unsigned char* ws; int ph_lo, ph_hi; };

struct TJob { const float* W; int N; bf16* WT; int ldk, koff, mode, nbase; };
__device__ __forceinline__ int rowmap(int mode, int n) {
    if (mode == 1) {
        if (n >= 1536 && n < 2560) { const int seg = n < 2048 ? 1536 : 2048, c = n - seg, hh = c >> 6, i = c & 63; return seg + (hh >> 2) * 256 + (i >> 5) * 128 + (hh & 3) * 32 + (i & 31); }
        return n;
    }
    if (mode == 2) return (n >> 7) * 256 + (n & 127);
    if (mode == 3) return (n >> 7) * 256 + 128 + (n & 127);
    return n;
}
__device__ __forceinline__ void p0_transpose_item(const TJob& J, LAS float* scr, int item, int lane) {
    const int nblk = J.N / 32, kb = item / nblk, nb = item % nblk, k0 = 64 * kb, n0 = 32 * nb;
#pragma unroll 8
    for (int i = 0; i < 32; ++i) { const int kk = 2 * i + (lane >> 5); scr[kk * 33 + (lane & 31)] = J.W[(size_t)(k0 + kk) * J.N + n0 + (lane & 31)]; }
    LDS_WAIT(); asm volatile("" ::: "memory");
    const int c = lane & 7;
#pragma unroll
    for (int j = 0; j < 4; ++j) { const int n = (lane >> 3) + 8 * j; const LAS float* s = scr + (8 * c) * 33 + n;
        const int ng = n0 + n; float sc = 1.f; if (J.mode == 1 && (ng < 512 || (ng >= 2048 && ng < 2560))) sc = 0.125f;
        v4u o; o.x = pk2(s[0 * 33] * sc, s[1 * 33] * sc); o.y = pk2(s[2 * 33] * sc, s[3 * 33] * sc); o.z = pk2(s[4 * 33] * sc, s[5 * 33] * sc); o.w = pk2(s[6 * 33] * sc, s[7 * 33] * sc);
        *(GAS v4u*)(J.WT + (size_t)(J.nbase + rowmap(J.mode, ng)) * J.ldk + J.koff + k0 + 8 * c) = o; }
    LDS_WAIT(); asm volatile("" ::: "memory");
}
__device__ __forceinline__ void p0_prologue(const Args& a, LAS unsigned char* lds, int vcu, int G, int wave, int lane) {
    unsigned char* ws = a.ws;
    LAS float* scr = (LAS float*)(lds + wave * 16384);
    const int gw = vcu * NWAVES + wave, NGW = G * NWAVES;
    constexpr int I0 = 16 * 144, I1 = 16 * 64, I2 = 8 * 32, I3 = 16 * 32, I4 = 16 * 32, I5 = 16 * 256, I6 = 16 * 256, I7 = 48 * 256;
    constexpr int NITEMS = I0 + I1 + I2 + I3 + I4 + I5 + I6 + I7;
    for (int it = gw; it < NITEMS; it += NGW) {
        int r = it; TJob J;
        if (r < I0) { J = TJob{a.in[2], 4608, (bf16*)(ws + WS_W1), 1024, 0, 1, 0}; }
        else if ((r -= I0) < I1) { J = TJob{a.in[3], 2048, (bf16*)(ws + WS_W1), 1024, 0, 0, 4608}; }
        else if ((r -= I1) < I2) { J = TJob{a.in[5], 1024, (bf16*)(ws + WS_WSB), 512, 0, 0, 0}; }
        else if ((r -= I2) < I3) { J = TJob{a.in[6], 1024, (bf16*)(ws + WS_WRET), 1024, 0, 0, 0}; }
        else if ((r -= I3) < I4) { J = TJob{a.in[8], 1024, (bf16*)(ws + WS_WOUT), 1024, 0, 0, 0}; }
        else if ((r -= I4) < I5) { const int e = r >> 8; r &= 255; J = TJob{a.in[14] + (size_t)e * 1024 * 512, 512, (bf16*)(ws + WS_WUP) + (size_t)e * 1024 * 1024, 1024, 0, 2, 0}; }
        else if ((r -= I5) < I6) { const int e = r >> 8; r &= 255; J = TJob{a.in[15] + (size_t)e * 1024 * 512, 512, (bf16*)(ws + WS_WUP) + (size_t)e * 1024 * 1024, 1024, 0, 3, 0}; }
        else { r -= I6; const int cs = r >> 8; r &= 255; const int cls = cs >> 1, slot = cs & 1, g = cls / 6, p = cls % 6;
            const int pa = p < 3 ? 0 : (p < 5 ? 1 : 2), pb = p == 0 ? 1 : (p == 1 ? 2 : (p == 2 ? 3 : (p == 3 ? 2 : 3)));
            const int e = 4 * g + (slot ? pb : pa);
            J = TJob{a.in[16] + (size_t)e * 512 * 1024, 1024, (bf16*)(ws + WS_WDN) + (size_t)cls * 1024 * 1024, 1024, slot * 512, 0, 0}; }
        p0_transpose_item(J, scr, r, lane);
    }
    const float* x = a.in[0]; const float* g = a.in[1]; bf16* xn = (bf16*)(ws + WS_R1);
    f32x4 gv[4];
#pragma unroll
    for (int j = 0; j < 4; ++j) gv[j] = ((const f32x4*)g)[lane + 64 * j];
    for (int m = gw; m < T; m += NGW) {
        const GAS f32x4* xr = (const GAS f32x4*)(x + (size_t)m * DM) + lane;
        f32x4 v[4]; float s = 0.f;
#pragma unroll
        for (int j = 0; j < 4; ++j) { v[j] = xr[64 * j]; s += (v[j].x * v[j].x + v[j].y * v[j].y) + (v[j].z * v[j].z + v[j].w * v[j].w); }
        const float rstd = 1.f / sqrtf(wave_sum(s) * (1.f / DM) + EPS);
        GAS unsigned long long* o8 = (GAS unsigned long long*)(xn + (size_t)m * DM) + lane;
#pragma unroll
        for (int j = 0; j < 4; ++j) { const f32x4 y = v[j] * rstd * gv[j]; o8[64 * j] = (unsigned long long)pk2(y.x, y.y) | ((unsigned long long)pk2(y.z, y.w) << 32); }
    }
    float* rot = (float*)(ws + WS_ROT);
    for (int idx = gw * 64 + lane; idx < SEQ * 32; idx += NGW * 64) {
        const int pos = idx >> 5, i = idx & 31;
        const float inv = (float)exp(-(double)i * (9.210340371976184 / 32.0));
        const float ang = (float)pos * inv;
        rot[idx] = (float)cos((double)ang); rot[SEQ * 32 + idx] = (float)sin((double)ang);
    }
}

typedef pg8::Unit Unit;
using pg8::cvt_pk_bf16;
__device__ __forceinline__ v4u pack8(const f32x4 a, const f32x4 b) { v4u w; w.x = cvt_pk_bf16(a[0], a[1]); w.y = cvt_pk_bf16(a[2], a[3]); w.z = cvt_pk_bf16(b[0], b[1]); w.w = cvt_pk_bf16(b[2], b[3]); return w; }
__device__ __forceinline__ float sigm(float x) { return 1.f / (1.f + __expf(-x)); }

struct Epi1 {
    static constexpr bool PERM = true, AFTER_DRAIN = false;
    bf16 *sbq, *sbk, *sbv, *rq, *rk, *rv, *rg, *gates; const float* bgate; const float* rot;
    __device__ __forceinline__ void operator()(const f32x4 (&acc)[2][2][4][2], const Unit& u, int wr, int wc, int fr, int fq) const {
        const int pn = u.tag, rowb = u.row0 + wr * 64 + fr, cw = wc * 32 + 8 * fq;
        if (pn >= 6 && pn < 10) {
            bf16* base = (pn < 8 ? rq : rk) + ((pn & 1) * 4 + wc) * 64 + 8 * fq;
#pragma unroll
            for (int ai = 0; ai < 2; ++ai)
#pragma unroll
                for (int m = 0; m < 4; ++m) { const int row = rowb + ai * 128 + m * 16, pos = row & (SEQ - 1);
                    const f32x4 c0 = *(const f32x4*)(rot + pos * 32 + 8 * fq), c1 = *(const f32x4*)(rot + pos * 32 + 8 * fq + 4);
                    const f32x4 s0 = *(const f32x4*)(rot + SEQ * 32 + pos * 32 + 8 * fq), s1 = *(const f32x4*)(rot + SEQ * 32 + pos * 32 + 8 * fq + 4);
                    const f32x4 x10 = acc[ai][0][m][0], x11 = acc[ai][0][m][1], x20 = acc[ai][1][m][0], x21 = acc[ai][1][m][1];
                    const f32x4 o10 = x10 * c0 - x20 * s0, o11 = x11 * c1 - x21 * s1, o20 = x20 * c0 + x10 * s0, o21 = x21 * c1 + x11 * s1;
                    bf16* rowp = base + (size_t)row * 512;
                    *(v4u*)rowp = pack8(o10, o11); *(v4u*)(rowp + 32) = pack8(o20, o21); }
            return;
        }
        bf16* base; int ld, colt, act = 0;
        if (pn < 2) { base = sbq; ld = 512; colt = pn * 256; } else if (pn < 4) { base = sbk; ld = 512; colt = (pn - 2) * 256; }
        else if (pn < 6) { base = sbv; ld = 512; colt = (pn - 4) * 256; } else if (pn < 14) { base = rv; ld = 1024; colt = (pn - 10) * 256; }
        else if (pn < 18) { base = rg; ld = 1024; colt = (pn - 14) * 256; act = 1; } else { base = gates; ld = 2048; colt = (pn - 18) * 256; act = 2; }
        f32x4 bv[2][2];
#pragma unroll
        for (int bj = 0; bj < 2; ++bj)
#pragma unroll
            for (int n = 0; n < 2; ++n) bv[bj][n] = act == 2 ? *(const f32x4*)(bgate + colt + bj * 128 + cw + 4 * n) : (f32x4){0.f, 0.f, 0.f, 0.f};
#pragma unroll
        for (int ai = 0; ai < 2; ++ai)
#pragma unroll
            for (int m = 0; m < 4; ++m) { bf16* rowp = base + (size_t)(rowb + ai * 128 + m * 16) * ld + colt + cw;
#pragma unroll
                for (int bj = 0; bj < 2; ++bj) { f32x4 v0 = acc[ai][bj][m][0] + bv[bj][0], v1 = acc[ai][bj][m][1] + bv[bj][1];
                    if (act == 1) {
#pragma unroll
                        for (int j = 0; j < 4; ++j) { v0[j] = v0[j] * sigm(v0[j]); v1[j] = v1[j] * sigm(v1[j]); } }
                    else if (act == 2) {
#pragma unroll
                        for (int j = 0; j < 4; ++j) { v0[j] = sigm(v0[j]); v1[j] = sigm(v1[j]); } }
                    *(v4u*)(rowp + bj * 128) = pack8(v0, v1); } }
    }
};
template <bool ADD> struct EpiMix {
    static constexpr bool PERM = true, AFTER_DRAIN = false;
    const bf16* gates; int goff; const bf16* prev; bf16* out;
    __device__ __forceinline__ void operator()(const f32x4 (&acc)[2][2][4][2], const Unit& u, int wr, int wc, int fr, int fq) const {
        const int rowb = u.row0 + wr * 64 + fr, colb = u.col0 + wc * 32 + 8 * fq;
#pragma unroll
        for (int ai = 0; ai < 2; ++ai)
#pragma unroll
            for (int m = 0; m < 4; ++m) { const size_t row = rowb + ai * 128 + m * 16;
#pragma unroll
                for (int bj = 0; bj < 2; ++bj) { const int col = colb + bj * 128;
                    const v4u g = *(const v4u*)(gates + row * 2048 + goff + col);
                    f32x4 v0 = acc[ai][bj][m][0], v1 = acc[ai][bj][m][1];
                    v0[0] *= bflo(g.x); v0[1] *= bfhi(g.x); v0[2] *= bflo(g.y); v0[3] *= bfhi(g.y); v1[0] *= bflo(g.z); v1[1] *= bfhi(g.z); v1[2] *= bflo(g.w); v1[3] *= bfhi(g.w);
                    if (ADD) { const v4u p = *(const v4u*)(prev + row * 1024 + col);
                        v0[0] += bflo(p.x); v0[1] += bfhi(p.x); v0[2] += bflo(p.y); v0[3] += bfhi(p.y); v1[0] += bflo(p.z); v1[1] += bfhi(p.z); v1[2] += bflo(p.w); v1[3] += bfhi(p.w); }
                    *(v4u*)(out + row * 1024 + col) = pack8(v0, v1); } }
    }
};
struct EpiOut {
    static constexpr bool PERM = false, AFTER_DRAIN = false;
    const float* x; float* out;
    __device__ __forceinline__ void operator()(const f32x4 (&acc)[2][2][4][2], const Unit& u, int wr, int wc, int fr, int fq) const {
        const int rowb = u.row0 + wr * 64 + fr, colb = u.col0 + wc * 32 + 4 * fq;
#pragma unroll
        for (int ai = 0; ai < 2; ++ai)
#pragma unroll
            for (int m = 0; m < 4; ++m) { const size_t off = (size_t)(rowb + ai * 128 + m * 16) * 1024 + colb;
#pragma unroll
                for (int bj = 0; bj < 2; ++bj)
#pragma unroll
                    for (int n = 0; n < 2; ++n) *(f32x4*)(out + off + bj * 128 + n * 16) = *(const f32x4*)(x + off + bj * 128 + n * 16) + acc[ai][bj][m][n]; }
    }
};
struct EpiUp {
    static constexpr bool PERM = true, AFTER_DRAIN = false;
    const SInfo* sinfo; bf16* hid;
    __device__ __forceinline__ void operator()(const f32x4 (&acc)[2][2][4][2], const Unit& u, int wr, int wc, int fr, int fq) const {
        const int ct = u.tag, rowb = u.row0 + wr * 64 + fr, col = ct * 128 + wc * 32 + 8 * fq;
#pragma unroll
        for (int ai = 0; ai < 2; ++ai)
#pragma unroll
            for (int m = 0; m < 4; ++m) { const size_t row = rowb + ai * 128 + m * 16; const SInfo si = sinfo[row]; const float gw = ct < 4 ? si.ga : si.gb;
                f32x4 v0, v1;
#pragma unroll
                for (int j = 0; j < 4; ++j) { const float g0 = acc[ai][0][m][0][j], g1 = acc[ai][0][m][1][j];
                    v0[j] = g0 * sigm(g0) * acc[ai][1][m][0][j] * gw; v1[j] = g1 * sigm(g1) * acc[ai][1][m][1][j] * gw; }
                *(v4u*)(hid + row * 1024 + col) = pack8(v0, v1); }
    }
};
struct EpiDown {
    static constexpr bool PERM = false, AFTER_DRAIN = false;
    const SInfo* sinfo; float* out;
    __device__ __forceinline__ void operator()(const f32x4 (&acc)[2][2][4][2], const Unit& u, int wr, int wc, int fr, int fq) const {
        const int rowb = u.row0 + wr * 64 + fr, colb = u.col0 + wc * 32 + 4 * fq;
#pragma unroll
        for (int ai = 0; ai < 2; ++ai)
#pragma unroll
            for (int m = 0; m < 4; ++m) { const int tok = sinfo[rowb + ai * 128 + m * 16].tok;
                if (tok >= 0) { float* p = out + (size_t)tok * 1024 + colb;
#pragma unroll
                    for (int bj = 0; bj < 2; ++bj)
#pragma unroll
                        for (int n = 0; n < 2; ++n) *(f32x4*)(p + bj * 128 + n * 16) = *(const f32x4*)(p + bj * 128 + n * 16) + acc[ai][bj][m][n]; } }
    }
};
struct MoeOrder {
    const char* A; const char* B; const volatile LAS int* tstart; int nct, up, G, c;
    __device__ bool next(int i, Unit& u) const {
        const int L = i * G + c; const int ntile = __builtin_amdgcn_readfirstlane(tstart[NCLS]);
        const int rt = L / nct, ct = L % nct; if (rt >= ntile) return false;
        int cls = 0;
        for (int k = 1; k < NCLS; ++k) cls += (rt >= __builtin_amdgcn_readfirstlane(tstart[k])) ? 1 : 0;
        const int g = cls / 6, p = cls % 6, pa = p < 3 ? 0 : (p < 5 ? 1 : 2), pb = p == 0 ? 1 : (p == 1 ? 2 : (p == 2 ? 3 : (p == 3 ? 2 : 3)));
        u.a = A + (size_t)rt * 256 * 1024 * 2; u.row0 = rt * 256; u.tag = ct;
        if (up) { const int e = 4 * g + (ct < 4 ? pa : pb); u.b = B + ((size_t)e * 1024 + (ct & 3) * 256) * 1024 * 2; u.col0 = ct * 128; }
        else { u.b = B + ((size_t)cls * 1024 + ct * 256) * 1024 * 2; u.col0 = ct * 256; }
        return true;
    }
    __device__ __forceinline__ void a_ready(const Unit&) const {}
    __device__ __forceinline__ void done(const Unit&) const {}
};

__device__ __forceinline__ void sb_naive(const bf16* Q, const bf16* Kb, const bf16* Vb, bf16* O, LAS unsigned char* lds, int vcu, int G, int tid) {
    LAS v4u* kt4 = (LAS v4u*)lds; LAS v4u* vt4 = (LAS v4u*)(lds + 8192);
    for (int unit = vcu; unit < NB * 8 * 4; unit += G) {
        const int bh = unit >> 2, qb = unit & 3, b = bh >> 3, h = bh & 7;
        const int t = qb * 512 + tid;
        const size_t rbase = (size_t)b * SEQ;
        float q[64], acc[64];
        { const v4u* qp = (const v4u*)(Q + (rbase + t) * 512 + h * 64);
#pragma unroll
          for (int c = 0; c < 8; ++c) { const v4u w = qp[c]; q[8*c] = bflo(w.x); q[8*c+1] = bfhi(w.x); q[8*c+2] = bflo(w.y); q[8*c+3] = bfhi(w.y); q[8*c+4] = bflo(w.z); q[8*c+5] = bfhi(w.z); q[8*c+6] = bflo(w.w); q[8*c+7] = bfhi(w.w); } }
#pragma unroll
        for (int d = 0; d < 64; ++d) acc[d] = 0.f;
        float R = 0.f;
        for (int kt = qb * 8 + 7; kt >= 0; --kt) {
            __syncthreads();
            { const int key = tid >> 3, c = tid & 7; const size_t g = (rbase + kt * 64 + key) * 512 + h * 64 + c * 8;
              kt4[tid] = *(const v4u*)(Kb + g); vt4[tid] = *(const v4u*)(Vb + g); }
            __syncthreads();
            for (int j = 63; j >= 0; --j) {
                const int s = kt * 64 + j;
                float z = 0.f;
#pragma unroll
                for (int c = 0; c < 8; ++c) { const v4u w = kt4[j * 8 + c];
                    z += q[8*c] * bflo(w.x) + q[8*c+1] * bfhi(w.x) + q[8*c+2] * bflo(w.y) + q[8*c+3] * bfhi(w.y) + q[8*c+4] * bflo(w.z) + q[8*c+5] * bfhi(w.z) + q[8*c+6] * bflo(w.w) + q[8*c+7] * bfhi(w.w); }
                const bool valid = s < t;
                const float sp = fmaxf(z, 0.f) + __logf(1.f + __expf(-fabsf(z)));
                const float w_ = valid ? __expf(z - sp + R) : 0.f;
                R += valid ? -sp : 0.f;
#pragma unroll
                for (int c = 0; c < 8; ++c) { const v4u w = vt4[j * 8 + c];
                    acc[8*c] += w_ * bflo(w.x); acc[8*c+1] += w_ * bfhi(w.x); acc[8*c+2] += w_ * bflo(w.y); acc[8*c+3] += w_ * bfhi(w.y); acc[8*c+4] += w_ * bflo(w.z); acc[8*c+5] += w_ * bfhi(w.z); acc[8*c+6] += w_ * bflo(w.w); acc[8*c+7] += w_ * bfhi(w.w); }
            }
        }
        { v4u* op = (v4u*)(O + (rbase + t) * 512 + h * 64);
#pragma unroll
          for (int c = 0; c < 8; ++c) { v4u w; w.x = pk2(acc[8*c], acc[8*c+1]); w.y = pk2(acc[8*c+2], acc[8*c+3]); w.z = pk2(acc[8*c+4], acc[8*c+5]); w.w = pk2(acc[8*c+6], acc[8*c+7]); op[c] = w; } }
    }
}
__device__ __forceinline__ void ret_naive(const bf16* Q, const bf16* Kb, const bf16* Vb, const bf16* RG, const float* gn, bf16* Y, LAS unsigned char* lds, int vcu, int G, int tid) {
    LAS v4u* kt4 = (LAS v4u*)lds; LAS v4u* vt4 = (LAS v4u*)(lds + 8192);
    for (int unit = vcu; unit < NB * 8 * 8; unit += G) {
        const int bh = unit >> 3, qb = unit & 7, b = bh >> 3, h = bh & 7;
        const int n = qb * 256 + (tid >> 1), half = tid & 1;
        const size_t rbase = (size_t)b * SEQ;
        const float lg2 = log2f(1.f - exp2f(-5.f - (float)h));
        float q[64], acc[64];
        { const v4u* qp = (const v4u*)(Q + (rbase + n) * 512 + h * 64);
#pragma unroll
          for (int c = 0; c < 8; ++c) { const v4u w = qp[c]; q[8*c] = bflo(w.x); q[8*c+1] = bfhi(w.x); q[8*c+2] = bflo(w.y); q[8*c+3] = bfhi(w.y); q[8*c+4] = bflo(w.z); q[8*c+5] = bfhi(w.z); q[8*c+6] = bflo(w.w); q[8*c+7] = bfhi(w.w); } }
#pragma unroll
        for (int d = 0; d < 64; ++d) acc[d] = 0.f;
        for (int kt = 0; kt <= qb * 4 + 3; ++kt) {
            __syncthreads();
            { const int key = tid >> 3, c = tid & 7; kt4[tid] = *(const v4u*)(Kb + (rbase + kt * 64 + key) * 512 + h * 64 + c * 8); }
            { const int key = tid >> 4, c = tid & 15; const bf16* vp = Vb + (rbase + kt * 64 + key) * 1024 + h * 128 + c * 8; vt4[tid] = *(const v4u*)vp; vt4[tid + 512] = *(const v4u*)(vp + 32 * 1024); }
            __syncthreads();
            for (int j = 0; j < 64; ++j) {
                const int m = kt * 64 + j;
                float z = 0.f;
#pragma unroll
                for (int c = 0; c < 8; ++c) { const v4u w = kt4[j * 8 + c];
                    z += q[8*c] * bflo(w.x) + q[8*c+1] * bfhi(w.x) + q[8*c+2] * bflo(w.y) + q[8*c+3] * bfhi(w.y) + q[8*c+4] * bflo(w.z) + q[8*c+5] * bfhi(w.z) + q[8*c+6] * bflo(w.w) + q[8*c+7] * bfhi(w.w); }
                const bool valid = (m >> 6) <= (n >> 6);
                const float s_ = valid ? z * exp2f(lg2 * fabsf((float)(n - m))) : 0.f;
#pragma unroll
                for (int c = 0; c < 8; ++c) { const v4u w = vt4[j * 16 + half * 8 + c];
                    acc[8*c] += s_ * bflo(w.x); acc[8*c+1] += s_ * bfhi(w.x); acc[8*c+2] += s_ * bflo(w.y); acc[8*c+3] += s_ * bfhi(w.y); acc[8*c+4] += s_ * bflo(w.z); acc[8*c+5] += s_ * bfhi(w.z); acc[8*c+6] += s_ * bflo(w.w); acc[8*c+7] += s_ * bfhi(w.w); }
            }
        }
        float ss = 0.f;
#pragma unroll
        for (int d = 0; d < 64; ++d) ss += acc[d] * acc[d];
        ss += __shfl_xor(ss, 1);
        const float rstd = 1.f / sqrtf(ss * (1.f / 128.f) + EPS);
        const size_t o = (rbase + n) * 1024 + h * 128 + half * 64;
#pragma unroll
        for (int c = 0; c < 8; ++c) { const v4u rg = *(const v4u*)(RG + o + 8 * c); const f32x4 g0 = *(const f32x4*)(gn + h * 128 + half * 64 + 8 * c), g1 = *(const f32x4*)(gn + h * 128 + half * 64 + 8 * c + 4);
            v4u w; w.x = pk2(acc[8*c] * rstd * g0[0] * bflo(rg.x), acc[8*c+1] * rstd * g0[1] * bfhi(rg.x)); w.y = pk2(acc[8*c+2] * rstd * g0[2] * bflo(rg.y), acc[8*c+3] * rstd * g0[3] * bfhi(rg.y));
            w.z = pk2(acc[8*c+4] * rstd * g1[0] * bflo(rg.z), acc[8*c+5] * rstd * g1[1] * bfhi(rg.z)); w.w = pk2(acc[8*c+6] * rstd * g1[2] * bflo(rg.w), acc[8*c+7] * rstd * g1[3] * bfhi(rg.w));
            *(v4u*)(Y + o + 8 * c) = w; }
    }
}

__device__ __forceinline__ void p_route(const Args& a, LAS unsigned char* lds, int vcu, int G, int wave, int lane, int tid) {
    const float* h = a.out; const float* gf = a.in[9]; const float* wg = a.in[10]; const float* bg = a.in[11]; const float* we = a.in[12]; const float* be = a.in[13];
    LAS float* lw = (LAS float*)lds;
    for (int i = tid; i < 1024 * 20; i += NTHR) { const int k = i / 20, o = i % 20; lw[i] = o < 4 ? wg[k * 4 + o] : we[k * 16 + o - 4]; }
    __syncthreads();
    const int gw = vcu * NWAVES + wave, NGW = G * NWAVES;
    TokInfo* tinfo = (TokInfo*)(a.ws + WS_TOK); float* rstd_o = (float*)(a.ws + WS_RSTD);
    unsigned* cnt = (unsigned*)(a.ws + WS_CTL) + CW_CNT;
    f32x4 gv[4];
#pragma unroll
    for (int j = 0; j < 4; ++j) gv[j] = ((const f32x4*)gf)[lane + 64 * j];
    for (int base = gw; base < T; base += NGW * 16) {
        int my_cls = -1; float my_ga = 0.f, my_gb = 0.f, my_rstd = 0.f;
        for (int j = 0; j < 16; ++j) {
            const int t = base + NGW * j; if (t >= T) break;
            const GAS f32x4* xr = (const GAS f32x4*)(h + (size_t)t * DM) + lane;
            f32x4 v[4]; float s = 0.f;
#pragma unroll
            for (int jj = 0; jj < 4; ++jj) { v[jj] = xr[64 * jj]; s += (v[jj].x * v[jj].x + v[jj].y * v[jj].y) + (v[jj].z * v[jj].z + v[jj].w * v[jj].w); }
            const float rstd = 1.f / sqrtf(wave_sum(s) * (1.f / DM) + EPS);
            float part[20];
#pragma unroll
            for (int o = 0; o < 20; ++o) part[o] = 0.f;
#pragma unroll
            for (int jj = 0; jj < 4; ++jj) { const f32x4 y = v[jj] * rstd * gv[jj];
#pragma unroll
                for (int e = 0; e < 4; ++e) { const LAS f32x4* wp = (const LAS f32x4*)(lw + (256 * jj + 4 * lane + e) * 20);
#pragma unroll
                    for (int o4 = 0; o4 < 5; ++o4) { const f32x4 w = wp[o4]; part[4*o4] += y[e] * w[0]; part[4*o4+1] += y[e] * w[1]; part[4*o4+2] += y[e] * w[2]; part[4*o4+3] += y[e] * w[3]; } } }
#pragma unroll
            for (int o = 0; o < 20; ++o) part[o] = wave_sum(part[o]);
            float gl[4];
#pragma unroll
            for (int o = 0; o < 4; ++o) gl[o] = part[o] + bg[o];
            int gi = 0; float gm = gl[0];
#pragma unroll
            for (int o = 1; o < 4; ++o) if (gl[o] > gm) { gm = gl[o]; gi = o; }
            float gs = 0.f;
#pragma unroll
            for (int o = 0; o < 4; ++o) gs += __expf(gl[o] - gm);
            const float pgrp = 1.f / gs;
            float el[4];
#pragma unroll
            for (int e = 0; e < 4; ++e) { const float l0 = part[4 + e] + be[e], l1 = part[8 + e] + be[4 + e], l2 = part[12 + e] + be[8 + e], l3 = part[16 + e] + be[12 + e];
                el[e] = gi == 0 ? l0 : (gi == 1 ? l1 : (gi == 2 ? l2 : l3)); }
            int i1 = 0; float m1 = el[0];
#pragma unroll
            for (int e = 1; e < 4; ++e) if (el[e] > m1) { m1 = el[e]; i1 = e; }
            int i2 = -1; float m2 = -3.0e38f;
#pragma unroll
            for (int e = 0; e < 4; ++e) if (e != i1 && el[e] > m2) { m2 = el[e]; i2 = e; }
            const float s1 = 1.f / (1.f + __expf(m2 - m1)), g1 = s1 * pgrp, g2 = (1.f - s1) * pgrp;
            const int pa = i1 < i2 ? i1 : i2, pb = i1 < i2 ? i2 : i1;
            const float ga = i1 < i2 ? g1 : g2, gb = i1 < i2 ? g2 : g1;
            const int pidx = pa == 0 ? pb - 1 : (pa == 1 ? pb + 1 : 5);
            if (lane == j) { my_cls = gi * 6 + pidx; my_ga = ga; my_gb = gb; my_rstd = rstd; }
        }
        int my_pos = 0;
        for (int c = 0; c < NCLS; ++c) {
            const unsigned long long mask = __ballot(my_cls == c);
            if (mask) { const int nn = __popcll(mask), leader = __ffsll((long long)mask) - 1; unsigned bse = 0;
                if (lane == leader) bse = __hip_atomic_fetch_add(cnt + 64 * c, (unsigned)nn, __ATOMIC_RELAXED, __HIP_MEMORY_SCOPE_AGENT);
                bse = __shfl(bse, leader);
                if (my_cls == c) my_pos = (int)bse + __popcll(mask & ((1ull << lane) - 1ull)); }
        }
        if (my_cls >= 0) { const int t = base + NGW * lane; tinfo[t] = TokInfo{my_cls, my_pos, my_ga, my_gb}; rstd_o[t] = my_rstd; }
    }
}
__device__ __forceinline__ void build_class_table(const Args& a, volatile LAS int* tab, int tid) {
    if (tid == 0) { const unsigned* cnt = (const unsigned*)(a.ws + WS_CTL) + CW_CNT; int acc_ = 0;
        for (int c = 0; c < NCLS; ++c) { tab[c] = acc_; const int n = (int)__hip_atomic_load(cnt + 64 * c, __ATOMIC_RELAXED, __HIP_MEMORY_SCOPE_AGENT); tab[32 + c] = n; acc_ += (n + 255) >> 8; }
        tab[NCLS] = acc_; }
    __syncthreads();
}
__device__ __forceinline__ void p_scatter(const Args& a, volatile LAS int* tab, int vcu, int G, int wave, int lane, int tid) {
    const float* h = a.out; const float* gf = a.in[9];
    const TokInfo* tinfo = (const TokInfo*)(a.ws + WS_TOK); const float* rstd_i = (const float*)(a.ws + WS_RSTD);
    SInfo* sinfo = (SInfo*)(a.ws + WS_SINFO); bf16* hns = (bf16*)(a.ws + WS_HNS);
    const int gw = vcu * NWAVES + wave, NGW = G * NWAVES;
    f32x4 gv[4];
#pragma unroll
    for (int j = 0; j < 4; ++j) gv[j] = ((const f32x4*)gf)[lane + 64 * j];
    for (int t = gw; t < T; t += NGW) {
        const TokInfo ti = tinfo[t]; const float rstd = rstd_i[t];
        const int srow = tab[ti.cls] * 256 + ti.pos;
        const GAS f32x4* xr = (const GAS f32x4*)(h + (size_t)t * DM) + lane;
        GAS unsigned long long* o8 = (GAS unsigned long long*)(hns + (size_t)srow * DM) + lane;
#pragma unroll
        for (int j = 0; j < 4; ++j) { const f32x4 y = xr[64 * j] * rstd * gv[j]; o8[64 * j] = (unsigned long long)pk2(y.x, y.y) | ((unsigned long long)pk2(y.z, y.w) << 32); }
        if (lane == 0) sinfo[srow] = SInfo{t, ti.ga, ti.gb, 0};
    }
    for (int idx = (vcu * NTHR + tid); idx < NCLS * 256; idx += G * NTHR) { const int c = idx >> 8, r = tab[32 + c] + (idx & 255);
        if (r < (((tab[32 + c] + 255) >> 8) << 8)) sinfo[tab[c] * 256 + r] = SInfo{-1, 0.f, 0.f, 0}; }
}
__device__ __forceinline__ void p_final(const Args& a, int vcu, int G, int wave, int lane) {
    float* h = a.out; const float* gf = a.in[17];
    const int gw = vcu * NWAVES + wave, NGW = G * NWAVES;
    f32x4 gv[4];
#pragma unroll
    for (int j = 0; j < 4; ++j) gv[j] = ((const f32x4*)gf)[lane + 64 * j];
    for (int t = gw; t < T; t += NGW) {
        GAS f32x4* xr = (GAS f32x4*)(h + (size_t)t * DM) + lane;
        f32x4 v[4]; float s = 0.f;
#pragma unroll
        for (int j = 0; j < 4; ++j) { v[j] = xr[64 * j]; s += (v[j].x * v[j].x + v[j].y * v[j].y) + (v[j].z * v[j].z + v[j].w * v[j].w); }
        const float rstd = 1.f / sqrtf(wave_sum(s) * (1.f / DM) + EPS);
#pragma unroll
        for (int j = 0; j < 4; ++j) xr[64 * j] = v[j] * rstd * gv[j];
    }
}

#ifndef MK_ONE_LAUNCH
#define MK_ONE_LAUNCH 0
#endif
constexpr int NPHASE = 11;
__global__ void __launch_bounds__(NTHR, 2) fwd_kernel(Args args) {
    extern __shared__ __attribute__((aligned(16))) unsigned char lds_raw[];
    LAS unsigned char* lds = (LAS unsigned char*)lds_raw;
    volatile LAS unsigned* MISC = (volatile LAS unsigned*)(lds + MISC_OFF);
    volatile LAS int* tab = (volatile LAS int*)(lds + TAB_OFF);
    const int tid = threadIdx.x, lane = tid & 63, wave = __builtin_amdgcn_readfirstlane(tid >> 6);
    const int G = gridDim.x; const int bx = blockIdx.x; const int vcu = (G % 8 == 0) ? (bx % 8) * (G / 8) + bx / 8 : bx;
    unsigned char* ws = args.ws;
    for (int u = tid; u < (LDS_BYTES - LDSCTL_OFF) / 4; u += NTHR) ((LAS unsigned*)(lds + LDSCTL_OFF))[u] = 0u;
    __syncthreads();
    XcdBarrier bar; bar.bar = (unsigned*)(ws + WS_CTL) + CW_BAR; bar.x = 0; bar.st = nullptr;
    if (MK_ONE_LAUNCH) bar = xcd_barrier_post((unsigned*)(ws + WS_CTL) + CW_BAR, MISC + 8);
    const int lo = args.ph_lo, hi = args.ph_hi;
#define IN(k) (lo <= (k) && (k) < hi)
#define SEAM(k) do { if (MK_ONE_LAUNCH && IN(k) && IN((k) + 1)) xcd_barrier(bar); } while (0)
    bf16* W1 = (bf16*)(ws + WS_W1); bf16* XN = (bf16*)(ws + WS_R1); bf16* YRET = (bf16*)(ws + WS_R1); bf16* HIDS = (bf16*)(ws + WS_R1);
    bf16* SBQ = (bf16*)(ws + WS_SBQ); bf16* SBK = (bf16*)(ws + WS_SBK); bf16* SBV = (bf16*)(ws + WS_SBV); bf16* RQ = (bf16*)(ws + WS_RQ); bf16* RK = (bf16*)(ws + WS_RK);
    bf16* RV = (bf16*)(ws + WS_RV); bf16* RG = (bf16*)(ws + WS_RG); bf16* YSB = (bf16*)(ws + WS_YSB); bf16* GATES = (bf16*)args.out;
    bf16* TMP = (bf16*)(ws + WS_TMP); bf16* MIX = (bf16*)(ws + WS_MIX); bf16* HNS = (bf16*)(ws + WS_HNS);
    const SInfo* sinfo = (const SInfo*)(ws + WS_SINFO);

    if (IN(0)) { p0_prologue(args, lds, vcu, G, wave, lane); }
    SEAM(0);
    if (IN(1)) {
        pg8::StaticOrder S; S.init(XN, W1, T, N1, 1024, G, bx);
        Epi1 E{SBQ, SBK, SBV, RQ, RK, RV, RG, GATES, args.in[4], (const float*)(ws + WS_ROT)};
        pg8::gemm_phase<Epi1, pg8::StaticOrder, true, true>(lds, 1024, S, E);
    }
    SEAM(1);
    if (IN(2)) {
        sb_naive(SBQ, SBK, SBV, YSB, lds, vcu, G, tid);
        __syncthreads();
        ret_naive(RQ, RK, RV, RG, args.in[7], YRET, lds, vcu, G, tid);
        __syncthreads();
    }
    SEAM(2);
    if (IN(3)) {
        pg8::StaticOrder S; S.init(YSB, ws + WS_WSB, T, 1024, 512, G, bx);
        EpiMix<false> E{GATES, 0, nullptr, TMP};
        pg8::gemm_phase<EpiMix<false>, pg8::StaticOrder, true, true>(lds, 512, S, E);
    }
    SEAM(3);
    if (IN(4)) {
        pg8::StaticOrder S; S.init(YRET, ws + WS_WRET, T, 1024, 1024, G, bx);
        EpiMix<true> E{GATES, 1024, TMP, MIX};
        pg8::gemm_phase<EpiMix<true>, pg8::StaticOrder, true, true>(lds, 1024, S, E);
    }
    SEAM(4);
    if (IN(5)) {
        pg8::StaticOrder S; S.init(MIX, ws + WS_WOUT, T, 1024, 1024, G, bx);
        EpiOut E{args.in[0], args.out};
        pg8::gemm_phase<EpiOut, pg8::StaticOrder, true, true>(lds, 1024, S, E);
    }
    SEAM(5);
    if (IN(6)) { p_route(args, lds, vcu, G, wave, lane, tid); __syncthreads(); }
    SEAM(6);
    if (IN(7)) { build_class_table(args, tab, tid); p_scatter(args, tab, vcu, G, wave, lane, tid); }
    SEAM(7);
    if (IN(8)) {
        build_class_table(args, tab, tid);
        MoeOrder S{(const char*)HNS, (const char*)(ws + WS_WUP), tab, 8, 1, G, bx};
        EpiUp E{sinfo, HIDS};
        pg8::gemm_phase<EpiUp, MoeOrder, true, true>(lds, 1024, S, E);
    }
    SEAM(8);
    if (IN(9)) {
        build_class_table(args, tab, tid);
        MoeOrder S{(const char*)HIDS, (const char*)(ws + WS_WDN), tab, 4, 0, G, bx};
        EpiDown E{sinfo, args.out};
        pg8::gemm_phase<EpiDown, MoeOrder, true, true>(lds, 1024, S, E);
    }
    SEAM(9);
    if (IN(10)) { p_final(args, vcu, G, wave, lane); }
#undef IN
#undef SEAM
}

extern "C" void kernel_launch(void* const* d_in, const int* in_sizes, int n_in, void* d_out, int out_size, void* d_ws, size_t ws_size, hipStream_t stream) {
    static int grid = 0;
    if (grid == 0) {
        if (n_in != 18 || in_sizes[0] != T * DM || out_size != T * DM || ws_size < WS_END) { fprintf(stderr, "kernel_launch: unexpected shapes (n_in %d, in0 %d, out %d, ws %zu < %zu)\n", n_in, n_in > 0 ? in_sizes[0] : -1, out_size, ws_size, (size_t)WS_END); grid = -1; return; }
        int dev = 0, cus = 0, per_cu = 0;
        if (hipGetDevice(&dev) != hipSuccess || hipDeviceGetAttribute(&cus, hipDeviceAttributeMultiprocessorCount, dev) != hipSuccess) { grid = -1; return; }
        if (hipFuncSetAttribute((const void*)fwd_kernel, hipFuncAttributeMaxDynamicSharedMemorySize, LDS_BYTES) != hipSuccess) { fprintf(stderr, "kernel_launch: hipFuncSetAttribute failed\n"); grid = -1; return; }
        if (hipOccupancyMaxActiveBlocksPerMultiprocessor(&per_cu, (const void*)fwd_kernel, NTHR, LDS_BYTES) != hipSuccess || per_cu < 1) fprintf(stderr, "kernel_launch: occupancy query reports %d\n", per_cu);
        (void)hipGetLastError();
        grid = cus;
    }
    if (grid < 0) return;
    hipMemsetAsync((char*)d_ws + WS_CTL, 0, CTL_ZERO_BYTES, stream);
    Args a{};
    for (int i = 0; i < 18; ++i) a.in[i] = (const float*)d_in[i];
    a.out = (float*)d_out; a.ws = (unsigned char*)d_ws;
#if MK_ONE_LAUNCH
    a.ph_lo = 0; a.ph_hi = NPHASE;
    hipLaunchKernelGGL(fwd_kernel, dim3(grid), dim3(NTHR), LDS_BYTES, stream, a);
#else
    for (int p = 0; p < NPHASE; ++p) { a.ph_lo = p; a.ph_hi = p + 1; hipLaunchKernelGGL(fwd_kernel, dim3(grid), dim3(NTHR), LDS_BYTES, stream, a); }
#endif
}
```

```cpp
#include <hip/hip_runtime.h>
#include <cstdio>
#include <cstdint>
namespace pg8 {
#define PG8_LAS __attribute__((address_space(3)))
typedef unsigned short bf16_t;
typedef short bf16x8 __attribute__((ext_vector_type(8)));
typedef float f32x4 __attribute__((ext_vector_type(4)));
typedef unsigned u32x4 __attribute__((ext_vector_type(4)));
constexpr int BM = 256, BK = 64, HALF = 128, HTB = HALF * BK * 2  , STAGE_BYTES = 8 * HTB, NXCD = 8, WGM = 8;
__host__ __device__ __forceinline__ int lds_byte(int r, int c) { const int st = (r >> 4) * 2 + (c >> 5), rr = r & 15, cc = c & 31, ob = rr * 64 + cc * 2; return st * 1024 + (ob ^ (((ob >> 9) & 1) << 5)); }
__host__ __device__ __forceinline__ void stage_rc(int b, int& R, int& C) { const int st = b / 1024, sb = b % 1024, swz = sb ^ (((sb >> 9) & 1) << 5); R = (st >> 1) * 16 + swz / 64; C = (st & 1) * 32 + (swz % 64) / 2; }
__host__ __device__ __forceinline__ int perm32(int rho) { const int n = rho >> 4, i = rho & 15; return 8 * (i >> 2) + 4 * n + (i & 3); }

struct Unit { const char* a; const char* b; int row0, col0, tag; };
struct StaticOrder {
    const char* A; const char* Bt; int K, nM, nN, nwg, G, c;
    __device__ void init(const void* A_, const void* Bt_, int M, int N, int K_, int G_, int c_) { A = (const char*)A_; Bt = (const char*)Bt_; K = K_; nM = M / BM; nN = N / BM; nwg = nM * nN; G = G_; c = c_; }
    __device__ bool next(int i, Unit& u) const {
        const long L = (long)i * G + c; if (L >= nwg) return false;
        int wgid = (int)L; { const int q = nwg / NXCD, r = nwg % NXCD, xcd = wgid % NXCD, off = wgid / NXCD; wgid = (xcd < r ? xcd * (q + 1) : r * (q + 1) + (xcd - r) * q) + off; }
        const int nig = WGM * nN, gid = wgid / nig, fm = gid * WGM, gsz = (nM - fm) < WGM ? (nM - fm) : WGM;
        const int pm = fm + ((wgid % nig) % gsz), pn = (wgid % nig) / gsz;
        u.a = A + (size_t)pm * BM * K * 2; u.b = Bt + (size_t)pn * BM * K * 2; u.row0 = pm * BM; u.col0 = pn * BM; u.tag = pn; return true;
    }
    __device__ __forceinline__ void a_ready(const Unit&) const {}
    __device__ __forceinline__ void done(const Unit&) const {}
};
__device__ __forceinline__ unsigned cvt_pk_bf16(float lo, float hi) { unsigned r; asm volatile("v_cvt_pk_bf16_f32 %0, %1, %2" : "=v"(r) : "v"(lo), "v"(hi)); return r; }
template <class Epi, class Sched, bool ALIGN_EPI = false, bool SP2 = false>
__device__ __forceinline__ void gemm_phase(PG8_LAS unsigned char* lds, const int K, const Sched& S, const Epi& E) {
    const int tid = threadIdx.x, wid = __builtin_amdgcn_readfirstlane(tid >> 6), lane = tid & 63, wr = wid >> 2, wc = wid & 3, fr = lane & 15, fq = lane >> 4;
    const int nt = K / BK;
    unsigned voffA[2], voffB[2];
#pragma unroll
    for (int i = 0; i < 2; ++i) { int R, C; stage_rc(tid * 16 + i * 8192, R, C); const int Rb = Epi::PERM ? ((R & ~31) + perm32(R & 31)) : R;
        voffA[i] = (unsigned)(R * K + C) * 2u; voffB[i] = (unsigned)(Rb * K + C) * 2u; }
    const size_t kstep = (size_t)(BK * 2);
    const size_t hstep = (size_t)HALF * K * 2;
    const size_t tstep = 2 * hstep;
    const unsigned ldsw = (unsigned)wid * 1024u;
    const int aoff = lds_byte(wr * 64 + fr, fq * 8), boff = lds_byte(wc * 32 + fr, fq * 8);
#define PG8_SA(b, h) (((b) * 2 + (h)) * HTB)
#define PG8_SB(b, h) ((4 + (b) * 2 + (h)) * HTB)
#define PG8_STAGE(bufoff, gbase, voff) do { _Pragma("unroll") for (int _i = 0; _i < 2; ++_i) \
        __builtin_amdgcn_global_load_lds((const unsigned*)((const char*)(gbase) + (voff)[_i]), (PG8_LAS unsigned*)(lds + (bufoff) + ldsw + _i * 8192), 16, 0, 0); } while (0)
#define PG8_LDA(dst, b, h) do { _Pragma("unroll") for (int m = 0; m < 4; ++m) _Pragma("unroll") for (int k = 0; k < 2; ++k) dst[m][k] = *(const PG8_LAS bf16x8*)(lds + PG8_SA(b, h) + aoff + m * 2048 + k * 1024); } while (0)
#define PG8_LDB(dst, b, h) do { _Pragma("unroll") for (int n = 0; n < 2; ++n) _Pragma("unroll") for (int k = 0; k < 2; ++k) dst[n][k] = *(const PG8_LAS bf16x8*)(lds + PG8_SB(b, h) + boff + n * 2048 + k * 1024); } while (0)
#define PG8_MMA(ai, bj, At, Bt) do { __builtin_amdgcn_s_setprio(1); _Pragma("unroll") for (int m = 0; m < 4; ++m) _Pragma("unroll") for (int n = 0; n < 2; ++n) _Pragma("unroll") for (int k = 0; k < 2; ++k) \
        acc[ai][bj][m][n] = __builtin_amdgcn_mfma_f32_16x16x32_bf16(Bt[n][k], At[m][k], acc[ai][bj][m][n], 0, 0, 0); __builtin_amdgcn_s_setprio(0); } while (0)
#define PG8_WAIT_V(n) asm volatile("s_waitcnt vmcnt(" #n ")" ::: "memory")
#define PG8_WAIT_L(n) asm volatile("s_waitcnt lgkmcnt(" #n ")" ::: "memory")
#define PG8_BAR __builtin_amdgcn_s_barrier()
#define PG8_SCHED __builtin_amdgcn_sched_barrier(0)
    Unit cur, nxt; int ui = 0;
    if (!S.next(0, cur)) return;
    f32x4 acc[2][2][4][2];
#pragma unroll
    for (int a = 0; a < 2; ++a)
#pragma unroll
        for (int b = 0; b < 2; ++b)
#pragma unroll
            for (int m = 0; m < 4; ++m)
#pragma unroll
                for (int n = 0; n < 2; ++n) acc[a][b][m][n] = (f32x4){0.f, 0.f, 0.f, 0.f};
    bf16x8 At[4][2], B0[2][2], B1[2][2];
    const char* cA = cur.a; const char* cB = cur.b;
    S.a_ready(cur);
    if constexpr (SP2) {
        PG8_STAGE(PG8_SB(0, 0), cB, voffB); PG8_STAGE(PG8_SB(0, 1), cB + hstep, voffB); PG8_STAGE(PG8_SA(0, 0), cA, voffA); PG8_STAGE(PG8_SA(0, 1), cA + hstep, voffA);
        if (wr == 1) PG8_BAR;
        PG8_WAIT_V(2); PG8_BAR;
        PG8_STAGE(PG8_SB(1, 0), cB + kstep, voffB); PG8_STAGE(PG8_SA(1, 0), cA + kstep, voffA); PG8_STAGE(PG8_SB(1, 1), cB + hstep + kstep, voffB);
        PG8_WAIT_V(6); PG8_BAR;
    } else {
        PG8_STAGE(PG8_SB(0, 0), cB, voffB); PG8_STAGE(PG8_SA(0, 0), cA, voffA); PG8_STAGE(PG8_SB(0, 1), cB + hstep, voffB); PG8_STAGE(PG8_SA(0, 1), cA + hstep, voffA);
        if (wr == 1) PG8_BAR;
        PG8_WAIT_V(4); PG8_BAR;
        PG8_STAGE(PG8_SB(1, 0), cB + kstep, voffB); PG8_STAGE(PG8_SA(1, 0), cA + kstep, voffA); PG8_STAGE(PG8_SB(1, 1), cB + hstep + kstep, voffB);
        PG8_WAIT_V(6); PG8_BAR;
    }
    for (;;) {
        const bool has_next = S.next(ui + 1, nxt);
        const char* nA = has_next ? nxt.a : cA; const char* nB = has_next ? nxt.b : cB;
        for (int t = 0; t < nt; t += 2) {
            const bool last = (t == nt - 2);
            const char* a1 = cA + (size_t)(t + 1) * kstep;
            const char* a2 = last ? nA : cA + (size_t)(t + 2) * kstep; const char* b2 = last ? nB : cB + (size_t)(t + 2) * kstep;
            const char* a3 = a2 + kstep; const char* b3 = b2 + kstep;
            if (last && has_next) S.a_ready(nxt);
            if constexpr (SP2) {
            PG8_LDB(B0, 0, 0); PG8_LDB(B1, 0, 1); PG8_SCHED; PG8_LDA(At, 0, 0); PG8_STAGE(PG8_SA(1, 1), a1 + hstep, voffA);
            PG8_WAIT_V(8); PG8_WAIT_L(0); PG8_BAR; PG8_MMA(0, 0, At, B0); PG8_MMA(0, 1, At, B1); PG8_BAR; PG8_SCHED;
            PG8_LDA(At, 0, 1); PG8_STAGE(PG8_SB(0, 0), b2, voffB); PG8_STAGE(PG8_SB(0, 1), b2 + hstep, voffB); PG8_STAGE(PG8_SA(0, 0), a2, voffA);
            PG8_WAIT_V(8); PG8_WAIT_L(0); PG8_BAR; PG8_MMA(1, 0, At, B0); PG8_MMA(1, 1, At, B1); PG8_BAR; PG8_SCHED;
            PG8_LDB(B0, 1, 0); PG8_LDB(B1, 1, 1); PG8_SCHED; PG8_LDA(At, 1, 0); PG8_STAGE(PG8_SA(0, 1), a2 + hstep, voffA);
            PG8_WAIT_V(8); PG8_WAIT_L(0); PG8_BAR; PG8_MMA(0, 0, At, B0); PG8_MMA(0, 1, At, B1); PG8_BAR; PG8_SCHED;
            PG8_LDA(At, 1, 1); PG8_STAGE(PG8_SB(1, 0), b3, voffB); PG8_STAGE(PG8_SB(1, 1), b3 + hstep, voffB); PG8_STAGE(PG8_SA(1, 0), a3, voffA);
            PG8_WAIT_V(8); PG8_WAIT_L(0); PG8_BAR; PG8_MMA(1, 0, At, B0); PG8_MMA(1, 1, At, B1); PG8_BAR; PG8_SCHED;
            } else {
            PG8_LDB(B0, 0, 0); PG8_SCHED; PG8_LDA(At, 0, 0); PG8_STAGE(PG8_SA(1, 1), a1 + hstep, voffA);
            PG8_WAIT_L(8); PG8_BAR; PG8_WAIT_L(0); PG8_MMA(0, 0, At, B0); PG8_BAR; PG8_SCHED;
            PG8_LDB(B1, 0, 1); PG8_STAGE(PG8_SB(0, 0), b2, voffB);
            PG8_BAR; PG8_WAIT_L(0); PG8_MMA(0, 1, At, B1); PG8_BAR;
            PG8_LDA(At, 0, 1); PG8_STAGE(PG8_SA(0, 0), a2, voffA);
            PG8_BAR; PG8_WAIT_L(0); PG8_MMA(1, 0, At, B0); PG8_BAR; PG8_SCHED;
            PG8_STAGE(PG8_SB(0, 1), b2 + hstep, voffB);
            PG8_WAIT_V(6); PG8_BAR; PG8_MMA(1, 1, At, B1); PG8_BAR;
            PG8_LDB(B0, 1, 0); PG8_SCHED; PG8_LDA(At, 1, 0); PG8_STAGE(PG8_SA(0, 1), a2 + hstep, voffA);
            PG8_WAIT_L(8); PG8_BAR; PG8_WAIT_L(0); PG8_MMA(0, 0, At, B0); PG8_BAR; PG8_SCHED;
            PG8_LDB(B1, 1, 1); PG8_STAGE(PG8_SB(1, 0), b3, voffB);
            PG8_BAR; PG8_WAIT_L(0); PG8_MMA(0, 1, At, B1); PG8_BAR;
            PG8_LDA(At, 1, 1); PG8_STAGE(PG8_SA(1, 0), a3, voffA);
            PG8_BAR; PG8_WAIT_L(0); PG8_MMA(1, 0, At, B0); PG8_BAR; PG8_SCHED;
            PG8_STAGE(PG8_SB(1, 1), b3 + hstep, voffB);
            PG8_WAIT_V(6); PG8_BAR; PG8_MMA(1, 1, At, B1); PG8_BAR;
            }
        }
        if constexpr (ALIGN_EPI) { if (wr == 0) PG8_BAR; }
        if constexpr (!Epi::AFTER_DRAIN) { E(acc, cur, wr, wc, fr, fq); S.done(cur); }
        if (!has_next) break;
#pragma unroll
        for (int a = 0; a < 2; ++a)
#pragma unroll
            for (int b = 0; b < 2; ++b)
#pragma unroll
                for (int m = 0; m < 4; ++m)
#pragma unroll
                    for (int n = 0; n < 2; ++n) acc[a][b][m][n] = (f32x4){0.f, 0.f, 0.f, 0.f};
        cur = nxt; cA = nA; cB = nB; ++ui;
        if constexpr (ALIGN_EPI) { if (wr == 1) PG8_BAR; }
    }
    PG8_WAIT_V(0);
    if constexpr (!ALIGN_EPI) { if (wr == 0) PG8_BAR; }
    PG8_BAR;
    if constexpr (Epi::AFTER_DRAIN) { E.fused(acc, cur, wr, wc, fr, fq, lds, wid, lane); S.done(cur); }
#undef PG8_SA
#undef PG8_SB
#undef PG8_STAGE
#undef PG8_LDA
#undef PG8_LDB
#undef PG8_MMA
#undef PG8_WAIT_V
#undef PG8_WAIT_L
#undef PG8_BAR
#undef PG8_SCHED
}
}
#define GAS __attribute__((address_space(1)))
#define LAS __attribute__((address_space(3)))
typedef unsigned short bf16;
typedef unsigned v4u __attribute__((ext_vector_type(4)));
typedef float f32x4 __attribute__((ext_vector_type(4)));
typedef short bf16x8 __attribute__((ext_vector_type(8)));
typedef GAS unsigned gu32;
typedef GAS unsigned long long gu64;
#define RLX_AGENT __ATOMIC_RELAXED, __HIP_MEMORY_SCOPE_AGENT
#define LDS_WAIT() asm volatile("s_waitcnt lgkmcnt(0)" ::: "memory")
#define VM_WAIT() asm volatile("s_waitcnt vmcnt(0)" ::: "memory")
__device__ __forceinline__ unsigned long long rt() { return __builtin_amdgcn_s_memrealtime(); }
__device__ __forceinline__ unsigned f2bf(float f) { unsigned u = __builtin_bit_cast(unsigned, f); return (u + 0x7fffu + ((u >> 16) & 1u)) >> 16; }
__device__ __forceinline__ unsigned pk2(float lo, float hi) { return f2bf(lo) | (f2bf(hi) << 16); }

#define XB_TMO      128
#define XB_XCNT(j)  (256  + 64 * (j))
#define XB_XSUB(j)  (1280 + 64 * (j))
#define XB_XGEN(j)  (2304 + 64 * (j))
#define XB_TOP      3328
#define XB_TOPGEN   3392
#define XCD_BAR_WORDS 3456
#define XB_SPIN_CAP (1u << 18)

__device__ __forceinline__ unsigned xb_ld(unsigned* p)              { return __hip_atomic_load(p, __ATOMIC_RELAXED, __HIP_MEMORY_SCOPE_AGENT); }
__device__ __forceinline__ unsigned xb_add(unsigned* p, unsigned v) { return __hip_atomic_fetch_add(p, v, __ATOMIC_RELAXED, __HIP_MEMORY_SCOPE_AGENT); }
__device__ __forceinline__ unsigned xb_xcc_id() { return (unsigned)__builtin_amdgcn_s_getreg((3 << 11) | 20) & 0xFu; }
#define XB_SPIN(cond, bar) do { unsigned _sp = 0; while (cond) { __builtin_amdgcn_s_sleep(1); \
    if ((++_sp & 255u) == 0u) { if (xb_ld(&(bar)[XB_TMO])) break; if (_sp > XB_SPIN_CAP) { atomicAdd(&(bar)[XB_TMO], 1u); break; } } } } while (0)

struct XcdBarrier {
    unsigned* bar; unsigned x;
    volatile LAS unsigned* st;
};

__device__ __forceinline__ XcdBarrier xcd_barrier_post(unsigned* bar, volatile LAS unsigned* st) {
    XcdBarrier b; b.bar = bar; b.x = xb_xcc_id(); b.st = st;
    if (threadIdx.x == 0) (void)xb_add(&bar[XB_XCNT(b.x)], 1u);
    return b;
}
__device__ __forceinline__ void xcd_barrier_complete(unsigned* bar, unsigned x, unsigned& nloc, unsigned& nx) {
    const unsigned G = gridDim.x * gridDim.y * gridDim.z;
    unsigned sum, cnt, mine, sp = 0u;
    for (;;) {
        sum = 0u; cnt = 0u; mine = 0u;
#pragma unroll
        for (unsigned j = 0; j < 16; ++j) { const unsigned c = xb_ld(&bar[XB_XCNT(j)]); sum += c; cnt += (c > 0u) ? 1u : 0u; mine = (j == x) ? c : mine; }
        if (sum == G) break;
        __builtin_amdgcn_s_sleep(1);
        if ((++sp & 255u) == 0u) { if (xb_ld(&bar[XB_TMO])) break; if (sp > XB_SPIN_CAP) { atomicAdd(&bar[XB_TMO], 1u); break; } }
    }
    nloc = mine > 0u ? mine : 1u; nx = cnt > 0u ? cnt : 1u;
}

__device__ __forceinline__ void xcd_barrier(const XcdBarrier& b) {
    asm volatile("s_waitcnt vmcnt(0)" ::: "memory");
    __syncthreads();
    if (threadIdx.x == 0) {
        unsigned* bar = b.bar;
        __builtin_amdgcn_s_waitcnt(0);
        unsigned nloc = b.st[0], nx = b.st[1];
        if (nloc == 0u) { xcd_barrier_complete(bar, b.x, nloc, nx); b.st[0] = nloc; b.st[1] = nx; }
        const unsigned old = xb_add(&bar[XB_XSUB(b.x)], 1u);
        const unsigned gen = old / nloc;
        if (old + 1u == (gen + 1u) * nloc) {
            __builtin_amdgcn_fence(__ATOMIC_RELEASE, "agent");
            asm volatile("s_waitcnt vmcnt(0)" ::: "memory");
            const unsigned og = xb_add(&bar[XB_TOP], 1u);
            const unsigned tg = og / nx;
            if (og + 1u == (tg + 1u) * nx) xb_add(&bar[XB_TOPGEN], 1u);
            else XB_SPIN(xb_ld(&bar[XB_TOPGEN]) == tg, bar);
            __builtin_amdgcn_fence(__ATOMIC_ACQUIRE, "agent");
            xb_add(&bar[XB_XGEN(b.x)], 1u);
            asm volatile("s_waitcnt vmcnt(0)" ::: "memory");
        } else {
            XB_SPIN(xb_ld(&bar[XB_XGEN(b.x)]) == gen, bar);
            __builtin_amdgcn_fence(__ATOMIC_ACQUIRE, "agent");
            asm volatile("s_waitcnt vmcnt(0)" ::: "memory");
        }
    }
    __syncthreads();
}


constexpr int NWAVES = 8, NTHR = NWAVES * 64;
constexpr int DM = 1024, NB = 16, SEQ = 2048, T = NB * SEQ;
constexpr int N1 = 6656;
constexpr int NCLS = 24, SROWS = T + NCLS * 256;
constexpr float EPS = 1e-6f;
constexpr size_t MiB = 1u << 20;
constexpr size_t WS_CTL = 0, CTL_ZERO_BYTES = 1 * MiB;
constexpr size_t WS_ROT = 1 * MiB;
constexpr size_t WS_TOK = 2 * MiB;
constexpr size_t WS_RSTD = 2 * MiB + 512 * 1024;
constexpr size_t WS_SINFO = 3 * MiB;
constexpr size_t WS_W1 = 4 * MiB, WS_WSB = 18 * MiB, WS_WRET = 19 * MiB, WS_WOUT = 21 * MiB, WS_WUP = 23 * MiB, WS_WDN = 55 * MiB;
constexpr size_t WS_R1 = 104 * MiB;
constexpr size_t WS_SBQ = 168 * MiB, WS_SBK = 200 * MiB, WS_SBV = 232 * MiB, WS_RQ = 264 * MiB, WS_RK = 296 * MiB, WS_RV = 328 * MiB, WS_RG = 392 * MiB, WS_YSB = 456 * MiB;
constexpr size_t WS_TMP = WS_SBQ, WS_MIX = WS_SBV, WS_HNS = WS_RV;
constexpr size_t WS_END = 488 * MiB;
constexpr int CW_BAR = 4096, CW_CNT = 8192;
constexpr int RING_BYTES = 131072, LDSCTL_OFF = RING_BYTES, MISC_OFF = LDSCTL_OFF + 320, TAB_OFF = LDSCTL_OFF + 1024;
constexpr int LDS_BYTES = 147456;

struct TokInfo { int cls, pos; float ga, gb; };
struct SInfo { int tok; float ga, gb; int pad; };

__device__ __forceinline__ float wave_sum(float v) {
#pragma unroll
    for (int o = 1; o < 64; o <<= 1) v += __shfl_xor(v, o);
    return v;
}
__device__ __forceinline__ float bf2f(unsigned short b) { return __builtin_bit_cast(float, (unsigned)b << 16); }
__device__ __forceinline__ float bflo(unsigned w) { return __builtin_bit_cast(float, w << 16); }
__device__ __forceinline__ float bfhi(unsigned w) { return __builtin_bit_cast(float, w & 0xffff0000u); }

struct Args { const float* in[18]; float* out; unsigned char* ws; int ph_lo, ph_hi; };

struct TJob { const float* W; int N; bf16* WT; int ldk, koff, mode, nbase; };
__device__ __forceinline__ int rowmap(int mode, int n) {
    if (mode == 1) {
        if (n >= 1536 && n < 2560) { const int seg = n < 2048 ? 1536 : 2048, c = n - seg, hh = c >> 6, i = c & 63; return seg + (hh >> 2) * 256 + (i >> 5) * 128 + (hh & 3) * 32 + (i & 31); }
        return n;
    }
    if (mode == 2) return (n >> 7) * 256 + (n & 127);
    if (mode == 3) return (n >> 7) * 256 + 128 + (n & 127);
    return n;
}
__device__ __forceinline__ void p0_transpose_item(const TJob& J, LAS float* scr, int item, int lane) {
    const int nblk = J.N / 32, kb = item / nblk, nb = item % nblk, k0 = 64 * kb, n0 = 32 * nb;
#pragma unroll 8
    for (int i = 0; i < 32; ++i) { const int kk = 2 * i + (lane >> 5); scr[kk * 33 + (lane & 31)] = J.W[(size_t)(k0 + kk) * J.N + n0 + (lane & 31)]; }
    LDS_WAIT(); asm volatile("" ::: "memory");
    const int c = lane & 7;
#pragma unroll
    for (int j = 0; j < 4; ++j) { const int n = (lane >> 3) + 8 * j; const LAS float* s = scr + (8 * c) * 33 + n;
        const int ng = n0 + n; float sc = 1.f; if (J.mode == 1 && (ng < 512 || (ng >= 2048 && ng < 2560))) sc = 0.125f;
        v4u o; o.x = pk2(s[0 * 33] * sc, s[1 * 33] * sc); o.y = pk2(s[2 * 33] * sc, s[3 * 33] * sc); o.z = pk2(s[4 * 33] * sc, s[5 * 33] * sc); o.w = pk2(s[6 * 33] * sc, s[7 * 33] * sc);
        *(GAS v4u*)(J.WT + (size_t)(J.nbase + rowmap(J.mode, ng)) * J.ldk + J.koff + k0 + 8 * c) = o; }
    LDS_WAIT(); asm volatile("" ::: "memory");
}
__device__ __forceinline__ void p0_prologue(const Args& a, LAS unsigned char* lds, int vcu, int G, int wave, int lane) {
    unsigned char* ws = a.ws;
    LAS float* scr = (LAS float*)(lds + wave * 16384);
    const int gw = vcu * NWAVES + wave, NGW = G * NWAVES;
    constexpr int I0 = 16 * 144, I1 = 16 * 64, I2 = 8 * 32, I3 = 16 * 32, I4 = 16 * 32, I5 = 16 * 256, I6 = 16 * 256, I7 = 48 * 256;
    constexpr int NITEMS = I0 + I1 + I2 + I3 + I4 + I5 + I6 + I7;
    for (int it = gw; it < NITEMS; it += NGW) {
        int r = it; TJob J;
        if (r < I0) { J = TJob{a.in[2], 4608, (bf16*)(ws + WS_W1), 1024, 0, 1, 0}; }
        else if ((r -= I0) < I1) { J = TJob{a.in[3], 2048, (bf16*)(ws + WS_W1), 1024, 0, 0, 4608}; }
        else if ((r -= I1) < I2) { J = TJob{a.in[5], 1024, (bf16*)(ws + WS_WSB), 512, 0, 0, 0}; }
        else if ((r -= I2) < I3) { J = TJob{a.in[6], 1024, (bf16*)(ws + WS_WRET), 1024, 0, 0, 0}; }
        else if ((r -= I3) < I4) { J = TJob{a.in[8], 1024, (bf16*)(ws + WS_WOUT), 1024, 0, 0, 0}; }
        else if ((r -= I4) < I5) { const int e = r >> 8; r &= 255; J = TJob{a.in[14] + (size_t)e * 1024 * 512, 512, (bf16*)(ws + WS_WUP) + (size_t)e * 1024 * 1024, 1024, 0, 2, 0}; }
        else if ((r -= I5) < I6) { const int e = r >> 8; r &= 255; J = TJob{a.in[15] + (size_t)e * 1024 * 512, 512, (bf16*)(ws + WS_WUP) + (size_t)e * 1024 * 1024, 1024, 0, 3, 0}; }
        else { r -= I6; const int cs = r >> 8; r &= 255; const int cls = cs >> 1, slot = cs & 1, g = cls / 6, p = cls % 6;
            const int pa = p < 3 ? 0 : (p < 5 ? 1 : 2), pb = p == 0 ? 1 : (p == 1 ? 2 : (p == 2 ? 3 : (p == 3 ? 2 : 3)));
            const int e = 4 * g + (slot ? pb : pa);
            J = TJob{a.in[16] + (size_t)e * 512 * 1024, 1024, (bf16*)(ws + WS_WDN) + (size_t)cls * 1024 * 1024, 1024, slot * 512, 0, 0}; }
        p0_transpose_item(J, scr, r, lane);
    }
    const float* x = a.in[0]; const float* g = a.in[1]; bf16* xn = (bf16*)(ws + WS_R1);
    f32x4 gv[4];
#pragma unroll
    for (int j = 0; j < 4; ++j) gv[j] = ((const f32x4*)g)[lane + 64 * j];
    for (int m = gw; m < T; m += NGW) {
        const GAS f32x4* xr = (const GAS f32x4*)(x + (size_t)m * DM) + lane;
        f32x4 v[4]; float s = 0.f;
#pragma unroll
        for (int j = 0; j < 4; ++j) { v[j] = xr[64 * j]; s += (v[j].x * v[j].x + v[j].y * v[j].y) + (v[j].z * v[j].z + v[j].w * v[j].w); }
        const float rstd = 1.f / sqrtf(wave_sum(s) * (1.f / DM) + EPS);
        GAS unsigned long long* o8 = (GAS unsigned long long*)(xn + (size_t)m * DM) + lane;
#pragma unroll
        for (int j = 0; j < 4; ++j) { const f32x4 y = v[j] * rstd * gv[j]; o8[64 * j] = (unsigned long long)pk2(y.x, y.y) | ((unsigned long long)pk2(y.z, y.w) << 32); }
    }
    float* rot = (float*)(ws + WS_ROT);
    for (int idx = gw * 64 + lane; idx < SEQ * 32; idx += NGW * 64) {
        const int pos = idx >> 5, i = idx & 31;
        const float inv = (float)exp(-(double)i * (9.210340371976184 / 32.0));
        const float ang = (float)pos * inv;
        rot[idx] = (float)cos((double)ang); rot[SEQ * 32 + idx] = (float)sin((double)ang);
    }
}

typedef pg8::Unit Unit;
using pg8::cvt_pk_bf16;
__device__ __forceinline__ v4u pack8(const f32x4 a, const f32x4 b) { v4u w; w.x = cvt_pk_bf16(a[0], a[1]); w.y = cvt_pk_bf16(a[2], a[3]); w.z = cvt_pk_bf16(b[0], b[1]); w.w = cvt_pk_bf16(b[2], b[3]); return w; }
__device__ __forceinline__ float sigm(float x) { return 1.f / (1.f + __expf(-x)); }

struct Epi1 {
    static constexpr bool PERM = true, AFTER_DRAIN = false;
    bf16 *sbq, *sbk, *sbv, *rq, *rk, *rv, *rg, *gates; const float* bgate; const float* rot;
    __device__ __forceinline__ void operator()(const f32x4 (&acc)[2][2][4][2], const Unit& u, int wr, int wc, int fr, int fq) const {
        const int pn = u.tag, rowb = u.row0 + wr * 64 + fr, cw = wc * 32 + 8 * fq;
        if (pn >= 6 && pn < 10) {
            bf16* base = (pn < 8 ? rq : rk) + ((pn & 1) * 4 + wc) * 64 + 8 * fq;
#pragma unroll
            for (int ai = 0; ai < 2; ++ai)
#pragma unroll
                for (int m = 0; m < 4; ++m) { const int row = rowb + ai * 128 + m * 16, pos = row & (SEQ - 1);
                    const f32x4 c0 = *(const f32x4*)(rot + pos * 32 + 8 * fq), c1 = *(const f32x4*)(rot + pos * 32 + 8 * fq + 4);
                    const f32x4 s0 = *(const f32x4*)(rot + SEQ * 32 + pos * 32 + 8 * fq), s1 = *(const f32x4*)(rot + SEQ * 32 + pos * 32 + 8 * fq + 4);
                    const f32x4 x10 = acc[ai][0][m][0], x11 = acc[ai][0][m][1], x20 = acc[ai][1][m][0], x21 = acc[ai][1][m][1];
                    const f32x4 o10 = x10 * c0 - x20 * s0, o11 = x11 * c1 - x21 * s1, o20 = x20 * c0 + x10 * s0, o21 = x21 * c1 + x11 * s1;
                    bf16* rowp = base + (size_t)row * 512;
                    *(v4u*)rowp = pack8(o10, o11); *(v4u*)(rowp + 32) = pack8(o20, o21); }
            return;
        }
        bf16* base; int ld, colt, act = 0;
        if (pn < 2) { base = sbq; ld = 512; colt = pn * 256; } else if (pn < 4) { base = sbk; ld = 512; colt = (pn - 2) * 256; }
        else if (pn < 6) { base = sbv; ld = 512; colt = (pn - 4) * 256; } else if (pn < 14) { base = rv; ld = 1024; colt = (pn - 10) * 256; }
        else if (pn < 18) { base = rg; ld = 1024; colt = (pn - 14) * 256; act = 1; } else { base = gates; ld = 2048; colt = (pn - 18) * 256; act = 2; }
        f32x4 bv[2][2];
#pragma unroll
        for (int bj = 0; bj < 2; ++bj)
#pragma unroll
            for (int n = 0; n < 2; ++n) bv[bj][n] = act == 2 ? *(const f32x4*)(bgate + colt + bj * 128 + cw + 4 * n) : (f32x4){0.f, 0.f, 0.f, 0.f};
#pragma unroll
        for (int ai = 0; ai < 2; ++ai)
#pragma unroll
            for (int m = 0; m < 4; ++m) { bf16* rowp = base + (size_t)(rowb + ai * 128 + m * 16) * ld + colt + cw;
#pragma unroll
                for (int bj = 0; bj < 2; ++bj) { f32x4 v0 = acc[ai][bj][m][0] + bv[bj][0], v1 = acc[ai][bj][m][1] + bv[bj][1];
                    if (act == 1) {
#pragma unroll
                        for (int j = 0; j < 4; ++j) { v0[j] = v0[j] * sigm(v0[j]); v1[j] = v1[j] * sigm(v1[j]); } }
                    else if (act == 2) {
#pragma unroll
                        for (int j = 0; j < 4; ++j) { v0[j] = sigm(v0[j]); v1[j] = sigm(v1[j]); } }
                    *(v4u*)(rowp + bj * 128) = pack8(v0, v1); } }
    }
};
template <bool ADD> struct EpiMix {
    static constexpr bool PERM = true, AFTER_DRAIN = false;
    const bf16* gates; int goff; const bf16* prev; bf16* out;
    __device__ __forceinline__ void operator()(const f32x4 (&acc)[2][2][4][2], const Unit& u, int wr, int wc, int fr, int fq) const {
        const int rowb = u.row0 + wr * 64 + fr, colb = u.col0 + wc * 32 + 8 * fq;
#pragma unroll
        for (int ai = 0; ai < 2; ++ai)
#pragma unroll
            for (int m = 0; m < 4; ++m) { const size_t row = rowb + ai * 128 + m * 16;
#pragma unroll
                for (int bj = 0; bj < 2; ++bj) { const int col = colb + bj * 128;
                    const v4u g = *(const v4u*)(gates + row * 2048 + goff + col);
                    f32x4 v0 = acc[ai][bj][m][0], v1 = acc[ai][bj][m][1];
                    v0[0] *= bflo(g.x); v0[1] *= bfhi(g.x); v0[2] *= bflo(g.y); v0[3] *= bfhi(g.y); v1[0] *= bflo(g.z); v1[1] *= bfhi(g.z); v1[2] *= bflo(g.w); v1[3] *= bfhi(g.w);
                    if (ADD) { const v4u p = *(const v4u*)(prev + row * 1024 + col);
                        v0[0] += bflo(p.x); v0[1] += bfhi(p.x); v0[2] += bflo(p.y); v0[3] += bfhi(p.y); v1[0] += bflo(p.z); v1[1] += bfhi(p.z); v1[2] += bflo(p.w); v1[3] += bfhi(p.w); }
                    *(v4u*)(out + row * 1024 + col) = pack8(v0, v1); } }
    }
};
struct EpiOut {
    static constexpr bool PERM = false, AFTER_DRAIN = false;
    const float* x; float* out;
    __device__ __forceinline__ void operator()(const f32x4 (&acc)[2][2][4][2], const Unit& u, int wr, int wc, int fr, int fq) const {
        const int rowb = u.row0 + wr * 64 + fr, colb = u.col0 + wc * 32 + 4 * fq;
#pragma unroll
        for (int ai = 0; ai < 2; ++ai)
#pragma unroll
            for (int m = 0; m < 4; ++m) { const size_t off = (size_t)(rowb + ai * 128 + m * 16) * 1024 + colb;
#pragma unroll
                for (int bj = 0; bj < 2; ++bj)
#pragma unroll
                    for (int n = 0; n < 2; ++n) *(f32x4*)(out + off + bj * 128 + n * 16) = *(const f32x4*)(x + off + bj * 128 + n * 16) + acc[ai][bj][m][n]; }
    }
};
struct EpiUp {
    static constexpr bool PERM = true, AFTER_DRAIN = false;
    const SInfo* sinfo; bf16* hid;
    __device__ __forceinline__ void operator()(const f32x4 (&acc)[2][2][4][2], const Unit& u, int wr, int wc, int fr, int fq) const {
        const int ct = u.tag, rowb = u.row0 + wr * 64 + fr, col = ct * 128 + wc * 32 + 8 * fq;
#pragma unroll
        for (int ai = 0; ai < 2; ++ai)
#pragma unroll
            for (int m = 0; m < 4; ++m) { const size_t row = rowb + ai * 128 + m * 16; const SInfo si = sinfo[row]; const float gw = ct < 4 ? si.ga : si.gb;
                f32x4 v0, v1;
#pragma unroll
                for (int j = 0; j < 4; ++j) { const float g0 = acc[ai][0][m][0][j], g1 = acc[ai][0][m][1][j];
                    v0[j] = g0 * sigm(g0) * acc[ai][1][m][0][j] * gw; v1[j] = g1 * sigm(g1) * acc[ai][1][m][1][j] * gw; }
                *(v4u*)(hid + row * 1024 + col) = pack8(v0, v1); }
    }
};
struct EpiDown {
    static constexpr bool PERM = false, AFTER_DRAIN = false;
    const SInfo* sinfo; float* out;
    __device__ __forceinline__ void operator()(const f32x4 (&acc)[2][2][4][2], const Unit& u, int wr, int wc, int fr, int fq) const {
        const int rowb = u.row0 + wr * 64 + fr, colb = u.col0 + wc * 32 + 4 * fq;
#pragma unroll
        for (int ai = 0; ai < 2; ++ai)
#pragma unroll
            for (int m = 0; m < 4; ++m) { const int tok = sinfo[rowb + ai * 128 + m * 16].tok;
                if (tok >= 0) { float* p = out + (size_t)tok * 1024 + colb;
#pragma unroll
                    for (int bj = 0; bj < 2; ++bj)
#pragma unroll
                        for (int n = 0; n < 2; ++n) *(f32x4*)(p + bj * 128 + n * 16) = *(const f32x4*)(p + bj * 128 + n * 16) + acc[ai][bj][m][n]; } }
    }
};
struct MoeOrder {
    const char* A; const char* B; const volatile LAS int* tstart; int nct, up, G, c;
    __device__ bool next(int i, Unit& u) const {
        const int L = i * G + c; const int ntile = __builtin_amdgcn_readfirstlane(tstart[NCLS]);
        const int rt = L / nct, ct = L % nct; if (rt >= ntile) return false;
        int cls = 0;
        for (int k = 1; k < NCLS; ++k) cls += (rt >= __builtin_amdgcn_readfirstlane(tstart[k])) ? 1 : 0;
        const int g = cls / 6, p = cls % 6, pa = p < 3 ? 0 : (p < 5 ? 1 : 2), pb = p == 0 ? 1 : (p == 1 ? 2 : (p == 2 ? 3 : (p == 3 ? 2 : 3)));
        u.a = A + (size_t)rt * 256 * 1024 * 2; u.row0 = rt * 256; u.tag = ct;
        if (up) { const int e = 4 * g + (ct < 4 ? pa : pb); u.b = B + ((size_t)e * 1024 + (ct & 3) * 256) * 1024 * 2; u.col0 = ct * 128; }
        else { u.b = B + ((size_t)cls * 1024 + ct * 256) * 1024 * 2; u.col0 = ct * 256; }
        return true;
    }
    __device__ __forceinline__ void a_ready(const Unit&) const {}
    __device__ __forceinline__ void done(const Unit&) const {}
};

__device__ __forceinline__ void sb_naive(const bf16* Q, const bf16* Kb, const bf16* Vb, bf16* O, LAS unsigned char* lds, int vcu, int G, int tid) {
    LAS v4u* kt4 = (LAS v4u*)lds; LAS v4u* vt4 = (LAS v4u*)(lds + 8192);
    for (int unit = vcu; unit < NB * 8 * 4; unit += G) {
        const int bh = unit >> 2, qb = unit & 3, b = bh >> 3, h = bh & 7;
        const int t = qb * 512 + tid;
        const size_t rbase = (size_t)b * SEQ;
        float q[64], acc[64];
        { const v4u* qp = (const v4u*)(Q + (rbase + t) * 512 + h * 64);
#pragma unroll
          for (int c = 0; c < 8; ++c) { const v4u w = qp[c]; q[8*c] = bflo(w.x); q[8*c+1] = bfhi(w.x); q[8*c+2] = bflo(w.y); q[8*c+3] = bfhi(w.y); q[8*c+4] = bflo(w.z); q[8*c+5] = bfhi(w.z); q[8*c+6] = bflo(w.w); q[8*c+7] = bfhi(w.w); } }
#pragma unroll
        for (int d = 0; d < 64; ++d) acc[d] = 0.f;
        float R = 0.f;
        for (int kt = qb * 8 + 7; kt >= 0; --kt) {
            __syncthreads();
            { const int key = tid >> 3, c = tid & 7; const size_t g = (rbase + kt * 64 + key) * 512 + h * 64 + c * 8;
              kt4[tid] = *(const v4u*)(Kb + g); vt4[tid] = *(const v4u*)(Vb + g); }
            __syncthreads();
            for (int j = 63; j >= 0; --j) {
                const int s = kt * 64 + j;
                float z = 0.f;
#pragma unroll
                for (int c = 0; c < 8; ++c) { const v4u w = kt4[j * 8 + c];
                    z += q[8*c] * bflo(w.x) + q[8*c+1] * bfhi(w.x) + q[8*c+2] * bflo(w.y) + q[8*c+3] * bfhi(w.y) + q[8*c+4] * bflo(w.z) + q[8*c+5] * bfhi(w.z) + q[8*c+6] * bflo(w.w) + q[8*c+7] * bfhi(w.w); }
                const bool valid = s < t;
                const float sp = fmaxf(z, 0.f) + __logf(1.f + __expf(-fabsf(z)));
                const float w_ = valid ? __expf(z - sp + R) : 0.f;
                R += valid ? -sp : 0.f;
#pragma unroll
                for (int c = 0; c < 8; ++c) { const v4u w = vt4[j * 8 + c];
                    acc[8*c] += w_ * bflo(w.x); acc[8*c+1] += w_ * bfhi(w.x); acc[8*c+2] += w_ * bflo(w.y); acc[8*c+3] += w_ * bfhi(w.y); acc[8*c+4] += w_ * bflo(w.z); acc[8*c+5] += w_ * bfhi(w.z); acc[8*c+6] += w_ * bflo(w.w); acc[8*c+7] += w_ * bfhi(w.w); }
            }
        }
        { v4u* op = (v4u*)(O + (rbase + t) * 512 + h * 64);
#pragma unroll
          for (int c = 0; c < 8; ++c) { v4u w; w.x = pk2(acc[8*c], acc[8*c+1]); w.y = pk2(acc[8*c+2], acc[8*c+3]); w.z = pk2(acc[8*c+4], acc[8*c+5]); w.w = pk2(acc[8*c+6], acc[8*c+7]); op[c] = w; } }
    }
}
__device__ __forceinline__ void ret_naive(const bf16* Q, const bf16* Kb, const bf16* Vb, const bf16* RG, const float* gn, bf16* Y, LAS unsigned char* lds, int vcu, int G, int tid) {
    LAS v4u* kt4 = (LAS v4u*)lds; LAS v4u* vt4 = (LAS v4u*)(lds + 8192);
    for (int unit = vcu; unit < NB * 8 * 8; unit += G) {
        const int bh = unit >> 3, qb = unit & 7, b = bh >> 3, h = bh & 7;
        const int n = qb * 256 + (tid >> 1), half = tid & 1;
        const size_t rbase = (size_t)b * SEQ;
        const float lg2 = log2f(1.f - exp2f(-5.f - (float)h));
        float q[64], acc[64];
        { const v4u* qp = (const v4u*)(Q + (rbase + n) * 512 + h * 64);
#pragma unroll
          for (int c = 0; c < 8; ++c) { const v4u w = qp[c]; q[8*c] = bflo(w.x); q[8*c+1] = bfhi(w.x); q[8*c+2] = bflo(w.y); q[8*c+3] = bfhi(w.y); q[8*c+4] = bflo(w.z); q[8*c+5] = bfhi(w.z); q[8*c+6] = bflo(w.w); q[8*c+7] = bfhi(w.w); } }
#pragma unroll
        for (int d = 0; d < 64; ++d) acc[d] = 0.f;
        for (int kt = 0; kt <= qb * 4 + 3; ++kt) {
            __syncthreads();
            { const int key = tid >> 3, c = tid & 7; kt4[tid] = *(const v4u*)(Kb + (rbase + kt * 64 + key) * 512 + h * 64 + c * 8); }
            { const int key = tid >> 4, c = tid & 15; const bf16* vp = Vb + (rbase + kt * 64 + key) * 1024 + h * 128 + c * 8; vt4[tid] = *(const v4u*)vp; vt4[tid + 512] = *(const v4u*)(vp + 32 * 1024); }
            __syncthreads();
            for (int j = 0; j < 64; ++j) {
                const int m = kt * 64 + j;
                float z = 0.f;
#pragma unroll
                for (int c = 0; c < 8; ++c) { const v4u w = kt4[j * 8 + c];
                    z += q[8*c] * bflo(w.x) + q[8*c+1] * bfhi(w.x) + q[8*c+2] * bflo(w.y) + q[8*c+3] * bfhi(w.y) + q[8*c+4] * bflo(w.z) + q[8*c+5] * bfhi(w.z) + q[8*c+6] * bflo(w.w) + q[8*c+7] * bfhi(w.w); }
                const bool valid = (m >> 6) <= (n >> 6);
                const float s_ = valid ? z * exp2f(lg2 * fabsf((float)(n - m))) : 0.f;
#pragma unroll
                for (int c = 0; c < 8; ++c) { const v4u w = vt4[j * 16 + half * 8 + c];
                    acc[8*c] += s_ * bflo(w.x); acc[8*c+1] += s_ * bfhi(w.x); acc[8*c+2] += s_ * bflo(w.y); acc[8*c+3] += s_ * bfhi(w.y); acc[8*c+4] += s_ * bflo(w.z); acc[8*c+5] += s_ * bfhi(w.z); acc[8*c+6] += s_ * bflo(w.w); acc[8*c+7] += s_ * bfhi(w.w); }
            }
        }
        float ss = 0.f;
#pragma unroll
        for (int d = 0; d < 64; ++d) ss += acc[d] * acc[d];
        ss += __shfl_xor(ss, 1);
        const float rstd = 1.f / sqrtf(ss * (1.f / 128.f) + EPS);
        const size_t o = (rbase + n) * 1024 + h * 128 + half * 64;
#pragma unroll
        for (int c = 0; c < 8; ++c) { const v4u rg = *(const v4u*)(RG + o + 8 * c); const f32x4 g0 = *(const f32x4*)(gn + h * 128 + half * 64 + 8 * c), g1 = *(const f32x4*)(gn + h * 128 + half * 64 + 8 * c + 4);
            v4u w; w.x = pk2(acc[8*c] * rstd * g0[0] * bflo(rg.x), acc[8*c+1] * rstd * g0[1] * bfhi(rg.x)); w.y = pk2(acc[8*c+2] * rstd * g0[2] * bflo(rg.y), acc[8*c+3] * rstd * g0[3] * bfhi(rg.y));
            w.z = pk2(acc[8*c+4] * rstd * g1[0] * bflo(rg.z), acc[8*c+5] * rstd * g1[1] * bfhi(rg.z)); w.w = pk2(acc[8*c+6] * rstd * g1[2] * bflo(rg.w), acc[8*c+7] * rstd * g1[3] * bfhi(rg.w));
            *(v4u*)(Y + o + 8 * c) = w; }
    }
}

__device__ __forceinline__ void p_route(const Args& a, LAS unsigned char* lds, int vcu, int G, int wave, int lane, int tid) {
    const float* h = a.out; const float* gf = a.in[9]; const float* wg = a.in[10]; const float* bg = a.in[11]; const float* we = a.in[12]; const float* be = a.in[13];
    LAS float* lw = (LAS float*)lds;
    for (int i = tid; i < 1024 * 20; i += NTHR) { const int k = i / 20, o = i % 20; lw[i] = o < 4 ? wg[k * 4 + o] : we[k * 16 + o - 4]; }
    __syncthreads();
    const int gw = vcu * NWAVES + wave, NGW = G * NWAVES;
    TokInfo* tinfo = (TokInfo*)(a.ws + WS_TOK); float* rstd_o = (float*)(a.ws + WS_RSTD);
    unsigned* cnt = (unsigned*)(a.ws + WS_CTL) + CW_CNT;
    f32x4 gv[4];
#pragma unroll
    for (int j = 0; j < 4; ++j) gv[j] = ((const f32x4*)gf)[lane + 64 * j];
    for (int base = gw; base < T; base += NGW * 16) {
        int my_cls = -1; float my_ga = 0.f, my_gb = 0.f, my_rstd = 0.f;
        for (int j = 0; j < 16; ++j) {
            const int t = base + NGW * j; if (t >= T) break;
            const GAS f32x4* xr = (const GAS f32x4*)(h + (size_t)t * DM) + lane;
            f32x4 v[4]; float s = 0.f;
#pragma unroll
            for (int jj = 0; jj < 4; ++jj) { v[jj] = xr[64 * jj]; s += (v[jj].x * v[jj].x + v[jj].y * v[jj].y) + (v[jj].z * v[jj].z + v[jj].w * v[jj].w); }
            const float rstd = 1.f / sqrtf(wave_sum(s) * (1.f / DM) + EPS);
            float part[20];
#pragma unroll
            for (int o = 0; o < 20; ++o) part[o] = 0.f;
#pragma unroll
            for (int jj = 0; jj < 4; ++jj) { const f32x4 y = v[jj] * rstd * gv[jj];
#pragma unroll
                for (int e = 0; e < 4; ++e) { const LAS f32x4* wp = (const LAS f32x4*)(lw + (256 * jj + 4 * lane + e) * 20);
#pragma unroll
                    for (int o4 = 0; o4 < 5; ++o4) { const f32x4 w = wp[o4]; part[4*o4] += y[e] * w[0]; part[4*o4+1] += y[e] * w[1]; part[4*o4+2] += y[e] * w[2]; part[4*o4+3] += y[e] * w[3]; } } }
#pragma unroll
            for (int o = 0; o < 20; ++o) part[o] = wave_sum(part[o]);
            float gl[4];
#pragma unroll
            for (int o = 0; o < 4; ++o) gl[o] = part[o] + bg[o];
            int gi = 0; float gm = gl[0];
#pragma unroll
            for (int o = 1; o < 4; ++o) if (gl[o] > gm) { gm = gl[o]; gi = o; }
            float gs = 0.f;
#pragma unroll
            for (int o = 0; o < 4; ++o) gs += __expf(gl[o] - gm);
            const float pgrp = 1.f / gs;
            float el[4];
#pragma unroll
            for (int e = 0; e < 4; ++e) { const float l0 = part[4 + e] + be[e], l1 = part[8 + e] + be[4 + e], l2 = part[12 + e] + be[8 + e], l3 = part[16 + e] + be[12 + e];
                el[e] = gi == 0 ? l0 : (gi == 1 ? l1 : (gi == 2 ? l2 : l3)); }
            int i1 = 0; float m1 = el[0];
#pragma unroll
            for (int e = 1; e < 4; ++e) if (el[e] > m1) { m1 = el[e]; i1 = e; }
            int i2 = -1; float m2 = -3.0e38f;
#pragma unroll
            for (int e = 0; e < 4; ++e) if (e != i1 && el[e] > m2) { m2 = el[e]; i2 = e; }
            const float s1 = 1.f / (1.f + __expf(m2 - m1)), g1 = s1 * pgrp, g2 = (1.f - s1) * pgrp;
            const int pa = i1 < i2 ? i1 : i2, pb = i1 < i2 ? i2 : i1;
            const float ga = i1 < i2 ? g1 : g2, gb = i1 < i2 ? g2 : g1;
            const int pidx = pa == 0 ? pb - 1 : (pa == 1 ? pb + 1 : 5);
            if (lane == j) { my_cls = gi * 6 + pidx; my_ga = ga; my_gb = gb; my_rstd = rstd; }
        }
        int my_pos = 0;
        for (int c = 0; c < NCLS; ++c) {
            const unsigned long long mask = __ballot(my_cls == c);
            if (mask) { const int nn = __popcll(mask), leader = __ffsll((long long)mask) - 1; unsigned bse = 0;
                if (lane == leader) bse = __hip_atomic_fetch_add(cnt + 64 * c, (unsigned)nn, __ATOMIC_RELAXED, __HIP_MEMORY_SCOPE_AGENT);
                bse = __shfl(bse, leader);
                if (my_cls == c) my_pos = (int)bse + __popcll(mask & ((1ull << lane) - 1ull)); }
        }
        if (my_cls >= 0) { const int t = base + NGW * lane; tinfo[t] = TokInfo{my_cls, my_pos, my_ga, my_gb}; rstd_o[t] = my_rstd; }
    }
}
__device__ __forceinline__ void build_class_table(const Args& a, volatile LAS int* tab, int tid) {
    if (tid == 0) { const unsigned* cnt = (const unsigned*)(a.ws + WS_CTL) + CW_CNT; int acc_ = 0;
        for (int c = 0; c < NCLS; ++c) { tab[c] = acc_; const int n = (int)__hip_atomic_load(cnt + 64 * c, __ATOMIC_RELAXED, __HIP_MEMORY_SCOPE_AGENT); tab[32 + c] = n; acc_ += (n + 255) >> 8; }
        tab[NCLS] = acc_; }
    __syncthreads();
}
__device__ __forceinline__ void p_scatter(const Args& a, volatile LAS int* tab, int vcu, int G, int wave, int lane, int tid) {
    const float* h = a.out; const float* gf = a.in[9];
    const TokInfo* tinfo = (const TokInfo*)(a.ws + WS_TOK); const float* rstd_i = (const float*)(a.ws + WS_RSTD);
    SInfo* sinfo = (SInfo*)(a.ws + WS_SINFO); bf16* hns = (bf16*)(a.ws + WS_HNS);
    const int gw = vcu * NWAVES + wave, NGW = G * NWAVES;
    f32x4 gv[4];
#pragma unroll
    for (int j = 0; j < 4; ++j) gv[j] = ((const f32x4*)gf)[lane + 64 * j];
    for (int t = gw; t < T; t += NGW) {
        const TokInfo ti = tinfo[t]; const float rstd = rstd_i[t];
        const int srow = tab[ti.cls] * 256 + ti.pos;
        const GAS f32x4* xr = (const GAS f32x4*)(h + (size_t)t * DM) + lane;
        GAS unsigned long long* o8 = (GAS unsigned long long*)(hns + (size_t)srow * DM) + lane;
#pragma unroll
        for (int j = 0; j < 4; ++j) { const f32x4 y = xr[64 * j] * rstd * gv[j]; o8[64 * j] = (unsigned long long)pk2(y.x, y.y) | ((unsigned long long)pk2(y.z, y.w) << 32); }
        if (lane == 0) sinfo[srow] = SInfo{t, ti.ga, ti.gb, 0};
    }
    for (int idx = (vcu * NTHR + tid); idx < NCLS * 256; idx += G * NTHR) { const int c = idx >> 8, r = tab[32 + c] + (idx & 255);
        if (r < (((tab[32 + c] + 255) >> 8) << 8)) sinfo[tab[c] * 256 + r] = SInfo{-1, 0.f, 0.f, 0}; }
}
__device__ __forceinline__ void p_final(const Args& a, int vcu, int G, int wave, int lane) {
    float* h = a.out; const float* gf = a.in[17];
    const int gw = vcu * NWAVES + wave, NGW = G * NWAVES;
    f32x4 gv[4];
#pragma unroll
    for (int j = 0; j < 4; ++j) gv[j] = ((const f32x4*)gf)[lane + 64 * j];
    for (int t = gw; t < T; t += NGW) {
        GAS f32x4* xr = (GAS f32x4*)(h + (size_t)t * DM) + lane;
        f32x4 v[4]; float s = 0.f;
#pragma unroll
        for (int j = 0; j < 4; ++j) { v[j] = xr[64 * j]; s += (v[j].x * v[j].x + v[j].y * v[j].y) + (v[j].z * v[j].z + v[j].w * v[j].w); }
        const float rstd = 1.f / sqrtf(wave_sum(s) * (1.f / DM) + EPS);
#pragma unroll
        for (int j = 0; j < 4; ++j) xr[64 * j] = v[j] * rstd * gv[j];
    }
}

#ifndef MK_ONE_LAUNCH
#define MK_ONE_LAUNCH 1
#endif
constexpr int NPHASE = 11;
__global__ void __launch_bounds__(NTHR, 2) fwd_kernel(Args args) {
    extern __shared__ __attribute__((aligned(16))) unsigned char lds_raw[];
    LAS unsigned char* lds = (LAS unsigned char*)lds_raw;
    volatile LAS unsigned* MISC = (volatile LAS unsigned*)(lds + MISC_OFF);
    volatile LAS int* tab = (volatile LAS int*)(lds + TAB_OFF);
    const int tid = threadIdx.x, lane = tid & 63, wave = __builtin_amdgcn_readfirstlane(tid >> 6);
    const int G = gridDim.x; const int bx = blockIdx.x; const int vcu = (G % 8 == 0) ? (bx % 8) * (G / 8) + bx / 8 : bx;
    unsigned char* ws = args.ws;
    for (int u = tid; u < (LDS_BYTES - LDSCTL_OFF) / 4; u += NTHR) ((LAS unsigned*)(lds + LDSCTL_OFF))[u] = 0u;
    __syncthreads();
    XcdBarrier bar; bar.bar = (unsigned*)(ws + WS_CTL) + CW_BAR; bar.x = 0; bar.st = nullptr;
    if (MK_ONE_LAUNCH) bar = xcd_barrier_post((unsigned*)(ws + WS_CTL) + CW_BAR, MISC + 8);
    const int lo = args.ph_lo, hi = args.ph_hi;
#define IN(k) (lo <= (k) && (k) < hi)
#define SEAM(k) do { if (MK_ONE_LAUNCH && IN(k) && IN((k) + 1)) xcd_barrier(bar); } while (0)
    bf16* W1 = (bf16*)(ws + WS_W1); bf16* XN = (bf16*)(ws + WS_R1); bf16* YRET = (bf16*)(ws + WS_R1); bf16* HIDS = (bf16*)(ws + WS_R1);
    bf16* SBQ = (bf16*)(ws + WS_SBQ); bf16* SBK = (bf16*)(ws + WS_SBK); bf16* SBV = (bf16*)(ws + WS_SBV); bf16* RQ = (bf16*)(ws + WS_RQ); bf16* RK = (bf16*)(ws + WS_RK);
    bf16* RV = (bf16*)(ws + WS_RV); bf16* RG = (bf16*)(ws + WS_RG); bf16* YSB = (bf16*)(ws + WS_YSB); bf16* GATES = (bf16*)args.out;
    bf16* TMP = (bf16*)(ws + WS_TMP); bf16* MIX = (bf16*)(ws + WS_MIX); bf16* HNS = (bf16*)(ws + WS_HNS);
    const SInfo* sinfo = (const SInfo*)(ws + WS_SINFO);

    if (IN(0)) { p0_prologue(args, lds, vcu, G, wave, lane); }
    SEAM(0);
    if (IN(1)) {
        pg8::StaticOrder S; S.init(XN, W1, T, N1, 1024, G, bx);
        Epi1 E{SBQ, SBK, SBV, RQ, RK, RV, RG, GATES, args.in[4], (const float*)(ws + WS_ROT)};
        pg8::gemm_phase<Epi1, pg8::StaticOrder, true, true>(lds, 1024, S, E);
    }
    SEAM(1);
    if (IN(2)) {
        sb_naive(SBQ, SBK, SBV, YSB, lds, vcu, G, tid);
        __syncthreads();
        ret_naive(RQ, RK, RV, RG, args.in[7], YRET, lds, vcu, G, tid);
        __syncthreads();
    }
    SEAM(2);
    if (IN(3)) {
        pg8::StaticOrder S; S.init(YSB, ws + WS_WSB, T, 1024, 512, G, bx);
        EpiMix<false> E{GATES, 0, nullptr, TMP};
        pg8::gemm_phase<EpiMix<false>, pg8::StaticOrder, true, true>(lds, 512, S, E);
    }
    SEAM(3);
    if (IN(4)) {
        pg8::StaticOrder S; S.init(YRET, ws + WS_WRET, T, 1024, 1024, G, bx);
        EpiMix<true> E{GATES, 1024, TMP, MIX};
        pg8::gemm_phase<EpiMix<true>, pg8::StaticOrder, true, true>(lds, 1024, S, E);
    }
    SEAM(4);
    if (IN(5)) {
        pg8::StaticOrder S; S.init(MIX, ws + WS_WOUT, T, 1024, 1024, G, bx);
        EpiOut E{args.in[0], args.out};
        pg8::gemm_phase<EpiOut, pg8::StaticOrder, true, true>(lds, 1024, S, E);
    }
    SEAM(5);
    if (IN(6)) { p_route(args, lds, vcu, G, wave, lane, tid); __syncthreads(); }
    SEAM(6);
    if (IN(7)) { build_class_table(args, tab, tid); p_scatter(args, tab, vcu, G, wave, lane, tid); }
    SEAM(7);
    if (IN(8)) {
        build_class_table(args, tab, tid);
        MoeOrder S{(const char*)HNS, (const char*)(ws + WS_WUP), tab, 8, 1, G, bx};
        EpiUp E{sinfo, HIDS};
        pg8::gemm_phase<EpiUp, MoeOrder, true, true>(lds, 1024, S, E);
    }
    SEAM(8);
    if (IN(9)) {
        build_class_table(args, tab, tid);
        MoeOrder S{(const char*)HIDS, (const char*)(ws + WS_WDN), tab, 4, 0, G, bx};
        EpiDown E{sinfo, args.out};
        pg8::gemm_phase<EpiDown, MoeOrder, true, true>(lds, 1024, S, E);
    }
    SEAM(9);
    if (IN(10)) { p_final(args, vcu, G, wave, lane); }
#undef IN
#undef SEAM
}

extern "C" void kernel_launch(void* const* d_in, const int* in_sizes, int n_in, void* d_out, int out_size, void* d_ws, size_t ws_size, hipStream_t stream) {
    static int grid = 0;
    if (grid == 0) {
        if (n_in != 18 || in_sizes[0] != T * DM || out_size != T * DM || ws_size < WS_END) { fprintf(stderr, "kernel_launch: unexpected shapes (n_in %d, in0 %d, out %d, ws %zu < %zu)\n", n_in, n_in > 0 ? in_sizes[0] : -1, out_size, ws_size, (size_t)WS_END); grid = -1; return; }
        int dev = 0, cus = 0, per_cu = 0;
        if (hipGetDevice(&dev) != hipSuccess || hipDeviceGetAttribute(&cus, hipDeviceAttributeMultiprocessorCount, dev) != hipSuccess) { grid = -1; return; }
        if (hipFuncSetAttribute((const void*)fwd_kernel, hipFuncAttributeMaxDynamicSharedMemorySize, LDS_BYTES) != hipSuccess) { fprintf(stderr, "kernel_launch: hipFuncSetAttribute failed\n"); grid = -1; return; }
        if (hipOccupancyMaxActiveBlocksPerMultiprocessor(&per_cu, (const void*)fwd_kernel, NTHR, LDS_BYTES) != hipSuccess || per_cu < 1) fprintf(stderr, "kernel_launch: occupancy query reports %d\n", per_cu);
        (void)hipGetLastError();
        grid = cus;
    }
    if (grid < 0) return;
    hipMemsetAsync((char*)d_ws + WS_CTL, 0, CTL_ZERO_BYTES, stream);
    Args a{};
    for (int i = 0; i < 18; ++i) a.in[i] = (const float*)d_in[i];
    a.out = (float*)d_out; a.ws = (unsigned char*)d_ws;
#if MK_ONE_LAUNCH
    a.ph_lo = 0; a.ph_hi = NPHASE;
    hipLaunchKernelGGL(fwd_kernel, dim3(grid), dim3(NTHR), LDS_BYTES, stream, a);
#else
    for (int p = 0; p < NPHASE; ++p) { a.ph_lo = p; a.ph_hi = p + 1; hipLaunchKernelGGL(fwd_kernel, dim3(grid), dim3(NTHR), LDS_BYTES, stream, a); }
#endif
}
```

```cpp
#include <hip/hip_runtime.h>
#include <cstdio>
#include <cstdint>
namespace pg8 {
#define PG8_LAS __attribute__((address_space(3)))
typedef unsigned short bf16_t;
typedef short bf16x8 __attribute__((ext_vector_type(8)));
typedef float f32x4 __attribute__((ext_vector_type(4)));
typedef unsigned u32x4 __attribute__((ext_vector_type(4)));
constexpr int BM = 256, BK = 64, HALF = 128, HTB = HALF * BK * 2  , STAGE_BYTES = 8 * HTB, NXCD = 8, WGM = 8;
__host__ __device__ __forceinline__ int lds_byte(int r, int c) { const int st = (r >> 4) * 2 + (c >> 5), rr = r & 15, cc = c & 31, ob = rr * 64 + cc * 2; return st * 1024 + (ob ^ (((ob >> 9) & 1) << 5)); }
__host__ __device__ __forceinline__ void stage_rc(int b, int& R, int& C) { const int st = b / 1024, sb = b % 1024, swz = sb ^ (((sb >> 9) & 1) << 5); R = (st >> 1) * 16 + swz / 64; C = (st & 1) * 32 + (swz % 64) / 2; }
__host__ __device__ __forceinline__ int perm32(int rho) { const int n = rho >> 4, i = rho & 15; return 8 * (i >> 2) + 4 * n + (i & 3); }

struct Unit { const char* a; const char* b; int row0, col0, tag; };
struct StaticOrder {
    const char* A; const char* Bt; int K, nM, nN, nwg, G, c;
    __device__ void init(const void* A_, const void* Bt_, int M, int N, int K_, int G_, int c_) { A = (const char*)A_; Bt = (const char*)Bt_; K = K_; nM = M / BM; nN = N / BM; nwg = nM * nN; G = G_; c = c_; }
    __device__ bool next(int i, Unit& u) const {
        const long L = (long)i * G + c; if (L >= nwg) return false;
        int wgid = (int)L; { const int q = nwg / NXCD, r = nwg % NXCD, xcd = wgid % NXCD, off = wgid / NXCD; wgid = (xcd < r ? xcd * (q + 1) : r * (q + 1) + (xcd - r) * q) + off; }
        const int nig = WGM * nN, gid = wgid / nig, fm = gid * WGM, gsz = (nM - fm) < WGM ? (nM - fm) : WGM;
        const int pm = fm + ((wgid % nig) % gsz), pn = (wgid % nig) / gsz;
        u.a = A + (size_t)pm * BM * K * 2; u.b = Bt + (size_t)pn * BM * K * 2; u.row0 = pm * BM; u.col0 = pn * BM; u.tag = pn; return true;
    }
    __device__ __forceinline__ void a_ready(const Unit&) const {}
    __device__ __forceinline__ void done(const Unit&) const {}
};
__device__ __forceinline__ unsigned cvt_pk_bf16(float lo, float hi) { unsigned r; asm volatile("v_cvt_pk_bf16_f32 %0, %1, %2" : "=v"(r) : "v"(lo), "v"(hi)); return r; }
template <class Epi, class Sched, bool ALIGN_EPI = false, bool SP2 = false>
__device__ __forceinline__ void gemm_phase(PG8_LAS unsigned char* lds, const int K, const Sched& S, const Epi& E) {
    const int tid = threadIdx.x, wid = __builtin_amdgcn_readfirstlane(tid >> 6), lane = tid & 63, wr = wid >> 2, wc = wid & 3, fr = lane & 15, fq = lane >> 4;
    const int nt = K / BK;
    unsigned voffA[2], voffB[2];
#pragma unroll
    for (int i = 0; i < 2; ++i) { int R, C; stage_rc(tid * 16 + i * 8192, R, C); const int Rb = Epi::PERM ? ((R & ~31) + perm32(R & 31)) : R;
        voffA[i] = (unsigned)(R * K + C) * 2u; voffB[i] = (unsigned)(Rb * K + C) * 2u; }
    const size_t kstep = (size_t)(BK * 2);
    const size_t hstep = (size_t)HALF * K * 2;
    const size_t tstep = 2 * hstep;
    const unsigned ldsw = (unsigned)wid * 1024u;
    const int aoff = lds_byte(wr * 64 + fr, fq * 8), boff = lds_byte(wc * 32 + fr, fq * 8);
#define PG8_SA(b, h) (((b) * 2 + (h)) * HTB)
#define PG8_SB(b, h) ((4 + (b) * 2 + (h)) * HTB)
#define PG8_STAGE(bufoff, gbase, voff) do { _Pragma("unroll") for (int _i = 0; _i < 2; ++_i) \
        __builtin_amdgcn_global_load_lds((const unsigned*)((const char*)(gbase) + (voff)[_i]), (PG8_LAS unsigned*)(lds + (bufoff) + ldsw + _i * 8192), 16, 0, 0); } while (0)
#define PG8_LDA(dst, b, h) do { _Pragma("unroll") for (int m = 0; m < 4; ++m) _Pragma("unroll") for (int k = 0; k < 2; ++k) dst[m][k] = *(const PG8_LAS bf16x8*)(lds + PG8_SA(b, h) + aoff + m * 2048 + k * 1024); } while (0)
#define PG8_LDB(dst, b, h) do { _Pragma("unroll") for (int n = 0; n < 2; ++n) _Pragma("unroll") for (int k = 0; k < 2; ++k) dst[n][k] = *(const PG8_LAS bf16x8*)(lds + PG8_SB(b, h) + boff + n * 2048 + k * 1024); } while (0)
#define PG8_MMA(ai, bj, At, Bt) do { __builtin_amdgcn_s_setprio(1); _Pragma("unroll") for (int m = 0; m < 4; ++m) _Pragma("unroll") for (int n = 0; n < 2; ++n) _Pragma("unroll") for (int k = 0; k < 2; ++k) \
        acc[ai][bj][m][n] = __builtin_amdgcn_mfma_f32_16x16x32_bf16(Bt[n][k], At[m][k], acc[ai][bj][m][n], 0, 0, 0); __builtin_amdgcn_s_setprio(0); } while (0)
#define PG8_WAIT_V(n) asm volatile("s_waitcnt vmcnt(" #n ")" ::: "memory")
#define PG8_WAIT_L(n) asm volatile("s_waitcnt lgkmcnt(" #n ")" ::: "memory")
#define PG8_BAR __builtin_amdgcn_s_barrier()
#define PG8_SCHED __builtin_amdgcn_sched_barrier(0)
    Unit cur, nxt; int ui = 0;
    if (!S.next(0, cur)) return;
    f32x4 acc[2][2][4][2];
#pragma unroll
    for (int a = 0; a < 2; ++a)
#pragma unroll
        for (int b = 0; b < 2; ++b)
#pragma unroll
            for (int m = 0; m < 4; ++m)
#pragma unroll
                for (int n = 0; n < 2; ++n) acc[a][b][m][n] = (f32x4){0.f, 0.f, 0.f, 0.f};
    bf16x8 At[4][2], B0[2][2], B1[2][2];
    const char* cA = cur.a; const char* cB = cur.b;
    S.a_ready(cur);
    if constexpr (SP2) {
        PG8_STAGE(PG8_SB(0, 0), cB, voffB); PG8_STAGE(PG8_SB(0, 1), cB + hstep, voffB); PG8_STAGE(PG8_SA(0, 0), cA, voffA); PG8_STAGE(PG8_SA(0, 1), cA + hstep, voffA);
        if (wr == 1) PG8_BAR;
        PG8_WAIT_V(2); PG8_BAR;
        PG8_STAGE(PG8_SB(1, 0), cB + kstep, voffB); PG8_STAGE(PG8_SA(1, 0), cA + kstep, voffA); PG8_STAGE(PG8_SB(1, 1), cB + hstep + kstep, voffB);
        PG8_WAIT_V(6); PG8_BAR;
    } else {
        PG8_STAGE(PG8_SB(0, 0), cB, voffB); PG8_STAGE(PG8_SA(0, 0), cA, voffA); PG8_STAGE(PG8_SB(0, 1), cB + hstep, voffB); PG8_STAGE(PG8_SA(0, 1), cA + hstep, voffA);
        if (wr == 1) PG8_BAR;
        PG8_WAIT_V(4); PG8_BAR;
        PG8_STAGE(PG8_SB(1, 0), cB + kstep, voffB); PG8_STAGE(PG8_SA(1, 0), cA + kstep, voffA); PG8_STAGE(PG8_SB(1, 1), cB + hstep + kstep, voffB);
        PG8_WAIT_V(6); PG8_BAR;
    }
    for (;;) {
        const bool has_next = S.next(ui + 1, nxt);
        const char* nA = has_next ? nxt.a : cA; const char* nB = has_next ? nxt.b : cB;
        for (int t = 0; t < nt; t += 2) {
            const bool last = (t == nt - 2);
            const char* a1 = cA + (size_t)(t + 1) * kstep;
            const char* a2 = last ? nA : cA + (size_t)(t + 2) * kstep; const char* b2 = last ? nB : cB + (size_t)(t + 2) * kstep;
            const char* a3 = a2 + kstep; const char* b3 = b2 + kstep;
            if (last && has_next) S.a_ready(nxt);
            if constexpr (SP2) {
            PG8_LDB(B0, 0, 0); PG8_LDB(B1, 0, 1); PG8_SCHED; PG8_LDA(At, 0, 0); PG8_STAGE(PG8_SA(1, 1), a1 + hstep, voffA);
            PG8_WAIT_V(8); PG8_WAIT_L(0); PG8_BAR; PG8_MMA(0, 0, At, B0); PG8_MMA(0, 1, At, B1); PG8_BAR; PG8_SCHED;
            PG8_LDA(At, 0, 1); PG8_STAGE(PG8_SB(0, 0), b2, voffB); PG8_STAGE(PG8_SB(0, 1), b2 + hstep, voffB); PG8_STAGE(PG8_SA(0, 0), a2, voffA);
            PG8_WAIT_V(8); PG8_WAIT_L(0); PG8_BAR; PG8_MMA(1, 0, At, B0); PG8_MMA(1, 1, At, B1); PG8_BAR; PG8_SCHED;
            PG8_LDB(B0, 1, 0); PG8_LDB(B1, 1, 1); PG8_SCHED; PG8_LDA(At, 1, 0); PG8_STAGE(PG8_SA(0, 1), a2 + hstep, voffA);
            PG8_WAIT_V(8); PG8_WAIT_L(0); PG8_BAR; PG8_MMA(0, 0, At, B0); PG8_MMA(0, 1, At, B1); PG8_BAR; PG8_SCHED;
            PG8_LDA(At, 1, 1); PG8_STAGE(PG8_SB(1, 0), b3, voffB); PG8_STAGE(PG8_SB(1, 1), b3 + hstep, voffB); PG8_STAGE(PG8_SA(1, 0), a3, voffA);
            PG8_WAIT_V(8); PG8_WAIT_L(0); PG8_BAR; PG8_MMA(1, 0, At, B0); PG8_MMA(1, 1, At, B1); PG8_BAR; PG8_SCHED;
            } else {
            PG8_LDB(B0, 0, 0); PG8_SCHED; PG8_LDA(At, 0, 0); PG8_STAGE(PG8_SA(1, 1), a1 + hstep, voffA);
            PG8_WAIT_L(8); PG8_BAR; PG8_WAIT_L(0); PG8_MMA(0, 0, At, B0); PG8_BAR; PG8_SCHED;
            PG8_LDB(B1, 0, 1); PG8_STAGE(PG8_SB(0, 0), b2, voffB);
            PG8_BAR; PG8_WAIT_L(0); PG8_MMA(0, 1, At, B1); PG8_BAR;
            PG8_LDA(At, 0, 1); PG8_STAGE(PG8_SA(0, 0), a2, voffA);
            PG8_BAR; PG8_WAIT_L(0); PG8_MMA(1, 0, At, B0); PG8_BAR; PG8_SCHED;
            PG8_STAGE(PG8_SB(0, 1), b2 + hstep, voffB);
            PG8_WAIT_V(6); PG8_BAR; PG8_MMA(1, 1, At, B1); PG8_BAR;
            PG8_LDB(B0, 1, 0); PG8_SCHED; PG8_LDA(At, 1, 0); PG8_STAGE(PG8_SA(0, 1), a2 + hstep, voffA);
            PG8_WAIT_L(8); PG8_BAR; PG8_WAIT_L(0); PG8_MMA(0, 0, At, B0); PG8_BAR; PG8_SCHED;
            PG8_LDB(B1, 1, 1); PG8_STAGE(PG8_SB(1, 0), b3, voffB);
            PG8_BAR; PG8_WAIT_L(0); PG8_MMA(0, 1, At, B1); PG8_BAR;
            PG8_LDA(At, 1, 1); PG8_STAGE(PG8_SA(1, 0), a3, voffA);
            PG8_BAR; PG8_WAIT_L(0); PG8_MMA(1, 0, At, B0); PG8_BAR; PG8_SCHED;
            PG8_STAGE(PG8_SB(1, 1), b3 + hstep, voffB);
            PG8_WAIT_V(6); PG8_BAR; PG8_MMA(1, 1, At, B1); PG8_BAR;
            }
        }
        if constexpr (ALIGN_EPI) { if (wr == 0) PG8_BAR; }
        if constexpr (!Epi::AFTER_DRAIN) { E(acc, cur, wr, wc, fr, fq); S.done(cur); }
        if (!has_next) break;
#pragma unroll
        for (int a = 0; a < 2; ++a)
#pragma unroll
            for (int b = 0; b < 2; ++b)
#pragma unroll
                for (int m = 0; m < 4; ++m)
#pragma unroll
                    for (int n = 0; n < 2; ++n) acc[a][b][m][n] = (f32x4){0.f, 0.f, 0.f, 0.f};
        cur = nxt; cA = nA; cB = nB; ++ui;
        if constexpr (ALIGN_EPI) { if (wr == 1) PG8_BAR; }
    }
    PG8_WAIT_V(0);
    if constexpr (!ALIGN_EPI) { if (wr == 0) PG8_BAR; }
    PG8_BAR;
    if constexpr (Epi::AFTER_DRAIN) { E.fused(acc, cur, wr, wc, fr, fq, lds, wid, lane); S.done(cur); }
#undef PG8_SA
#undef PG8_SB
#undef PG8_STAGE
#undef PG8_LDA
#undef PG8_LDB
#undef PG8_MMA
#undef PG8_WAIT_V
#undef PG8_WAIT_L
#undef PG8_BAR
#undef PG8_SCHED
}
}
#define GAS __attribute__((address_space(1)))
#define LAS __attribute__((address_space(3)))
typedef unsigned short bf16;
typedef unsigned v4u __attribute__((ext_vector_type(4)));
typedef float f32x4 __attribute__((ext_vector_type(4)));
typedef short bf16x8 __attribute__((ext_vector_type(8)));
typedef GAS unsigned gu32;
typedef GAS unsigned long long gu64;
#define RLX_AGENT __ATOMIC_RELAXED, __HIP_MEMORY_SCOPE_AGENT
#define LDS_WAIT() asm volatile("s_waitcnt lgkmcnt(0)" ::: "memory")
#define VM_WAIT() asm volatile("s_waitcnt vmcnt(0)" ::: "memory")
__device__ __forceinline__ unsigned long long rt() { return __builtin_amdgcn_s_memrealtime(); }
__device__ __forceinline__ unsigned f2bf(float f) { unsigned u = __builtin_bit_cast(unsigned, f); return (u + 0x7fffu + ((u >> 16) & 1u)) >> 16; }
__device__ __forceinline__ unsigned pk2(float lo, float hi) { return f2bf(lo) | (f2bf(hi) << 16); }

#define XB_TMO      128
#define XB_XCNT(j)  (256  + 64 * (j))
#define XB_XSUB(j)  (1280 + 64 * (j))
#define XB_XGEN(j)  (2304 + 64 * (j))
#define XB_TOP      3328
#define XB_TOPGEN   3392
#define XCD_BAR_WORDS 3456
#define XB_SPIN_CAP (1u << 18)

__device__ __forceinline__ unsigned xb_ld(unsigned* p)              { return __hip_atomic_load(p, __ATOMIC_RELAXED, __HIP_MEMORY_SCOPE_AGENT); }
__device__ __forceinline__ unsigned xb_add(unsigned* p, unsigned v) { return __hip_atomic_fetch_add(p, v, __ATOMIC_RELAXED, __HIP_MEMORY_SCOPE_AGENT); }
__device__ __forceinline__ unsigned xb_xcc_id() { return (unsigned)__builtin_amdgcn_s_getreg((3 << 11) | 20) & 0xFu; }
#define XB_SPIN(cond, bar) do { unsigned _sp = 0; while (cond) { __builtin_amdgcn_s_sleep(1); \
    if ((++_sp & 255u) == 0u) { if (xb_ld(&(bar)[XB_TMO])) break; if (_sp > XB_SPIN_CAP) { atomicAdd(&(bar)[XB_TMO], 1u); break; } } } } while (0)

struct XcdBarrier {
    unsigned* bar; unsigned x;
    volatile LAS unsigned* st;
};

__device__ __forceinline__ XcdBarrier xcd_barrier_post(unsigned* bar, volatile LAS unsigned* st) {
    XcdBarrier b; b.bar = bar; b.x = xb_xcc_id(); b.st = st;
    if (threadIdx.x == 0) (void)xb_add(&bar[XB_XCNT(b.x)], 1u);
    return b;
}
__device__ __forceinline__ void xcd_barrier_complete(unsigned* bar, unsigned x, unsigned& nloc, unsigned& nx) {
    const unsigned G = gridDim.x * gridDim.y * gridDim.z;
    unsigned sum, cnt, mine, sp = 0u;
    for (;;) {
        sum = 0u; cnt = 0u; mine = 0u;
#pragma unroll
        for (unsigned j = 0; j < 16; ++j) { const unsigned c = xb_ld(&bar[XB_XCNT(j)]); sum += c; cnt += (c > 0u) ? 1u : 0u; mine = (j == x) ? c : mine; }
        if (sum == G) break;
        __builtin_amdgcn_s_sleep(1);
        if ((++sp & 255u) == 0u) { if (xb_ld(&bar[XB_TMO])) break; if (sp > XB_SPIN_CAP) { atomicAdd(&bar[XB_TMO], 1u); break; } }
    }
    nloc = mine > 0u ? mine : 1u; nx = cnt > 0u ? cnt : 1u;
}

__device__ __forceinline__ void xcd_barrier(const XcdBarrier& b) {
    asm volatile("s_waitcnt vmcnt(0)" ::: "memory");
    __syncthreads();
    if (threadIdx.x == 0) {
        unsigned* bar = b.bar;
        __builtin_amdgcn_s_waitcnt(0);
        unsigned nloc = b.st[0], nx = b.st[1];
        if (nloc == 0u) { xcd_barrier_complete(bar, b.x, nloc, nx); b.st[0] = nloc; b.st[1] = nx; }
        const unsigned old = xb_add(&bar[XB_XSUB(b.x)], 1u);
        const unsigned gen = old / nloc;
        if (old + 1u == (gen + 1u) * nloc) {
            __builtin_amdgcn_fence(__ATOMIC_RELEASE, "agent");
            asm volatile("s_waitcnt vmcnt(0)" ::: "memory");
            const unsigned og = xb_add(&bar[XB_TOP], 1u);
            const unsigned tg = og / nx;
            if (og + 1u == (tg + 1u) * nx) xb_add(&bar[XB_TOPGEN], 1u);
            else XB_SPIN(xb_ld(&bar[XB_TOPGEN]) == tg, bar);
            __builtin_amdgcn_fence(__ATOMIC_ACQUIRE, "agent");
            xb_add(&bar[XB_XGEN(b.x)], 1u);
            asm volatile("s_waitcnt vmcnt(0)" ::: "memory");
        } else {
            XB_SPIN(xb_ld(&bar[XB_XGEN(b.x)]) == gen, bar);
            __builtin_amdgcn_fence(__ATOMIC_ACQUIRE, "agent");
            asm volatile("s_waitcnt vmcnt(0)" ::: "memory");
        }
    }
    __syncthreads();
}


constexpr int NWAVES = 8, NTHR = NWAVES * 64;
constexpr int DM = 1024, NB = 16, SEQ = 2048, T = NB * SEQ;
constexpr int N1 = 6656;
constexpr int NCLS = 24, SROWS = T + NCLS * 256;
constexpr float EPS = 1e-6f;
constexpr size_t MiB = 1u << 20;
constexpr size_t WS_CTL = 0, CTL_ZERO_BYTES = 1 * MiB;
constexpr size_t WS_ROT = 1 * MiB;
constexpr size_t WS_TOK = 2 * MiB;
constexpr size_t WS_RSTD = 2 * MiB + 512 * 1024;
constexpr size_t WS_SINFO = 3 * MiB;
constexpr size_t WS_W1 = 4 * MiB, WS_WSB = 18 * MiB, WS_WRET = 19 * MiB, WS_WOUT = 21 * MiB, WS_WUP = 23 * MiB, WS_WDN = 55 * MiB;
constexpr size_t WS_R1 = 104 * MiB;
constexpr size_t WS_SBQ = 168 * MiB, WS_SBK = 200 * MiB, WS_SBV = 232 * MiB, WS_RQ = 264 * MiB, WS_RK = 296 * MiB, WS_RV = 328 * MiB, WS_RG = 392 * MiB, WS_YSB = 456 * MiB;
constexpr size_t WS_TMP = WS_SBQ, WS_MIX = WS_SBV, WS_HNS = WS_RV;
constexpr size_t WS_END = 488 * MiB;
constexpr int CW_BAR = 4096, CW_CNT = 8192;
constexpr int RING_BYTES = 131072, LDSCTL_OFF = RING_BYTES, MISC_OFF = LDSCTL_OFF + 320, TAB_OFF = LDSCTL_OFF + 1024;
constexpr int LDS_BYTES = 147456;

struct TokInfo { int cls, pos; float ga, gb; };
struct SInfo { int tok; float ga, gb; int pad; };

__device__ __forceinline__ float wave_sum(float v) {
#pragma unroll
    for (int o = 1; o < 64; o <<= 1) v += __shfl_xor(v, o);
    return v;
}
__device__ __forceinline__ float bf2f(unsigned short b) { return __builtin_bit_cast(float, (unsigned)b << 16); }
__device__ __forceinline__ float bflo(unsigned w) { return __builtin_bit_cast(float, w << 16); }
__device__ __forceinline__ float bfhi(unsigned w) { return __builtin_bit_cast(float, w & 0xffff0000u); }

struct Args { const float* in[18]; float* out; unsigned char* ws; int ph_lo, ph_hi; };

struct TJob { const float* W; int N; bf16* WT; int ldk, koff, mode, nbase; };
__device__ __forceinline__ int rowmap(int mode, int n) {
    if (mode == 1) {
        if (n >= 1536 && n < 2560) { const int seg = n < 2048 ? 1536 : 2048, c = n - seg, hh = c >> 6, i = c & 63; return seg + (hh >> 2) * 256 + (i >> 5) * 128 + (hh & 3) * 32 + (i & 31); }
        return n;
    }
    if (mode == 2) return (n >> 7) * 256 + (n & 127);
    if (mode == 3) return (n >> 7) * 256 + 128 + (n & 127);
    return n;
}
__device__ __forceinline__ void p0_transpose_item(const TJob& J, LAS float* scr, int item, int lane) {
    const int nblk = J.N / 32, kb = item / nblk, nb = item % nblk, k0 = 64 * kb, n0 = 32 * nb;
#pragma unroll 8
    for (int i = 0; i < 32; ++i) { const int kk = 2 * i + (lane >> 5); scr[kk * 33 + (lane & 31)] = J.W[(size_t)(k0 + kk) * J.N + n0 + (lane & 31)]; }
    LDS_WAIT(); asm volatile("" ::: "memory");
    const int c = lane & 7;
#pragma unroll
    for (int j = 0; j < 4; ++j) { const int n = (lane >> 3) + 8 * j; const LAS float* s = scr + (8 * c) * 33 + n;
        const int ng = n0 + n; float sc = 1.f; if (J.mode == 1) { if (ng < 512) sc = 0.125f * 1.4426950408889634f; else if (ng >= 2048 && ng < 2560) sc = 0.125f; }
        v4u o; o.x = pk2(s[0 * 33] * sc, s[1 * 33] * sc); o.y = pk2(s[2 * 33] * sc, s[3 * 33] * sc); o.z = pk2(s[4 * 33] * sc, s[5 * 33] * sc); o.w = pk2(s[6 * 33] * sc, s[7 * 33] * sc);
        *(GAS v4u*)(J.WT + (size_t)(J.nbase + rowmap(J.mode, ng)) * J.ldk + J.koff + k0 + 8 * c) = o; }
    LDS_WAIT(); asm volatile("" ::: "memory");
}
__device__ __forceinline__ void p0_prologue(const Args& a, LAS unsigned char* lds, int vcu, int G, int wave, int lane) {
    unsigned char* ws = a.ws;
    LAS float* scr = (LAS float*)(lds + wave * 16384);
    const int gw = vcu * NWAVES + wave, NGW = G * NWAVES;
    constexpr int I0 = 16 * 144, I1 = 16 * 64, I2 = 8 * 32, I3 = 16 * 32, I4 = 16 * 32, I5 = 16 * 256, I6 = 16 * 256, I7 = 48 * 256;
    constexpr int NITEMS = I0 + I1 + I2 + I3 + I4 + I5 + I6 + I7;
    for (int it = gw; it < NITEMS; it += NGW) {
        int r = it; TJob J;
        if (r < I0) { J = TJob{a.in[2], 4608, (bf16*)(ws + WS_W1), 1024, 0, 1, 0}; }
        else if ((r -= I0) < I1) { J = TJob{a.in[3], 2048, (bf16*)(ws + WS_W1), 1024, 0, 0, 4608}; }
        else if ((r -= I1) < I2) { J = TJob{a.in[5], 1024, (bf16*)(ws + WS_WSB), 512, 0, 0, 0}; }
        else if ((r -= I2) < I3) { J = TJob{a.in[6], 1024, (bf16*)(ws + WS_WRET), 1024, 0, 0, 0}; }
        else if ((r -= I3) < I4) { J = TJob{a.in[8], 1024, (bf16*)(ws + WS_WOUT), 1024, 0, 0, 0}; }
        else if ((r -= I4) < I5) { const int e = r >> 8; r &= 255; J = TJob{a.in[14] + (size_t)e * 1024 * 512, 512, (bf16*)(ws + WS_WUP) + (size_t)e * 1024 * 1024, 1024, 0, 2, 0}; }
        else if ((r -= I5) < I6) { const int e = r >> 8; r &= 255; J = TJob{a.in[15] + (size_t)e * 1024 * 512, 512, (bf16*)(ws + WS_WUP) + (size_t)e * 1024 * 1024, 1024, 0, 3, 0}; }
        else { r -= I6; const int cs = r >> 8; r &= 255; const int cls = cs >> 1, slot = cs & 1, g = cls / 6, p = cls % 6;
            const int pa = p < 3 ? 0 : (p < 5 ? 1 : 2), pb = p == 0 ? 1 : (p == 1 ? 2 : (p == 2 ? 3 : (p == 3 ? 2 : 3)));
            const int e = 4 * g + (slot ? pb : pa);
            J = TJob{a.in[16] + (size_t)e * 512 * 1024, 1024, (bf16*)(ws + WS_WDN) + (size_t)cls * 1024 * 1024, 1024, slot * 512, 0, 0}; }
        p0_transpose_item(J, scr, r, lane);
    }
    const float* x = a.in[0]; const float* g = a.in[1]; bf16* xn = (bf16*)(ws + WS_R1);
    f32x4 gv[4];
#pragma unroll
    for (int j = 0; j < 4; ++j) gv[j] = ((const f32x4*)g)[lane + 64 * j];
    for (int m = gw; m < T; m += NGW) {
        const GAS f32x4* xr = (const GAS f32x4*)(x + (size_t)m * DM) + lane;
        f32x4 v[4]; float s = 0.f;
#pragma unroll
        for (int j = 0; j < 4; ++j) { v[j] = xr[64 * j]; s += (v[j].x * v[j].x + v[j].y * v[j].y) + (v[j].z * v[j].z + v[j].w * v[j].w); }
        const float rstd = 1.f / sqrtf(wave_sum(s) * (1.f / DM) + EPS);
        GAS unsigned long long* o8 = (GAS unsigned long long*)(xn + (size_t)m * DM) + lane;
#pragma unroll
        for (int j = 0; j < 4; ++j) { const f32x4 y = v[j] * rstd * gv[j]; o8[64 * j] = (unsigned long long)pk2(y.x, y.y) | ((unsigned long long)pk2(y.z, y.w) << 32); }
    }
    float* rot = (float*)(ws + WS_ROT);
    for (int idx = gw * 64 + lane; idx < SEQ * 32; idx += NGW * 64) {
        const int pos = idx >> 5, i = idx & 31;
        const float inv = (float)exp(-(double)i * (9.210340371976184 / 32.0));
        const float ang = (float)pos * inv;
        rot[idx] = (float)cos((double)ang); rot[SEQ * 32 + idx] = (float)sin((double)ang);
    }
}

typedef pg8::Unit Unit;
using pg8::cvt_pk_bf16;
__device__ __forceinline__ v4u pack8(const f32x4 a, const f32x4 b) { v4u w; w.x = cvt_pk_bf16(a[0], a[1]); w.y = cvt_pk_bf16(a[2], a[3]); w.z = cvt_pk_bf16(b[0], b[1]); w.w = cvt_pk_bf16(b[2], b[3]); return w; }
__device__ __forceinline__ float sigm(float x) { return 1.f / (1.f + __expf(-x)); }

struct Epi1 {
    static constexpr bool PERM = true, AFTER_DRAIN = false;
    bf16 *sbq, *sbk, *sbv, *rq, *rk, *rv, *rg, *gates; const float* bgate; const float* rot;
    __device__ __forceinline__ void operator()(const f32x4 (&acc)[2][2][4][2], const Unit& u, int wr, int wc, int fr, int fq) const {
        const int pn = u.tag, rowb = u.row0 + wr * 64 + fr, cw = wc * 32 + 8 * fq;
        if (pn >= 6 && pn < 10) {
            bf16* base = (pn < 8 ? rq : rk) + ((pn & 1) * 4 + wc) * 64 + 8 * fq;
#pragma unroll
            for (int ai = 0; ai < 2; ++ai)
#pragma unroll
                for (int m = 0; m < 4; ++m) { const int row = rowb + ai * 128 + m * 16, pos = row & (SEQ - 1);
                    const f32x4 c0 = *(const f32x4*)(rot + pos * 32 + 8 * fq), c1 = *(const f32x4*)(rot + pos * 32 + 8 * fq + 4);
                    const f32x4 s0 = *(const f32x4*)(rot + SEQ * 32 + pos * 32 + 8 * fq), s1 = *(const f32x4*)(rot + SEQ * 32 + pos * 32 + 8 * fq + 4);
                    const f32x4 x10 = acc[ai][0][m][0], x11 = acc[ai][0][m][1], x20 = acc[ai][1][m][0], x21 = acc[ai][1][m][1];
                    const f32x4 o10 = x10 * c0 - x20 * s0, o11 = x11 * c1 - x21 * s1, o20 = x20 * c0 + x10 * s0, o21 = x21 * c1 + x11 * s1;
                    bf16* rowp = base + (size_t)row * 512;
                    *(v4u*)rowp = pack8(o10, o11); *(v4u*)(rowp + 32) = pack8(o20, o21); }
            return;
        }
        bf16* base; int ld, colt, act = 0;
        if (pn < 2) { base = sbq; ld = 512; colt = pn * 256; } else if (pn < 4) { base = sbk; ld = 512; colt = (pn - 2) * 256; }
        else if (pn < 6) { base = sbv; ld = 512; colt = (pn - 4) * 256; } else if (pn < 14) { base = rv; ld = 1024; colt = (pn - 10) * 256; }
        else if (pn < 18) { base = rg; ld = 1024; colt = (pn - 14) * 256; act = 1; } else { base = gates; ld = 2048; colt = (pn - 18) * 256; act = 2; }
        f32x4 bv[2][2];
#pragma unroll
        for (int bj = 0; bj < 2; ++bj)
#pragma unroll
            for (int n = 0; n < 2; ++n) bv[bj][n] = act == 2 ? *(const f32x4*)(bgate + colt + bj * 128 + cw + 4 * n) : (f32x4){0.f, 0.f, 0.f, 0.f};
#pragma unroll
        for (int ai = 0; ai < 2; ++ai)
#pragma unroll
            for (int m = 0; m < 4; ++m) { bf16* rowp = base + (size_t)(rowb + ai * 128 + m * 16) * ld + colt + cw;
#pragma unroll
                for (int bj = 0; bj < 2; ++bj) { f32x4 v0 = acc[ai][bj][m][0] + bv[bj][0], v1 = acc[ai][bj][m][1] + bv[bj][1];
                    if (act == 1) {
#pragma unroll
                        for (int j = 0; j < 4; ++j) { v0[j] = v0[j] * sigm(v0[j]); v1[j] = v1[j] * sigm(v1[j]); } }
                    else if (act == 2) {
#pragma unroll
                        for (int j = 0; j < 4; ++j) { v0[j] = sigm(v0[j]); v1[j] = sigm(v1[j]); } }
                    *(v4u*)(rowp + bj * 128) = pack8(v0, v1); } }
    }
};
template <bool ADD> struct EpiMix {
    static constexpr bool PERM = true, AFTER_DRAIN = false;
    const bf16* gates; int goff; const bf16* prev; bf16* out;
    __device__ __forceinline__ void operator()(const f32x4 (&acc)[2][2][4][2], const Unit& u, int wr, int wc, int fr, int fq) const {
        const int rowb = u.row0 + wr * 64 + fr, colb = u.col0 + wc * 32 + 8 * fq;
#pragma unroll
        for (int ai = 0; ai < 2; ++ai)
#pragma unroll
            for (int m = 0; m < 4; ++m) { const size_t row = rowb + ai * 128 + m * 16;
#pragma unroll
                for (int bj = 0; bj < 2; ++bj) { const int col = colb + bj * 128;
                    const v4u g = *(const v4u*)(gates + row * 2048 + goff + col);
                    f32x4 v0 = acc[ai][bj][m][0], v1 = acc[ai][bj][m][1];
                    v0[0] *= bflo(g.x); v0[1] *= bfhi(g.x); v0[2] *= bflo(g.y); v0[3] *= bfhi(g.y); v1[0] *= bflo(g.z); v1[1] *= bfhi(g.z); v1[2] *= bflo(g.w); v1[3] *= bfhi(g.w);
                    if (ADD) { const v4u p = *(const v4u*)(prev + row * 1024 + col);
                        v0[0] += bflo(p.x); v0[1] += bfhi(p.x); v0[2] += bflo(p.y); v0[3] += bfhi(p.y); v1[0] += bflo(p.z); v1[1] += bfhi(p.z); v1[2] += bflo(p.w); v1[3] += bfhi(p.w); }
                    *(v4u*)(out + row * 1024 + col) = pack8(v0, v1); } }
    }
};
struct EpiOut {
    static constexpr bool PERM = false, AFTER_DRAIN = false;
    const float* x; float* out;
    __device__ __forceinline__ void operator()(const f32x4 (&acc)[2][2][4][2], const Unit& u, int wr, int wc, int fr, int fq) const {
        const int rowb = u.row0 + wr * 64 + fr, colb = u.col0 + wc * 32 + 4 * fq;
#pragma unroll
        for (int ai = 0; ai < 2; ++ai)
#pragma unroll
            for (int m = 0; m < 4; ++m) { const size_t off = (size_t)(rowb + ai * 128 + m * 16) * 1024 + colb;
#pragma unroll
                for (int bj = 0; bj < 2; ++bj)
#pragma unroll
                    for (int n = 0; n < 2; ++n) *(f32x4*)(out + off + bj * 128 + n * 16) = *(const f32x4*)(x + off + bj * 128 + n * 16) + acc[ai][bj][m][n]; }
    }
};
struct EpiUp {
    static constexpr bool PERM = true, AFTER_DRAIN = false;
    const SInfo* sinfo; bf16* hid;
    __device__ __forceinline__ void operator()(const f32x4 (&acc)[2][2][4][2], const Unit& u, int wr, int wc, int fr, int fq) const {
        const int ct = u.tag, rowb = u.row0 + wr * 64 + fr, col = ct * 128 + wc * 32 + 8 * fq;
#pragma unroll
        for (int ai = 0; ai < 2; ++ai)
#pragma unroll
            for (int m = 0; m < 4; ++m) { const size_t row = rowb + ai * 128 + m * 16; const SInfo si = sinfo[row]; const float gw = ct < 4 ? si.ga : si.gb;
                f32x4 v0, v1;
#pragma unroll
                for (int j = 0; j < 4; ++j) { const float g0 = acc[ai][0][m][0][j], g1 = acc[ai][0][m][1][j];
                    v0[j] = g0 * sigm(g0) * acc[ai][1][m][0][j] * gw; v1[j] = g1 * sigm(g1) * acc[ai][1][m][1][j] * gw; }
                *(v4u*)(hid + row * 1024 + col) = pack8(v0, v1); }
    }
};
struct EpiDown {
    static constexpr bool PERM = false, AFTER_DRAIN = false;
    const SInfo* sinfo; float* out;
    __device__ __forceinline__ void operator()(const f32x4 (&acc)[2][2][4][2], const Unit& u, int wr, int wc, int fr, int fq) const {
        const int rowb = u.row0 + wr * 64 + fr, colb = u.col0 + wc * 32 + 4 * fq;
#pragma unroll
        for (int ai = 0; ai < 2; ++ai)
#pragma unroll
            for (int m = 0; m < 4; ++m) { const int tok = sinfo[rowb + ai * 128 + m * 16].tok;
                if (tok >= 0) { float* p = out + (size_t)tok * 1024 + colb;
#pragma unroll
                    for (int bj = 0; bj < 2; ++bj)
#pragma unroll
                        for (int n = 0; n < 2; ++n) *(f32x4*)(p + bj * 128 + n * 16) = *(const f32x4*)(p + bj * 128 + n * 16) + acc[ai][bj][m][n]; } }
    }
};
struct MoeOrder {
    const char* A; const char* B; const volatile LAS int* tstart; int nct, up, G, c;
    __device__ bool next(int i, Unit& u) const {
        const int L = i * G + c; const int ntile = __builtin_amdgcn_readfirstlane(tstart[NCLS]);
        const int rt = L / nct, ct = L % nct; if (rt >= ntile) return false;
        int cls = 0;
        for (int k = 1; k < NCLS; ++k) cls += (rt >= __builtin_amdgcn_readfirstlane(tstart[k])) ? 1 : 0;
        const int g = cls / 6, p = cls % 6, pa = p < 3 ? 0 : (p < 5 ? 1 : 2), pb = p == 0 ? 1 : (p == 1 ? 2 : (p == 2 ? 3 : (p == 3 ? 2 : 3)));
        u.a = A + (size_t)rt * 256 * 1024 * 2; u.row0 = rt * 256; u.tag = ct;
        if (up) { const int e = 4 * g + (ct < 4 ? pa : pb); u.b = B + ((size_t)e * 1024 + (ct & 3) * 256) * 1024 * 2; u.col0 = ct * 128; }
        else { u.b = B + ((size_t)cls * 1024 + ct * 256) * 1024 * 2; u.col0 = ct * 256; }
        return true;
    }
    __device__ __forceinline__ void a_ready(const Unit&) const {}
    __device__ __forceinline__ void done(const Unit&) const {}
};

typedef float f32x16 __attribute__((ext_vector_type(16)));
typedef short s16x4 __attribute__((ext_vector_type(4)));
typedef float f32x2_t __attribute__((ext_vector_type(2))); typedef __bf16 bf16x2_t __attribute__((ext_vector_type(2)));
__device__ __forceinline__ unsigned cvtpk_s(float lo, float hi) { f32x2_t v = {lo, hi}; bf16x2_t b = __builtin_convertvector(v, bf16x2_t); return __builtin_bit_cast(unsigned, b); }
__device__ __forceinline__ s16x4 vtr(const LAS unsigned char* p) { return __builtin_bit_cast(s16x4, __builtin_amdgcn_ds_read_tr16_b64_v4i16((LAS s16x4*)p)); }
__device__ __forceinline__ int crow(int r, int hi) { return (r & 3) + 8 * (r >> 2) + 4 * hi; }
#define MFMA32(a, b, c) __builtin_amdgcn_mfma_f32_32x32x16_bf16((a), (b), (c), 0, 0, 0)
__device__ __forceinline__ bf16x8 packfrag(const f32x16& p, int s) {
    v4u w; w.x = cvtpk_s(p[8 * s], p[8 * s + 1]); w.y = cvtpk_s(p[8 * s + 2], p[8 * s + 3]); w.z = cvtpk_s(p[8 * s + 4], p[8 * s + 5]); w.w = cvtpk_s(p[8 * s + 6], p[8 * s + 7]);
    return __builtin_bit_cast(bf16x8, w);
}
__device__ __forceinline__ bf16x8 vfrag(const LAS unsigned char* p, int rowbytes) {
    const s16x4 lo = vtr(p), hi_ = vtr(p + 8 * rowbytes);
    return (bf16x8){lo[0], lo[1], lo[2], lo[3], hi_[0], hi_[1], hi_[2], hi_[3]};
}
constexpr float SB_THR2 = -60.f;

template <bool MASK>
__device__ __forceinline__ void sb_tile(const LAS unsigned char* Kt, const LAS unsigned char* Vt, const bf16x8 (&qf)[4], const bf16x8 tri0, const bf16x8 tri1, const bf16x8 ones,
                                        f32x16& o0, f32x16& o1, float& R, int kt, int t, int hi, int kbase, int kx, int v0, int v1) {
    f32x16 p0 = {}, p1 = {};
#pragma unroll
    for (int ks = 0; ks < 4; ++ks) {
        const int co = kbase + (((2 * ks + hi) ^ kx) << 4);
        const bf16x8 a0 = *(const LAS bf16x8*)(Kt + co), a1 = *(const LAS bf16x8*)(Kt + 4096 + co);
        p0 = MFMA32(a0, qf[ks], p0); p1 = MFMA32(a1, qf[ks], p1);
    }
    f32x16 l0, l1; float cs = 0.f;
#pragma unroll
    for (int r = 0; r < 16; ++r) {
        const float z0 = p0[r], z1 = p1[r];
        float k0 = -(fmaxf(z0, 0.f) + __builtin_amdgcn_logf(1.f + __builtin_amdgcn_exp2f(-fabsf(z0))));
        float k1 = -(fmaxf(z1, 0.f) + __builtin_amdgcn_logf(1.f + __builtin_amdgcn_exp2f(-fabsf(z1))));
        if (MASK) { const int key = kt * 64 + crow(r, hi); k0 = key < t ? k0 : 0.f; k1 = key + 32 < t ? k1 : 0.f; }
        l0[r] = k0; l1[r] = k1; cs += k0 + k1;
    }
    cs += __shfl_xor(cs, 32);
    const bf16x8 lb00 = packfrag(l0, 0), lb01 = packfrag(l0, 1), lb10 = packfrag(l1, 0), lb11 = packfrag(l1, 1);
    f32x16 y0 = {}, y1 = {};
    y0 = MFMA32(tri0, lb00, y0); y0 = MFMA32(tri1, lb01, y0); y0 = MFMA32(ones, lb10, y0); y0 = MFMA32(ones, lb11, y0);
    y1 = MFMA32(tri0, lb10, y1); y1 = MFMA32(tri1, lb11, y1);
#pragma unroll
    for (int r = 0; r < 16; ++r) {
        float w0 = __builtin_amdgcn_exp2f(p0[r] + y0[r] + R), w1 = __builtin_amdgcn_exp2f(p1[r] + y1[r] + R);
        if (MASK) { const int key = kt * 64 + crow(r, hi); w0 = key < t ? w0 : 0.f; w1 = key + 32 < t ? w1 : 0.f; }
        p0[r] = w0; p1[r] = w1;
    }
    R += cs;
    const bf16x8 wb00 = packfrag(p0, 0), wb01 = packfrag(p0, 1), wb10 = packfrag(p1, 0), wb11 = packfrag(p1, 1);
    o0 = MFMA32(vfrag(Vt + 0 * 2048 + v0, 128), wb00, o0); o1 = MFMA32(vfrag(Vt + 0 * 2048 + v1, 128), wb00, o1);
    o0 = MFMA32(vfrag(Vt + 1 * 2048 + v0, 128), wb01, o0); o1 = MFMA32(vfrag(Vt + 1 * 2048 + v1, 128), wb01, o1);
    o0 = MFMA32(vfrag(Vt + 2 * 2048 + v0, 128), wb10, o0); o1 = MFMA32(vfrag(Vt + 2 * 2048 + v1, 128), wb10, o1);
    o0 = MFMA32(vfrag(Vt + 3 * 2048 + v0, 128), wb11, o0); o1 = MFMA32(vfrag(Vt + 3 * 2048 + v1, 128), wb11, o1);
}
__device__ __forceinline__ void unit_map(int u, int& bh, int& qb) {
    bh = u & 127; const int hb = (u >> 7) & 1, i = u >> 8;
    qb = hb ? (i == 0 ? 1 : (i == 1 ? 6 : (i == 2 ? 3 : 4))) : (i == 0 ? 0 : (i == 1 ? 7 : (i == 2 ? 2 : 5)));
}
__device__ __forceinline__ void sb_phase(const bf16* Q, const bf16* Kg, const bf16* Vg, bf16* O, LAS unsigned char* lds, int bx, int G, int tid, int wave, int lane) {
    const int r32 = lane & 31, hi = lane >> 5;
    bf16x8 tri0, tri1, ones;
#pragma unroll
    for (int j = 0; j < 8; ++j) { const int kk = 8 * (j >> 2) + 4 * hi + (j & 3); tri0[j] = kk >= r32 ? (short)0x3F80 : (short)0; tri1[j] = 16 + kk >= r32 ? (short)0x3F80 : (short)0; ones[j] = (short)0x3F80; }
    const int skey = tid >> 3, sc = tid & 7;
    const int kdst = skey * 128 + ((sc ^ (skey & 7)) << 4), vdst = 16384 + skey * 128 + ((sc * 16) ^ (((skey >> 1) & 1) << 6));
    const int kbase = r32 * 128, kx = r32 & 7;
    const int q4 = (lane & 15) >> 2, v0 = ((4 * hi + q4) * 128 + 32 * ((lane >> 4) & 1) + 8 * (lane & 3)) ^ (((q4 >> 1) & 1) << 6), v1 = v0 ^ 64;
    volatile LAS int* flags = (volatile LAS int*)(lds + 32768);
    for (int u = bx; u < 1024; u += G) {
        int bh, qb; unit_map(u, bh, qb);
        const int b = bh >> 3, h = bh & 7, q0w = qb * 256 + 32 * wave, my_kt = q0w >> 6, kt_hi = qb * 4 + 3, t = q0w + r32;
        const size_t rbase = (size_t)b * SEQ;
        bf16x8 qf[4];
#pragma unroll
        for (int ks = 0; ks < 4; ++ks) qf[ks] = *(const bf16x8*)(Q + (rbase + t) * 512 + h * 64 + 16 * ks + 8 * hi);
        f32x16 o0 = {}, o1 = {}; float R = 0.f;
        __syncthreads();
        { const size_t g = (rbase + kt_hi * 64 + skey) * 512 + h * 64 + sc * 8; const v4u kr = *(const v4u*)(Kg + g), vr = *(const v4u*)(Vg + g);
          *(LAS v4u*)(lds + kdst) = kr; *(LAS v4u*)(lds + vdst) = vr; }
        __syncthreads();
        bool mydone = false; int cur = 0;
        for (int kt = kt_hi; kt >= 0; --kt) {
            v4u kr = {}, vr = {};
            if (kt > 0) { const size_t g = (rbase + (kt - 1) * 64 + skey) * 512 + h * 64 + sc * 8; kr = *(const v4u*)(Kg + g); vr = *(const v4u*)(Vg + g); }
            if (kt <= my_kt && !mydone) {
                const LAS unsigned char* Kt = lds + cur * 8192; const LAS unsigned char* Vt = lds + 16384 + cur * 8192;
                if (kt == my_kt) sb_tile<true>(Kt, Vt, qf, tri0, tri1, ones, o0, o1, R, kt, t, hi, kbase, kx, v0, v1);
                else sb_tile<false>(Kt, Vt, qf, tri0, tri1, ones, o0, o1, R, kt, t, hi, kbase, kx, v0, v1);
                mydone = __all(R < SB_THR2) != 0;
            }
            if (kt > 0) { *(LAS v4u*)(lds + (cur ^ 1) * 8192 + kdst) = kr; *(LAS v4u*)(lds + (cur ^ 1) * 8192 + vdst) = vr; }
            if (lane == 0) flags[cur * 8 + wave] = mydone ? 1 : 0;
            __syncthreads();
            int alld = 1;
#pragma unroll
            for (int w = 0; w < 8; ++w) alld &= flags[cur * 8 + w];
            if (alld) break;
            cur ^= 1;
        }
        bf16* op = O + (rbase + t) * 512 + h * 64 + 4 * hi;
#pragma unroll
        for (int g4 = 0; g4 < 4; ++g4) {
            *(unsigned long long*)(op + 8 * g4) = (unsigned long long)cvtpk_s(o0[4 * g4], o0[4 * g4 + 1]) | ((unsigned long long)cvtpk_s(o0[4 * g4 + 2], o0[4 * g4 + 3]) << 32);
            *(unsigned long long*)(op + 32 + 8 * g4) = (unsigned long long)cvtpk_s(o1[4 * g4], o1[4 * g4 + 1]) | ((unsigned long long)cvtpk_s(o1[4 * g4 + 2], o1[4 * g4 + 3]) << 32);
        }
    }
}
__device__ __forceinline__ void ret_phase(const bf16* Q, const bf16* Kg, const bf16* Vg, const bf16* RG, const float* gn, bf16* Y, LAS unsigned char* lds, int bx, int G, int tid, int wave, int lane) {
    const int r32 = lane & 31, hi = lane >> 5;
    const int skey = tid >> 3, sc = tid & 7, kdst = skey * 128 + ((sc ^ (skey & 7)) << 4);
    const int vkey = tid >> 4, vc = tid & 15, vdst = 16384 + vkey * 256 + ((vc * 16) ^ ((vkey & 3) << 6));
    const int kbase = r32 * 128, kx = r32 & 7;
    const int q4 = (lane & 15) >> 2, vb = ((4 * hi + q4) * 256 + 32 * ((lane >> 4) & 1) + 8 * (lane & 3)) ^ (q4 << 6);
    for (int u = bx; u < 1024; u += G) {
        int bh, qb; unit_map(u, bh, qb);
        const int b = bh >> 3, h = bh & 7, q0w = qb * 256 + 32 * wave, my_kt = q0w >> 6, kt_hi = qb * 4 + 3, n = q0w + r32;
        const size_t rbase = (size_t)b * SEQ;
        const float lg2 = log2f(1.f - exp2f(-5.f - (float)h));
        bf16x8 qf[4];
#pragma unroll
        for (int ks = 0; ks < 4; ++ks) qf[ks] = *(const bf16x8*)(Q + (rbase + n) * 512 + h * 64 + 16 * ks + 8 * hi);
        f32x16 o[4] = {{}, {}, {}, {}};
        __syncthreads();
        { const v4u kr = *(const v4u*)(Kg + (rbase + skey) * 512 + h * 64 + sc * 8);
          const bf16* vp = Vg + (rbase + vkey) * 1024 + h * 128 + vc * 8; const v4u vr0 = *(const v4u*)vp, vr1 = *(const v4u*)(vp + 32 * 1024);
          *(LAS v4u*)(lds + kdst) = kr; *(LAS v4u*)(lds + vdst) = vr0; *(LAS v4u*)(lds + vdst + 32 * 256) = vr1; }
        __syncthreads();
        int cur = 0;
        for (int kt = 0; kt <= kt_hi; ++kt) {
            v4u kr = {}, vr0 = {}, vr1 = {};
            if (kt < kt_hi) { kr = *(const v4u*)(Kg + (rbase + (kt + 1) * 64 + skey) * 512 + h * 64 + sc * 8);
                const bf16* vp = Vg + (rbase + (kt + 1) * 64 + vkey) * 1024 + h * 128 + vc * 8; vr0 = *(const v4u*)vp; vr1 = *(const v4u*)(vp + 32 * 1024); }
            if (kt <= my_kt) {
                const LAS unsigned char* Kt = lds + cur * 8192; const LAS unsigned char* Vt = lds + 16384 + cur * 16384;
                f32x16 p0 = {}, p1 = {};
#pragma unroll
                for (int ks = 0; ks < 4; ++ks) {
                    const int co = kbase + (((2 * ks + hi) ^ kx) << 4);
                    const bf16x8 a0 = *(const LAS bf16x8*)(Kt + co), a1 = *(const LAS bf16x8*)(Kt + 4096 + co);
                    p0 = MFMA32(a0, qf[ks], p0); p1 = MFMA32(a1, qf[ks], p1);
                }
#pragma unroll
                for (int r = 0; r < 16; ++r) { const int m = kt * 64 + crow(r, hi);
                    p0[r] *= __builtin_amdgcn_exp2f(lg2 * fabsf((float)(n - m))); p1[r] *= __builtin_amdgcn_exp2f(lg2 * fabsf((float)(n - m - 32))); }
                const bf16x8 wb00 = packfrag(p0, 0), wb01 = packfrag(p0, 1), wb10 = packfrag(p1, 0), wb11 = packfrag(p1, 1);
#pragma unroll
                for (int dt = 0; dt < 4; ++dt) { const LAS unsigned char* vp = Vt + (vb ^ (dt << 6));
                    o[dt] = MFMA32(vfrag(vp + 0 * 4096, 256), wb00, o[dt]); o[dt] = MFMA32(vfrag(vp + 1 * 4096, 256), wb01, o[dt]);
                    o[dt] = MFMA32(vfrag(vp + 2 * 4096, 256), wb10, o[dt]); o[dt] = MFMA32(vfrag(vp + 3 * 4096, 256), wb11, o[dt]); }
            }
            if (kt < kt_hi) { *(LAS v4u*)(lds + (cur ^ 1) * 8192 + kdst) = kr; *(LAS v4u*)(lds + (cur ^ 1) * 16384 + vdst) = vr0; *(LAS v4u*)(lds + (cur ^ 1) * 16384 + vdst + 32 * 256) = vr1; }
            __syncthreads();
            cur ^= 1;
        }
        float ss = 0.f;
#pragma unroll
        for (int dt = 0; dt < 4; ++dt)
#pragma unroll
            for (int r = 0; r < 16; ++r) ss += o[dt][r] * o[dt][r];
        ss += __shfl_xor(ss, 32);
        const float rstd = 1.f / sqrtf(ss * (1.f / 128.f) + EPS);
        const size_t ob = (rbase + n) * 1024 + h * 128 + 4 * hi;
#pragma unroll
        for (int dt = 0; dt < 4; ++dt)
#pragma unroll
            for (int g4 = 0; g4 < 4; ++g4) { const int e = 32 * dt + 8 * g4;
                const f32x4 gv = *(const f32x4*)(gn + h * 128 + 4 * hi + e); const unsigned long long rg = *(const unsigned long long*)(RG + ob + e);
                const unsigned rl = (unsigned)rg, rh = (unsigned)(rg >> 32);
                const float y0 = o[dt][4 * g4] * rstd * gv[0] * bflo(rl), y1 = o[dt][4 * g4 + 1] * rstd * gv[1] * bfhi(rl), y2 = o[dt][4 * g4 + 2] * rstd * gv[2] * bflo(rh), y3 = o[dt][4 * g4 + 3] * rstd * gv[3] * bfhi(rh);
                *(unsigned long long*)(Y + ob + e) = (unsigned long long)cvtpk_s(y0, y1) | ((unsigned long long)cvtpk_s(y2, y3) << 32); }
    }
}

__device__ __forceinline__ void p_route(const Args& a, LAS unsigned char* lds, int vcu, int G, int wave, int lane, int tid) {
    const float* h = a.out; const float* gf = a.in[9]; const float* wg = a.in[10]; const float* bg = a.in[11]; const float* we = a.in[12]; const float* be = a.in[13];
    LAS float* lw = (LAS float*)lds;
    for (int i = tid; i < 1024 * 20; i += NTHR) { const int k = i / 20, o = i % 20; lw[i] = o < 4 ? wg[k * 4 + o] : we[k * 16 + o - 4]; }
    __syncthreads();
    const int gw = vcu * NWAVES + wave, NGW = G * NWAVES;
    TokInfo* tinfo = (TokInfo*)(a.ws + WS_TOK); float* rstd_o = (float*)(a.ws + WS_RSTD);
    unsigned* cnt = (unsigned*)(a.ws + WS_CTL) + CW_CNT;
    f32x4 gv[4];
#pragma unroll
    for (int j = 0; j < 4; ++j) gv[j] = ((const f32x4*)gf)[lane + 64 * j];
    for (int base = gw; base < T; base += NGW * 16) {
        int my_cls = -1; float my_ga = 0.f, my_gb = 0.f, my_rstd = 0.f;
        for (int j = 0; j < 16; ++j) {
            const int t = base + NGW * j; if (t >= T) break;
            const GAS f32x4* xr = (const GAS f32x4*)(h + (size_t)t * DM) + lane;
            f32x4 v[4]; float s = 0.f;
#pragma unroll
            for (int jj = 0; jj < 4; ++jj) { v[jj] = xr[64 * jj]; s += (v[jj].x * v[jj].x + v[jj].y * v[jj].y) + (v[jj].z * v[jj].z + v[jj].w * v[jj].w); }
            const float rstd = 1.f / sqrtf(wave_sum(s) * (1.f / DM) + EPS);
            float part[20];
#pragma unroll
            for (int o = 0; o < 20; ++o) part[o] = 0.f;
#pragma unroll
            for (int jj = 0; jj < 4; ++jj) { const f32x4 y = v[jj] * rstd * gv[jj];
#pragma unroll
                for (int e = 0; e < 4; ++e) { const LAS f32x4* wp = (const LAS f32x4*)(lw + (256 * jj + 4 * lane + e) * 20);
#pragma unroll
                    for (int o4 = 0; o4 < 5; ++o4) { const f32x4 w = wp[o4]; part[4*o4] += y[e] * w[0]; part[4*o4+1] += y[e] * w[1]; part[4*o4+2] += y[e] * w[2]; part[4*o4+3] += y[e] * w[3]; } } }
#pragma unroll
            for (int o = 0; o < 20; ++o) part[o] = wave_sum(part[o]);
            float gl[4];
#pragma unroll
            for (int o = 0; o < 4; ++o) gl[o] = part[o] + bg[o];
            int gi = 0; float gm = gl[0];
#pragma unroll
            for (int o = 1; o < 4; ++o) if (gl[o] > gm) { gm = gl[o]; gi = o; }
            float gs = 0.f;
#pragma unroll
            for (int o = 0; o < 4; ++o) gs += __expf(gl[o] - gm);
            const float pgrp = 1.f / gs;
            float el[4];
#pragma unroll
            for (int e = 0; e < 4; ++e) { const float l0 = part[4 + e] + be[e], l1 = part[8 + e] + be[4 + e], l2 = part[12 + e] + be[8 + e], l3 = part[16 + e] + be[12 + e];
                el[e] = gi == 0 ? l0 : (gi == 1 ? l1 : (gi == 2 ? l2 : l3)); }
            int i1 = 0; float m1 = el[0];
#pragma unroll
            for (int e = 1; e < 4; ++e) if (el[e] > m1) { m1 = el[e]; i1 = e; }
            int i2 = -1; float m2 = -3.0e38f;
#pragma unroll
            for (int e = 0; e < 4; ++e) if (e != i1 && el[e] > m2) { m2 = el[e]; i2 = e; }
            const float s1 = 1.f / (1.f + __expf(m2 - m1)), g1 = s1 * pgrp, g2 = (1.f - s1) * pgrp;
            const int pa = i1 < i2 ? i1 : i2, pb = i1 < i2 ? i2 : i1;
            const float ga = i1 < i2 ? g1 : g2, gb = i1 < i2 ? g2 : g1;
            const int pidx = pa == 0 ? pb - 1 : (pa == 1 ? pb + 1 : 5);
            if (lane == j) { my_cls = gi * 6 + pidx; my_ga = ga; my_gb = gb; my_rstd = rstd; }
        }
        int my_pos = 0;
        for (int c = 0; c < NCLS; ++c) {
            const unsigned long long mask = __ballot(my_cls == c);
            if (mask) { const int nn = __popcll(mask), leader = __ffsll((long long)mask) - 1; unsigned bse = 0;
                if (lane == leader) bse = __hip_atomic_fetch_add(cnt + 64 * c, (unsigned)nn, __ATOMIC_RELAXED, __HIP_MEMORY_SCOPE_AGENT);
                bse = __shfl(bse, leader);
                if (my_cls == c) my_pos = (int)bse + __popcll(mask & ((1ull << lane) - 1ull)); }
        }
        if (my_cls >= 0) { const int t = base + NGW * lane; tinfo[t] = TokInfo{my_cls, my_pos, my_ga, my_gb}; rstd_o[t] = my_rstd; }
    }
}
__device__ __forceinline__ void build_class_table(const Args& a, volatile LAS int* tab, int tid) {
    if (tid == 0) { const unsigned* cnt = (const unsigned*)(a.ws + WS_CTL) + CW_CNT; int acc_ = 0;
        for (int c = 0; c < NCLS; ++c) { tab[c] = acc_; const int n = (int)__hip_atomic_load(cnt + 64 * c, __ATOMIC_RELAXED, __HIP_MEMORY_SCOPE_AGENT); tab[32 + c] = n; acc_ += (n + 255) >> 8; }
        tab[NCLS] = acc_; }
    __syncthreads();
}
__device__ __forceinline__ void p_scatter(const Args& a, volatile LAS int* tab, int vcu, int G, int wave, int lane, int tid) {
    const float* h = a.out; const float* gf = a.in[9];
    const TokInfo* tinfo = (const TokInfo*)(a.ws + WS_TOK); const float* rstd_i = (const float*)(a.ws + WS_RSTD);
    SInfo* sinfo = (SInfo*)(a.ws + WS_SINFO); bf16* hns = (bf16*)(a.ws + WS_HNS);
    const int gw = vcu * NWAVES + wave, NGW = G * NWAVES;
    f32x4 gv[4];
#pragma unroll
    for (int j = 0; j < 4; ++j) gv[j] = ((const f32x4*)gf)[lane + 64 * j];
    for (int t = gw; t < T; t += NGW) {
        const TokInfo ti = tinfo[t]; const float rstd = rstd_i[t];
        const int srow = tab[ti.cls] * 256 + ti.pos;
        const GAS f32x4* xr = (const GAS f32x4*)(h + (size_t)t * DM) + lane;
        GAS unsigned long long* o8 = (GAS unsigned long long*)(hns + (size_t)srow * DM) + lane;
#pragma unroll
        for (int j = 0; j < 4; ++j) { const f32x4 y = xr[64 * j] * rstd * gv[j]; o8[64 * j] = (unsigned long long)pk2(y.x, y.y) | ((unsigned long long)pk2(y.z, y.w) << 32); }
        if (lane == 0) sinfo[srow] = SInfo{t, ti.ga, ti.gb, 0};
    }
    for (int idx = (vcu * NTHR + tid); idx < NCLS * 256; idx += G * NTHR) { const int c = idx >> 8, r = tab[32 + c] + (idx & 255);
        if (r < (((tab[32 + c] + 255) >> 8) << 8)) sinfo[tab[c] * 256 + r] = SInfo{-1, 0.f, 0.f, 0}; }
}
__device__ __forceinline__ void p_final(const Args& a, int vcu, int G, int wave, int lane) {
    float* h = a.out; const float* gf = a.in[17];
    const int gw = vcu * NWAVES + wave, NGW = G * NWAVES;
    f32x4 gv[4];
#pragma unroll
    for (int j = 0; j < 4; ++j) gv[j] = ((const f32x4*)gf)[lane + 64 * j];
    for (int t = gw; t < T; t += NGW) {
        GAS f32x4* xr = (GAS f32x4*)(h + (size_t)t * DM) + lane;
        f32x4 v[4]; float s = 0.f;
#pragma unroll
        for (int j = 0; j < 4; ++j) { v[j] = xr[64 * j]; s += (v[j].x * v[j].x + v[j].y * v[j].y) + (v[j].z * v[j].z + v[j].w * v[j].w); }
        const float rstd = 1.f / sqrtf(wave_sum(s) * (1.f / DM) + EPS);
#pragma unroll
        for (int j = 0; j < 4; ++j) xr[64 * j] = v[j] * rstd * gv[j];
    }
}

#ifndef MK_ONE_LAUNCH
#define MK_ONE_LAUNCH 1
#endif
constexpr int NPHASE = 11;
__global__ void __launch_bounds__(NTHR, 2) fwd_kernel(Args args) {
    extern __shared__ __attribute__((aligned(16))) unsigned char lds_raw[];
    LAS unsigned char* lds = (LAS unsigned char*)lds_raw;
    volatile LAS unsigned* MISC = (volatile LAS unsigned*)(lds + MISC_OFF);
    volatile LAS int* tab = (volatile LAS int*)(lds + TAB_OFF);
    const int tid = threadIdx.x, lane = tid & 63, wave = __builtin_amdgcn_readfirstlane(tid >> 6);
    const int G = gridDim.x; const int bx = blockIdx.x; const int vcu = (G % 8 == 0) ? (bx % 8) * (G / 8) + bx / 8 : bx;
    unsigned char* ws = args.ws;
    for (int u = tid; u < (LDS_BYTES - LDSCTL_OFF) / 4; u += NTHR) ((LAS unsigned*)(lds + LDSCTL_OFF))[u] = 0u;
    __syncthreads();
    XcdBarrier bar; bar.bar = (unsigned*)(ws + WS_CTL) + CW_BAR; bar.x = 0; bar.st = nullptr;
    if (MK_ONE_LAUNCH) bar = xcd_barrier_post((unsigned*)(ws + WS_CTL) + CW_BAR, MISC + 8);
    const int lo = args.ph_lo, hi = args.ph_hi;
#define IN(k) (lo <= (k) && (k) < hi)
#define SEAM(k) do { if (MK_ONE_LAUNCH && IN(k) && IN((k) + 1)) xcd_barrier(bar); } while (0)
    bf16* W1 = (bf16*)(ws + WS_W1); bf16* XN = (bf16*)(ws + WS_R1); bf16* YRET = (bf16*)(ws + WS_R1); bf16* HIDS = (bf16*)(ws + WS_R1);
    bf16* SBQ = (bf16*)(ws + WS_SBQ); bf16* SBK = (bf16*)(ws + WS_SBK); bf16* SBV = (bf16*)(ws + WS_SBV); bf16* RQ = (bf16*)(ws + WS_RQ); bf16* RK = (bf16*)(ws + WS_RK);
    bf16* RV = (bf16*)(ws + WS_RV); bf16* RG = (bf16*)(ws + WS_RG); bf16* YSB = (bf16*)(ws + WS_YSB); bf16* GATES = (bf16*)args.out;
    bf16* TMP = (bf16*)(ws + WS_TMP); bf16* MIX = (bf16*)(ws + WS_MIX); bf16* HNS = (bf16*)(ws + WS_HNS);
    const SInfo* sinfo = (const SInfo*)(ws + WS_SINFO);

    if (IN(0)) { p0_prologue(args, lds, vcu, G, wave, lane); }
    SEAM(0);
    if (IN(1)) {
        pg8::StaticOrder S; S.init(XN, W1, T, N1, 1024, G, bx);
        Epi1 E{SBQ, SBK, SBV, RQ, RK, RV, RG, GATES, args.in[4], (const float*)(ws + WS_ROT)};
        pg8::gemm_phase<Epi1, pg8::StaticOrder, true, true>(lds, 1024, S, E);
    }
    SEAM(1);
    if (IN(2)) {
        ret_phase(RQ, RK, RV, RG, args.in[7], YRET, lds, bx, G, tid, wave, lane);
        __syncthreads();
        sb_phase(SBQ, SBK, SBV, YSB, lds, bx, G, tid, wave, lane);
        __syncthreads();
    }
    SEAM(2);
    if (IN(3)) {
        pg8::StaticOrder S; S.init(YSB, ws + WS_WSB, T, 1024, 512, G, bx);
        EpiMix<false> E{GATES, 0, nullptr, TMP};
        pg8::gemm_phase<EpiMix<false>, pg8::StaticOrder, true, true>(lds, 512, S, E);
    }
    SEAM(3);
    if (IN(4)) {
        pg8::StaticOrder S; S.init(YRET, ws + WS_WRET, T, 1024, 1024, G, bx);
        EpiMix<true> E{GATES, 1024, TMP, MIX};
        pg8::gemm_phase<EpiMix<true>, pg8::StaticOrder, true, true>(lds, 1024, S, E);
    }
    SEAM(4);
    if (IN(5)) {
        pg8::StaticOrder S; S.init(MIX, ws + WS_WOUT, T, 1024, 1024, G, bx);
        EpiOut E{args.in[0], args.out};
        pg8::gemm_phase<EpiOut, pg8::StaticOrder, true, true>(lds, 1024, S, E);
    }
    SEAM(5);
    if (IN(6)) { p_route(args, lds, vcu, G, wave, lane, tid); __syncthreads(); }
    SEAM(6);
    if (IN(7)) { build_class_table(args, tab, tid); p_scatter(args, tab, vcu, G, wave, lane, tid); }
    SEAM(7);
    if (IN(8)) {
        build_class_table(args, tab, tid);
        MoeOrder S{(const char*)HNS, (const char*)(ws + WS_WUP), tab, 8, 1, G, bx};
        EpiUp E{sinfo, HIDS};
        pg8::gemm_phase<EpiUp, MoeOrder, true, true>(lds, 1024, S, E);
    }
    SEAM(8);
    if (IN(9)) {
        build_class_table(args, tab, tid);
        MoeOrder S{(const char*)HIDS, (const char*)(ws + WS_WDN), tab, 4, 0, G, bx};
        EpiDown E{sinfo, args.out};
        pg8::gemm_phase<EpiDown, MoeOrder, true, true>(lds, 1024, S, E);
    }
    SEAM(9);
    if (IN(10)) { p_final(args, vcu, G, wave, lane); }
#undef IN
#undef SEAM
}

extern "C" void kernel_launch(void* const* d_in, const int* in_sizes, int n_in, void* d_out, int out_size, void* d_ws, size_t ws_size, hipStream_t stream) {
    static int grid = 0;
    if (grid == 0) {
        if (n_in != 18 || in_sizes[0] != T * DM || out_size != T * DM || ws_size < WS_END) { fprintf(stderr, "kernel_launch: unexpected shapes (n_in %d, in0 %d, out %d, ws %zu < %zu)\n", n_in, n_in > 0 ? in_sizes[0] : -1, out_size, ws_size, (size_t)WS_END); grid = -1; return; }
        int dev = 0, cus = 0, per_cu = 0;
        if (hipGetDevice(&dev) != hipSuccess || hipDeviceGetAttribute(&cus, hipDeviceAttributeMultiprocessorCount, dev) != hipSuccess) { grid = -1; return; }
        if (hipFuncSetAttribute((const void*)fwd_kernel, hipFuncAttributeMaxDynamicSharedMemorySize, LDS_BYTES) != hipSuccess) { fprintf(stderr, "kernel_launch: hipFuncSetAttribute failed\n"); grid = -1; return; }
        if (hipOccupancyMaxActiveBlocksPerMultiprocessor(&per_cu, (const void*)fwd_kernel, NTHR, LDS_BYTES) != hipSuccess || per_cu < 1) fprintf(stderr, "kernel_launch: occupancy query reports %d\n", per_cu);
        (void)hipGetLastError();
        grid = cus;
    }
    if (grid < 0) return;
    hipMemsetAsync((char*)d_ws + WS_CTL, 0, CTL_ZERO_BYTES, stream);
    Args a{};
    for (int i = 0; i < 18; ++i) a.in[i] = (const float*)d_in[i];
    a.out = (float*)d_out; a.ws = (unsigned char*)d_ws;
#if MK_ONE_LAUNCH
    a.ph_lo = 0; a.ph_hi = NPHASE;
    hipLaunchKernelGGL(fwd_kernel, dim3(grid), dim3(NTHR), LDS_BYTES, stream, a);
#else
    for (int p = 0; p < NPHASE; ++p) { a.ph_lo = p; a.ph_hi = p + 1; hipLaunchKernelGGL(fwd_kernel, dim3(grid), dim3(NTHR), LDS_BYTES, stream, a); }
#endif
}
```

```cpp
#include <hip/hip_runtime.h>
#include <cstdio>
#include <cstdint>
namespace pg8 {
#define PG8_LAS __attribute__((address_space(3)))
typedef unsigned short bf16_t;
typedef short bf16x8 __attribute__((ext_vector_type(8)));
typedef float f32x4 __attribute__((ext_vector_type(4)));
typedef unsigned u32x4 __attribute__((ext_vector_type(4)));
constexpr int BM = 256, BK = 64, HALF = 128, HTB = HALF * BK * 2  , STAGE_BYTES = 8 * HTB, NXCD = 8, WGM = 8;
__host__ __device__ __forceinline__ int lds_byte(int r, int c) { const int st = (r >> 4) * 2 + (c >> 5), rr = r & 15, cc = c & 31, ob = rr * 64 + cc * 2; return st * 1024 + (ob ^ (((ob >> 9) & 1) << 5)); }
__host__ __device__ __forceinline__ void stage_rc(int b, int& R, int& C) { const int st = b / 1024, sb = b % 1024, swz = sb ^ (((sb >> 9) & 1) << 5); R = (st >> 1) * 16 + swz / 64; C = (st & 1) * 32 + (swz % 64) / 2; }
__host__ __device__ __forceinline__ int perm32(int rho) { const int n = rho >> 4, i = rho & 15; return 8 * (i >> 2) + 4 * n + (i & 3); }

struct Unit { const char* a; const char* b; int row0, col0, tag; };
struct StaticOrder {
    const char* A; const char* Bt; int K, nM, nN, nwg, G, c;
    __device__ void init(const void* A_, const void* Bt_, int M, int N, int K_, int G_, int c_) { A = (const char*)A_; Bt = (const char*)Bt_; K = K_; nM = M / BM; nN = N / BM; nwg = nM * nN; G = G_; c = c_; }
    __device__ bool next(int i, Unit& u) const {
        const long L = (long)i * G + c; if (L >= nwg) return false;
        int wgid = (int)L; { const int q = nwg / NXCD, r = nwg % NXCD, xcd = wgid % NXCD, off = wgid / NXCD; wgid = (xcd < r ? xcd * (q + 1) : r * (q + 1) + (xcd - r) * q) + off; }
        const int nig = WGM * nN, gid = wgid / nig, fm = gid * WGM, gsz = (nM - fm) < WGM ? (nM - fm) : WGM;
        const int pm = fm + ((wgid % nig) % gsz), pn = (wgid % nig) / gsz;
        u.a = A + (size_t)pm * BM * K * 2; u.b = Bt + (size_t)pn * BM * K * 2; u.row0 = pm * BM; u.col0 = pn * BM; u.tag = pn; return true;
    }
    __device__ __forceinline__ void a_ready(const Unit&) const {}
    __device__ __forceinline__ void done(const Unit&) const {}
};
__device__ __forceinline__ unsigned cvt_pk_bf16(float lo, float hi) { unsigned r; asm volatile("v_cvt_pk_bf16_f32 %0, %1, %2" : "=v"(r) : "v"(lo), "v"(hi)); return r; }
template <class Epi, class Sched, bool ALIGN_EPI = false, bool SP2 = false>
__device__ __forceinline__ void gemm_phase(PG8_LAS unsigned char* lds, const int K, const Sched& S, const Epi& E) {
    const int tid = threadIdx.x, wid = __builtin_amdgcn_readfirstlane(tid >> 6), lane = tid & 63, wr = wid >> 2, wc = wid & 3, fr = lane & 15, fq = lane >> 4;
    const int nt = K / BK;
    unsigned voffA[2], voffB[2];
#pragma unroll
    for (int i = 0; i < 2; ++i) { int R, C; stage_rc(tid * 16 + i * 8192, R, C); const int Rb = Epi::PERM ? ((R & ~31) + perm32(R & 31)) : R;
        voffA[i] = (unsigned)(R * K + C) * 2u; voffB[i] = (unsigned)(Rb * K + C) * 2u; }
    const size_t kstep = (size_t)(BK * 2);
    const size_t hstep = (size_t)HALF * K * 2;
    const size_t tstep = 2 * hstep;
    const unsigned ldsw = (unsigned)wid * 1024u;
    const int aoff = lds_byte(wr * 64 + fr, fq * 8), boff = lds_byte(wc * 32 + fr, fq * 8);
#define PG8_SA(b, h) (((b) * 2 + (h)) * HTB)
#define PG8_SB(b, h) ((4 + (b) * 2 + (h)) * HTB)
#define PG8_STAGE(bufoff, gbase, voff) do { _Pragma("unroll") for (int _i = 0; _i < 2; ++_i) \
        __builtin_amdgcn_global_load_lds((const unsigned*)((const char*)(gbase) + (voff)[_i]), (PG8_LAS unsigned*)(lds + (bufoff) + ldsw + _i * 8192), 16, 0, 0); } while (0)
#define PG8_LDA(dst, b, h) do { _Pragma("unroll") for (int m = 0; m < 4; ++m) _Pragma("unroll") for (int k = 0; k < 2; ++k) dst[m][k] = *(const PG8_LAS bf16x8*)(lds + PG8_SA(b, h) + aoff + m * 2048 + k * 1024); } while (0)
#define PG8_LDB(dst, b, h) do { _Pragma("unroll") for (int n = 0; n < 2; ++n) _Pragma("unroll") for (int k = 0; k < 2; ++k) dst[n][k] = *(const PG8_LAS bf16x8*)(lds + PG8_SB(b, h) + boff + n * 2048 + k * 1024); } while (0)
#define PG8_MMA(ai, bj, At, Bt) do { __builtin_amdgcn_s_setprio(1); _Pragma("unroll") for (int m = 0; m < 4; ++m) _Pragma("unroll") for (int n = 0; n < 2; ++n) _Pragma("unroll") for (int k = 0; k < 2; ++k) \
        acc[ai][bj][m][n] = __builtin_amdgcn_mfma_f32_16x16x32_bf16(Bt[n][k], At[m][k], acc[ai][bj][m][n], 0, 0, 0); __builtin_amdgcn_s_setprio(0); } while (0)
#define PG8_WAIT_V(n) asm volatile("s_waitcnt vmcnt(" #n ")" ::: "memory")
#define PG8_WAIT_L(n) asm volatile("s_waitcnt lgkmcnt(" #n ")" ::: "memory")
#define PG8_BAR __builtin_amdgcn_s_barrier()
#define PG8_SCHED __builtin_amdgcn_sched_barrier(0)
    Unit cur, nxt; int ui = 0;
    if (!S.next(0, cur)) return;
    f32x4 acc[2][2][4][2];
#pragma unroll
    for (int a = 0; a < 2; ++a)
#pragma unroll
        for (int b = 0; b < 2; ++b)
#pragma unroll
            for (int m = 0; m < 4; ++m)
#pragma unroll
                for (int n = 0; n < 2; ++n) acc[a][b][m][n] = (f32x4){0.f, 0.f, 0.f, 0.f};
    bf16x8 At[4][2], B0[2][2], B1[2][2];
    const char* cA = cur.a; const char* cB = cur.b;
    S.a_ready(cur);
    if constexpr (SP2) {
        PG8_STAGE(PG8_SB(0, 0), cB, voffB); PG8_STAGE(PG8_SB(0, 1), cB + hstep, voffB); PG8_STAGE(PG8_SA(0, 0), cA, voffA); PG8_STAGE(PG8_SA(0, 1), cA + hstep, voffA);
        if (wr == 1) PG8_BAR;
        PG8_WAIT_V(2); PG8_BAR;
        PG8_STAGE(PG8_SB(1, 0), cB + kstep, voffB); PG8_STAGE(PG8_SA(1, 0), cA + kstep, voffA); PG8_STAGE(PG8_SB(1, 1), cB + hstep + kstep, voffB);
        PG8_WAIT_V(6); PG8_BAR;
    } else {
        PG8_STAGE(PG8_SB(0, 0), cB, voffB); PG8_STAGE(PG8_SA(0, 0), cA, voffA); PG8_STAGE(PG8_SB(0, 1), cB + hstep, voffB); PG8_STAGE(PG8_SA(0, 1), cA + hstep, voffA);
        if (wr == 1) PG8_BAR;
        PG8_WAIT_V(4); PG8_BAR;
        PG8_STAGE(PG8_SB(1, 0), cB + kstep, voffB); PG8_STAGE(PG8_SA(1, 0), cA + kstep, voffA); PG8_STAGE(PG8_SB(1, 1), cB + hstep + kstep, voffB);
        PG8_WAIT_V(6); PG8_BAR;
    }
    for (;;) {
        const bool has_next = S.next(ui + 1, nxt);
        const char* nA = has_next ? nxt.a : cA; const char* nB = has_next ? nxt.b : cB;
        for (int t = 0; t < nt; t += 2) {
            const bool last = (t == nt - 2);
            const char* a1 = cA + (size_t)(t + 1) * kstep;
            const char* a2 = last ? nA : cA + (size_t)(t + 2) * kstep; const char* b2 = last ? nB : cB + (size_t)(t + 2) * kstep;
            const char* a3 = a2 + kstep; const char* b3 = b2 + kstep;
            if (last && has_next) S.a_ready(nxt);
            if constexpr (SP2) {
            PG8_LDB(B0, 0, 0); PG8_LDB(B1, 0, 1); PG8_SCHED; PG8_LDA(At, 0, 0); PG8_STAGE(PG8_SA(1, 1), a1 + hstep, voffA);
            PG8_WAIT_V(8); PG8_WAIT_L(0); PG8_BAR; PG8_MMA(0, 0, At, B0); PG8_MMA(0, 1, At, B1); PG8_BAR; PG8_SCHED;
            PG8_LDA(At, 0, 1); PG8_STAGE(PG8_SB(0, 0), b2, voffB); PG8_STAGE(PG8_SB(0, 1), b2 + hstep, voffB); PG8_STAGE(PG8_SA(0, 0), a2, voffA);
            PG8_WAIT_V(8); PG8_WAIT_L(0); PG8_BAR; PG8_MMA(1, 0, At, B0); PG8_MMA(1, 1, At, B1); PG8_BAR; PG8_SCHED;
            PG8_LDB(B0, 1, 0); PG8_LDB(B1, 1, 1); PG8_SCHED; PG8_LDA(At, 1, 0); PG8_STAGE(PG8_SA(0, 1), a2 + hstep, voffA);
            PG8_WAIT_V(8); PG8_WAIT_L(0); PG8_BAR; PG8_MMA(0, 0, At, B0); PG8_MMA(0, 1, At, B1); PG8_BAR; PG8_SCHED;
            PG8_LDA(At, 1, 1); PG8_STAGE(PG8_SB(1, 0), b3, voffB); PG8_STAGE(PG8_SB(1, 1), b3 + hstep, voffB); PG8_STAGE(PG8_SA(1, 0), a3, voffA);
            PG8_WAIT_V(8); PG8_WAIT_L(0); PG8_BAR; PG8_MMA(1, 0, At, B0); PG8_MMA(1, 1, At, B1); PG8_BAR; PG8_SCHED;
            } else {
            PG8_LDB(B0, 0, 0); PG8_SCHED; PG8_LDA(At, 0, 0); PG8_STAGE(PG8_SA(1, 1), a1 + hstep, voffA);
            PG8_WAIT_L(8); PG8_BAR; PG8_WAIT_L(0); PG8_MMA(0, 0, At, B0); PG8_BAR; PG8_SCHED;
            PG8_LDB(B1, 0, 1); PG8_STAGE(PG8_SB(0, 0), b2, voffB);
            PG8_BAR; PG8_WAIT_L(0); PG8_MMA(0, 1, At, B1); PG8_BAR;
            PG8_LDA(At, 0, 1); PG8_STAGE(PG8_SA(0, 0), a2, voffA);
            PG8_BAR; PG8_WAIT_L(0); PG8_MMA(1, 0, At, B0); PG8_BAR; PG8_SCHED;
            PG8_STAGE(PG8_SB(0, 1), b2 + hstep, voffB);
            PG8_WAIT_V(6); PG8_BAR; PG8_MMA(1, 1, At, B1); PG8_BAR;
            PG8_LDB(B0, 1, 0); PG8_SCHED; PG8_LDA(At, 1, 0); PG8_STAGE(PG8_SA(0, 1), a2 + hstep, voffA);
            PG8_WAIT_L(8); PG8_BAR; PG8_WAIT_L(0); PG8_MMA(0, 0, At, B0); PG8_BAR; PG8_SCHED;
            PG8_LDB(B1, 1, 1); PG8_STAGE(PG8_SB(1, 0), b3, voffB);
            PG8_BAR; PG8_WAIT_L(0); PG8_MMA(0, 1, At, B1); PG8_BAR;
            PG8_LDA(At, 1, 1); PG8_STAGE(PG8_SA(1, 0), a3, voffA);
            PG8_BAR; PG8_WAIT_L(0); PG8_MMA(1, 0, At, B0); PG8_BAR; PG8_SCHED;
            PG8_STAGE(PG8_SB(1, 1), b3 + hstep, voffB);
            PG8_WAIT_V(6); PG8_BAR; PG8_MMA(1, 1, At, B1); PG8_BAR;
            }
        }
        if constexpr (ALIGN_EPI) { if (wr == 0) PG8_BAR; }
        if constexpr (!Epi::AFTER_DRAIN) { E(acc, cur, wr, wc, fr, fq); S.done(cur); }
        if (!has_next) break;
#pragma unroll
        for (int a = 0; a < 2; ++a)
#pragma unroll
            for (int b = 0; b < 2; ++b)
#pragma unroll
                for (int m = 0; m < 4; ++m)
#pragma unroll
                    for (int n = 0; n < 2; ++n) acc[a][b][m][n] = (f32x4){0.f, 0.f, 0.f, 0.f};
        cur = nxt; cA = nA; cB = nB; ++ui;
        if constexpr (ALIGN_EPI) { if (wr == 1) PG8_BAR; }
    }
    PG8_WAIT_V(0);
    if constexpr (!ALIGN_EPI) { if (wr == 0) PG8_BAR; }
    PG8_BAR;
    if constexpr (Epi::AFTER_DRAIN) { E.fused(acc, cur, wr, wc, fr, fq, lds, wid, lane); S.done(cur); }
#undef PG8_SA
#undef PG8_SB
#undef PG8_STAGE
#undef PG8_LDA
#undef PG8_LDB
#undef PG8_MMA
#undef PG8_WAIT_V
#undef PG8_WAIT_L
#undef PG8_BAR
#undef PG8_SCHED
}
}
#define GAS __attribute__((address_space(1)))
#define LAS __attribute__((address_space(3)))
typedef unsigned short bf16;
typedef unsigned v4u __attribute__((ext_vector_type(4)));
typedef float f32x4 __attribute__((ext_vector_type(4)));
typedef short bf16x8 __attribute__((ext_vector_type(8)));
typedef GAS unsigned gu32;
typedef GAS unsigned long long gu64;
#define RLX_AGENT __ATOMIC_RELAXED, __HIP_MEMORY_SCOPE_AGENT
#define LDS_WAIT() asm volatile("s_waitcnt lgkmcnt(0)" ::: "memory")
#define VM_WAIT() asm volatile("s_waitcnt vmcnt(0)" ::: "memory")
__device__ __forceinline__ unsigned long long rt() { return __builtin_amdgcn_s_memrealtime(); }
__device__ __forceinline__ unsigned f2bf(float f) { unsigned u = __builtin_bit_cast(unsigned, f); return (u + 0x7fffu + ((u >> 16) & 1u)) >> 16; }
__device__ __forceinline__ unsigned pk2(float lo, float hi) { return f2bf(lo) | (f2bf(hi) << 16); }

#define XB_TMO      128
#define XB_XCNT(j)  (256  + 64 * (j))
#define XB_XSUB(j)  (1280 + 64 * (j))
#define XB_XGEN(j)  (2304 + 64 * (j))
#define XB_TOP      3328
#define XB_TOPGEN   3392
#define XCD_BAR_WORDS 3456
#define XB_SPIN_CAP (1u << 18)

__device__ __forceinline__ unsigned xb_ld(unsigned* p)              { return __hip_atomic_load(p, __ATOMIC_RELAXED, __HIP_MEMORY_SCOPE_AGENT); }
__device__ __forceinline__ unsigned xb_add(unsigned* p, unsigned v) { return __hip_atomic_fetch_add(p, v, __ATOMIC_RELAXED, __HIP_MEMORY_SCOPE_AGENT); }
__device__ __forceinline__ unsigned xb_xcc_id() { return (unsigned)__builtin_amdgcn_s_getreg((3 << 11) | 20) & 0xFu; }
#define XB_SPIN(cond, bar) do { unsigned _sp = 0; while (cond) { __builtin_amdgcn_s_sleep(1); \
    if ((++_sp & 255u) == 0u) { if (xb_ld(&(bar)[XB_TMO])) break; if (_sp > XB_SPIN_CAP) { atomicAdd(&(bar)[XB_TMO], 1u); break; } } } } while (0)

struct XcdBarrier {
    unsigned* bar; unsigned x;
    volatile LAS unsigned* st;
};

__device__ __forceinline__ XcdBarrier xcd_barrier_post(unsigned* bar, volatile LAS unsigned* st) {
    XcdBarrier b; b.bar = bar; b.x = xb_xcc_id(); b.st = st;
    if (threadIdx.x == 0) (void)xb_add(&bar[XB_XCNT(b.x)], 1u);
    return b;
}
__device__ __forceinline__ void xcd_barrier_complete(unsigned* bar, unsigned x, unsigned& nloc, unsigned& nx) {
    const unsigned G = gridDim.x * gridDim.y * gridDim.z;
    unsigned sum, cnt, mine, sp = 0u;
    for (;;) {
        sum = 0u; cnt = 0u; mine = 0u;
#pragma unroll
        for (unsigned j = 0; j < 16; ++j) { const unsigned c = xb_ld(&bar[XB_XCNT(j)]); sum += c; cnt += (c > 0u) ? 1u : 0u; mine = (j == x) ? c : mine; }
        if (sum == G) break;
        __builtin_amdgcn_s_sleep(1);
        if ((++sp & 255u) == 0u) { if (xb_ld(&bar[XB_TMO])) break; if (sp > XB_SPIN_CAP) { atomicAdd(&bar[XB_TMO], 1u); break; } }
    }
    nloc = mine > 0u ? mine : 1u; nx = cnt > 0u ? cnt : 1u;
}

__device__ __forceinline__ void xcd_barrier(const XcdBarrier& b) {
    asm volatile("s_waitcnt vmcnt(0)" ::: "memory");
    __syncthreads();
    if (threadIdx.x == 0) {
        unsigned* bar = b.bar;
        __builtin_amdgcn_s_waitcnt(0);
        unsigned nloc = b.st[0], nx = b.st[1];
        if (nloc == 0u) { xcd_barrier_complete(bar, b.x, nloc, nx); b.st[0] = nloc; b.st[1] = nx; }
        const unsigned old = xb_add(&bar[XB_XSUB(b.x)], 1u);
        const unsigned gen = old / nloc;
        if (old + 1u == (gen + 1u) * nloc) {
            __builtin_amdgcn_fence(__ATOMIC_RELEASE, "agent");
            asm volatile("s_waitcnt vmcnt(0)" ::: "memory");
            const unsigned og = xb_add(&bar[XB_TOP], 1u);
            const unsigned tg = og / nx;
            if (og + 1u == (tg + 1u) * nx) xb_add(&bar[XB_TOPGEN], 1u);
            else XB_SPIN(xb_ld(&bar[XB_TOPGEN]) == tg, bar);
            __builtin_amdgcn_fence(__ATOMIC_ACQUIRE, "agent");
            xb_add(&bar[XB_XGEN(b.x)], 1u);
            asm volatile("s_waitcnt vmcnt(0)" ::: "memory");
        } else {
            XB_SPIN(xb_ld(&bar[XB_XGEN(b.x)]) == gen, bar);
            __builtin_amdgcn_fence(__ATOMIC_ACQUIRE, "agent");
            asm volatile("s_waitcnt vmcnt(0)" ::: "memory");
        }
    }
    __syncthreads();
}


constexpr int NWAVES = 8, NTHR = NWAVES * 64;
constexpr int DM = 1024, NB = 16, SEQ = 2048, T = NB * SEQ;
constexpr int N1 = 6656;
constexpr int NCLS = 24, SROWS = T + NCLS * 256;
constexpr float EPS = 1e-6f;
constexpr size_t MiB = 1u << 20;
constexpr size_t WS_CTL = 0, CTL_ZERO_BYTES = 1 * MiB;
constexpr size_t WS_ROT = 1 * MiB;
constexpr size_t WS_TOK = 2 * MiB;
constexpr size_t WS_RSTD = 2 * MiB + 512 * 1024;
constexpr size_t WS_SINFO = 3 * MiB;
constexpr size_t WS_W1 = 4 * MiB, WS_WSB = 18 * MiB, WS_WRET = 19 * MiB, WS_WOUT = 21 * MiB, WS_WUP = 23 * MiB, WS_WDN = 55 * MiB;
constexpr size_t WS_R1 = 104 * MiB;
constexpr size_t WS_SBQ = 168 * MiB, WS_SBK = 200 * MiB, WS_SBV = 232 * MiB, WS_RQ = 264 * MiB, WS_RK = 296 * MiB, WS_RV = 328 * MiB, WS_RG = 392 * MiB, WS_YSB = WS_SBQ;
constexpr size_t WS_TMP = WS_RV, WS_MIX = WS_SBV, WS_HNS = WS_RV;
constexpr size_t WS_KV = 456 * MiB;
constexpr size_t WS_END = 488 * MiB;
constexpr size_t WS_PROBE = 200 * MiB;
constexpr int CW_BAR = 4096, CW_CNT = 8192;
constexpr int LDS_BYTES = 147456;
constexpr int LDSCTL_OFF = LDS_BYTES - 2048, MISC_OFF = LDSCTL_OFF + 320, TAB_OFF = LDSCTL_OFF + 1024;

struct TokInfo { int cls, pos; float ga, gb; };
struct SInfo { int tok; float ga, gb; int pad; };

__device__ __forceinline__ float wave_sum(float v) {
#pragma unroll
    for (int o = 1; o < 64; o <<= 1) v += __shfl_xor(v, o);
    return v;
}
__device__ __forceinline__ float bf2f(unsigned short b) { return __builtin_bit_cast(float, (unsigned)b << 16); }
__device__ __forceinline__ float bflo(unsigned w) { return __builtin_bit_cast(float, w << 16); }
__device__ __forceinline__ float bfhi(unsigned w) { return __builtin_bit_cast(float, w & 0xffff0000u); }

struct Args { const float* in[18]; float* out; unsigned char* ws; int ph_lo, ph_hi, rep, pad; };

struct TJob { const float* W; int N; bf16* WT; int ldk, koff, mode, nbase; };
__device__ __forceinline__ int rowmap(int mode, int n) {
    if (mode == 1) {
        if (n >= 1536 && n < 2560) { const int seg = n < 2048 ? 1536 : 2048, c = n - seg, hh = c >> 6, i = c & 63; return seg + (hh >> 2) * 256 + (i >> 5) * 128 + (hh & 3) * 32 + (i & 31); }
        return n;
    }
    if (mode == 2) return (n >> 7) * 256 + (n & 127);
    if (mode == 3) return (n >> 7) * 256 + 128 + (n & 127);
    return n;
}
__device__ __forceinline__ void p0_transpose_item(const TJob& J, LAS float* scr, int item, int lane) {
    const int nblk = J.N / 32, kb = item / nblk, nb = item % nblk, k0 = 64 * kb, n0 = 32 * nb;
#pragma unroll 8
    for (int i = 0; i < 32; ++i) { const int kk = 2 * i + (lane >> 5); scr[kk * 33 + (lane & 31)] = J.W[(size_t)(k0 + kk) * J.N + n0 + (lane & 31)]; }
    LDS_WAIT(); asm volatile("" ::: "memory");
    const int c = lane & 7;
#pragma unroll
    for (int j = 0; j < 4; ++j) { const int n = (lane >> 3) + 8 * j; const LAS float* s = scr + (8 * c) * 33 + n;
        const int ng = n0 + n; float sc = 1.f; if (J.mode == 1) { if (ng < 512) sc = 0.125f * 1.4426950408889634f; else if (ng >= 2048 && ng < 2560) sc = 0.125f; }
        v4u o; o.x = pk2(s[0 * 33] * sc, s[1 * 33] * sc); o.y = pk2(s[2 * 33] * sc, s[3 * 33] * sc); o.z = pk2(s[4 * 33] * sc, s[5 * 33] * sc); o.w = pk2(s[6 * 33] * sc, s[7 * 33] * sc);
        *(GAS v4u*)(J.WT + (size_t)(J.nbase + rowmap(J.mode, ng)) * J.ldk + J.koff + k0 + 8 * c) = o; }
    LDS_WAIT(); asm volatile("" ::: "memory");
}
__device__ __forceinline__ void p0_prologue(const Args& a, LAS unsigned char* lds, int vcu, int G, int wave, int lane) {
    unsigned char* ws = a.ws;
    LAS float* scr = (LAS float*)(lds + wave * 16384);
    const int gw = vcu * NWAVES + wave, NGW = G * NWAVES;
    constexpr int I0 = 16 * 144, I1 = 16 * 64, I2 = 8 * 32, I3 = 16 * 32, I4 = 16 * 32, I5 = 16 * 256, I6 = 16 * 256, I7 = 48 * 256;
    constexpr int NITEMS = I0 + I1 + I2 + I3 + I4 + I5 + I6 + I7;
    for (int it = gw; it < NITEMS; it += NGW) {
        int r = it; TJob J;
        if (r < I0) { J = TJob{a.in[2], 4608, (bf16*)(ws + WS_W1), 1024, 0, 1, 0}; }
        else if ((r -= I0) < I1) { J = TJob{a.in[3], 2048, (bf16*)(ws + WS_W1), 1024, 0, 0, 4608}; }
        else if ((r -= I1) < I2) { J = TJob{a.in[5], 1024, (bf16*)(ws + WS_WSB), 512, 0, 0, 0}; }
        else if ((r -= I2) < I3) { J = TJob{a.in[6], 1024, (bf16*)(ws + WS_WRET), 1024, 0, 0, 0}; }
        else if ((r -= I3) < I4) { J = TJob{a.in[8], 1024, (bf16*)(ws + WS_WOUT), 1024, 0, 0, 0}; }
        else if ((r -= I4) < I5) { const int e = r >> 8; r &= 255; J = TJob{a.in[14] + (size_t)e * 1024 * 512, 512, (bf16*)(ws + WS_WUP) + (size_t)e * 1024 * 1024, 1024, 0, 2, 0}; }
        else if ((r -= I5) < I6) { const int e = r >> 8; r &= 255; J = TJob{a.in[15] + (size_t)e * 1024 * 512, 512, (bf16*)(ws + WS_WUP) + (size_t)e * 1024 * 1024, 1024, 0, 3, 0}; }
        else { r -= I6; const int cs = r >> 8; r &= 255; const int cls = cs >> 1, slot = cs & 1, g = cls / 6, p = cls % 6;
            const int pa = p < 3 ? 0 : (p < 5 ? 1 : 2), pb = p == 0 ? 1 : (p == 1 ? 2 : (p == 2 ? 3 : (p == 3 ? 2 : 3)));
            const int e = 4 * g + (slot ? pb : pa);
            J = TJob{a.in[16] + (size_t)e * 512 * 1024, 1024, (bf16*)(ws + WS_WDN) + (size_t)cls * 1024 * 1024, 1024, slot * 512, 0, 0}; }
        p0_transpose_item(J, scr, r, lane);
    }
    const float* x = a.in[0]; const float* g = a.in[1]; bf16* xn = (bf16*)(ws + WS_R1);
    f32x4 gv[4];
#pragma unroll
    for (int j = 0; j < 4; ++j) gv[j] = ((const f32x4*)g)[lane + 64 * j];
    for (int m = gw; m < T; m += NGW) {
        const GAS f32x4* xr = (const GAS f32x4*)(x + (size_t)m * DM) + lane;
        f32x4 v[4]; float s = 0.f;
#pragma unroll
        for (int j = 0; j < 4; ++j) { v[j] = xr[64 * j]; s += (v[j].x * v[j].x + v[j].y * v[j].y) + (v[j].z * v[j].z + v[j].w * v[j].w); }
        const float rstd = 1.f / sqrtf(wave_sum(s) * (1.f / DM) + EPS);
        GAS unsigned long long* o8 = (GAS unsigned long long*)(xn + (size_t)m * DM) + lane;
#pragma unroll
        for (int j = 0; j < 4; ++j) { const f32x4 y = v[j] * rstd * gv[j]; o8[64 * j] = (unsigned long long)pk2(y.x, y.y) | ((unsigned long long)pk2(y.z, y.w) << 32); }
    }
    float* rot = (float*)(ws + WS_ROT);
    for (int idx = gw * 64 + lane; idx < SEQ * 32; idx += NGW * 64) {
        const int pos = idx >> 5, i = idx & 31;
        const float inv = (float)exp(-(double)i * (9.210340371976184 / 32.0));
        const float ang = (float)pos * inv;
        rot[idx] = (float)cos((double)ang); rot[SEQ * 32 + idx] = (float)sin((double)ang);
    }
}

typedef pg8::Unit Unit;
using pg8::cvt_pk_bf16;
__device__ __forceinline__ v4u pack8(const f32x4 a, const f32x4 b) { v4u w; w.x = cvt_pk_bf16(a[0], a[1]); w.y = cvt_pk_bf16(a[2], a[3]); w.z = cvt_pk_bf16(b[0], b[1]); w.w = cvt_pk_bf16(b[2], b[3]); return w; }
__device__ __forceinline__ float sigm(float x) { return 1.f / (1.f + __expf(-x)); }

struct Epi1 {
    static constexpr bool PERM = true, AFTER_DRAIN = false;
    bf16 *sbq, *sbk, *sbv, *rq, *rk, *rv, *rg, *gates; const float* bgate; const float* rot;
    __device__ __forceinline__ void operator()(const f32x4 (&acc)[2][2][4][2], const Unit& u, int wr, int wc, int fr, int fq) const {
        const int pn = u.tag, rowb = u.row0 + wr * 64 + fr, cw = wc * 32 + 8 * fq;
        if (pn >= 6 && pn < 10) {
            bf16* base = (pn < 8 ? rq : rk) + ((pn & 1) * 4 + wc) * 64 + 8 * fq;
            const int hh_ = (pn & 1) * 4 + wc; const float lg2h = hh_ == 0 ? -4.5803689613e-02f : (hh_ == 1 ? -2.2720076500e-02f : (hh_ == 2 ? -1.1315313228e-02f : (hh_ == 3 ? -5.6465631411e-03f : (hh_ == 4 ? -2.8205190624e-03f : (hh_ == 5 ? -1.4095702547e-03f : (hh_ == 6 ? -7.0461297659e-04f : (-3.5226347163e-04f)))))));
#pragma unroll
            for (int ai = 0; ai < 2; ++ai)
#pragma unroll
                for (int m = 0; m < 4; ++m) { const int row = rowb + ai * 128 + m * 16, pos = row & (SEQ - 1);
                    const f32x4 c0 = *(const f32x4*)(rot + pos * 32 + 8 * fq), c1 = *(const f32x4*)(rot + pos * 32 + 8 * fq + 4);
                    const f32x4 s0 = *(const f32x4*)(rot + SEQ * 32 + pos * 32 + 8 * fq), s1 = *(const f32x4*)(rot + SEQ * 32 + pos * 32 + 8 * fq + 4);
                    const f32x4 x10 = acc[ai][0][m][0], x11 = acc[ai][0][m][1], x20 = acc[ai][1][m][0], x21 = acc[ai][1][m][1];
                    f32x4 o10 = x10 * c0 - x20 * s0, o11 = x11 * c1 - x21 * s1, o20 = x20 * c0 + x10 * s0, o21 = x21 * c1 + x11 * s1;
                    if (pn >= 8) { const float kd = __builtin_amdgcn_exp2f(lg2h * (float)(64 - (pos & 63))); o10 *= kd; o11 *= kd; o20 *= kd; o21 *= kd; }
                    bf16* rowp = base + (size_t)row * 512;
                    *(v4u*)rowp = pack8(o10, o11); *(v4u*)(rowp + 32) = pack8(o20, o21); }
            return;
        }
        bf16* base; int ld, colt, act = 0;
        if (pn < 2) { base = sbq; ld = 512; colt = pn * 256; } else if (pn < 4) { base = sbk; ld = 512; colt = (pn - 2) * 256; }
        else if (pn < 6) { base = sbv; ld = 512; colt = (pn - 4) * 256; } else if (pn < 14) { base = rv; ld = 1024; colt = (pn - 10) * 256; }
        else if (pn < 18) { base = rg; ld = 1024; colt = (pn - 14) * 256; act = 1; } else { base = gates; ld = 2048; colt = (pn - 18) * 256; act = 2; }
        f32x4 bv[2][2];
#pragma unroll
        for (int bj = 0; bj < 2; ++bj)
#pragma unroll
            for (int n = 0; n < 2; ++n) bv[bj][n] = act == 2 ? *(const f32x4*)(bgate + colt + bj * 128 + cw + 4 * n) : (f32x4){0.f, 0.f, 0.f, 0.f};
#pragma unroll
        for (int ai = 0; ai < 2; ++ai)
#pragma unroll
            for (int m = 0; m < 4; ++m) { bf16* rowp = base + (size_t)(rowb + ai * 128 + m * 16) * ld + colt + cw;
#pragma unroll
                for (int bj = 0; bj < 2; ++bj) { f32x4 v0 = acc[ai][bj][m][0] + bv[bj][0], v1 = acc[ai][bj][m][1] + bv[bj][1];
                    if (act == 1) {
#pragma unroll
                        for (int j = 0; j < 4; ++j) { v0[j] = v0[j] * sigm(v0[j]); v1[j] = v1[j] * sigm(v1[j]); } }
                    else if (act == 2) {
#pragma unroll
                        for (int j = 0; j < 4; ++j) { v0[j] = sigm(v0[j]); v1[j] = sigm(v1[j]); } }
                    *(v4u*)(rowp + bj * 128) = pack8(v0, v1); } }
    }
};
template <bool ADD> struct EpiMix {
    static constexpr bool PERM = true, AFTER_DRAIN = false;
    const bf16* gates; int goff; const bf16* prev; bf16* out;
    __device__ __forceinline__ void operator()(const f32x4 (&acc)[2][2][4][2], const Unit& u, int wr, int wc, int fr, int fq) const {
        const int rowb = u.row0 + wr * 64 + fr, colb = u.col0 + wc * 32 + 8 * fq;
#pragma unroll
        for (int ai = 0; ai < 2; ++ai)
#pragma unroll
            for (int m = 0; m < 4; ++m) { const size_t row = rowb + ai * 128 + m * 16;
#pragma unroll
                for (int bj = 0; bj < 2; ++bj) { const int col = colb + bj * 128;
                    const v4u g = *(const v4u*)(gates + row * 2048 + goff + col);
                    f32x4 v0 = acc[ai][bj][m][0], v1 = acc[ai][bj][m][1];
                    v0[0] *= bflo(g.x); v0[1] *= bfhi(g.x); v0[2] *= bflo(g.y); v0[3] *= bfhi(g.y); v1[0] *= bflo(g.z); v1[1] *= bfhi(g.z); v1[2] *= bflo(g.w); v1[3] *= bfhi(g.w);
                    if (ADD) { const v4u p = *(const v4u*)(prev + row * 1024 + col);
                        v0[0] += bflo(p.x); v0[1] += bfhi(p.x); v0[2] += bflo(p.y); v0[3] += bfhi(p.y); v1[0] += bflo(p.z); v1[1] += bfhi(p.z); v1[2] += bflo(p.w); v1[3] += bfhi(p.w); }
                    *(v4u*)(out + row * 1024 + col) = pack8(v0, v1); } }
    }
};
struct EpiOut {
    static constexpr bool PERM = true, AFTER_DRAIN = false;
    const float* x; float* out;
    __device__ __forceinline__ void operator()(const f32x4 (&acc)[2][2][4][2], const Unit& u, int wr, int wc, int fr, int fq) const {
        const int rowb = u.row0 + wr * 64 + fr, colb = u.col0 + wc * 32 + 8 * fq;
#pragma unroll
        for (int ai = 0; ai < 2; ++ai)
#pragma unroll
            for (int m = 0; m < 4; ++m) { const size_t off = (size_t)(rowb + ai * 128 + m * 16) * 1024 + colb;
#pragma unroll
                for (int bj = 0; bj < 2; ++bj)
#pragma unroll
                    for (int n = 0; n < 2; ++n) *(f32x4*)(out + off + bj * 128 + n * 4) = *(const f32x4*)(x + off + bj * 128 + n * 4) + acc[ai][bj][m][n]; }
    }
};
struct EpiUp {
    static constexpr bool PERM = true, AFTER_DRAIN = false;
    const SInfo* sinfo; bf16* hid;
    __device__ __forceinline__ void operator()(const f32x4 (&acc)[2][2][4][2], const Unit& u, int wr, int wc, int fr, int fq) const {
        const int ct = u.tag, rowb = u.row0 + wr * 64 + fr, col = ct * 128 + wc * 32 + 8 * fq;
#pragma unroll
        for (int ai = 0; ai < 2; ++ai)
#pragma unroll
            for (int m = 0; m < 4; ++m) { const size_t row = rowb + ai * 128 + m * 16; const SInfo si = sinfo[row]; const float gw = ct < 4 ? si.ga : si.gb;
                f32x4 v0, v1;
#pragma unroll
                for (int j = 0; j < 4; ++j) { const float g0 = acc[ai][0][m][0][j], g1 = acc[ai][0][m][1][j];
                    v0[j] = g0 * sigm(g0) * acc[ai][1][m][0][j] * gw; v1[j] = g1 * sigm(g1) * acc[ai][1][m][1][j] * gw; }
                *(v4u*)(hid + row * 1024 + col) = pack8(v0, v1); }
    }
};
struct EpiDown {
    static constexpr bool PERM = true, AFTER_DRAIN = false;
    const SInfo* sinfo; float* out;
    __device__ __forceinline__ void operator()(const f32x4 (&acc)[2][2][4][2], const Unit& u, int wr, int wc, int fr, int fq) const {
        const int rowb = u.row0 + wr * 64 + fr, colb = u.col0 + wc * 32 + 8 * fq;
#pragma unroll
        for (int ai = 0; ai < 2; ++ai)
#pragma unroll
            for (int m = 0; m < 4; ++m) { const int tok = sinfo[rowb + ai * 128 + m * 16].tok;
                if (tok >= 0) { float* p = out + (size_t)tok * 1024 + colb;
#pragma unroll
                    for (int bj = 0; bj < 2; ++bj)
#pragma unroll
                        for (int n = 0; n < 2; ++n) *(f32x4*)(p + bj * 128 + n * 4) = *(const f32x4*)(p + bj * 128 + n * 4) + acc[ai][bj][m][n]; } }
    }
};
struct MoeOrder {
    const char* A; const char* B; const volatile LAS int* tstart; int nct, up, G, c;
    __device__ bool next(int i, Unit& u) const {
        const int L = i * G + c; const int ntile = __builtin_amdgcn_readfirstlane(tstart[NCLS]);
        const int rt = L / nct, ct = L % nct; if (rt >= ntile) return false;
        int cls = 0;
        for (int k = 1; k < NCLS; ++k) cls += (rt >= __builtin_amdgcn_readfirstlane(tstart[k])) ? 1 : 0;
        const int g = cls / 6, p = cls % 6, pa = p < 3 ? 0 : (p < 5 ? 1 : 2), pb = p == 0 ? 1 : (p == 1 ? 2 : (p == 2 ? 3 : (p == 3 ? 2 : 3)));
        u.a = A + (size_t)rt * 256 * 1024 * 2; u.row0 = rt * 256; u.tag = ct;
        if (up) { const int e = 4 * g + (ct < 4 ? pa : pb); u.b = B + ((size_t)e * 1024 + (ct & 3) * 256) * 1024 * 2; u.col0 = ct * 128; }
        else { u.b = B + ((size_t)cls * 1024 + ct * 256) * 1024 * 2; u.col0 = ct * 256; }
        return true;
    }
    __device__ __forceinline__ void a_ready(const Unit&) const {}
    __device__ __forceinline__ void done(const Unit&) const {}
};

typedef float f32x16 __attribute__((ext_vector_type(16)));
typedef short s16x4 __attribute__((ext_vector_type(4)));
typedef float f32x2_t __attribute__((ext_vector_type(2))); typedef __bf16 bf16x2_t __attribute__((ext_vector_type(2)));
__device__ __forceinline__ unsigned cvtpk_s(float lo, float hi) { f32x2_t v = {lo, hi}; bf16x2_t b = __builtin_convertvector(v, bf16x2_t); return __builtin_bit_cast(unsigned, b); }
__device__ __forceinline__ s16x4 vtr(const LAS unsigned char* p) { return __builtin_bit_cast(s16x4, __builtin_amdgcn_ds_read_tr16_b64_v4i16((LAS s16x4*)p)); }
__device__ __forceinline__ int crow(int r, int hi) { return (r & 3) + 8 * (r >> 2) + 4 * hi; }
#define MFMA32(a, b, c) __builtin_amdgcn_mfma_f32_32x32x16_bf16((a), (b), (c), 0, 0, 0)
__device__ __forceinline__ bf16x8 packfrag(const f32x16& p, int s) {
    v4u w; w.x = cvtpk_s(p[8 * s], p[8 * s + 1]); w.y = cvtpk_s(p[8 * s + 2], p[8 * s + 3]); w.z = cvtpk_s(p[8 * s + 4], p[8 * s + 5]); w.w = cvtpk_s(p[8 * s + 6], p[8 * s + 7]);
    return __builtin_bit_cast(bf16x8, w);
}
__device__ __forceinline__ bf16x8 vfrag(const LAS unsigned char* p, int rowbytes) {
    const s16x4 lo = vtr(p), hi_ = vtr(p + 8 * rowbytes);
    return (bf16x8){lo[0], lo[1], lo[2], lo[3], hi_[0], hi_[1], hi_[2], hi_[3]};
}
__device__ __forceinline__ void glds16(const void* gsrc, unsigned lds_dst) { unsigned keep;
    asm volatile("s_mov_b32 %0, m0\n\ts_mov_b32 m0, %2\n\ts_nop 0\n\tglobal_load_lds_dwordx4 %1, off\n\ts_mov_b32 m0, %0" : "=&s"(keep) : "v"(gsrc), "s"(lds_dst) : "memory"); }
#define WAIT_BAR(N) asm volatile("s_waitcnt vmcnt(" #N ") lgkmcnt(0)\n\ts_barrier" ::: "memory")
constexpr float SB_THR2 = -40.f;

template <bool MASK>
__device__ __forceinline__ void sb_tile(const LAS unsigned char* Kt, const LAS unsigned char* Vt, const bf16x8 (&qf)[4], const bf16x8 tri0, const bf16x8 tri1, const bf16x8 ones,
                                        f32x16& o0, f32x16& o1, float& R, int kt, int t, int hi, int kbase, int kx, int v0, int v1) {
    f32x16 p0 = {}, p1 = {};
#pragma unroll
    for (int ks = 0; ks < 4; ++ks) {
        const int co = kbase + (((2 * ks + hi) ^ kx) << 4);
        const bf16x8 a0 = *(const LAS bf16x8*)(Kt + co), a1 = *(const LAS bf16x8*)(Kt + 4096 + co);
        p0 = MFMA32(a0, qf[ks], p0); p1 = MFMA32(a1, qf[ks], p1);
    }
    f32x16 l0, l1; float cs = 0.f;
#pragma unroll
    for (int r = 0; r < 16; ++r) {
        const float z0 = p0[r], z1 = p1[r];
        float k0 = -(fmaxf(z0, 0.f) + __builtin_amdgcn_logf(1.f + __builtin_amdgcn_exp2f(-fabsf(z0))));
        float k1 = -(fmaxf(z1, 0.f) + __builtin_amdgcn_logf(1.f + __builtin_amdgcn_exp2f(-fabsf(z1))));
        if (MASK) { const int key = kt * 64 + crow(r, hi); k0 = key < t ? k0 : 0.f; k1 = key + 32 < t ? k1 : 0.f; }
        l0[r] = k0; l1[r] = k1; cs += k0 + k1;
    }
    cs += __shfl_xor(cs, 32);
    const bf16x8 lb00 = packfrag(l0, 0), lb01 = packfrag(l0, 1), lb10 = packfrag(l1, 0), lb11 = packfrag(l1, 1);
    f32x16 y0 = {}, y1 = {};
    y0 = MFMA32(tri0, lb00, y0); y0 = MFMA32(tri1, lb01, y0); y0 = MFMA32(ones, lb10, y0); y0 = MFMA32(ones, lb11, y0);
    y1 = MFMA32(tri0, lb10, y1); y1 = MFMA32(tri1, lb11, y1);
#pragma unroll
    for (int r = 0; r < 16; ++r) {
        float w0 = __builtin_amdgcn_exp2f(p0[r] + y0[r] + R), w1 = __builtin_amdgcn_exp2f(p1[r] + y1[r] + R);
        if (MASK) { const int key = kt * 64 + crow(r, hi); w0 = key < t ? w0 : 0.f; w1 = key + 32 < t ? w1 : 0.f; }
        p0[r] = w0; p1[r] = w1;
    }
    R += cs;
    const bf16x8 wb00 = packfrag(p0, 0), wb01 = packfrag(p0, 1), wb10 = packfrag(p1, 0), wb11 = packfrag(p1, 1);
    o0 = MFMA32(vfrag(Vt + 0 * 2048 + v0, 128), wb00, o0); o1 = MFMA32(vfrag(Vt + 0 * 2048 + v1, 128), wb00, o1);
    o0 = MFMA32(vfrag(Vt + 1 * 2048 + v0, 128), wb01, o0); o1 = MFMA32(vfrag(Vt + 1 * 2048 + v1, 128), wb01, o1);
    o0 = MFMA32(vfrag(Vt + 2 * 2048 + v0, 128), wb10, o0); o1 = MFMA32(vfrag(Vt + 2 * 2048 + v1, 128), wb10, o1);
    o0 = MFMA32(vfrag(Vt + 3 * 2048 + v0, 128), wb11, o0); o1 = MFMA32(vfrag(Vt + 3 * 2048 + v1, 128), wb11, o1);
}
__device__ __forceinline__ void unit_map(int u, int G, int& bh, int& qb) {
    if (G == 256) { const int bx = u & 255, i = u >> 8, xcd = bx & 7, slot = bx >> 3, gi = slot >> 2, j = slot & 3;
        bh = (xcd * 8 + gi) * 2 + (i >> 1); qb = (i & 1) ? 7 - j : j; }
    else { bh = u >> 3; qb = u & 7; }
}
__device__ __forceinline__ void sb_phase(const bf16* Q, const bf16* Kg, const bf16* Vg, bf16* O, LAS unsigned char* lds, int bx, int G, int tid, int wave, int lane, bool nostore = false) {
    const int r32 = lane & 31, hi = lane >> 5;
    bf16x8 tri0, tri1, ones;
#pragma unroll
    for (int j = 0; j < 8; ++j) { const int kk = 8 * (j >> 2) + 4 * hi + (j & 3); tri0[j] = kk >= r32 ? (short)0x3F80 : (short)0; tri1[j] = 16 + kk >= r32 ? (short)0x3F80 : (short)0; ones[j] = (short)0x3F80; }
    const int skey = wave * 8 + (lane >> 3), sc = (lane & 7) ^ (lane >> 3), svc = (lane & 7) ^ (((lane >> 4) & 1) << 2);
    const unsigned lds0 = (unsigned)(size_t)lds + (unsigned)wave * 1024u;
#define SB_STAGE(kt_, st_) do { const unsigned d_ = (unsigned)__builtin_amdgcn_readfirstlane(lds0 + (unsigned)(st_) * 16384u); \
        glds16(Kg + (rbase + (size_t)(kt_) * 64 + skey) * 512 + h * 64 + sc * 8, d_); glds16(Vg + (rbase + (size_t)(kt_) * 64 + skey) * 512 + h * 64 + svc * 8, d_ + 8192u); } while (0)
    const int kbase = r32 * 128, kx = r32 & 7;
    const int q4 = (lane & 15) >> 2, v0 = ((4 * hi + q4) * 128 + 32 * ((lane >> 4) & 1) + 8 * (lane & 3)) ^ (((q4 >> 1) & 1) << 6), v1 = v0 ^ 64;
    volatile LAS int* flags = (volatile LAS int*)(lds + 49152);
    for (int u = bx; u < 1024; u += G) {
        const int bh = u >> 3, qb = u & 7;
        const int b = bh >> 3, h = bh & 7, q0w = qb * 256 + 32 * wave, my_kt = q0w >> 6, kt_hi = qb * 4 + 3, t = q0w + r32;
        const size_t rbase = (size_t)b * SEQ;
        SB_STAGE(kt_hi, 0);
        if (kt_hi > 0) SB_STAGE(kt_hi - 1, 1);
        bf16x8 qf[4];
#pragma unroll
        for (int ks = 0; ks < 4; ++ks) qf[ks] = *(const bf16x8*)(Q + (rbase + t) * 512 + h * 64 + 16 * ks + 8 * hi);
        f32x16 o0 = {}, o1 = {}; float R = 0.f;
        if (kt_hi > 0) WAIT_BAR(2); else WAIT_BAR(0);
        bool mydone = false; int st = 0, it = 0;
        for (int kt = kt_hi; kt >= 0; --kt, ++it) {
            int st2 = st + 2; if (st2 >= 3) st2 -= 3;
            if (kt >= 2) SB_STAGE(kt - 2, st2);
            if (kt <= my_kt && !mydone) {
                const LAS unsigned char* Kt = lds + st * 16384; const LAS unsigned char* Vt = Kt + 8192;
                if (kt == my_kt) sb_tile<true>(Kt, Vt, qf, tri0, tri1, ones, o0, o1, R, kt, t, hi, kbase, kx, v0, v1);
                else sb_tile<false>(Kt, Vt, qf, tri0, tri1, ones, o0, o1, R, kt, t, hi, kbase, kx, v0, v1);
                mydone = __all(R < SB_THR2) != 0;
            }
            if (lane == 0) flags[(it & 1) * 8 + wave] = mydone ? 1 : 0;
            if (kt >= 2) WAIT_BAR(2); else WAIT_BAR(0);
            int alld = 1;
#pragma unroll
            for (int w = 0; w < 8; ++w) alld &= flags[(it & 1) * 8 + w];
            if (alld) break;
            st = st + 1; if (st >= 3) st = 0;
        }
        { LAS unsigned char* ep = lds + 53248 + wave * 4608;
#pragma unroll
          for (int g4 = 0; g4 < 4; ++g4) {
            *(LAS unsigned long long*)(ep + r32 * 144 + (8 * g4 + 4 * hi) * 2) = (unsigned long long)cvtpk_s(o0[4 * g4], o0[4 * g4 + 1]) | ((unsigned long long)cvtpk_s(o0[4 * g4 + 2], o0[4 * g4 + 3]) << 32);
            *(LAS unsigned long long*)(ep + r32 * 144 + (32 + 8 * g4 + 4 * hi) * 2) = (unsigned long long)cvtpk_s(o1[4 * g4], o1[4 * g4 + 1]) | ((unsigned long long)cvtpk_s(o1[4 * g4 + 2], o1[4 * g4 + 3]) << 32); }
#pragma unroll
          for (int i = 0; i < 4; ++i) { const int row = (lane >> 3) + 8 * i;
            const v4u ov = *(const LAS v4u*)(ep + row * 144 + (lane & 7) * 16); if (!nostore) *(v4u*)(O + (rbase + q0w + row) * 512 + h * 64 + (lane & 7) * 8) = ov; else asm volatile("" :: "v"(ov)); } }
        WAIT_BAR(0);
    }
#undef SB_STAGE
}
template <bool EDGE>
__device__ __forceinline__ void ret_tile(const LAS unsigned char* Kt, const LAS unsigned char* Vt, const bf16x8 (&qf)[4], f32x16 (&o)[4], float lg2, int kt, int my_kt, int n, int hi, int kbase, int kx, int vb) {
    f32x16 p0 = {}, p1 = {};
#pragma unroll
    for (int ks = 0; ks < 4; ++ks) {
        const int co = kbase + (((2 * ks + hi) ^ kx) << 4);
        const bf16x8 a0 = *(const LAS bf16x8*)(Kt + co), a1 = *(const LAS bf16x8*)(Kt + 4096 + co);
        p0 = MFMA32(a0, qf[ks], p0); p1 = MFMA32(a1, qf[ks], p1);
    }
    const int e_off = n - 64 * (kt + 1);
    if (EDGE) {
        const bool diag = kt == my_kt; float fnn = (float)(n & 63); asm volatile("" : "+v"(fnn));
        const float base = diag ? fnn - 64.f : (float)e_off, two = diag ? 2.f : 0.f, h4 = (float)(4 * hi);
#pragma unroll
        for (int r = 0; r < 16; ++r) {
            const float m0 = (float)((r & 3) + 8 * (r >> 2)) + h4;
            p0[r] *= __builtin_amdgcn_exp2f(lg2 * (base + two * fmaxf(m0 - fnn, 0.f))); p1[r] *= __builtin_amdgcn_exp2f(lg2 * (base + two * fmaxf(m0 + 32.f - fnn, 0.f)));
            if ((r & 3) == 3) __builtin_amdgcn_sched_barrier(0);
        }
    } else {
        const float f = __builtin_amdgcn_exp2f(lg2 * (float)e_off);
#pragma unroll
        for (int r = 0; r < 16; ++r) { p0[r] *= f; p1[r] *= f; }
    }
    const bf16x8 wb00 = packfrag(p0, 0), wb01 = packfrag(p0, 1), wb10 = packfrag(p1, 0), wb11 = packfrag(p1, 1);
#pragma unroll
    for (int dt = 0; dt < 4; ++dt) { const LAS unsigned char* vp = Vt + (vb ^ (dt << 6));
        o[dt] = MFMA32(vfrag(vp + 0 * 4096, 256), wb00, o[dt]); o[dt] = MFMA32(vfrag(vp + 1 * 4096, 256), wb01, o[dt]);
        o[dt] = MFMA32(vfrag(vp + 2 * 4096, 256), wb10, o[dt]); o[dt] = MFMA32(vfrag(vp + 3 * 4096, 256), wb11, o[dt]); }
}
__device__ __forceinline__ void kv_chain(const bf16* Kg, const bf16* Vg, bf16* STg, LAS unsigned char* lds, int bh0, int bhs, int tid, int wave, int lane) {
    const int r32 = lane & 31, hi = lane >> 5, q4 = (lane & 15) >> 2, g1 = (lane >> 4) & 1, p = lane & 3, dh = wave >> 2, eq = wave & 3;
    const int skey = wave * 8 + (lane >> 3), sc = (lane & 7) ^ (lane >> 3);
    const int vkey = wave * 8 + (lane >> 4), vc = (lane & 15) ^ (((lane >> 4) & 3) << 2);
    const unsigned ldsk = (unsigned)(size_t)lds + (unsigned)wave * 1024u, ldsv = (unsigned)(size_t)lds + 8192u + (unsigned)wave * 2048u;
#define RET_STAGE(kt_, st_) do { const unsigned so_ = (unsigned)(st_) * 24576u; \
        glds16(Kg + (rbase + (size_t)(kt_) * 64 + skey) * 512 + h * 64 + sc * 8, (unsigned)__builtin_amdgcn_readfirstlane(ldsk + so_)); \
        glds16(Vg + (rbase + (size_t)(kt_) * 64 + vkey) * 1024 + h * 128 + vc * 8, (unsigned)__builtin_amdgcn_readfirstlane(ldsv + so_)); \
        glds16(Vg + (rbase + (size_t)(kt_) * 64 + vkey + 4) * 1024 + h * 128 + vc * 8, (unsigned)__builtin_amdgcn_readfirstlane(ldsv + so_ + 1024u)); } while (0)
    int aoff[2], boff[2];
#pragma unroll
    for (int e = 0; e < 2; ++e) { const int m = 8 * hi + q4 + 4 * e;
        aoff[e] = m * 128 + (((4 * dh + 2 * g1 + (p >> 1)) ^ (m & 7)) << 4) + (p & 1) * 8;
        boff[e] = m * 256 + ((64 * eq + 32 * g1 + 8 * p) ^ ((m & 3) << 6)); }
    for (int bh = bh0; bh < 128; bh += bhs) {
        const int b = bh >> 3, h = bh & 7;
        const size_t rbase = (size_t)b * SEQ;
        const float lg2 = log2f(1.f - exp2f(-5.f - (float)h)), g64 = exp2f(64.f * lg2), g256 = exp2f(256.f * lg2), ginv = exp2f(-lg2);
        RET_STAGE(0, 0); RET_STAGE(1, 1);
        f32x16 S = {}, kv = {};
        WAIT_BAR(3);
        int st = 0;
        for (int kt = 0; kt < 28; ++kt) {
            int st2 = st + 2; if (st2 >= 3) st2 -= 3;
            if (kt + 2 < 28) RET_STAGE(kt + 2, st2);
            const LAS unsigned char* Kt = lds + st * 24576; const LAS unsigned char* Vt = Kt + 8192;
#pragma unroll
            for (int r = 0; r < 16; ++r) kv[r] *= g64;
#pragma unroll
            for (int ks = 0; ks < 4; ++ks) {
                const s16x4 a0 = vtr(Kt + aoff[0] + ks * 2048), a1 = vtr(Kt + aoff[1] + ks * 2048), b0 = vtr(Vt + boff[0] + ks * 4096), b1 = vtr(Vt + boff[1] + ks * 4096);
                kv = MFMA32(((bf16x8){a0[0], a0[1], a0[2], a0[3], a1[0], a1[1], a1[2], a1[3]}), ((bf16x8){b0[0], b0[1], b0[2], b0[3], b1[0], b1[1], b1[2], b1[3]}), kv);
            }
            if ((kt & 3) == 3) {
                bf16* sp = STg + ((size_t)(bh * 8 + (kt >> 2) + 1) * 64 + 32 * dh) * 128 + 32 * eq + r32;
#pragma unroll
                for (int r = 0; r < 16; ++r) { S[r] = S[r] * g256 + kv[r] * ginv; kv[r] = 0.f; sp[crow(r, hi) * 128] = (bf16)(cvtpk_s(S[r], 0.f) & 0xffffu); }
            }
            if (kt + 2 < 28) WAIT_BAR(3); else WAIT_BAR(0);
            st = st + 1; if (st >= 3) st = 0;
        }
    }
#undef RET_STAGE
}
__device__ __forceinline__ void ret_phase(const bf16* Q, const bf16* Kg, const bf16* Vg, const bf16* RG, const float* gn, const bf16* STg, bf16* Y, LAS unsigned char* lds, int bx, int G, int tid, int wave, int lane) {
    const int r32 = lane & 31, hi = lane >> 5;
    const int skey = wave * 8 + (lane >> 3), sc = (lane & 7) ^ (lane >> 3);
    const int vkey = wave * 8 + (lane >> 4), vc = (lane & 15) ^ (((lane >> 4) & 3) << 2);
    const unsigned ldsk = (unsigned)(size_t)lds + (unsigned)wave * 1024u, ldsv = (unsigned)(size_t)lds + 8192u + (unsigned)wave * 2048u, ldss = (unsigned)(size_t)lds + 73728u + (unsigned)wave * 2048u;
#define RET_STAGE(kt_, st_) do { const unsigned so_ = (unsigned)(st_) * 24576u; \
        glds16(Kg + (rbase + (size_t)(kt_) * 64 + skey) * 512 + h * 64 + sc * 8, (unsigned)__builtin_amdgcn_readfirstlane(ldsk + so_)); \
        glds16(Vg + (rbase + (size_t)(kt_) * 64 + vkey) * 1024 + h * 128 + vc * 8, (unsigned)__builtin_amdgcn_readfirstlane(ldsv + so_)); \
        glds16(Vg + (rbase + (size_t)(kt_) * 64 + vkey + 4) * 1024 + h * 128 + vc * 8, (unsigned)__builtin_amdgcn_readfirstlane(ldsv + so_ + 1024u)); } while (0)
#define RET_STAGES(qb_) do { const bf16* s_ = STg + ((size_t)(bh * 8 + (qb_)) * 64 + vkey) * 128 + vc * 8; \
        glds16(s_, (unsigned)__builtin_amdgcn_readfirstlane(ldss)); glds16(s_ + 4 * 128, (unsigned)__builtin_amdgcn_readfirstlane(ldss + 1024u)); } while (0)
    const int kbase = r32 * 128, kx = r32 & 7;
    const int q4 = (lane & 15) >> 2, vb = ((4 * hi + q4) * 256 + 32 * ((lane >> 4) & 1) + 8 * (lane & 3)) ^ (q4 << 6);
    const int sb_ = ((8 * hi + q4) * 256 + 32 * ((lane >> 4) & 1) + 8 * (lane & 3)) ^ (q4 << 6);
    const LAS unsigned char* St = lds + 73728;
    LAS unsigned char* ep = lds + 90112 + wave * 4608;
    const int nper = (2 * 128 + G - 1) / G;
    for (int it = bx * nper; it < (bx + 1) * nper && it < 256; ++it) {
        const int bh = it >> 1, qb0 = 4 * (it & 1), b = bh >> 3, h = bh & 7, kt_end = 4 * qb0 + 15;
        const size_t rbase = (size_t)b * SEQ;
        const float lg2 = log2f(1.f - exp2f(-5.f - (float)h));
        if (qb0 > 0) RET_STAGES(qb0);
        RET_STAGE(4 * qb0, 0); RET_STAGE(4 * qb0 + 1, 1);
        int st = 0;
        WAIT_BAR(3);
        for (int qb = qb0; qb < qb0 + 4; ++qb) {
            const int q0w = qb * 256 + 32 * wave, my_kt = q0w >> 6, n = q0w + r32;
            bf16x8 qf[4];
#pragma unroll
            for (int ks = 0; ks < 4; ++ks) qf[ks] = *(const bf16x8*)(Q + (rbase + n) * 512 + h * 64 + 16 * ks + 8 * hi);
            f32x16 o[4] = {{}, {}, {}, {}};
            if (qb > 0) {
#pragma unroll
                for (int ks = 0; ks < 4; ++ks) {
#pragma unroll
                    for (int dt = 0; dt < 4; ++dt) { const LAS unsigned char* sp = St + (sb_ ^ (dt << 6)) + ks * 4096;
                        const s16x4 a0 = vtr(sp), a1 = vtr(sp + 4 * 256);
                        o[dt] = MFMA32(((bf16x8){a0[0], a0[1], a0[2], a0[3], a1[0], a1[1], a1[2], a1[3]}), qf[ks], o[dt]); }
                    __builtin_amdgcn_sched_barrier(0);
                }
                const float qs = exp2f(lg2 * (float)(32 * wave + r32 + 1));
#pragma unroll
                for (int dt = 0; dt < 4; ++dt)
#pragma unroll
                    for (int r = 0; r < 16; ++r) o[dt][r] *= qs;
            }
#define RET_STEP(BODY) do { const int kt = 4 * qb + t; \
                int st2 = st + 2; if (st2 >= 3) st2 -= 3; \
                if (t == 3 && qb + 1 < qb0 + 4) RET_STAGES(qb + 1);     \
                if (kt + 2 <= kt_end) RET_STAGE(kt + 2, st2); \
                BODY; \
                if (kt + 2 <= kt_end) WAIT_BAR(3); else WAIT_BAR(0); \
                st = st + 1; if (st >= 3) st = 0; } while (0)
            { const int cw = wave >> 1; int t = 0;
              for (; t < cw; ++t) RET_STEP(ret_tile<false>(lds + st * 24576, lds + st * 24576 + 8192, qf, o, lg2, kt, my_kt, n, hi, kbase, kx, vb));
              RET_STEP(ret_tile<true>(lds + st * 24576, lds + st * 24576 + 8192, qf, o, lg2, kt, my_kt, n, hi, kbase, kx, vb)); ++t;
              for (; t < 4; ++t) RET_STEP((void)0); }
#undef RET_STEP
            float ss = 0.f;
#pragma unroll
            for (int dt = 0; dt < 4; ++dt)
#pragma unroll
                for (int r = 0; r < 16; ++r) ss += o[dt][r] * o[dt][r];
            ss += __shfl_xor(ss, 32);
            const float rstd = 1.f / sqrtf(ss * (1.f / 128.f) + EPS);
#pragma unroll
            for (int half = 0; half < 2; ++half) {
#pragma unroll
                for (int dtl = 0; dtl < 2; ++dtl)
#pragma unroll
                    for (int g4 = 0; g4 < 4; ++g4) { const f32x16& od = o[2 * half + dtl];
                        *(LAS unsigned long long*)(ep + r32 * 144 + (32 * dtl + 8 * g4 + 4 * hi) * 2) =
                            (unsigned long long)cvtpk_s(od[4 * g4] * rstd, od[4 * g4 + 1] * rstd) | ((unsigned long long)cvtpk_s(od[4 * g4 + 2] * rstd, od[4 * g4 + 3] * rstd) << 32); }
#pragma unroll
                for (int i = 0; i < 4; ++i) { const int row = (lane >> 3) + 8 * i, e = 64 * half + (lane & 7) * 8;
                    const v4u y = *(const LAS v4u*)(ep + row * 144 + (lane & 7) * 16);
                    const size_t go = (rbase + q0w + row) * 1024 + h * 128 + e;
                    const v4u rg = *(const v4u*)(RG + go); const f32x4 g0 = *(const f32x4*)(gn + h * 128 + e), g1 = *(const f32x4*)(gn + h * 128 + e + 4);
                    f32x4 v0, v1;
                    v0[0] = bflo(y.x) * g0[0] * bflo(rg.x); v0[1] = bfhi(y.x) * g0[1] * bfhi(rg.x); v0[2] = bflo(y.y) * g0[2] * bflo(rg.y); v0[3] = bfhi(y.y) * g0[3] * bfhi(rg.y);
                    v1[0] = bflo(y.z) * g1[0] * bflo(rg.z); v1[1] = bfhi(y.z) * g1[1] * bfhi(rg.z); v1[2] = bflo(y.w) * g1[2] * bflo(rg.w); v1[3] = bfhi(y.w) * g1[3] * bfhi(rg.w);
                    *(v4u*)(Y + go) = pack8(v0, v1); }
            }
        }
    }
#undef RET_STAGE
#undef RET_STAGES
}

__device__ __forceinline__ void p_route(const Args& a, LAS unsigned char* lds, int vcu, int G, int wave, int lane, int tid) {
    const float* h = a.out; const float* gf = a.in[9]; const float* wg = a.in[10]; const float* bg = a.in[11]; const float* we = a.in[12]; const float* be = a.in[13];
    LAS float* lw = (LAS float*)lds;
    for (int i = tid; i < 1024 * 20; i += NTHR) { const int k = i / 20, o = i % 20; lw[i] = o < 4 ? wg[k * 4 + o] : we[k * 16 + o - 4]; }
    __syncthreads();
    const int gw = vcu * NWAVES + wave, NGW = G * NWAVES;
    TokInfo* tinfo = (TokInfo*)(a.ws + (a.rep ? WS_PROBE : WS_TOK)); float* rstd_o = (float*)(a.ws + (a.rep ? WS_PROBE + MiB : WS_RSTD));
    unsigned* cnt = (unsigned*)(a.ws + WS_CTL) + (a.rep ? CW_CNT + 4096 : CW_CNT);
    f32x4 gv[4];
#pragma unroll
    for (int j = 0; j < 4; ++j) gv[j] = ((const f32x4*)gf)[lane + 64 * j];
    for (int base = gw; base < T; base += NGW * 16) {
        int my_cls = -1; float my_ga = 0.f, my_gb = 0.f, my_rstd = 0.f;
        for (int j = 0; j < 16; ++j) {
            const int t = base + NGW * j; if (t >= T) break;
            const GAS f32x4* xr = (const GAS f32x4*)(h + (size_t)t * DM) + lane;
            f32x4 v[4]; float s = 0.f;
#pragma unroll
            for (int jj = 0; jj < 4; ++jj) { v[jj] = xr[64 * jj]; s += (v[jj].x * v[jj].x + v[jj].y * v[jj].y) + (v[jj].z * v[jj].z + v[jj].w * v[jj].w); }
            const float rstd = 1.f / sqrtf(wave_sum(s) * (1.f / DM) + EPS);
            float part[20];
#pragma unroll
            for (int o = 0; o < 20; ++o) part[o] = 0.f;
#pragma unroll
            for (int jj = 0; jj < 4; ++jj) { const f32x4 y = v[jj] * rstd * gv[jj];
#pragma unroll
                for (int e = 0; e < 4; ++e) { const LAS f32x4* wp = (const LAS f32x4*)(lw + (256 * jj + 4 * lane + e) * 20);
#pragma unroll
                    for (int o4 = 0; o4 < 5; ++o4) { const f32x4 w = wp[o4]; part[4*o4] += y[e] * w[0]; part[4*o4+1] += y[e] * w[1]; part[4*o4+2] += y[e] * w[2]; part[4*o4+3] += y[e] * w[3]; } } }
#pragma unroll
            for (int o = 0; o < 20; ++o) part[o] = wave_sum(part[o]);
            float gl[4];
#pragma unroll
            for (int o = 0; o < 4; ++o) gl[o] = part[o] + bg[o];
            int gi = 0; float gm = gl[0];
#pragma unroll
            for (int o = 1; o < 4; ++o) if (gl[o] > gm) { gm = gl[o]; gi = o; }
            float gs = 0.f;
#pragma unroll
            for (int o = 0; o < 4; ++o) gs += __expf(gl[o] - gm);
            const float pgrp = 1.f / gs;
            float el[4];
#pragma unroll
            for (int e = 0; e < 4; ++e) { const float l0 = part[4 + e] + be[e], l1 = part[8 + e] + be[4 + e], l2 = part[12 + e] + be[8 + e], l3 = part[16 + e] + be[12 + e];
                el[e] = gi == 0 ? l0 : (gi == 1 ? l1 : (gi == 2 ? l2 : l3)); }
            int i1 = 0; float m1 = el[0];
#pragma unroll
            for (int e = 1; e < 4; ++e) if (el[e] > m1) { m1 = el[e]; i1 = e; }
            int i2 = -1; float m2 = -3.0e38f;
#pragma unroll
            for (int e = 0; e < 4; ++e) if (e != i1 && el[e] > m2) { m2 = el[e]; i2 = e; }
            const float s1 = 1.f / (1.f + __expf(m2 - m1)), g1 = s1 * pgrp, g2 = (1.f - s1) * pgrp;
            const int pa = i1 < i2 ? i1 : i2, pb = i1 < i2 ? i2 : i1;
            const float ga = i1 < i2 ? g1 : g2, gb = i1 < i2 ? g2 : g1;
            const int pidx = pa == 0 ? pb - 1 : (pa == 1 ? pb + 1 : 5);
            if (lane == j) { my_cls = gi * 6 + pidx; my_ga = ga; my_gb = gb; my_rstd = rstd; }
        }
        int my_pos = 0;
        for (int c = 0; c < NCLS; ++c) {
            const unsigned long long mask = __ballot(my_cls == c);
            if (mask) { const int nn = __popcll(mask), leader = __ffsll((long long)mask) - 1; unsigned bse = 0;
                if (lane == leader) bse = __hip_atomic_fetch_add(cnt + 64 * c, (unsigned)nn, __ATOMIC_RELAXED, __HIP_MEMORY_SCOPE_AGENT);
                bse = __shfl(bse, leader);
                if (my_cls == c) my_pos = (int)bse + __popcll(mask & ((1ull << lane) - 1ull)); }
        }
        if (my_cls >= 0) { const int t = base + NGW * lane; tinfo[t] = TokInfo{my_cls, my_pos, my_ga, my_gb}; rstd_o[t] = my_rstd; }
    }
}
__device__ __forceinline__ void build_class_table(const Args& a, volatile LAS int* tab, int tid) {
    if (tid == 0) { const unsigned* cnt = (const unsigned*)(a.ws + WS_CTL) + CW_CNT; int acc_ = 0;
        for (int c = 0; c < NCLS; ++c) { tab[c] = acc_; const int n = (int)__hip_atomic_load(cnt + 64 * c, __ATOMIC_RELAXED, __HIP_MEMORY_SCOPE_AGENT); tab[32 + c] = n; acc_ += (n + 255) >> 8; }
        tab[NCLS] = acc_; }
    __syncthreads();
}
__device__ __forceinline__ void p_scatter(const Args& a, volatile LAS int* tab, int vcu, int G, int wave, int lane, int tid) {
    const float* h = a.out; const float* gf = a.in[9];
    const TokInfo* tinfo = (const TokInfo*)(a.ws + WS_TOK); const float* rstd_i = (const float*)(a.ws + WS_RSTD);
    SInfo* sinfo = (SInfo*)(a.ws + WS_SINFO); bf16* hns = (bf16*)(a.ws + WS_HNS);
    const int gw = vcu * NWAVES + wave, NGW = G * NWAVES;
    f32x4 gv[4];
#pragma unroll
    for (int j = 0; j < 4; ++j) gv[j] = ((const f32x4*)gf)[lane + 64 * j];
    for (int t = gw; t < T; t += NGW) {
        const TokInfo ti = tinfo[t]; const float rstd = rstd_i[t];
        const int srow = tab[ti.cls] * 256 + ti.pos;
        const GAS f32x4* xr = (const GAS f32x4*)(h + (size_t)t * DM) + lane;
        GAS unsigned long long* o8 = (GAS unsigned long long*)(hns + (size_t)srow * DM) + lane;
#pragma unroll
        for (int j = 0; j < 4; ++j) { const f32x4 y = xr[64 * j] * rstd * gv[j]; o8[64 * j] = (unsigned long long)pk2(y.x, y.y) | ((unsigned long long)pk2(y.z, y.w) << 32); }
        if (lane == 0) sinfo[srow] = SInfo{t, ti.ga, ti.gb, 0};
    }
    for (int idx = (vcu * NTHR + tid); idx < NCLS * 256; idx += G * NTHR) { const int c = idx >> 8, r = tab[32 + c] + (idx & 255);
        if (r < (((tab[32 + c] + 255) >> 8) << 8)) sinfo[tab[c] * 256 + r] = SInfo{-1, 0.f, 0.f, 0}; }
}
__device__ __forceinline__ void p_final(const Args& a, int vcu, int G, int wave, int lane) {
    float* h = a.rep ? (float*)(a.ws + WS_PROBE) : a.out; const float* gf = a.in[17];
    const int gw = vcu * NWAVES + wave, NGW = G * NWAVES;
    f32x4 gv[4];
#pragma unroll
    for (int j = 0; j < 4; ++j) gv[j] = ((const f32x4*)gf)[lane + 64 * j];
    for (int t = gw; t < T; t += NGW) {
        GAS f32x4* xr = (GAS f32x4*)(h + (size_t)t * DM) + lane;
        f32x4 v[4]; float s = 0.f;
#pragma unroll
        for (int j = 0; j < 4; ++j) { v[j] = xr[64 * j]; s += (v[j].x * v[j].x + v[j].y * v[j].y) + (v[j].z * v[j].z + v[j].w * v[j].w); }
        const float rstd = 1.f / sqrtf(wave_sum(s) * (1.f / DM) + EPS);
#pragma unroll
        for (int j = 0; j < 4; ++j) xr[64 * j] = v[j] * rstd * gv[j];
    }
}

#ifndef PROBE_MASK
#define PROBE_MASK 0
#endif
#ifndef MK_ONE_LAUNCH
#if PROBE_MASK
#define MK_ONE_LAUNCH 0
#else
#define MK_ONE_LAUNCH 1
#endif
#endif
constexpr int NPHASE = 12;
__global__ void __launch_bounds__(NTHR, 2) fwd_kernel(Args args) {
    extern __shared__ __attribute__((aligned(16))) unsigned char lds_raw[];
    LAS unsigned char* lds = (LAS unsigned char*)lds_raw;
    volatile LAS unsigned* MISC = (volatile LAS unsigned*)(lds + MISC_OFF);
    volatile LAS int* tab = (volatile LAS int*)(lds + TAB_OFF);
    const int tid = threadIdx.x, lane = tid & 63, wave = __builtin_amdgcn_readfirstlane(tid >> 6);
    const int G = gridDim.x; const int bx = blockIdx.x; const int vcu = (G % 8 == 0) ? (bx % 8) * (G / 8) + bx / 8 : bx;
    unsigned char* ws = args.ws;
    for (int u = tid; u < (LDS_BYTES - LDSCTL_OFF) / 4; u += NTHR) ((LAS unsigned*)(lds + LDSCTL_OFF))[u] = 0u;
    __syncthreads();
    XcdBarrier bar; bar.bar = (unsigned*)(ws + WS_CTL) + CW_BAR; bar.x = 0; bar.st = nullptr;
    if (MK_ONE_LAUNCH) bar = xcd_barrier_post((unsigned*)(ws + WS_CTL) + CW_BAR, MISC + 8);
    const int lo = args.ph_lo, hi = args.ph_hi;
#define IN(k) (lo <= (k) && (k) < hi)
#define SEAM(k) do { if (MK_ONE_LAUNCH && IN(k) && IN((k) + 1)) xcd_barrier(bar); } while (0)
    bf16* W1 = (bf16*)(ws + WS_W1); bf16* XN = (bf16*)(ws + WS_R1); bf16* YRET = (bf16*)(ws + WS_R1); bf16* HIDS = (bf16*)(ws + WS_R1);
    bf16* SBQ = (bf16*)(ws + WS_SBQ); bf16* SBK = (bf16*)(ws + WS_SBK); bf16* SBV = (bf16*)(ws + WS_SBV); bf16* RQ = (bf16*)(ws + WS_RQ); bf16* RK = (bf16*)(ws + WS_RK);
    bf16* RV = (bf16*)(ws + WS_RV); bf16* RG = (bf16*)(ws + WS_RG); bf16* YSB = (bf16*)(ws + WS_YSB); bf16* GATES = (bf16*)args.out;
    bf16* TMP = (bf16*)(ws + WS_TMP); bf16* MIX = (bf16*)(ws + WS_MIX); bf16* HNS = (bf16*)(ws + WS_HNS);
    const SInfo* sinfo = (const SInfo*)(ws + WS_SINFO);

    if (IN(0)) { p0_prologue(args, lds, vcu, G, wave, lane); }
    SEAM(0);
    if (IN(1)) {
        pg8::StaticOrder S; S.init(XN, W1, T, N1, 1024, G, bx);
        Epi1 E{SBQ, SBK, SBV, RQ, RK, RV, RG, GATES, args.in[4], (const float*)(ws + WS_ROT)};
        pg8::gemm_phase<Epi1, pg8::StaticOrder, true, true>(lds, 1024, S, E);
    }
    SEAM(1);
    if (IN(2)) {
        const int nret = G >> 1;
#ifdef PROBE_ABL
        if (args.rep) { if (PROBE_ABL == 1) { if (bx < nret) kv_chain(RK, RV, (bf16*)(ws + WS_KV), lds, bx, nret, tid, wave, lane); }
                        else { sb_phase(SBQ, SBK, SBV, YSB, lds, bx, G, tid, wave, lane, true); } } else
#endif
        {
        if (bx < nret) kv_chain(RK, RV, (bf16*)(ws + WS_KV), lds, bx, nret, tid, wave, lane);
        if (G == 256) { for (int k = 0; k < (bx < nret ? 3 : 5); ++k) { const int u = bx < nret ? 8 * bx + k : 8 * (bx - nret) + 3 + k; sb_phase(SBQ, SBK, SBV, YSB, lds, u, 1 << 20, tid, wave, lane); } }
        else sb_phase(SBQ, SBK, SBV, YSB, lds, bx, G, tid, wave, lane);
        }
    }
    SEAM(2);
    if (IN(3)) { ret_phase(RQ, RK, RV, RG, args.in[7], (const bf16*)(ws + WS_KV), YRET, lds, bx, G, tid, wave, lane); }
    SEAM(3);
    if (IN(4)) {
        pg8::StaticOrder S; S.init(YSB, ws + WS_WSB, T, 1024, 512, G, bx);
        EpiMix<false> E{GATES, 0, nullptr, TMP};
        pg8::gemm_phase<EpiMix<false>, pg8::StaticOrder, true, true>(lds, 512, S, E);
    }
    SEAM(4);
    if (IN(5)) {
        pg8::StaticOrder S; S.init(YRET, ws + WS_WRET, T, 1024, 1024, G, bx);
        EpiMix<true> E{GATES, 1024, TMP, MIX};
        pg8::gemm_phase<EpiMix<true>, pg8::StaticOrder, true, true>(lds, 1024, S, E);
    }
    SEAM(5);
    if (IN(6)) {
        pg8::StaticOrder S; S.init(MIX, ws + WS_WOUT, T, 1024, 1024, G, bx);
        EpiOut E{args.in[0], args.out};
        pg8::gemm_phase<EpiOut, pg8::StaticOrder, true, true>(lds, 1024, S, E);
    }
    SEAM(6);
    if (IN(7)) { p_route(args, lds, vcu, G, wave, lane, tid); __syncthreads(); }
    SEAM(7);
    if (IN(8)) { build_class_table(args, tab, tid); p_scatter(args, tab, vcu, G, wave, lane, tid); }
    SEAM(8);
    if (IN(9)) {
        build_class_table(args, tab, tid);
        MoeOrder S{(const char*)HNS, (const char*)(ws + WS_WUP), tab, 8, 1, G, bx};
        EpiUp E{sinfo, HIDS};
        pg8::gemm_phase<EpiUp, MoeOrder, true, true>(lds, 1024, S, E);
    }
    SEAM(9);
    if (IN(10)) {
        build_class_table(args, tab, tid);
        MoeOrder S{(const char*)HIDS, (const char*)(ws + WS_WDN), tab, 4, 0, G, bx};
        EpiDown E{sinfo, args.rep ? (float*)(ws + WS_PROBE) : args.out};
        pg8::gemm_phase<EpiDown, MoeOrder, true, true>(lds, 1024, S, E);
    }
    SEAM(10);
    if (IN(11)) { p_final(args, vcu, G, wave, lane); }
#undef IN
#undef SEAM
}

extern "C" void kernel_launch(void* const* d_in, const int* in_sizes, int n_in, void* d_out, int out_size, void* d_ws, size_t ws_size, hipStream_t stream) {
    static int grid = 0;
    if (grid == 0) {
        if (n_in != 18 || in_sizes[0] != T * DM || out_size != T * DM || ws_size < WS_END) { fprintf(stderr, "kernel_launch: unexpected shapes (n_in %d, in0 %d, out %d, ws %zu < %zu)\n", n_in, n_in > 0 ? in_sizes[0] : -1, out_size, ws_size, (size_t)WS_END); grid = -1; return; }
        int dev = 0, cus = 0, per_cu = 0;
        if (hipGetDevice(&dev) != hipSuccess || hipDeviceGetAttribute(&cus, hipDeviceAttributeMultiprocessorCount, dev) != hipSuccess) { grid = -1; return; }
        if (hipFuncSetAttribute((const void*)fwd_kernel, hipFuncAttributeMaxDynamicSharedMemorySize, LDS_BYTES) != hipSuccess) { fprintf(stderr, "kernel_launch: hipFuncSetAttribute failed\n"); grid = -1; return; }
        if (hipOccupancyMaxActiveBlocksPerMultiprocessor(&per_cu, (const void*)fwd_kernel, NTHR, LDS_BYTES) != hipSuccess || per_cu < 1) fprintf(stderr, "kernel_launch: occupancy query reports %d\n", per_cu);
        (void)hipGetLastError();
        grid = cus;
    }
    if (grid < 0) return;
    hipMemsetAsync((char*)d_ws + WS_CTL, 0, CTL_ZERO_BYTES, stream);
    Args a{};
    for (int i = 0; i < 18; ++i) a.in[i] = (const float*)d_in[i];
    a.out = (float*)d_out; a.ws = (unsigned char*)d_ws;
#if MK_ONE_LAUNCH
    a.ph_lo = 0; a.ph_hi = NPHASE;
    hipLaunchKernelGGL(fwd_kernel, dim3(grid), dim3(NTHR), LDS_BYTES, stream, a);
#else
    for (int p = 0; p < NPHASE; ++p) for (int rep = 0; rep < ((PROBE_MASK >> p) & 1) + 1; ++rep) { a.ph_lo = p; a.ph_hi = p + 1; a.rep = rep; hipLaunchKernelGGL(fwd_kernel, dim3(grid), dim3(NTHR), LDS_BYTES, stream, a); }
#endif
}
```

```cpp
#include <hip/hip_runtime.h>
#include <cstdio>
#include <cstdint>
namespace pg8 {
#define PG8_LAS __attribute__((address_space(3)))
typedef unsigned short bf16_t;
typedef short bf16x8 __attribute__((ext_vector_type(8)));
typedef float f32x4 __attribute__((ext_vector_type(4)));
typedef unsigned u32x4 __attribute__((ext_vector_type(4)));
constexpr int BM = 256, BK = 64, HALF = 128, HTB = HALF * BK * 2  , STAGE_BYTES = 8 * HTB, NXCD = 8, WGM = 8;
__host__ __device__ __forceinline__ int lds_byte(int r, int c) { const int st = (r >> 4) * 2 + (c >> 5), rr = r & 15, cc = c & 31, ob = rr * 64 + cc * 2; return st * 1024 + (ob ^ (((ob >> 9) & 1) << 5)); }
__host__ __device__ __forceinline__ void stage_rc(int b, int& R, int& C) { const int st = b / 1024, sb = b % 1024, swz = sb ^ (((sb >> 9) & 1) << 5); R = (st >> 1) * 16 + swz / 64; C = (st & 1) * 32 + (swz % 64) / 2; }
__host__ __device__ __forceinline__ int perm32(int rho) { const int n = rho >> 4, i = rho & 15; return 8 * (i >> 2) + 4 * n + (i & 3); }

struct Unit { const char* a; const char* b; int row0, col0, tag, idx; };
struct StaticOrder {
    const char* A; const char* Bt; int K, nM, nN, nwg, G, c;
    __device__ void init(const void* A_, const void* Bt_, int M, int N, int K_, int G_, int c_) { A = (const char*)A_; Bt = (const char*)Bt_; K = K_; nM = M / BM; nN = N / BM; nwg = nM * nN; G = G_; c = c_; }
    __device__ bool next(int i, Unit& u) const {
        const long L = (long)i * G + c; if (L >= nwg) return false;
        int wgid = (int)L; { const int q = nwg / NXCD, r = nwg % NXCD, xcd = wgid % NXCD, off = wgid / NXCD; wgid = (xcd < r ? xcd * (q + 1) : r * (q + 1) + (xcd - r) * q) + off; }
        const int nig = WGM * nN, gid = wgid / nig, fm = gid * WGM, gsz = (nM - fm) < WGM ? (nM - fm) : WGM;
        const int pm = fm + ((wgid % nig) % gsz), pn = (wgid % nig) / gsz;
        u.a = A + (size_t)pm * BM * K * 2; u.b = Bt + (size_t)pn * BM * K * 2; u.row0 = pm * BM; u.col0 = pn * BM; u.tag = pn; u.idx = i; return true;
    }
    __device__ __forceinline__ void a_ready(const Unit&) const {}
    __device__ __forceinline__ void done(const Unit&) const {}
};
__device__ __forceinline__ unsigned cvt_pk_bf16(float lo, float hi) { unsigned r; asm volatile("v_cvt_pk_bf16_f32 %0, %1, %2" : "=v"(r) : "v"(lo), "v"(hi)); return r; }
template <class Epi, class Sched, bool ALIGN_EPI = false, bool SP2 = false, bool GATHER = false>
__device__ __forceinline__ void gemm_phase(PG8_LAS unsigned char* lds, const int K, const Sched& S, const Epi& E) {
    const int tid = threadIdx.x, wid = __builtin_amdgcn_readfirstlane(tid >> 6), lane = tid & 63, wr = wid >> 2, wc = wid & 3, fr = lane & 15, fq = lane >> 4;
    const int nt = K / BK;
    static_assert(!GATHER || SP2, "GATHER is implemented on the SP2 loop only");
    unsigned voffA[2], voffA1[2], voffB[2], voffAn[2] = {0u, 0u}, voffA1n[2] = {0u, 0u}; int Rr[2], Cc[2];
#pragma unroll
    for (int i = 0; i < 2; ++i) { int R, C; stage_rc(tid * 16 + i * 8192, R, C); const int Rb = Epi::PERM ? ((R & ~31) + perm32(R & 31)) : R; Rr[i] = R; Cc[i] = C;
        voffA[i] = (unsigned)(R * K + C) * 2u; voffA1[i] = voffA[i] + (unsigned)(HALF * K * 2); voffB[i] = (unsigned)(Rb * K + C) * 2u; }
#define PG8_AROWS(ui_, v0_, v1_) do { _Pragma("unroll") for (int i_ = 0; i_ < 2; ++i_) { \
        v0_[i_] = (unsigned)(S.arow((ui_), Rr[i_]) * K + Cc[i_]) * 2u; v1_[i_] = (unsigned)(S.arow((ui_), Rr[i_] + HALF) * K + Cc[i_]) * 2u; } } while (0)
    const size_t kstep = (size_t)(BK * 2);
    const size_t hstep = (size_t)HALF * K * 2;
    const size_t tstep = 2 * hstep;
    const unsigned ldsw = (unsigned)wid * 1024u;
    const int aoff = lds_byte(wr * 64 + fr, fq * 8), boff = lds_byte(wc * 32 + fr, fq * 8);
#define PG8_SA(b, h) (((b) * 2 + (h)) * HTB)
#define PG8_SB(b, h) ((4 + (b) * 2 + (h)) * HTB)
#define PG8_STAGE(bufoff, gbase, voff) do { _Pragma("unroll") for (int _i = 0; _i < 2; ++_i) \
        __builtin_amdgcn_global_load_lds((const unsigned*)((const char*)(gbase) + (voff)[_i]), (PG8_LAS unsigned*)(lds + (bufoff) + ldsw + _i * 8192), 16, 0, 0); } while (0)
#define PG8_LDA(dst, b, h) do { _Pragma("unroll") for (int m = 0; m < 4; ++m) _Pragma("unroll") for (int k = 0; k < 2; ++k) dst[m][k] = *(const PG8_LAS bf16x8*)(lds + PG8_SA(b, h) + aoff + m * 2048 + k * 1024); } while (0)
#define PG8_LDB(dst, b, h) do { _Pragma("unroll") for (int n = 0; n < 2; ++n) _Pragma("unroll") for (int k = 0; k < 2; ++k) dst[n][k] = *(const PG8_LAS bf16x8*)(lds + PG8_SB(b, h) + boff + n * 2048 + k * 1024); } while (0)
#define PG8_MMA(ai, bj, At, Bt) do { __builtin_amdgcn_s_setprio(1); _Pragma("unroll") for (int m = 0; m < 4; ++m) _Pragma("unroll") for (int n = 0; n < 2; ++n) _Pragma("unroll") for (int k = 0; k < 2; ++k) \
        acc[ai][bj][m][n] = __builtin_amdgcn_mfma_f32_16x16x32_bf16(Bt[n][k], At[m][k], acc[ai][bj][m][n], 0, 0, 0); __builtin_amdgcn_s_setprio(0); } while (0)
#define PG8_WAIT_V(n) asm volatile("s_waitcnt vmcnt(" #n ")" ::: "memory")
#define PG8_WAIT_L(n) asm volatile("s_waitcnt lgkmcnt(" #n ")" ::: "memory")
#define PG8_BAR __builtin_amdgcn_s_barrier()
#define PG8_SCHED __builtin_amdgcn_sched_barrier(0)
    Unit cur, nxt; int ui = 0;
    if (!S.next(0, cur)) return;
    f32x4 acc[2][2][4][2];
#pragma unroll
    for (int a = 0; a < 2; ++a)
#pragma unroll
        for (int b = 0; b < 2; ++b)
#pragma unroll
            for (int m = 0; m < 4; ++m)
#pragma unroll
                for (int n = 0; n < 2; ++n) acc[a][b][m][n] = (f32x4){0.f, 0.f, 0.f, 0.f};
    bf16x8 At[4][2], B0[2][2], B1[2][2];
    const char* cA = cur.a; const char* cB = cur.b;
    S.a_ready(cur);
    if constexpr (SP2) {
        if constexpr (GATHER) PG8_AROWS(0, voffA, voffA1);
        PG8_STAGE(PG8_SB(0, 0), cB, voffB); PG8_STAGE(PG8_SB(0, 1), cB + hstep, voffB); PG8_STAGE(PG8_SA(0, 0), cA, voffA); PG8_STAGE(PG8_SA(0, 1), cA, voffA1);
        if (wr == 1) PG8_BAR;
        PG8_WAIT_V(2); PG8_BAR;
        PG8_STAGE(PG8_SB(1, 0), cB + kstep, voffB); PG8_STAGE(PG8_SA(1, 0), cA + kstep, voffA); PG8_STAGE(PG8_SB(1, 1), cB + hstep + kstep, voffB);
        PG8_WAIT_V(6); PG8_BAR;
    } else {
        PG8_STAGE(PG8_SB(0, 0), cB, voffB); PG8_STAGE(PG8_SA(0, 0), cA, voffA); PG8_STAGE(PG8_SB(0, 1), cB + hstep, voffB); PG8_STAGE(PG8_SA(0, 1), cA + hstep, voffA);
        if (wr == 1) PG8_BAR;
        PG8_WAIT_V(4); PG8_BAR;
        PG8_STAGE(PG8_SB(1, 0), cB + kstep, voffB); PG8_STAGE(PG8_SA(1, 0), cA + kstep, voffA); PG8_STAGE(PG8_SB(1, 1), cB + hstep + kstep, voffB);
        PG8_WAIT_V(6); PG8_BAR;
    }
    for (;;) {
        const bool has_next = S.next(ui + 1, nxt);
        if constexpr (GATHER) { if (has_next) PG8_AROWS(ui + 1, voffAn, voffA1n); }
        const char* nA = has_next ? nxt.a : cA; const char* nB = has_next ? nxt.b : cB;
        for (int t = 0; t < nt; t += 2) {
            const bool last = (t == nt - 2);
            const char* a1 = cA + (size_t)(t + 1) * kstep;
            const char* a2 = last ? nA : cA + (size_t)(t + 2) * kstep; const char* b2 = last ? nB : cB + (size_t)(t + 2) * kstep;
            const char* a3 = a2 + kstep; const char* b3 = b2 + kstep;
            if (last && has_next) S.a_ready(nxt);
            unsigned vx0[2], vx1[2];
#pragma unroll
            for (int i = 0; i < 2; ++i) { vx0[i] = (GATHER && last && has_next) ? voffAn[i] : voffA[i]; vx1[i] = (GATHER && last && has_next) ? voffA1n[i] : voffA1[i]; }
            if constexpr (SP2) {
            PG8_LDB(B0, 0, 0); PG8_LDB(B1, 0, 1); PG8_SCHED; PG8_LDA(At, 0, 0); PG8_STAGE(PG8_SA(1, 1), a1, voffA1);
            PG8_WAIT_V(8); PG8_WAIT_L(0); PG8_BAR; PG8_MMA(0, 0, At, B0); PG8_MMA(0, 1, At, B1); PG8_BAR; PG8_SCHED;
            PG8_LDA(At, 0, 1); PG8_STAGE(PG8_SB(0, 0), b2, voffB); PG8_STAGE(PG8_SB(0, 1), b2 + hstep, voffB); PG8_STAGE(PG8_SA(0, 0), a2, vx0);
            PG8_WAIT_V(8); PG8_WAIT_L(0); PG8_BAR; PG8_MMA(1, 0, At, B0); PG8_MMA(1, 1, At, B1); PG8_BAR; PG8_SCHED;
            PG8_LDB(B0, 1, 0); PG8_LDB(B1, 1, 1); PG8_SCHED; PG8_LDA(At, 1, 0); PG8_STAGE(PG8_SA(0, 1), a2, vx1);
            PG8_WAIT_V(8); PG8_WAIT_L(0); PG8_BAR; PG8_MMA(0, 0, At, B0); PG8_MMA(0, 1, At, B1); PG8_BAR; PG8_SCHED;
            PG8_LDA(At, 1, 1); PG8_STAGE(PG8_SB(1, 0), b3, voffB); PG8_STAGE(PG8_SB(1, 1), b3 + hstep, voffB); PG8_STAGE(PG8_SA(1, 0), a3, vx0);
            PG8_WAIT_V(8); PG8_WAIT_L(0); PG8_BAR; PG8_MMA(1, 0, At, B0); PG8_MMA(1, 1, At, B1); PG8_BAR; PG8_SCHED;
            } else {
            PG8_LDB(B0, 0, 0); PG8_SCHED; PG8_LDA(At, 0, 0); PG8_STAGE(PG8_SA(1, 1), a1 + hstep, voffA);
            PG8_WAIT_L(8); PG8_BAR; PG8_WAIT_L(0); PG8_MMA(0, 0, At, B0); PG8_BAR; PG8_SCHED;
            PG8_LDB(B1, 0, 1); PG8_STAGE(PG8_SB(0, 0), b2, voffB);
            PG8_BAR; PG8_WAIT_L(0); PG8_MMA(0, 1, At, B1); PG8_BAR;
            PG8_LDA(At, 0, 1); PG8_STAGE(PG8_SA(0, 0), a2, voffA);
            PG8_BAR; PG8_WAIT_L(0); PG8_MMA(1, 0, At, B0); PG8_BAR; PG8_SCHED;
            PG8_STAGE(PG8_SB(0, 1), b2 + hstep, voffB);
            PG8_WAIT_V(6); PG8_BAR; PG8_MMA(1, 1, At, B1); PG8_BAR;
            PG8_LDB(B0, 1, 0); PG8_SCHED; PG8_LDA(At, 1, 0); PG8_STAGE(PG8_SA(0, 1), a2 + hstep, voffA);
            PG8_WAIT_L(8); PG8_BAR; PG8_WAIT_L(0); PG8_MMA(0, 0, At, B0); PG8_BAR; PG8_SCHED;
            PG8_LDB(B1, 1, 1); PG8_STAGE(PG8_SB(1, 0), b3, voffB);
            PG8_BAR; PG8_WAIT_L(0); PG8_MMA(0, 1, At, B1); PG8_BAR;
            PG8_LDA(At, 1, 1); PG8_STAGE(PG8_SA(1, 0), a3, voffA);
            PG8_BAR; PG8_WAIT_L(0); PG8_MMA(1, 0, At, B0); PG8_BAR; PG8_SCHED;
            PG8_STAGE(PG8_SB(1, 1), b3 + hstep, voffB);
            PG8_WAIT_V(6); PG8_BAR; PG8_MMA(1, 1, At, B1); PG8_BAR;
            }
        }
        if constexpr (ALIGN_EPI) { if (wr == 0) PG8_BAR; }
        if constexpr (!Epi::AFTER_DRAIN) { E(acc, cur, wr, wc, fr, fq); S.done(cur); }
        if (!has_next) break;
#pragma unroll
        for (int a = 0; a < 2; ++a)
#pragma unroll
            for (int b = 0; b < 2; ++b)
#pragma unroll
                for (int m = 0; m < 4; ++m)
#pragma unroll
                    for (int n = 0; n < 2; ++n) acc[a][b][m][n] = (f32x4){0.f, 0.f, 0.f, 0.f};
        cur = nxt; cA = nA; cB = nB; ++ui;
        if constexpr (GATHER) {
#pragma unroll
            for (int i = 0; i < 2; ++i) { voffA[i] = voffAn[i]; voffA1[i] = voffA1n[i]; } }
        if constexpr (ALIGN_EPI) { if (wr == 1) PG8_BAR; }
    }
    PG8_WAIT_V(0);
    if constexpr (!ALIGN_EPI) { if (wr == 0) PG8_BAR; }
    PG8_BAR;
    if constexpr (Epi::AFTER_DRAIN) { E.fused(acc, cur, wr, wc, fr, fq, lds, wid, lane); S.done(cur); }
#undef PG8_AROWS
#undef PG8_SA
#undef PG8_SB
#undef PG8_STAGE
#undef PG8_LDA
#undef PG8_LDB
#undef PG8_MMA
#undef PG8_WAIT_V
#undef PG8_WAIT_L
#undef PG8_BAR
#undef PG8_SCHED
}
}
#define GAS __attribute__((address_space(1)))
#define LAS __attribute__((address_space(3)))
typedef unsigned short bf16;
typedef unsigned v4u __attribute__((ext_vector_type(4)));
typedef float f32x4 __attribute__((ext_vector_type(4)));
typedef short bf16x8 __attribute__((ext_vector_type(8)));
typedef GAS unsigned gu32;
typedef GAS unsigned long long gu64;
#define RLX_AGENT __ATOMIC_RELAXED, __HIP_MEMORY_SCOPE_AGENT
#define LDS_WAIT() asm volatile("s_waitcnt lgkmcnt(0)" ::: "memory")
#define VM_WAIT() asm volatile("s_waitcnt vmcnt(0)" ::: "memory")
__device__ __forceinline__ unsigned long long rt() { return __builtin_amdgcn_s_memrealtime(); }
__device__ __forceinline__ unsigned f2bf(float f) { unsigned u = __builtin_bit_cast(unsigned, f); return (u + 0x7fffu + ((u >> 16) & 1u)) >> 16; }
__device__ __forceinline__ unsigned pk2(float lo, float hi) { return f2bf(lo) | (f2bf(hi) << 16); }

#define XB_TMO      128
#define XB_XCNT(j)  (256  + 64 * (j))
#define XB_XSUB(j)  (1280 + 64 * (j))
#define XB_XGEN(j)  (2304 + 64 * (j))
#define XB_TOP      3328
#define XB_TOPGEN   3392
#define XCD_BAR_WORDS 3456
#define XB_SPIN_CAP (1u << 18)

__device__ __forceinline__ unsigned xb_ld(unsigned* p)              { return __hip_atomic_load(p, __ATOMIC_RELAXED, __HIP_MEMORY_SCOPE_AGENT); }
__device__ __forceinline__ unsigned xb_add(unsigned* p, unsigned v) { return __hip_atomic_fetch_add(p, v, __ATOMIC_RELAXED, __HIP_MEMORY_SCOPE_AGENT); }
__device__ __forceinline__ unsigned xb_xcc_id() { return (unsigned)__builtin_amdgcn_s_getreg((3 << 11) | 20) & 0xFu; }
#define XB_SPIN(cond, bar) do { unsigned _sp = 0; while (cond) { __builtin_amdgcn_s_sleep(1); \
    if ((++_sp & 255u) == 0u) { if (xb_ld(&(bar)[XB_TMO])) break; if (_sp > XB_SPIN_CAP) { atomicAdd(&(bar)[XB_TMO], 1u); break; } } } } while (0)

struct XcdBarrier {
    unsigned* bar; unsigned x;
    volatile LAS unsigned* st;
};

__device__ __forceinline__ XcdBarrier xcd_barrier_post(unsigned* bar, volatile LAS unsigned* st) {
    XcdBarrier b; b.bar = bar; b.x = xb_xcc_id(); b.st = st;
    if (threadIdx.x == 0) (void)xb_add(&bar[XB_XCNT(b.x)], 1u);
    return b;
}
__device__ __forceinline__ void xcd_barrier_complete(unsigned* bar, unsigned x, unsigned& nloc, unsigned& nx) {
    const unsigned G = gridDim.x * gridDim.y * gridDim.z;
    unsigned sum, cnt, mine, sp = 0u;
    for (;;) {
        sum = 0u; cnt = 0u; mine = 0u;
#pragma unroll
        for (unsigned j = 0; j < 16; ++j) { const unsigned c = xb_ld(&bar[XB_XCNT(j)]); sum += c; cnt += (c > 0u) ? 1u : 0u; mine = (j == x) ? c : mine; }
        if (sum == G) break;
        __builtin_amdgcn_s_sleep(1);
        if ((++sp & 255u) == 0u) { if (xb_ld(&bar[XB_TMO])) break; if (sp > XB_SPIN_CAP) { atomicAdd(&bar[XB_TMO], 1u); break; } }
    }
    nloc = mine > 0u ? mine : 1u; nx = cnt > 0u ? cnt : 1u;
}

__device__ __forceinline__ void xcd_barrier(const XcdBarrier& b) {
    asm volatile("s_waitcnt vmcnt(0)" ::: "memory");
    __syncthreads();
    if (threadIdx.x == 0) {
        unsigned* bar = b.bar;
        __builtin_amdgcn_s_waitcnt(0);
        unsigned nloc = b.st[0], nx = b.st[1];
        if (nloc == 0u) { xcd_barrier_complete(bar, b.x, nloc, nx); b.st[0] = nloc; b.st[1] = nx; }
        const unsigned old = xb_add(&bar[XB_XSUB(b.x)], 1u);
        const unsigned gen = old / nloc;
        if (old + 1u == (gen + 1u) * nloc) {
            __builtin_amdgcn_fence(__ATOMIC_RELEASE, "agent");
            asm volatile("s_waitcnt vmcnt(0)" ::: "memory");
            const unsigned og = xb_add(&bar[XB_TOP], 1u);
            const unsigned tg = og / nx;
            if (og + 1u == (tg + 1u) * nx) xb_add(&bar[XB_TOPGEN], 1u);
            else XB_SPIN(xb_ld(&bar[XB_TOPGEN]) == tg, bar);
            __builtin_amdgcn_fence(__ATOMIC_ACQUIRE, "agent");
            xb_add(&bar[XB_XGEN(b.x)], 1u);
            asm volatile("s_waitcnt vmcnt(0)" ::: "memory");
        } else {
            XB_SPIN(xb_ld(&bar[XB_XGEN(b.x)]) == gen, bar);
            __builtin_amdgcn_fence(__ATOMIC_ACQUIRE, "agent");
            asm volatile("s_waitcnt vmcnt(0)" ::: "memory");
        }
    }
    __syncthreads();
}


constexpr int NWAVES = 8, NTHR = NWAVES * 64;
constexpr int DM = 1024, NB = 16, SEQ = 2048, T = NB * SEQ;
constexpr int N1 = 6656;
constexpr int NCLS = 24, SROWS = T + NCLS * 256;
constexpr float EPS = 1e-6f;
constexpr size_t MiB = 1u << 20;
constexpr size_t WS_CTL = 0, CTL_ZERO_BYTES = 1 * MiB;
constexpr size_t WS_ROT = 1 * MiB;
constexpr size_t WS_WRT = 1 * MiB + 512 * 1024;
constexpr size_t WS_TOK = 2 * MiB;
constexpr size_t WS_RSTD = 2 * MiB + 512 * 1024;
constexpr size_t WS_SINFO = 3 * MiB;
constexpr size_t WS_W1 = 4 * MiB, WS_WSB = 18 * MiB, WS_WRET = 19 * MiB, WS_WOUT = 21 * MiB, WS_WUP = 23 * MiB, WS_WDN = 55 * MiB;
constexpr size_t WS_R1 = 104 * MiB;
constexpr size_t WS_SBQ = 168 * MiB, WS_SBK = 200 * MiB, WS_SBV = 232 * MiB, WS_RQ = 264 * MiB, WS_RK = 296 * MiB, WS_RV = 328 * MiB, WS_RG = 392 * MiB, WS_YSB = WS_SBQ;
constexpr size_t WS_TMP = WS_RV, WS_MIX = WS_SBV, WS_HB = WS_RG;
constexpr size_t WS_PERM = WS_W1;
constexpr size_t WS_KV = 456 * MiB;
constexpr size_t WS_END = 488 * MiB;
constexpr size_t WS_PROBE = 200 * MiB;
constexpr int CW_BAR = 4096, CW_CNT = 8192;
constexpr int LDS_BYTES = 147456;
constexpr int LDSCTL_OFF = LDS_BYTES - 2048, MISC_OFF = LDSCTL_OFF + 320, TAB_OFF = LDSCTL_OFF + 1024;

struct TokInfo { float ga, gb, rstd; int cls; };

__device__ __forceinline__ float wave_sum(float v) {
#pragma unroll
    for (int o = 1; o < 64; o <<= 1) v += __shfl_xor(v, o);
    return v;
}
__device__ __forceinline__ float bf2f(unsigned short b) { return __builtin_bit_cast(float, (unsigned)b << 16); }
__device__ __forceinline__ float bflo(unsigned w) { return __builtin_bit_cast(float, w << 16); }
__device__ __forceinline__ float bfhi(unsigned w) { return __builtin_bit_cast(float, w & 0xffff0000u); }

struct Args { const float* in[18]; float* out; unsigned char* ws; int ph_lo, ph_hi, rep, pad; };

struct TJob { const float* W; int N; bf16* WT; int ldk, koff, mode, nbase; const float* gk; };
__device__ __forceinline__ int rowmap(int mode, int n) {
    if (mode == 1) {
        if (n >= 1536 && n < 2560) { const int seg = n < 2048 ? 1536 : 2048, c = n - seg, hh = c >> 6, i = c & 63; return seg + (hh >> 2) * 256 + (i >> 5) * 128 + (hh & 3) * 32 + (i & 31); }
        return n;
    }
    if (mode == 2) return (n >> 7) * 256 + (n & 127);
    if (mode == 3) return (n >> 7) * 256 + 128 + (n & 127);
    return n;
}
__device__ __forceinline__ void p0_transpose_item(const TJob& J, LAS float* scr, int item, int lane) {
    const int nblk = J.N / 32, kb = item / nblk, nb = item % nblk, k0 = 64 * kb, n0 = 32 * nb;
#pragma unroll 8
    for (int i = 0; i < 32; ++i) { const int kk = 2 * i + (lane >> 5); scr[kk * 33 + (lane & 31)] = J.W[(size_t)(k0 + kk) * J.N + n0 + (lane & 31)]; }
    LDS_WAIT(); asm volatile("" ::: "memory");
    const int c = lane & 7;
#pragma unroll
    for (int j = 0; j < 4; ++j) { const int n = (lane >> 3) + 8 * j; const LAS float* s = scr + (8 * c) * 33 + n;
        const int ng = n0 + n; float sc = 1.f; if (J.mode == 1) { if (ng < 512) sc = 0.125f * 1.4426950408889634f; else if (ng >= 2048 && ng < 2560) sc = 0.125f; }
        float g8[8];
#pragma unroll
        for (int q = 0; q < 8; ++q) g8[q] = J.gk ? J.gk[k0 + 8 * c + q] * sc : sc;
        v4u o; o.x = pk2(s[0 * 33] * g8[0], s[1 * 33] * g8[1]); o.y = pk2(s[2 * 33] * g8[2], s[3 * 33] * g8[3]); o.z = pk2(s[4 * 33] * g8[4], s[5 * 33] * g8[5]); o.w = pk2(s[6 * 33] * g8[6], s[7 * 33] * g8[7]);
        *(GAS v4u*)(J.WT + (size_t)(J.nbase + rowmap(J.mode, ng)) * J.ldk + J.koff + k0 + 8 * c) = o; }
    LDS_WAIT(); asm volatile("" ::: "memory");
}
__device__ __forceinline__ void p0_prologue(const Args& a, LAS unsigned char* lds, int vcu, int G, int wave, int lane) {
    unsigned char* ws = a.ws;
    LAS float* scr = (LAS float*)(lds + wave * 16384);
    const int gw = vcu * NWAVES + wave, NGW = G * NWAVES;
    constexpr int I0 = 16 * 144, I1 = 16 * 64, I2 = 8 * 32, I3 = 16 * 32, I4 = 16 * 32, I5 = 16 * 256, I6 = 16 * 256, I7 = 48 * 256;
    constexpr int NITEMS = I0 + I1 + I2 + I3 + I4 + I5 + I6 + I7;
    for (int it = gw; it < NITEMS; it += NGW) {
        int r = it; TJob J;
        if (r < I0) { J = TJob{a.in[2], 4608, (bf16*)(ws + WS_W1), 1024, 0, 1, 0, nullptr}; }
        else if ((r -= I0) < I1) { J = TJob{a.in[3], 2048, (bf16*)(ws + WS_W1), 1024, 0, 0, 4608, nullptr}; }
        else if ((r -= I1) < I2) { J = TJob{a.in[5], 1024, (bf16*)(ws + WS_WSB), 512, 0, 0, 0, nullptr}; }
        else if ((r -= I2) < I3) { J = TJob{a.in[6], 1024, (bf16*)(ws + WS_WRET), 1024, 0, 0, 0, nullptr}; }
        else if ((r -= I3) < I4) { J = TJob{a.in[8], 1024, (bf16*)(ws + WS_WOUT), 1024, 0, 0, 0, nullptr}; }
        else if ((r -= I4) < I5) { const int e = r >> 8; r &= 255; J = TJob{a.in[14] + (size_t)e * 1024 * 512, 512, (bf16*)(ws + WS_WUP) + (size_t)e * 1024 * 1024, 1024, 0, 2, 0, a.in[9]}; }
        else if ((r -= I5) < I6) { const int e = r >> 8; r &= 255; J = TJob{a.in[15] + (size_t)e * 1024 * 512, 512, (bf16*)(ws + WS_WUP) + (size_t)e * 1024 * 1024, 1024, 0, 3, 0, a.in[9]}; }
        else { r -= I6; const int cs = r >> 8; r &= 255; const int cls = cs >> 1, slot = cs & 1, g = cls / 6, p = cls % 6;
            const int pa = p < 3 ? 0 : (p < 5 ? 1 : 2), pb = p == 0 ? 1 : (p == 1 ? 2 : (p == 2 ? 3 : (p == 3 ? 2 : 3)));
            const int e = 4 * g + (slot ? pb : pa);
            J = TJob{a.in[16] + (size_t)e * 512 * 1024, 1024, (bf16*)(ws + WS_WDN) + (size_t)cls * 1024 * 1024, 1024, slot * 512, 0, 0, nullptr}; }
        p0_transpose_item(J, scr, r, lane);
    }
    const float* x = a.in[0]; const float* g = a.in[1]; bf16* xn = (bf16*)(ws + WS_R1);
    f32x4 gv[4];
#pragma unroll
    for (int j = 0; j < 4; ++j) gv[j] = ((const f32x4*)g)[lane + 64 * j];
    for (int m = gw; m < T; m += NGW) {
        const GAS f32x4* xr = (const GAS f32x4*)(x + (size_t)m * DM) + lane;
        f32x4 v[4]; float s = 0.f;
#pragma unroll
        for (int j = 0; j < 4; ++j) { v[j] = xr[64 * j]; s += (v[j].x * v[j].x + v[j].y * v[j].y) + (v[j].z * v[j].z + v[j].w * v[j].w); }
        const float rstd = 1.f / sqrtf(wave_sum(s) * (1.f / DM) + EPS);
        GAS unsigned long long* o8 = (GAS unsigned long long*)(xn + (size_t)m * DM) + lane;
#pragma unroll
        for (int j = 0; j < 4; ++j) { const f32x4 y = v[j] * rstd * gv[j]; o8[64 * j] = (unsigned long long)pk2(y.x, y.y) | ((unsigned long long)pk2(y.z, y.w) << 32); }
    }
    float* rot = (float*)(ws + WS_ROT);
    for (int idx = gw * 64 + lane; idx < SEQ * 32; idx += NGW * 64) {
        const int pos = idx >> 5, i = idx & 31;
        const float inv = (float)exp(-(double)i * (9.210340371976184 / 32.0));
        const float ang = (float)pos * inv;
        rot[idx] = (float)cos((double)ang); rot[SEQ * 32 + idx] = (float)sin((double)ang);
    }
    bf16* wrt = (bf16*)(ws + WS_WRT);
    for (int idx = gw * 64 + lane; idx < 32 * 1024; idx += NGW * 64) {
        const int o = idx >> 10, k = idx & 1023;
        float v = 0.f; if (o < 8) v = a.in[10][k * 4 + (o & 3)]; else if (o < 24) v = a.in[12][k * 16 + (o - 8)];
        v *= a.in[9][k];
        const unsigned hb_ = f2bf(v); const float lo = v - __builtin_bit_cast(float, hb_ << 16);
        wrt[idx] = (bf16)hb_; wrt[32 * 1024 + idx] = (bf16)f2bf(lo);
    }
}

typedef pg8::Unit Unit;
using pg8::cvt_pk_bf16;
__device__ __forceinline__ v4u pack8(const f32x4 a, const f32x4 b) { v4u w; w.x = cvt_pk_bf16(a[0], a[1]); w.y = cvt_pk_bf16(a[2], a[3]); w.z = cvt_pk_bf16(b[0], b[1]); w.w = cvt_pk_bf16(b[2], b[3]); return w; }
__device__ __forceinline__ float sigm(float x) { return 1.f / (1.f + __expf(-x)); }

struct Epi1 {
    static constexpr bool PERM = true, AFTER_DRAIN = false;
    bf16 *sbq, *sbk, *sbv, *rq, *rk, *rv, *rg, *gates; const float* bgate; const float* rot;
    __device__ __forceinline__ void operator()(const f32x4 (&acc)[2][2][4][2], const Unit& u, int wr, int wc, int fr, int fq) const {
        const int pn = u.tag, rowb = u.row0 + wr * 64 + fr, cw = wc * 32 + 8 * fq;
        if (pn >= 6 && pn < 10) {
            bf16* base = (pn < 8 ? rq : rk) + ((pn & 1) * 4 + wc) * 64 + 8 * fq;
            const int hh_ = (pn & 1) * 4 + wc; const float lg2h = hh_ == 0 ? -4.5803689613e-02f : (hh_ == 1 ? -2.2720076500e-02f : (hh_ == 2 ? -1.1315313228e-02f : (hh_ == 3 ? -5.6465631411e-03f : (hh_ == 4 ? -2.8205190624e-03f : (hh_ == 5 ? -1.4095702547e-03f : (hh_ == 6 ? -7.0461297659e-04f : (-3.5226347163e-04f)))))));
#pragma unroll
            for (int ai = 0; ai < 2; ++ai)
#pragma unroll
                for (int m = 0; m < 4; ++m) { const int row = rowb + ai * 128 + m * 16, pos = row & (SEQ - 1);
                    const f32x4 c0 = *(const f32x4*)(rot + pos * 32 + 8 * fq), c1 = *(const f32x4*)(rot + pos * 32 + 8 * fq + 4);
                    const f32x4 s0 = *(const f32x4*)(rot + SEQ * 32 + pos * 32 + 8 * fq), s1 = *(const f32x4*)(rot + SEQ * 32 + pos * 32 + 8 * fq + 4);
                    const f32x4 x10 = acc[ai][0][m][0], x11 = acc[ai][0][m][1], x20 = acc[ai][1][m][0], x21 = acc[ai][1][m][1];
                    f32x4 o10 = x10 * c0 - x20 * s0, o11 = x11 * c1 - x21 * s1, o20 = x20 * c0 + x10 * s0, o21 = x21 * c1 + x11 * s1;
                    if (pn >= 8) { const float kd = __builtin_amdgcn_exp2f(lg2h * (float)(64 - (pos & 63))); o10 *= kd; o11 *= kd; o20 *= kd; o21 *= kd; }
                    bf16* rowp = base + (size_t)row * 512;
                    *(v4u*)rowp = pack8(o10, o11); *(v4u*)(rowp + 32) = pack8(o20, o21); }
            return;
        }
        bf16* base; int ld, colt, act = 0;
        if (pn < 2) { base = sbq; ld = 512; colt = pn * 256; } else if (pn < 4) { base = sbk; ld = 512; colt = (pn - 2) * 256; }
        else if (pn < 6) { base = sbv; ld = 512; colt = (pn - 4) * 256; } else if (pn < 14) { base = rv; ld = 1024; colt = (pn - 10) * 256; }
        else if (pn < 18) { base = rg; ld = 1024; colt = (pn - 14) * 256; act = 1; } else { base = gates; ld = 2048; colt = (pn - 18) * 256; act = 2; }
        f32x4 bv[2][2];
#pragma unroll
        for (int bj = 0; bj < 2; ++bj)
#pragma unroll
            for (int n = 0; n < 2; ++n) bv[bj][n] = act == 2 ? *(const f32x4*)(bgate + colt + bj * 128 + cw + 4 * n) : (f32x4){0.f, 0.f, 0.f, 0.f};
#pragma unroll
        for (int ai = 0; ai < 2; ++ai)
#pragma unroll
            for (int m = 0; m < 4; ++m) { bf16* rowp = base + (size_t)(rowb + ai * 128 + m * 16) * ld + colt + cw;
#pragma unroll
                for (int bj = 0; bj < 2; ++bj) { f32x4 v0 = acc[ai][bj][m][0] + bv[bj][0], v1 = acc[ai][bj][m][1] + bv[bj][1];
                    if (act == 1) {
#pragma unroll
                        for (int j = 0; j < 4; ++j) { v0[j] = v0[j] * sigm(v0[j]); v1[j] = v1[j] * sigm(v1[j]); } }
                    else if (act == 2) {
#pragma unroll
                        for (int j = 0; j < 4; ++j) { v0[j] = sigm(v0[j]); v1[j] = sigm(v1[j]); } }
                    *(v4u*)(rowp + bj * 128) = pack8(v0, v1); } }
    }
};
template <bool ADD> struct EpiMix {
    static constexpr bool PERM = true, AFTER_DRAIN = false;
    const bf16* gates; int goff; const bf16* prev; bf16* out;
    __device__ __forceinline__ void operator()(const f32x4 (&acc)[2][2][4][2], const Unit& u, int wr, int wc, int fr, int fq) const {
        const int rowb = u.row0 + wr * 64 + fr, colb = u.col0 + wc * 32 + 8 * fq;
#pragma unroll
        for (int ai = 0; ai < 2; ++ai)
#pragma unroll
            for (int m = 0; m < 4; ++m) { const size_t row = rowb + ai * 128 + m * 16;
#pragma unroll
                for (int bj = 0; bj < 2; ++bj) { const int col = colb + bj * 128;
                    const v4u g = *(const v4u*)(gates + row * 2048 + goff + col);
                    f32x4 v0 = acc[ai][bj][m][0], v1 = acc[ai][bj][m][1];
                    v0[0] *= bflo(g.x); v0[1] *= bfhi(g.x); v0[2] *= bflo(g.y); v0[3] *= bfhi(g.y); v1[0] *= bflo(g.z); v1[1] *= bfhi(g.z); v1[2] *= bflo(g.w); v1[3] *= bfhi(g.w);
                    if (ADD) { const v4u p = *(const v4u*)(prev + row * 1024 + col);
                        v0[0] += bflo(p.x); v0[1] += bfhi(p.x); v0[2] += bflo(p.y); v0[3] += bfhi(p.y); v1[0] += bflo(p.z); v1[1] += bfhi(p.z); v1[2] += bflo(p.w); v1[3] += bfhi(p.w); }
                    *(v4u*)(out + row * 1024 + col) = pack8(v0, v1); } }
    }
};
struct EpiOut {
    static constexpr bool PERM = true, AFTER_DRAIN = false;
    const float* x; float* out; bf16* hb;
    __device__ __forceinline__ void operator()(const f32x4 (&acc)[2][2][4][2], const Unit& u, int wr, int wc, int fr, int fq) const {
        const int rowb = u.row0 + wr * 64 + fr, colb = u.col0 + wc * 32 + 8 * fq;
#pragma unroll
        for (int ai = 0; ai < 2; ++ai)
#pragma unroll
            for (int m = 0; m < 4; ++m) { const size_t off = (size_t)(rowb + ai * 128 + m * 16) * 1024 + colb;
#pragma unroll
                for (int bj = 0; bj < 2; ++bj)
                { const f32x4 v0 = *(const f32x4*)(x + off + bj * 128) + acc[ai][bj][m][0], v1 = *(const f32x4*)(x + off + bj * 128 + 4) + acc[ai][bj][m][1];
                    *(f32x4*)(out + off + bj * 128) = v0; *(f32x4*)(out + off + bj * 128 + 4) = v1; *(v4u*)(hb + off + bj * 128) = pack8(v0, v1); } }
    }
};
struct EpiUp {
    static constexpr bool PERM = true, AFTER_DRAIN = false;
    const TokInfo* tinfo; const volatile LAS int* rowtok; bf16* hid;
    __device__ __forceinline__ void operator()(const f32x4 (&acc)[2][2][4][2], const Unit& u, int wr, int wc, int fr, int fq) const {
        const int ct = u.tag, lrb = wr * 64 + fr, col = ct * 128 + wc * 32 + 8 * fq;
#pragma unroll
        for (int ai = 0; ai < 2; ++ai)
#pragma unroll
            for (int m = 0; m < 4; ++m) { const int lr = lrb + ai * 128 + m * 16, tok = rowtok[u.idx * 256 + lr];
                if (tok >= 0) { const TokInfo ti = tinfo[tok]; const float gw = ct < 4 ? ti.ga : ti.gb, rs = ti.rstd;
                    f32x4 v0, v1;
#pragma unroll
                    for (int j = 0; j < 4; ++j) { const float g0 = acc[ai][0][m][0][j] * rs, g1 = acc[ai][0][m][1][j] * rs;
                        v0[j] = g0 * sigm(g0) * acc[ai][1][m][0][j] * (rs * gw); v1[j] = g1 * sigm(g1) * acc[ai][1][m][1][j] * (rs * gw); }
                    *(v4u*)(hid + (size_t)(u.row0 + lr) * 1024 + col) = pack8(v0, v1); } }
    }
};
struct EpiDown {
    static constexpr bool PERM = true, AFTER_DRAIN = false;
    const volatile LAS int* rowtok; float* out;
    __device__ __forceinline__ void operator()(const f32x4 (&acc)[2][2][4][2], const Unit& u, int wr, int wc, int fr, int fq) const {
        const int lrb = wr * 64 + fr, colb = u.col0 + wc * 32 + 8 * fq;
#pragma unroll
        for (int ai = 0; ai < 2; ++ai)
#pragma unroll
            for (int m = 0; m < 4; ++m) { const int tok = rowtok[u.idx * 256 + lrb + ai * 128 + m * 16];
                if (tok >= 0) { float* p = out + (size_t)tok * 1024 + colb;
#pragma unroll
                    for (int bj = 0; bj < 2; ++bj)
#pragma unroll
                        for (int n = 0; n < 2; ++n) *(f32x4*)(p + bj * 128 + n * 4) = *(const f32x4*)(p + bj * 128 + n * 4) + acc[ai][bj][m][n]; } }
    }
};
struct MoeOrder {
    const char* A; const char* B; const volatile LAS int* tstart; volatile LAS int* rowtok; int nct, up, G, c;
    __device__ __forceinline__ void locate(int L, int& rt, int& ct, int& cls) const {
        rt = L / nct; ct = L % nct; cls = 0;
        for (int k = 1; k < NCLS; ++k) cls += (rt >= __builtin_amdgcn_readfirstlane(tstart[k])) ? 1 : 0;
    }
    __device__ bool next(int i, Unit& u) const {
        const int L = i * G + c; const int ntile = __builtin_amdgcn_readfirstlane(tstart[NCLS]);
        if (L >= ntile * nct) return false;
        int rt, ct, cls; locate(L, rt, ct, cls);
        const int g = cls / 6, p = cls % 6, pa = p < 3 ? 0 : (p < 5 ? 1 : 2), pb = p == 0 ? 1 : (p == 1 ? 2 : (p == 2 ? 3 : (p == 3 ? 2 : 3)));
        u.row0 = rt * 256; u.tag = ct; u.idx = i;
        if (up) { const int e = 4 * g + (ct < 4 ? pa : pb); u.a = A; u.b = B + ((size_t)e * 1024 + (ct & 3) * 256) * 1024 * 2; u.col0 = ct * 128; }
        else { u.a = A + (size_t)rt * 256 * 1024 * 2; u.b = B + ((size_t)cls * 1024 + ct * 256) * 1024 * 2; u.col0 = ct * 256; }
        return true;
    }
    __device__ __forceinline__ int arow(int ui, int r) const { const int t = rowtok[ui * 256 + r]; return t < 0 ? 0 : t; }
    __device__ __forceinline__ void build(const int* perm, int tid) const {
        const int ntile = tstart[NCLS];
        for (int i = 0; i * G + c < ntile * nct; ++i) { int rt, ct, cls; locate(i * G + c, rt, ct, cls);
            for (int r = tid; r < 256; r += NTHR) { const int idx = (rt - tstart[cls]) * 256 + r; rowtok[i * 256 + r] = idx < tstart[32 + cls] ? perm[(size_t)cls * T + idx] : -1; } }
        __syncthreads();
    }
    __device__ __forceinline__ void a_ready(const Unit&) const {}
    __device__ __forceinline__ void done(const Unit&) const {}
};

typedef float f32x16 __attribute__((ext_vector_type(16)));
typedef short s16x4 __attribute__((ext_vector_type(4)));
typedef float f32x2_t __attribute__((ext_vector_type(2))); typedef __bf16 bf16x2_t __attribute__((ext_vector_type(2)));
__device__ __forceinline__ unsigned cvtpk_s(float lo, float hi) { f32x2_t v = {lo, hi}; bf16x2_t b = __builtin_convertvector(v, bf16x2_t); return __builtin_bit_cast(unsigned, b); }
__device__ __forceinline__ s16x4 vtr(const LAS unsigned char* p) { return __builtin_bit_cast(s16x4, __builtin_amdgcn_ds_read_tr16_b64_v4i16((LAS s16x4*)p)); }
__device__ __forceinline__ int crow(int r, int hi) { return (r & 3) + 8 * (r >> 2) + 4 * hi; }
#define MFMA32(a, b, c) __builtin_amdgcn_mfma_f32_32x32x16_bf16((a), (b), (c), 0, 0, 0)
__device__ __forceinline__ bf16x8 packfrag(const f32x16& p, int s) {
    v4u w; w.x = cvtpk_s(p[8 * s], p[8 * s + 1]); w.y = cvtpk_s(p[8 * s + 2], p[8 * s + 3]); w.z = cvtpk_s(p[8 * s + 4], p[8 * s + 5]); w.w = cvtpk_s(p[8 * s + 6], p[8 * s + 7]);
    return __builtin_bit_cast(bf16x8, w);
}
__device__ __forceinline__ bf16x8 vfrag(const LAS unsigned char* p, int rowbytes) {
    const s16x4 lo = vtr(p), hi_ = vtr(p + 8 * rowbytes);
    return (bf16x8){lo[0], lo[1], lo[2], lo[3], hi_[0], hi_[1], hi_[2], hi_[3]};
}
__device__ __forceinline__ void glds16(const void* gsrc, unsigned lds_dst) { unsigned keep;
    asm volatile("s_mov_b32 %0, m0\n\ts_mov_b32 m0, %2\n\ts_nop 0\n\tglobal_load_lds_dwordx4 %1, off\n\ts_mov_b32 m0, %0" : "=&s"(keep) : "v"(gsrc), "s"(lds_dst) : "memory"); }
#define WAIT_BAR(N) asm volatile("s_waitcnt vmcnt(" #N ") lgkmcnt(0)\n\ts_barrier" ::: "memory")
constexpr float SB_THR2 = -40.f;

template <bool MASK>
__device__ __forceinline__ void sb_tile(const LAS unsigned char* Kt, const LAS unsigned char* Vt, const bf16x8 (&qf)[4], const bf16x8 tri0, const bf16x8 tri1, const bf16x8 ones,
                                        f32x16& o0, f32x16& o1, float& R, int kt, int t, int hi, int kbase, int kx, int v0, int v1) {
    f32x16 p0 = {}, p1 = {};
#pragma unroll
    for (int ks = 0; ks < 4; ++ks) {
        const int co = kbase + (((2 * ks + hi) ^ kx) << 4);
        const bf16x8 a0 = *(const LAS bf16x8*)(Kt + co), a1 = *(const LAS bf16x8*)(Kt + 4096 + co);
        p0 = MFMA32(a0, qf[ks], p0); p1 = MFMA32(a1, qf[ks], p1);
    }
    f32x16 l0, l1; float cs = 0.f;
#pragma unroll
    for (int r = 0; r < 16; ++r) {
        const float z0 = p0[r], z1 = p1[r];
        float k0 = -(fmaxf(z0, 0.f) + __builtin_amdgcn_logf(1.f + __builtin_amdgcn_exp2f(-fabsf(z0))));
        float k1 = -(fmaxf(z1, 0.f) + __builtin_amdgcn_logf(1.f + __builtin_amdgcn_exp2f(-fabsf(z1))));
        if (MASK) { const int key = kt * 64 + crow(r, hi); k0 = key < t ? k0 : 0.f; k1 = key + 32 < t ? k1 : 0.f; }
        l0[r] = k0; l1[r] = k1; cs += k0 + k1;
    }
    cs += __shfl_xor(cs, 32);
    const bf16x8 lb00 = packfrag(l0, 0), lb01 = packfrag(l0, 1), lb10 = packfrag(l1, 0), lb11 = packfrag(l1, 1);
    f32x16 y0 = {}, y1 = {};
    y0 = MFMA32(tri0, lb00, y0); y0 = MFMA32(tri1, lb01, y0); y0 = MFMA32(ones, lb10, y0); y0 = MFMA32(ones, lb11, y0);
    y1 = MFMA32(tri0, lb10, y1); y1 = MFMA32(tri1, lb11, y1);
#pragma unroll
    for (int r = 0; r < 16; ++r) {
        float w0 = __builtin_amdgcn_exp2f(p0[r] + y0[r] + R), w1 = __builtin_amdgcn_exp2f(p1[r] + y1[r] + R);
        if (MASK) { const int key = kt * 64 + crow(r, hi); w0 = key < t ? w0 : 0.f; w1 = key + 32 < t ? w1 : 0.f; }
        p0[r] = w0; p1[r] = w1;
    }
    R += cs;
    const bf16x8 wb00 = packfrag(p0, 0), wb01 = packfrag(p0, 1), wb10 = packfrag(p1, 0), wb11 = packfrag(p1, 1);
    o0 = MFMA32(vfrag(Vt + 0 * 2048 + v0, 128), wb00, o0); o1 = MFMA32(vfrag(Vt + 0 * 2048 + v1, 128), wb00, o1);
    o0 = MFMA32(vfrag(Vt + 1 * 2048 + v0, 128), wb01, o0); o1 = MFMA32(vfrag(Vt + 1 * 2048 + v1, 128), wb01, o1);
    o0 = MFMA32(vfrag(Vt + 2 * 2048 + v0, 128), wb10, o0); o1 = MFMA32(vfrag(Vt + 2 * 2048 + v1, 128), wb10, o1);
    o0 = MFMA32(vfrag(Vt + 3 * 2048 + v0, 128), wb11, o0); o1 = MFMA32(vfrag(Vt + 3 * 2048 + v1, 128), wb11, o1);
}
__device__ __forceinline__ void unit_map(int u, int G, int& bh, int& qb) {
    if (G == 256) { const int bx = u & 255, i = u >> 8, xcd = bx & 7, slot = bx >> 3, gi = slot >> 2, j = slot & 3;
        bh = (xcd * 8 + gi) * 2 + (i >> 1); qb = (i & 1) ? 7 - j : j; }
    else { bh = u >> 3; qb = u & 7; }
}
__device__ __forceinline__ void sb_phase(const bf16* Q, const bf16* Kg, const bf16* Vg, bf16* O, LAS unsigned char* lds, int bx, int G, int tid, int wave, int lane, bool nostore = false) {
    const int r32 = lane & 31, hi = lane >> 5;
    bf16x8 tri0, tri1, ones;
#pragma unroll
    for (int j = 0; j < 8; ++j) { const int kk = 8 * (j >> 2) + 4 * hi + (j & 3); tri0[j] = kk >= r32 ? (short)0x3F80 : (short)0; tri1[j] = 16 + kk >= r32 ? (short)0x3F80 : (short)0; ones[j] = (short)0x3F80; }
    const int skey = wave * 8 + (lane >> 3), sc = (lane & 7) ^ (lane >> 3), svc = (lane & 7) ^ (((lane >> 4) & 1) << 2);
    const unsigned lds0 = (unsigned)(size_t)lds + (unsigned)wave * 1024u;
#define SB_STAGE(kt_, st_) do { const unsigned d_ = (unsigned)__builtin_amdgcn_readfirstlane(lds0 + (unsigned)(st_) * 16384u); \
        glds16(Kg + (rbase + (size_t)(kt_) * 64 + skey) * 512 + h * 64 + sc * 8, d_); glds16(Vg + (rbase + (size_t)(kt_) * 64 + skey) * 512 + h * 64 + svc * 8, d_ + 8192u); } while (0)
    const int kbase = r32 * 128, kx = r32 & 7;
    const int q4 = (lane & 15) >> 2, v0 = ((4 * hi + q4) * 128 + 32 * ((lane >> 4) & 1) + 8 * (lane & 3)) ^ (((q4 >> 1) & 1) << 6), v1 = v0 ^ 64;
    volatile LAS int* flags = (volatile LAS int*)(lds + 49152);
    for (int u = bx; u < 1024; u += G) {
        const int bh = u >> 3, qb = u & 7;
        const int b = bh >> 3, h = bh & 7, q0w = qb * 256 + 32 * wave, my_kt = q0w >> 6, kt_hi = qb * 4 + 3, t = q0w + r32;
        const size_t rbase = (size_t)b * SEQ;
        SB_STAGE(kt_hi, 0);
        if (kt_hi > 0) SB_STAGE(kt_hi - 1, 1);
        bf16x8 qf[4];
#pragma unroll
        for (int ks = 0; ks < 4; ++ks) qf[ks] = *(const bf16x8*)(Q + (rbase + t) * 512 + h * 64 + 16 * ks + 8 * hi);
        f32x16 o0 = {}, o1 = {}; float R = 0.f;
        if (kt_hi > 0) WAIT_BAR(2); else WAIT_BAR(0);
        bool mydone = false; int st = 0, it = 0;
        for (int kt = kt_hi; kt >= 0; --kt, ++it) {
            int st2 = st + 2; if (st2 >= 3) st2 -= 3;
            if (kt >= 2) SB_STAGE(kt - 2, st2);
            if (kt <= my_kt && !mydone) {
                const LAS unsigned char* Kt = lds + st * 16384; const LAS unsigned char* Vt = Kt + 8192;
                if (kt == my_kt) sb_tile<true>(Kt, Vt, qf, tri0, tri1, ones, o0, o1, R, kt, t, hi, kbase, kx, v0, v1);
                else sb_tile<false>(Kt, Vt, qf, tri0, tri1, ones, o0, o1, R, kt, t, hi, kbase, kx, v0, v1);
                mydone = __all(R < SB_THR2) != 0;
            }
            if (lane == 0) flags[(it & 1) * 8 + wave] = mydone ? 1 : 0;
            if (kt >= 2) WAIT_BAR(2); else WAIT_BAR(0);
            int alld = 1;
#pragma unroll
            for (int w = 0; w < 8; ++w) alld &= flags[(it & 1) * 8 + w];
            if (alld) break;
            st = st + 1; if (st >= 3) st = 0;
        }
        { LAS unsigned char* ep = lds + 53248 + wave * 4608;
#pragma unroll
          for (int g4 = 0; g4 < 4; ++g4) {
            *(LAS unsigned long long*)(ep + r32 * 144 + (8 * g4 + 4 * hi) * 2) = (unsigned long long)cvtpk_s(o0[4 * g4], o0[4 * g4 + 1]) | ((unsigned long long)cvtpk_s(o0[4 * g4 + 2], o0[4 * g4 + 3]) << 32);
            *(LAS unsigned long long*)(ep + r32 * 144 + (32 + 8 * g4 + 4 * hi) * 2) = (unsigned long long)cvtpk_s(o1[4 * g4], o1[4 * g4 + 1]) | ((unsigned long long)cvtpk_s(o1[4 * g4 + 2], o1[4 * g4 + 3]) << 32); }
#pragma unroll
          for (int i = 0; i < 4; ++i) { const int row = (lane >> 3) + 8 * i;
            const v4u ov = *(const LAS v4u*)(ep + row * 144 + (lane & 7) * 16); if (!nostore) *(v4u*)(O + (rbase + q0w + row) * 512 + h * 64 + (lane & 7) * 8) = ov; else asm volatile("" :: "v"(ov)); } }
        WAIT_BAR(0);
    }
#undef SB_STAGE
}
template <bool EDGE>
__device__ __forceinline__ void ret_tile(const LAS unsigned char* Kt, const LAS unsigned char* Vt, const bf16x8 (&qf)[4], f32x16 (&o)[4], float lg2, int kt, int my_kt, int n, int hi, int kbase, int kx, int vb) {
    f32x16 p0 = {}, p1 = {};
#pragma unroll
    for (int ks = 0; ks < 4; ++ks) {
        const int co = kbase + (((2 * ks + hi) ^ kx) << 4);
        const bf16x8 a0 = *(const LAS bf16x8*)(Kt + co), a1 = *(const LAS bf16x8*)(Kt + 4096 + co);
        p0 = MFMA32(a0, qf[ks], p0); p1 = MFMA32(a1, qf[ks], p1);
    }
    const int e_off = n - 64 * (kt + 1);
    if (EDGE) {
        const bool diag = kt == my_kt; float fnn = (float)(n & 63); asm volatile("" : "+v"(fnn));
        const float base = diag ? fnn - 64.f : (float)e_off, two = diag ? 2.f : 0.f, h4 = (float)(4 * hi);
#pragma unroll
        for (int r = 0; r < 16; ++r) {
            const float m0 = (float)((r & 3) + 8 * (r >> 2)) + h4;
            p0[r] *= __builtin_amdgcn_exp2f(lg2 * (base + two * fmaxf(m0 - fnn, 0.f))); p1[r] *= __builtin_amdgcn_exp2f(lg2 * (base + two * fmaxf(m0 + 32.f - fnn, 0.f)));
            if ((r & 3) == 3) __builtin_amdgcn_sched_barrier(0);
        }
    } else {
        const float f = __builtin_amdgcn_exp2f(lg2 * (float)e_off);
#pragma unroll
        for (int r = 0; r < 16; ++r) { p0[r] *= f; p1[r] *= f; }
    }
    const bf16x8 wb00 = packfrag(p0, 0), wb01 = packfrag(p0, 1), wb10 = packfrag(p1, 0), wb11 = packfrag(p1, 1);
#pragma unroll
    for (int dt = 0; dt < 4; ++dt) { const LAS unsigned char* vp = Vt + (vb ^ (dt << 6));
        o[dt] = MFMA32(vfrag(vp + 0 * 4096, 256), wb00, o[dt]); o[dt] = MFMA32(vfrag(vp + 1 * 4096, 256), wb01, o[dt]);
        o[dt] = MFMA32(vfrag(vp + 2 * 4096, 256), wb10, o[dt]); o[dt] = MFMA32(vfrag(vp + 3 * 4096, 256), wb11, o[dt]); }
}
__device__ __forceinline__ void kv_chain(const bf16* Kg, const bf16* Vg, bf16* STg, LAS unsigned char* lds, int bh0, int bhs, int tid, int wave, int lane) {
    const int r32 = lane & 31, hi = lane >> 5, q4 = (lane & 15) >> 2, g1 = (lane >> 4) & 1, p = lane & 3, dh = wave >> 2, eq = wave & 3;
    const int skey = wave * 8 + (lane >> 3), sc = (lane & 7) ^ (lane >> 3);
    const int vkey = wave * 8 + (lane >> 4), vc = (lane & 15) ^ (((lane >> 4) & 3) << 2);
    const unsigned ldsk = (unsigned)(size_t)lds + (unsigned)wave * 1024u, ldsv = (unsigned)(size_t)lds + 8192u + (unsigned)wave * 2048u;
#define RET_STAGE(kt_, st_) do { const unsigned so_ = (unsigned)(st_) * 24576u; \
        glds16(Kg + (rbase + (size_t)(kt_) * 64 + skey) * 512 + h * 64 + sc * 8, (unsigned)__builtin_amdgcn_readfirstlane(ldsk + so_)); \
        glds16(Vg + (rbase + (size_t)(kt_) * 64 + vkey) * 1024 + h * 128 + vc * 8, (unsigned)__builtin_amdgcn_readfirstlane(ldsv + so_)); \
        glds16(Vg + (rbase + (size_t)(kt_) * 64 + vkey + 4) * 1024 + h * 128 + vc * 8, (unsigned)__builtin_amdgcn_readfirstlane(ldsv + so_ + 1024u)); } while (0)
    int aoff[2], boff[2];
#pragma unroll
    for (int e = 0; e < 2; ++e) { const int m = 8 * hi + q4 + 4 * e;
        aoff[e] = m * 128 + (((4 * dh + 2 * g1 + (p >> 1)) ^ (m & 7)) << 4) + (p & 1) * 8;
        boff[e] = m * 256 + ((64 * eq + 32 * g1 + 8 * p) ^ ((m & 3) << 6)); }
    for (int bh = bh0; bh < 128; bh += bhs) {
        const int b = bh >> 3, h = bh & 7;
        const size_t rbase = (size_t)b * SEQ;
        const float lg2 = log2f(1.f - exp2f(-5.f - (float)h)), g64 = exp2f(64.f * lg2), g256 = exp2f(256.f * lg2), ginv = exp2f(-lg2);
        RET_STAGE(0, 0); RET_STAGE(1, 1);
        f32x16 S = {}, kv = {};
        WAIT_BAR(3);
        int st = 0;
        for (int kt = 0; kt < 28; ++kt) {
            int st2 = st + 2; if (st2 >= 3) st2 -= 3;
            if (kt + 2 < 28) RET_STAGE(kt + 2, st2);
            const LAS unsigned char* Kt = lds + st * 24576; const LAS unsigned char* Vt = Kt + 8192;
#pragma unroll
            for (int r = 0; r < 16; ++r) kv[r] *= g64;
#pragma unroll
            for (int ks = 0; ks < 4; ++ks) {
                const s16x4 a0 = vtr(Kt + aoff[0] + ks * 2048), a1 = vtr(Kt + aoff[1] + ks * 2048), b0 = vtr(Vt + boff[0] + ks * 4096), b1 = vtr(Vt + boff[1] + ks * 4096);
                kv = MFMA32(((bf16x8){a0[0], a0[1], a0[2], a0[3], a1[0], a1[1], a1[2], a1[3]}), ((bf16x8){b0[0], b0[1], b0[2], b0[3], b1[0], b1[1], b1[2], b1[3]}), kv);
            }
            if ((kt & 3) == 3) {
                bf16* sp = STg + ((size_t)(bh * 8 + (kt >> 2) + 1) * 64 + 32 * dh) * 128 + 32 * eq + r32;
#pragma unroll
                for (int r = 0; r < 16; ++r) { S[r] = S[r] * g256 + kv[r] * ginv; kv[r] = 0.f; sp[crow(r, hi) * 128] = (bf16)(cvtpk_s(S[r], 0.f) & 0xffffu); }
            }
            if (kt + 2 < 28) WAIT_BAR(3); else WAIT_BAR(0);
            st = st + 1; if (st >= 3) st = 0;
        }
    }
#undef RET_STAGE
}
__device__ __forceinline__ void ret_phase(const bf16* Q, const bf16* Kg, const bf16* Vg, const bf16* RG, const float* gn, const bf16* STg, bf16* Y, LAS unsigned char* lds, int bx, int G, int tid, int wave, int lane) {
    const int r32 = lane & 31, hi = lane >> 5;
    const int skey = wave * 8 + (lane >> 3), sc = (lane & 7) ^ (lane >> 3);
    const int vkey = wave * 8 + (lane >> 4), vc = (lane & 15) ^ (((lane >> 4) & 3) << 2);
    const unsigned ldsk = (unsigned)(size_t)lds + (unsigned)wave * 1024u, ldsv = (unsigned)(size_t)lds + 8192u + (unsigned)wave * 2048u, ldss = (unsigned)(size_t)lds + 73728u + (unsigned)wave * 2048u;
#define RET_STAGE(kt_, st_) do { const unsigned so_ = (unsigned)(st_) * 24576u; \
        glds16(Kg + (rbase + (size_t)(kt_) * 64 + skey) * 512 + h * 64 + sc * 8, (unsigned)__builtin_amdgcn_readfirstlane(ldsk + so_)); \
        glds16(Vg + (rbase + (size_t)(kt_) * 64 + vkey) * 1024 + h * 128 + vc * 8, (unsigned)__builtin_amdgcn_readfirstlane(ldsv + so_)); \
        glds16(Vg + (rbase + (size_t)(kt_) * 64 + vkey + 4) * 1024 + h * 128 + vc * 8, (unsigned)__builtin_amdgcn_readfirstlane(ldsv + so_ + 1024u)); } while (0)
#define RET_STAGES(qb_) do { const bf16* s_ = STg + ((size_t)(bh * 8 + (qb_)) * 64 + vkey) * 128 + vc * 8; \
        glds16(s_, (unsigned)__builtin_amdgcn_readfirstlane(ldss)); glds16(s_ + 4 * 128, (unsigned)__builtin_amdgcn_readfirstlane(ldss + 1024u)); } while (0)
    const int kbase = r32 * 128, kx = r32 & 7;
    const int q4 = (lane & 15) >> 2, vb = ((4 * hi + q4) * 256 + 32 * ((lane >> 4) & 1) + 8 * (lane & 3)) ^ (q4 << 6);
    const int sb_ = ((8 * hi + q4) * 256 + 32 * ((lane >> 4) & 1) + 8 * (lane & 3)) ^ (q4 << 6);
    const LAS unsigned char* St = lds + 73728;
    LAS unsigned char* ep = lds + 90112 + wave * 4608;
    const int nper = (2 * 128 + G - 1) / G;
    for (int it = bx * nper; it < (bx + 1) * nper && it < 256; ++it) {
        const int bh = it >> 1, qb0 = 4 * (it & 1), b = bh >> 3, h = bh & 7, kt_end = 4 * qb0 + 15;
        const size_t rbase = (size_t)b * SEQ;
        const float lg2 = log2f(1.f - exp2f(-5.f - (float)h));
        if (qb0 > 0) RET_STAGES(qb0);
        RET_STAGE(4 * qb0, 0); RET_STAGE(4 * qb0 + 1, 1);
        int st = 0;
        WAIT_BAR(3);
        for (int qb = qb0; qb < qb0 + 4; ++qb) {
            const int q0w = qb * 256 + 32 * wave, my_kt = q0w >> 6, n = q0w + r32;
            bf16x8 qf[4];
#pragma unroll
            for (int ks = 0; ks < 4; ++ks) qf[ks] = *(const bf16x8*)(Q + (rbase + n) * 512 + h * 64 + 16 * ks + 8 * hi);
            f32x16 o[4] = {{}, {}, {}, {}};
            if (qb > 0) {
#pragma unroll
                for (int ks = 0; ks < 4; ++ks) {
#pragma unroll
                    for (int dt = 0; dt < 4; ++dt) { const LAS unsigned char* sp = St + (sb_ ^ (dt << 6)) + ks * 4096;
                        const s16x4 a0 = vtr(sp), a1 = vtr(sp + 4 * 256);
                        o[dt] = MFMA32(((bf16x8){a0[0], a0[1], a0[2], a0[3], a1[0], a1[1], a1[2], a1[3]}), qf[ks], o[dt]); }
                    __builtin_amdgcn_sched_barrier(0);
                }
                const float qs = exp2f(lg2 * (float)(32 * wave + r32 + 1));
#pragma unroll
                for (int dt = 0; dt < 4; ++dt)
#pragma unroll
                    for (int r = 0; r < 16; ++r) o[dt][r] *= qs;
            }
#define RET_STEP(BODY) do { const int kt = 4 * qb + t; \
                int st2 = st + 2; if (st2 >= 3) st2 -= 3; \
                if (t == 3 && qb + 1 < qb0 + 4) RET_STAGES(qb + 1);     \
                if (kt + 2 <= kt_end) RET_STAGE(kt + 2, st2); \
                BODY; \
                if (kt + 2 <= kt_end) WAIT_BAR(3); else WAIT_BAR(0); \
                st = st + 1; if (st >= 3) st = 0; } while (0)
            { const int cw = wave >> 1; int t = 0;
              for (; t < cw; ++t) RET_STEP(ret_tile<false>(lds + st * 24576, lds + st * 24576 + 8192, qf, o, lg2, kt, my_kt, n, hi, kbase, kx, vb));
              RET_STEP(ret_tile<true>(lds + st * 24576, lds + st * 24576 + 8192, qf, o, lg2, kt, my_kt, n, hi, kbase, kx, vb)); ++t;
              for (; t < 4; ++t) RET_STEP((void)0); }
#undef RET_STEP
            float ss = 0.f;
#pragma unroll
            for (int dt = 0; dt < 4; ++dt)
#pragma unroll
                for (int r = 0; r < 16; ++r) ss += o[dt][r] * o[dt][r];
            ss += __shfl_xor(ss, 32);
            const float rstd = 1.f / sqrtf(ss * (1.f / 128.f) + EPS);
#pragma unroll
            for (int half = 0; half < 2; ++half) {
#pragma unroll
                for (int dtl = 0; dtl < 2; ++dtl)
#pragma unroll
                    for (int g4 = 0; g4 < 4; ++g4) { const f32x16& od = o[2 * half + dtl];
                        *(LAS unsigned long long*)(ep + r32 * 144 + (32 * dtl + 8 * g4 + 4 * hi) * 2) =
                            (unsigned long long)cvtpk_s(od[4 * g4] * rstd, od[4 * g4 + 1] * rstd) | ((unsigned long long)cvtpk_s(od[4 * g4 + 2] * rstd, od[4 * g4 + 3] * rstd) << 32); }
#pragma unroll
                for (int i = 0; i < 4; ++i) { const int row = (lane >> 3) + 8 * i, e = 64 * half + (lane & 7) * 8;
                    const v4u y = *(const LAS v4u*)(ep + row * 144 + (lane & 7) * 16);
                    const size_t go = (rbase + q0w + row) * 1024 + h * 128 + e;
                    const v4u rg = *(const v4u*)(RG + go); const f32x4 g0 = *(const f32x4*)(gn + h * 128 + e), g1 = *(const f32x4*)(gn + h * 128 + e + 4);
                    f32x4 v0, v1;
                    v0[0] = bflo(y.x) * g0[0] * bflo(rg.x); v0[1] = bfhi(y.x) * g0[1] * bfhi(rg.x); v0[2] = bflo(y.y) * g0[2] * bflo(rg.y); v0[3] = bfhi(y.y) * g0[3] * bfhi(rg.y);
                    v1[0] = bflo(y.z) * g1[0] * bflo(rg.z); v1[1] = bfhi(y.z) * g1[1] * bfhi(rg.z); v1[2] = bflo(y.w) * g1[2] * bflo(rg.w); v1[3] = bfhi(y.w) * g1[3] * bfhi(rg.w);
                    *(v4u*)(Y + go) = pack8(v0, v1); }
            }
        }
    }
#undef RET_STAGE
#undef RET_STAGES
}

__device__ __forceinline__ void p_route(const Args& a, LAS unsigned char* lds, int vcu, int G, int wave, int lane, int tid) {
    const float* h = a.out; const bf16* wrt = (const bf16*)(a.ws + WS_WRT); const float* bg = a.in[11]; const float* be = a.in[13];
    TokInfo* tinfo = (TokInfo*)(a.ws + WS_TOK); int* perm = (int*)(a.ws + WS_PERM);
    unsigned* cnt = (unsigned*)(a.ws + WS_CTL) + CW_CNT;
    const int r32 = lane & 31, hi = lane >> 5, kh = wave & 1, pair = wave >> 1;
    LAS float* xch = (LAS float*)lds + pair * 64 * 17;
    const int ntask = T / 32, tstride = G * 4, nround = (ntask + tstride - 1) / tstride;
    for (int rd = 0; rd < nround; ++rd) {
        const int task = rd * tstride + vcu * 4 + pair; const bool valid = task < ntask;
        const int t0 = (valid ? task : 0) * 32;
        const float* xp = h + (size_t)(t0 + r32) * DM + kh * 512 + 8 * hi;
        const bf16* ahp = wrt + r32 * 1024 + kh * 512 + 8 * hi;
        f32x16 acc = {}; float ss = 0.f;
#pragma unroll 4
        for (int ks = 0; ks < 32; ++ks) {
            const f32x4 x0 = *(const f32x4*)(xp + 16 * ks), x1 = *(const f32x4*)(xp + 16 * ks + 4);
            ss += (x0[0] * x0[0] + x0[1] * x0[1]) + (x0[2] * x0[2] + x0[3] * x0[3]) + (x1[0] * x1[0] + x1[1] * x1[1]) + (x1[2] * x1[2] + x1[3] * x1[3]);
            v4u wh, wl;
            wh.x = cvtpk_s(x0[0], x0[1]); wh.y = cvtpk_s(x0[2], x0[3]); wh.z = cvtpk_s(x1[0], x1[1]); wh.w = cvtpk_s(x1[2], x1[3]);
            wl.x = cvtpk_s(x0[0] - bflo(wh.x), x0[1] - bfhi(wh.x)); wl.y = cvtpk_s(x0[2] - bflo(wh.y), x0[3] - bfhi(wh.y));
            wl.z = cvtpk_s(x1[0] - bflo(wh.z), x1[1] - bfhi(wh.z)); wl.w = cvtpk_s(x1[2] - bflo(wh.w), x1[3] - bfhi(wh.w));
            const bf16x8 bh_ = __builtin_bit_cast(bf16x8, wh), bl_ = __builtin_bit_cast(bf16x8, wl);
            const bf16x8 ah = *(const bf16x8*)(ahp + 16 * ks), al = *(const bf16x8*)(ahp + 32 * 1024 + 16 * ks);
            acc = MFMA32(ah, bh_, acc); acc = MFMA32(ah, bl_, acc); acc = MFMA32(al, bh_, acc);
        }
        if (kh == 1) {
#pragma unroll
            for (int r = 0; r < 16; ++r) xch[lane * 17 + r] = acc[r];
            xch[lane * 17 + 16] = ss; }
        __syncthreads();
        if (kh == 0) {
#pragma unroll
            for (int r = 0; r < 16; ++r) acc[r] += xch[lane * 17 + r];
            ss += xch[lane * 17 + 16];
            ss += __shfl_xor(ss, 32);
            const float rstd = 1.f / sqrtf(ss * (1.f / DM) + EPS);
            float gl[4];
#pragma unroll
            for (int o = 0; o < 4; ++o) gl[o] = acc[o] * rstd + bg[o];
            int gi = 0; float gm = gl[0];
#pragma unroll
            for (int o = 1; o < 4; ++o) if (gl[o] > gm) { gm = gl[o]; gi = o; }
            float gs = 0.f;
#pragma unroll
            for (int o = 0; o < 4; ++o) gs += __expf(gl[o] - gm);
            const float pgrp = 1.f / gs;
            const bool owner = valid && (hi == (gi & 1));
            float el[4];
#pragma unroll
            for (int e = 0; e < 4; ++e) el[e] = ((gi >> 1) ? acc[8 + e] : acc[4 + e]) * rstd + be[4 * gi + e];
            int i1 = 0; float m1 = el[0];
#pragma unroll
            for (int e = 1; e < 4; ++e) if (el[e] > m1) { m1 = el[e]; i1 = e; }
            int i2 = -1; float m2 = -3.0e38f;
#pragma unroll
            for (int e = 0; e < 4; ++e) if (e != i1 && el[e] > m2) { m2 = el[e]; i2 = e; }
            const float s1 = 1.f / (1.f + __expf(m2 - m1)), g1 = s1 * pgrp, g2 = (1.f - s1) * pgrp;
            const int pa = i1 < i2 ? i1 : i2, pb = i1 < i2 ? i2 : i1;
            const float ga = i1 < i2 ? g1 : g2, gb = i1 < i2 ? g2 : g1;
            const int pidx = pa == 0 ? pb - 1 : (pa == 1 ? pb + 1 : 5);
            const int my_cls = owner ? gi * 6 + pidx : -1;
            int my_pos = 0;
            for (int c = 0; c < NCLS; ++c) {
                const unsigned long long mask = __ballot(my_cls == c);
                if (mask) { const int nn = __popcll(mask), leader = __ffsll((long long)mask) - 1; unsigned bse = 0;
                    if (lane == leader) bse = __hip_atomic_fetch_add(cnt + 64 * c, (unsigned)nn, __ATOMIC_RELAXED, __HIP_MEMORY_SCOPE_AGENT);
                    bse = __shfl(bse, leader);
                    if (my_cls == c) my_pos = (int)bse + __popcll(mask & ((1ull << lane) - 1ull)); }
            }
            if (owner) { const int t = t0 + r32; tinfo[t] = TokInfo{ga, gb, rstd, my_cls}; perm[(size_t)my_cls * T + my_pos] = t; }
        }
        __syncthreads();
    }
}
__device__ __forceinline__ void build_class_table(const Args& a, volatile LAS int* tab, int tid) {
    if (tid == 0) { const unsigned* cnt = (const unsigned*)(a.ws + WS_CTL) + CW_CNT; int acc_ = 0;
        for (int c = 0; c < NCLS; ++c) { tab[c] = acc_; const int n = (int)__hip_atomic_load(cnt + 64 * c, __ATOMIC_RELAXED, __HIP_MEMORY_SCOPE_AGENT); tab[32 + c] = n; acc_ += (n + 255) >> 8; }
        tab[NCLS] = acc_; }
    __syncthreads();
}
__device__ __forceinline__ void p_final(const Args& a, int vcu, int G, int wave, int lane) {
    float* h = a.out; const float* gf = a.in[17];
    const int gw = vcu * NWAVES + wave, NGW = G * NWAVES;
    f32x4 gv[4];
#pragma unroll
    for (int j = 0; j < 4; ++j) gv[j] = ((const f32x4*)gf)[lane + 64 * j];
    for (int t = gw; t < T; t += NGW) {
        GAS f32x4* xr = (GAS f32x4*)(h + (size_t)t * DM) + lane;
        f32x4 v[4]; float s = 0.f;
#pragma unroll
        for (int j = 0; j < 4; ++j) { v[j] = xr[64 * j]; s += (v[j].x * v[j].x + v[j].y * v[j].y) + (v[j].z * v[j].z + v[j].w * v[j].w); }
        const float rstd = 1.f / sqrtf(wave_sum(s) * (1.f / DM) + EPS);
#pragma unroll
        for (int j = 0; j < 4; ++j) xr[64 * j] = v[j] * rstd * gv[j];
    }
}

#ifndef PROBE_MASK
#define PROBE_MASK 0
#endif
#ifndef MK_ONE_LAUNCH
#if PROBE_MASK
#define MK_ONE_LAUNCH 0
#else
#define MK_ONE_LAUNCH 1
#endif
#endif
constexpr int NPHASE = 11;
__global__ void __launch_bounds__(NTHR, 2) fwd_kernel(Args args) {
    extern __shared__ __attribute__((aligned(16))) unsigned char lds_raw[];
    LAS unsigned char* lds = (LAS unsigned char*)lds_raw;
    volatile LAS unsigned* MISC = (volatile LAS unsigned*)(lds + MISC_OFF);
    volatile LAS int* tab = (volatile LAS int*)(lds + TAB_OFF);
    const int tid = threadIdx.x, lane = tid & 63, wave = __builtin_amdgcn_readfirstlane(tid >> 6);
    const int G = gridDim.x; const int bx = blockIdx.x; const int vcu = (G % 8 == 0) ? (bx % 8) * (G / 8) + bx / 8 : bx;
    unsigned char* ws = args.ws;
    for (int u = tid; u < (LDS_BYTES - LDSCTL_OFF) / 4; u += NTHR) ((LAS unsigned*)(lds + LDSCTL_OFF))[u] = 0u;
    __syncthreads();
    XcdBarrier bar; bar.bar = (unsigned*)(ws + WS_CTL) + CW_BAR; bar.x = 0; bar.st = nullptr;
    if (MK_ONE_LAUNCH) bar = xcd_barrier_post((unsigned*)(ws + WS_CTL) + CW_BAR, MISC + 8);
    const int lo = args.ph_lo, hi = args.ph_hi;
#define IN(k) (lo <= (k) && (k) < hi)
#define SEAM(k) do { if (MK_ONE_LAUNCH && IN(k) && IN((k) + 1)) xcd_barrier(bar); } while (0)
    bf16* W1 = (bf16*)(ws + WS_W1); bf16* XN = (bf16*)(ws + WS_R1); bf16* YRET = (bf16*)(ws + WS_R1); bf16* HIDS = (bf16*)(ws + WS_R1);
    bf16* SBQ = (bf16*)(ws + WS_SBQ); bf16* SBK = (bf16*)(ws + WS_SBK); bf16* SBV = (bf16*)(ws + WS_SBV); bf16* RQ = (bf16*)(ws + WS_RQ); bf16* RK = (bf16*)(ws + WS_RK);
    bf16* RV = (bf16*)(ws + WS_RV); bf16* RG = (bf16*)(ws + WS_RG); bf16* YSB = (bf16*)(ws + WS_YSB); bf16* GATES = (bf16*)args.out;
    bf16* TMP = (bf16*)(ws + WS_TMP); bf16* MIX = (bf16*)(ws + WS_MIX); bf16* HB = (bf16*)(ws + WS_HB);
    volatile LAS int* rowtok = (volatile LAS int*)(lds + 131072);

    if (IN(0)) { p0_prologue(args, lds, vcu, G, wave, lane); }
    SEAM(0);
    if (IN(1)) {
        pg8::StaticOrder S; S.init(XN, W1, T, N1, 1024, G, bx);
        Epi1 E{SBQ, SBK, SBV, RQ, RK, RV, RG, GATES, args.in[4], (const float*)(ws + WS_ROT)};
        pg8::gemm_phase<Epi1, pg8::StaticOrder, true, true>(lds, 1024, S, E);
    }
    SEAM(1);
    if (IN(2)) {
        const int nret = G >> 1;
#ifdef PROBE_ABL
        if (args.rep) { if (PROBE_ABL == 1) { if (bx < nret) kv_chain(RK, RV, (bf16*)(ws + WS_KV), lds, bx, nret, tid, wave, lane); }
                        else { sb_phase(SBQ, SBK, SBV, YSB, lds, bx, G, tid, wave, lane, true); } } else
#endif
        {
        if (bx < nret) kv_chain(RK, RV, (bf16*)(ws + WS_KV), lds, bx, nret, tid, wave, lane);
        if (G == 256) { for (int k = 0; k < (bx < nret ? 3 : 5); ++k) { const int u = bx < nret ? 8 * bx + k : 8 * (bx - nret) + 3 + k; sb_phase(SBQ, SBK, SBV, YSB, lds, u, 1 << 20, tid, wave, lane); } }
        else sb_phase(SBQ, SBK, SBV, YSB, lds, bx, G, tid, wave, lane);
        }
    }
    SEAM(2);
    if (IN(3)) { ret_phase(RQ, RK, RV, RG, args.in[7], (const bf16*)(ws + WS_KV), YRET, lds, bx, G, tid, wave, lane); }
    SEAM(3);
    if (IN(4)) {
        pg8::StaticOrder S; S.init(YSB, ws + WS_WSB, T, 1024, 512, G, bx);
        EpiMix<false> E{GATES, 0, nullptr, TMP};
        pg8::gemm_phase<EpiMix<false>, pg8::StaticOrder, true, true>(lds, 512, S, E);
    }
    SEAM(4);
    if (IN(5)) {
        pg8::StaticOrder S; S.init(YRET, ws + WS_WRET, T, 1024, 1024, G, bx);
        EpiMix<true> E{GATES, 1024, TMP, MIX};
        pg8::gemm_phase<EpiMix<true>, pg8::StaticOrder, true, true>(lds, 1024, S, E);
    }
    SEAM(5);
    if (IN(6)) {
        pg8::StaticOrder S; S.init(MIX, ws + WS_WOUT, T, 1024, 1024, G, bx);
        EpiOut E{args.in[0], args.out, HB};
        pg8::gemm_phase<EpiOut, pg8::StaticOrder, true, true>(lds, 1024, S, E);
    }
    SEAM(6);
    if (IN(7)) { p_route(args, lds, vcu, G, wave, lane, tid); }
    SEAM(7);
    if (IN(8)) {
        build_class_table(args, tab, tid);
        MoeOrder S{(const char*)HB, (const char*)(ws + WS_WUP), tab, rowtok, 8, 1, G, bx};
        S.build((const int*)(ws + WS_PERM), tid);
        EpiUp E{(const TokInfo*)(ws + WS_TOK), rowtok, HIDS};
        pg8::gemm_phase<EpiUp, MoeOrder, true, true, true>(lds, 1024, S, E);
    }
    SEAM(8);
    if (IN(9)) {
        build_class_table(args, tab, tid);
        MoeOrder S{(const char*)HIDS, (const char*)(ws + WS_WDN), tab, rowtok, 4, 0, G, bx};
        S.build((const int*)(ws + WS_PERM), tid);
        EpiDown E{rowtok, args.out};
        pg8::gemm_phase<EpiDown, MoeOrder, true, true>(lds, 1024, S, E);
    }
    SEAM(9);
    if (IN(10)) { p_final(args, vcu, G, wave, lane); }
#undef IN
#undef SEAM
}

extern "C" void kernel_launch(void* const* d_in, const int* in_sizes, int n_in, void* d_out, int out_size, void* d_ws, size_t ws_size, hipStream_t stream) {
    static int grid = 0;
    if (grid == 0) {
        if (n_in != 18 || in_sizes[0] != T * DM || out_size != T * DM || ws_size < WS_END) { fprintf(stderr, "kernel_launch: unexpected shapes (n_in %d, in0 %d, out %d, ws %zu < %zu)\n", n_in, n_in > 0 ? in_sizes[0] : -1, out_size, ws_size, (size_t)WS_END); grid = -1; return; }
        int dev = 0, cus = 0, per_cu = 0;
        if (hipGetDevice(&dev) != hipSuccess || hipDeviceGetAttribute(&cus, hipDeviceAttributeMultiprocessorCount, dev) != hipSuccess) { grid = -1; return; }
        if (hipFuncSetAttribute((const void*)fwd_kernel, hipFuncAttributeMaxDynamicSharedMemorySize, LDS_BYTES) != hipSuccess) { fprintf(stderr, "kernel_launch: hipFuncSetAttribute failed\n"); grid = -1; return; }
        if (hipOccupancyMaxActiveBlocksPerMultiprocessor(&per_cu, (const void*)fwd_kernel, NTHR, LDS_BYTES) != hipSuccess || per_cu < 1) fprintf(stderr, "kernel_launch: occupancy query reports %d\n", per_cu);
        (void)hipGetLastError();
        grid = cus;
    }
    if (grid < 0) return;
    hipMemsetAsync((char*)d_ws + WS_CTL, 0, CTL_ZERO_BYTES, stream);
    Args a{};
    for (int i = 0; i < 18; ++i) a.in[i] = (const float*)d_in[i];
    a.out = (float*)d_out; a.ws = (unsigned char*)d_ws;
#if MK_ONE_LAUNCH
    a.ph_lo = 0; a.ph_hi = NPHASE;
    hipLaunchKernelGGL(fwd_kernel, dim3(grid), dim3(NTHR), LDS_BYTES, stream, a);
#else
    for (int p = 0; p < NPHASE; ++p) for (int rep = 0; rep < ((PROBE_MASK >> p) & 1) + 1; ++rep) { a.ph_lo = p; a.ph_hi = p + 1; a.rep = rep; hipLaunchKernelGGL(fwd_kernel, dim3(grid), dim3(NTHR), LDS_BYTES, stream, a); }
#endif
}
```

```cpp
#include <hip/hip_runtime.h>
#include <cstdio>
#include <cstdint>
namespace pg8 {
#define PG8_LAS __attribute__((address_space(3)))
typedef unsigned short bf16_t;
typedef short bf16x8 __attribute__((ext_vector_type(8)));
typedef float f32x4 __attribute__((ext_vector_type(4)));
typedef unsigned u32x4 __attribute__((ext_vector_type(4)));
constexpr int BM = 256, BK = 64, HALF = 128, HTB = HALF * BK * 2  , STAGE_BYTES = 8 * HTB, NXCD = 8, WGM = 8;
__host__ __device__ __forceinline__ int lds_byte(int r, int c) { const int st = (r >> 4) * 2 + (c >> 5), rr = r & 15, cc = c & 31, ob = rr * 64 + cc * 2; return st * 1024 + (ob ^ (((ob >> 9) & 1) << 5)); }
__host__ __device__ __forceinline__ void stage_rc(int b, int& R, int& C) { const int st = b / 1024, sb = b % 1024, swz = sb ^ (((sb >> 9) & 1) << 5); R = (st >> 1) * 16 + swz / 64; C = (st & 1) * 32 + (swz % 64) / 2; }
__host__ __device__ __forceinline__ int perm32(int rho) { const int n = rho >> 4, i = rho & 15; return 8 * (i >> 2) + 4 * n + (i & 3); }

struct Unit { const char* a; const char* b; int row0, col0, tag, idx; };
struct StaticOrder {
    const char* A; const char* Bt; int K, nM, nN, nwg, G, c;
    __device__ void init(const void* A_, const void* Bt_, int M, int N, int K_, int G_, int c_) { A = (const char*)A_; Bt = (const char*)Bt_; K = K_; nM = M / BM; nN = N / BM; nwg = nM * nN; G = G_; c = c_; }
    __device__ bool next(int i, Unit& u) const {
        const long L = (long)i * G + c; if (L >= nwg) return false;
        int wgid = (int)L; { const int q = nwg / NXCD, r = nwg % NXCD, xcd = wgid % NXCD, off = wgid / NXCD; wgid = (xcd < r ? xcd * (q + 1) : r * (q + 1) + (xcd - r) * q) + off; }
        const int nig = WGM * nN, gid = wgid / nig, fm = gid * WGM, gsz = (nM - fm) < WGM ? (nM - fm) : WGM;
        const int pm = fm + ((wgid % nig) % gsz), pn = (wgid % nig) / gsz;
        u.a = A + (size_t)pm * BM * K * 2; u.b = Bt + (size_t)pn * BM * K * 2; u.row0 = pm * BM; u.col0 = pn * BM; u.tag = pn; u.idx = i; return true;
    }
    __device__ __forceinline__ void a_ready(const Unit&) const {}
    __device__ __forceinline__ void done(const Unit&) const {}
};
__device__ __forceinline__ unsigned cvt_pk_bf16(float lo, float hi) { unsigned r; asm volatile("v_cvt_pk_bf16_f32 %0, %1, %2" : "=v"(r) : "v"(lo), "v"(hi)); return r; }
template <class Epi, class Sched, bool ALIGN_EPI = false, bool SP2 = false, bool GATHER = false>
__device__ __forceinline__ void gemm_phase(PG8_LAS unsigned char* lds, const int K, const Sched& S, const Epi& E) {
    const int tid = threadIdx.x, wid = __builtin_amdgcn_readfirstlane(tid >> 6), lane = tid & 63, wr = wid >> 2, wc = wid & 3, fr = lane & 15, fq = lane >> 4;
    const int nt = K / BK;
    static_assert(!GATHER || SP2, "GATHER is implemented on the SP2 loop only");
    unsigned voffA[2], voffA1[2], voffB[2], voffAn[2] = {0u, 0u}, voffA1n[2] = {0u, 0u}; int Rr[2], Cc[2];
#pragma unroll
    for (int i = 0; i < 2; ++i) { int R, C; stage_rc(tid * 16 + i * 8192, R, C); const int Rb = Epi::PERM ? ((R & ~31) + perm32(R & 31)) : R; Rr[i] = R; Cc[i] = C;
        voffA[i] = (unsigned)(R * K + C) * 2u; voffA1[i] = voffA[i] + (unsigned)(HALF * K * 2); voffB[i] = (unsigned)(Rb * K + C) * 2u; }
#define PG8_AROWS(ui_, v0_, v1_) do { _Pragma("unroll") for (int i_ = 0; i_ < 2; ++i_) { \
        v0_[i_] = (unsigned)(S.arow((ui_), Rr[i_]) * K + Cc[i_]) * 2u; v1_[i_] = (unsigned)(S.arow((ui_), Rr[i_] + HALF) * K + Cc[i_]) * 2u; } } while (0)
    const size_t kstep = (size_t)(BK * 2);
    const size_t hstep = (size_t)HALF * K * 2;
    const size_t tstep = 2 * hstep;
    const unsigned ldsw = (unsigned)wid * 1024u;
    const int aoff = lds_byte(wr * 64 + fr, fq * 8), boff = lds_byte(wc * 32 + fr, fq * 8);
#define PG8_SA(b, h) (((b) * 2 + (h)) * HTB)
#define PG8_SB(b, h) ((4 + (b) * 2 + (h)) * HTB)
#define PG8_STAGE(bufoff, gbase, voff) do { _Pragma("unroll") for (int _i = 0; _i < 2; ++_i) \
        __builtin_amdgcn_global_load_lds((const unsigned*)((const char*)(gbase) + (voff)[_i]), (PG8_LAS unsigned*)(lds + (bufoff) + ldsw + _i * 8192), 16, 0, 0); } while (0)
#define PG8_LDA(dst, b, h) do { _Pragma("unroll") for (int m = 0; m < 4; ++m) _Pragma("unroll") for (int k = 0; k < 2; ++k) dst[m][k] = *(const PG8_LAS bf16x8*)(lds + PG8_SA(b, h) + aoff + m * 2048 + k * 1024); } while (0)
#define PG8_LDB(dst, b, h) do { _Pragma("unroll") for (int n = 0; n < 2; ++n) _Pragma("unroll") for (int k = 0; k < 2; ++k) dst[n][k] = *(const PG8_LAS bf16x8*)(lds + PG8_SB(b, h) + boff + n * 2048 + k * 1024); } while (0)
#define PG8_MMA(ai, bj, At, Bt) do { __builtin_amdgcn_s_setprio(1); _Pragma("unroll") for (int m = 0; m < 4; ++m) _Pragma("unroll") for (int n = 0; n < 2; ++n) _Pragma("unroll") for (int k = 0; k < 2; ++k) \
        acc[ai][bj][m][n] = __builtin_amdgcn_mfma_f32_16x16x32_bf16(Bt[n][k], At[m][k], acc[ai][bj][m][n], 0, 0, 0); __builtin_amdgcn_s_setprio(0); } while (0)
#define PG8_WAIT_V(n) asm volatile("s_waitcnt vmcnt(" #n ")" ::: "memory")
#define PG8_WAIT_L(n) asm volatile("s_waitcnt lgkmcnt(" #n ")" ::: "memory")
#define PG8_BAR __builtin_amdgcn_s_barrier()
#define PG8_SCHED __builtin_amdgcn_sched_barrier(0)
    Unit cur, nxt; int ui = 0;
    if (!S.next(0, cur)) return;
    f32x4 acc[2][2][4][2];
#pragma unroll
    for (int a = 0; a < 2; ++a)
#pragma unroll
        for (int b = 0; b < 2; ++b)
#pragma unroll
            for (int m = 0; m < 4; ++m)
#pragma unroll
                for (int n = 0; n < 2; ++n) acc[a][b][m][n] = (f32x4){0.f, 0.f, 0.f, 0.f};
    bf16x8 At[4][2], B0[2][2], B1[2][2];
    const char* cA = cur.a; const char* cB = cur.b;
    S.a_ready(cur);
    if constexpr (SP2) {
        if constexpr (GATHER) PG8_AROWS(0, voffA, voffA1);
        PG8_STAGE(PG8_SB(0, 0), cB, voffB); PG8_STAGE(PG8_SB(0, 1), cB + hstep, voffB); PG8_STAGE(PG8_SA(0, 0), cA, voffA); PG8_STAGE(PG8_SA(0, 1), cA, voffA1);
        if (wr == 1) PG8_BAR;
        PG8_WAIT_V(2); PG8_BAR;
        PG8_STAGE(PG8_SB(1, 0), cB + kstep, voffB); PG8_STAGE(PG8_SA(1, 0), cA + kstep, voffA); PG8_STAGE(PG8_SB(1, 1), cB + hstep + kstep, voffB);
        PG8_WAIT_V(6); PG8_BAR;
    } else {
        PG8_STAGE(PG8_SB(0, 0), cB, voffB); PG8_STAGE(PG8_SA(0, 0), cA, voffA); PG8_STAGE(PG8_SB(0, 1), cB + hstep, voffB); PG8_STAGE(PG8_SA(0, 1), cA + hstep, voffA);
        if (wr == 1) PG8_BAR;
        PG8_WAIT_V(4); PG8_BAR;
        PG8_STAGE(PG8_SB(1, 0), cB + kstep, voffB); PG8_STAGE(PG8_SA(1, 0), cA + kstep, voffA); PG8_STAGE(PG8_SB(1, 1), cB + hstep + kstep, voffB);
        PG8_WAIT_V(6); PG8_BAR;
    }
    for (;;) {
        const bool has_next = S.next(ui + 1, nxt);
        if constexpr (GATHER) { if (has_next) PG8_AROWS(ui + 1, voffAn, voffA1n); }
        const char* nA = has_next ? nxt.a : cA; const char* nB = has_next ? nxt.b : cB;
        for (int t = 0; t < nt; t += 2) {
            const bool last = (t == nt - 2);
            const char* a1 = cA + (size_t)(t + 1) * kstep;
            const char* a2 = last ? nA : cA + (size_t)(t + 2) * kstep; const char* b2 = last ? nB : cB + (size_t)(t + 2) * kstep;
            const char* a3 = a2 + kstep; const char* b3 = b2 + kstep;
            if (last && has_next) S.a_ready(nxt);
            unsigned vx0[2], vx1[2];
#pragma unroll
            for (int i = 0; i < 2; ++i) { vx0[i] = (GATHER && last && has_next) ? voffAn[i] : voffA[i]; vx1[i] = (GATHER && last && has_next) ? voffA1n[i] : voffA1[i]; }
            if constexpr (SP2) {
            PG8_LDB(B0, 0, 0); PG8_LDB(B1, 0, 1); PG8_SCHED; PG8_LDA(At, 0, 0); PG8_STAGE(PG8_SA(1, 1), a1, voffA1);
            PG8_WAIT_V(8); PG8_WAIT_L(0); PG8_BAR; PG8_MMA(0, 0, At, B0); PG8_MMA(0, 1, At, B1); PG8_BAR; PG8_SCHED;
            PG8_LDA(At, 0, 1); PG8_STAGE(PG8_SB(0, 0), b2, voffB); PG8_STAGE(PG8_SB(0, 1), b2 + hstep, voffB); PG8_STAGE(PG8_SA(0, 0), a2, vx0);
            PG8_WAIT_V(8); PG8_WAIT_L(0); PG8_BAR; PG8_MMA(1, 0, At, B0); PG8_MMA(1, 1, At, B1); PG8_BAR; PG8_SCHED;
            PG8_LDB(B0, 1, 0); PG8_LDB(B1, 1, 1); PG8_SCHED; PG8_LDA(At, 1, 0); PG8_STAGE(PG8_SA(0, 1), a2, vx1);
            PG8_WAIT_V(8); PG8_WAIT_L(0); PG8_BAR; PG8_MMA(0, 0, At, B0); PG8_MMA(0, 1, At, B1); PG8_BAR; PG8_SCHED;
            PG8_LDA(At, 1, 1); PG8_STAGE(PG8_SB(1, 0), b3, voffB); PG8_STAGE(PG8_SB(1, 1), b3 + hstep, voffB); PG8_STAGE(PG8_SA(1, 0), a3, vx0);
            PG8_WAIT_V(8); PG8_WAIT_L(0); PG8_BAR; PG8_MMA(1, 0, At, B0); PG8_MMA(1, 1, At, B1); PG8_BAR; PG8_SCHED;
            } else {
            PG8_LDB(B0, 0, 0); PG8_SCHED; PG8_LDA(At, 0, 0); PG8_STAGE(PG8_SA(1, 1), a1 + hstep, voffA);
            PG8_WAIT_L(8); PG8_BAR; PG8_WAIT_L(0); PG8_MMA(0, 0, At, B0); PG8_BAR; PG8_SCHED;
            PG8_LDB(B1, 0, 1); PG8_STAGE(PG8_SB(0, 0), b2, voffB);
            PG8_BAR; PG8_WAIT_L(0); PG8_MMA(0, 1, At, B1); PG8_BAR;
            PG8_LDA(At, 0, 1); PG8_STAGE(PG8_SA(0, 0), a2, voffA);
            PG8_BAR; PG8_WAIT_L(0); PG8_MMA(1, 0, At, B0); PG8_BAR; PG8_SCHED;
            PG8_STAGE(PG8_SB(0, 1), b2 + hstep, voffB);
            PG8_WAIT_V(6); PG8_BAR; PG8_MMA(1, 1, At, B1); PG8_BAR;
            PG8_LDB(B0, 1, 0); PG8_SCHED; PG8_LDA(At, 1, 0); PG8_STAGE(PG8_SA(0, 1), a2 + hstep, voffA);
            PG8_WAIT_L(8); PG8_BAR; PG8_WAIT_L(0); PG8_MMA(0, 0, At, B0); PG8_BAR; PG8_SCHED;
            PG8_LDB(B1, 1, 1); PG8_STAGE(PG8_SB(1, 0), b3, voffB);
            PG8_BAR; PG8_WAIT_L(0); PG8_MMA(0, 1, At, B1); PG8_BAR;
            PG8_LDA(At, 1, 1); PG8_STAGE(PG8_SA(1, 0), a3, voffA);
            PG8_BAR; PG8_WAIT_L(0); PG8_MMA(1, 0, At, B0); PG8_BAR; PG8_SCHED;
            PG8_STAGE(PG8_SB(1, 1), b3 + hstep, voffB);
            PG8_WAIT_V(6); PG8_BAR; PG8_MMA(1, 1, At, B1); PG8_BAR;
            }
        }
        if constexpr (ALIGN_EPI) { if (wr == 0) PG8_BAR; }
        if constexpr (!Epi::AFTER_DRAIN) { if constexpr (Epi::INPLACE) E.inplace(acc, cur, wr, wc, fr, fq, wid, lane); else E(acc, cur, wr, wc, fr, fq); S.done(cur); }
        if (!has_next) break;
#pragma unroll
        for (int a = 0; a < 2; ++a)
#pragma unroll
            for (int b = 0; b < 2; ++b)
#pragma unroll
                for (int m = 0; m < 4; ++m)
#pragma unroll
                    for (int n = 0; n < 2; ++n) acc[a][b][m][n] = (f32x4){0.f, 0.f, 0.f, 0.f};
        cur = nxt; cA = nA; cB = nB; ++ui;
        if constexpr (GATHER) {
#pragma unroll
            for (int i = 0; i < 2; ++i) { voffA[i] = voffAn[i]; voffA1[i] = voffA1n[i]; } }
        if constexpr (ALIGN_EPI) { if (wr == 1) PG8_BAR; }
    }
    PG8_WAIT_V(0);
    if constexpr (!ALIGN_EPI) { if (wr == 0) PG8_BAR; }
    PG8_BAR;
    if constexpr (Epi::AFTER_DRAIN) { E.fused(acc, cur, wr, wc, fr, fq, lds, wid, lane); S.done(cur); }
#undef PG8_AROWS
#undef PG8_SA
#undef PG8_SB
#undef PG8_STAGE
#undef PG8_LDA
#undef PG8_LDB
#undef PG8_MMA
#undef PG8_WAIT_V
#undef PG8_WAIT_L
#undef PG8_BAR
#undef PG8_SCHED
}
}
#define GAS __attribute__((address_space(1)))
#define LAS __attribute__((address_space(3)))
typedef unsigned short bf16;
typedef unsigned v4u __attribute__((ext_vector_type(4)));
typedef float f32x4 __attribute__((ext_vector_type(4)));
typedef short bf16x8 __attribute__((ext_vector_type(8)));
typedef GAS unsigned gu32;
typedef GAS unsigned long long gu64;
#define RLX_AGENT __ATOMIC_RELAXED, __HIP_MEMORY_SCOPE_AGENT
#define LDS_WAIT() asm volatile("s_waitcnt lgkmcnt(0)" ::: "memory")
#define VM_WAIT() asm volatile("s_waitcnt vmcnt(0)" ::: "memory")
__device__ __forceinline__ unsigned long long rt() { return __builtin_amdgcn_s_memrealtime(); }
__device__ __forceinline__ unsigned f2bf(float f) { unsigned u = __builtin_bit_cast(unsigned, f); return (u + 0x7fffu + ((u >> 16) & 1u)) >> 16; }
__device__ __forceinline__ unsigned pk2(float lo, float hi) { return f2bf(lo) | (f2bf(hi) << 16); }

#define XB_TMO      128
#define XB_XCNT(j)  (256  + 64 * (j))
#define XB_XSUB(j)  (1280 + 64 * (j))
#define XB_XGEN(j)  (2304 + 64 * (j))
#define XB_TOP      3328
#define XB_TOPGEN   3392
#define XCD_BAR_WORDS 3456
#define XB_SPIN_CAP (1u << 18)

__device__ __forceinline__ unsigned xb_ld(unsigned* p)              { return __hip_atomic_load(p, __ATOMIC_RELAXED, __HIP_MEMORY_SCOPE_AGENT); }
__device__ __forceinline__ unsigned xb_add(unsigned* p, unsigned v) { return __hip_atomic_fetch_add(p, v, __ATOMIC_RELAXED, __HIP_MEMORY_SCOPE_AGENT); }
__device__ __forceinline__ unsigned xb_xcc_id() { return (unsigned)__builtin_amdgcn_s_getreg((3 << 11) | 20) & 0xFu; }
#define XB_SPIN(cond, bar) do { unsigned _sp = 0; while (cond) { __builtin_amdgcn_s_sleep(1); \
    if ((++_sp & 255u) == 0u) { if (xb_ld(&(bar)[XB_TMO])) break; if (_sp > XB_SPIN_CAP) { atomicAdd(&(bar)[XB_TMO], 1u); break; } } } } while (0)

struct XcdBarrier {
    unsigned* bar; unsigned x;
    volatile LAS unsigned* st;
};

__device__ __forceinline__ XcdBarrier xcd_barrier_post(unsigned* bar, volatile LAS unsigned* st) {
    XcdBarrier b; b.bar = bar; b.x = xb_xcc_id(); b.st = st;
    if (threadIdx.x == 0) (void)xb_add(&bar[XB_XCNT(b.x)], 1u);
    return b;
}
__device__ __forceinline__ void xcd_barrier_complete(unsigned* bar, unsigned x, unsigned& nloc, unsigned& nx) {
    const unsigned G = gridDim.x * gridDim.y * gridDim.z;
    unsigned sum, cnt, mine, sp = 0u;
    for (;;) {
        sum = 0u; cnt = 0u; mine = 0u;
#pragma unroll
        for (unsigned j = 0; j < 16; ++j) { const unsigned c = xb_ld(&bar[XB_XCNT(j)]); sum += c; cnt += (c > 0u) ? 1u : 0u; mine = (j == x) ? c : mine; }
        if (sum == G) break;
        __builtin_amdgcn_s_sleep(1);
        if ((++sp & 255u) == 0u) { if (xb_ld(&bar[XB_TMO])) break; if (sp > XB_SPIN_CAP) { atomicAdd(&bar[XB_TMO], 1u); break; } }
    }
    nloc = mine > 0u ? mine : 1u; nx = cnt > 0u ? cnt : 1u;
}

__device__ __forceinline__ void xcd_barrier(const XcdBarrier& b) {
    asm volatile("s_waitcnt vmcnt(0)" ::: "memory");
    __syncthreads();
    if (threadIdx.x == 0) {
        unsigned* bar = b.bar;
        __builtin_amdgcn_s_waitcnt(0);
        unsigned nloc = b.st[0], nx = b.st[1];
        if (nloc == 0u) { xcd_barrier_complete(bar, b.x, nloc, nx); b.st[0] = nloc; b.st[1] = nx; }
        const unsigned old = xb_add(&bar[XB_XSUB(b.x)], 1u);
        const unsigned gen = old / nloc;
        if (old + 1u == (gen + 1u) * nloc) {
            __builtin_amdgcn_fence(__ATOMIC_RELEASE, "agent");
            asm volatile("s_waitcnt vmcnt(0)" ::: "memory");
            const unsigned og = xb_add(&bar[XB_TOP], 1u);
            const unsigned tg = og / nx;
            if (og + 1u == (tg + 1u) * nx) xb_add(&bar[XB_TOPGEN], 1u);
            else XB_SPIN(xb_ld(&bar[XB_TOPGEN]) == tg, bar);
            __builtin_amdgcn_fence(__ATOMIC_ACQUIRE, "agent");
            xb_add(&bar[XB_XGEN(b.x)], 1u);
            asm volatile("s_waitcnt vmcnt(0)" ::: "memory");
        } else {
            XB_SPIN(xb_ld(&bar[XB_XGEN(b.x)]) == gen, bar);
            __builtin_amdgcn_fence(__ATOMIC_ACQUIRE, "agent");
            asm volatile("s_waitcnt vmcnt(0)" ::: "memory");
        }
    }
    __syncthreads();
}


constexpr int NWAVES = 8, NTHR = NWAVES * 64;
constexpr int DM = 1024, NB = 16, SEQ = 2048, T = NB * SEQ;
constexpr int N1 = 6656;
constexpr int NCLS = 24, SROWS = T + NCLS * 256;
constexpr float EPS = 1e-6f;
constexpr size_t MiB = 1u << 20;
constexpr size_t WS_CTL = 0, CTL_ZERO_BYTES = 1 * MiB;
constexpr size_t WS_ROT = 1 * MiB;
constexpr size_t WS_WRT = 1 * MiB + 512 * 1024;
constexpr size_t WS_TOK = 2 * MiB;
constexpr size_t WS_RSTD = 2 * MiB + 512 * 1024;
constexpr size_t WS_XBUF = 3 * MiB;
constexpr size_t WS_W1 = 4 * MiB, WS_WSB = 18 * MiB, WS_WRET = 19 * MiB, WS_WOUT = 21 * MiB, WS_WUP = 23 * MiB, WS_WDN = 55 * MiB;
constexpr size_t WS_R1 = 104 * MiB;
constexpr size_t WS_SBQ = 168 * MiB, WS_SBK = 200 * MiB, WS_SBV = 232 * MiB, WS_RQ = 264 * MiB, WS_RK = 296 * MiB, WS_RV = 328 * MiB, WS_RG = 392 * MiB, WS_YSB = WS_SBQ;
constexpr size_t WS_TMP = WS_RV, WS_MIX = WS_SBV, WS_HB = WS_RG;
constexpr size_t WS_PERM = WS_W1;
constexpr size_t WS_KV = 456 * MiB;
constexpr size_t WS_END = 488 * MiB;
constexpr size_t WS_PROBE = 200 * MiB;
constexpr int CW_BAR = 4096, CW_CNT = 8192, CW_ROWT = 16384;
constexpr int LDS_BYTES = 147456;
constexpr int LDSCTL_OFF = LDS_BYTES - 2048, MISC_OFF = LDSCTL_OFF + 320, TAB_OFF = LDSCTL_OFF + 1024;

struct TokInfo { float ga, gb, rstd; int cls; };

__device__ __forceinline__ float wave_sum(float v) {
#pragma unroll
    for (int o = 1; o < 64; o <<= 1) v += __shfl_xor(v, o);
    return v;
}
__device__ __forceinline__ float bf2f(unsigned short b) { return __builtin_bit_cast(float, (unsigned)b << 16); }
__device__ __forceinline__ float bflo(unsigned w) { return __builtin_bit_cast(float, w << 16); }
__device__ __forceinline__ float bfhi(unsigned w) { return __builtin_bit_cast(float, w & 0xffff0000u); }

struct Args { const float* in[18]; float* out; unsigned char* ws; int ph_lo, ph_hi, rep, pad; };

struct TJob { const float* W; int N; bf16* WT; int ldk, koff, mode, nbase; const float* gk; };
__device__ __forceinline__ int rowmap(int mode, int n) {
    if (mode == 1) {
        if (n >= 1536 && n < 2560) { const int seg = n < 2048 ? 1536 : 2048, c = n - seg, hh = c >> 6, i = c & 63; return seg + (hh >> 2) * 256 + (i >> 5) * 128 + (hh & 3) * 32 + (i & 31); }
        return n;
    }
    if (mode == 2) return (n >> 7) * 256 + (n & 127);
    if (mode == 3) return (n >> 7) * 256 + 128 + (n & 127);
    return n;
}
__device__ __forceinline__ void p0_transpose_item(const TJob& J, LAS float* scr, int item, int lane) {
    const int nblk = J.N / 32, kb = item / nblk, nb = item % nblk, k0 = 64 * kb, n0 = 32 * nb;
#pragma unroll 8
    for (int i = 0; i < 32; ++i) { const int kk = 2 * i + (lane >> 5); scr[kk * 33 + (lane & 31)] = J.W[(size_t)(k0 + kk) * J.N + n0 + (lane & 31)]; }
    LDS_WAIT(); asm volatile("" ::: "memory");
    const int c = lane & 7;
#pragma unroll
    for (int j = 0; j < 4; ++j) { const int n = (lane >> 3) + 8 * j; const LAS float* s = scr + (8 * c) * 33 + n;
        const int ng = n0 + n; float sc = 1.f; if (J.mode == 1) { if (ng < 512) sc = 0.125f * 1.4426950408889634f; else if (ng >= 2048 && ng < 2560) sc = 0.125f; }
        float g8[8];
#pragma unroll
        for (int q = 0; q < 8; ++q) g8[q] = J.gk ? J.gk[k0 + 8 * c + q] * sc : sc;
        v4u o; o.x = pk2(s[0 * 33] * g8[0], s[1 * 33] * g8[1]); o.y = pk2(s[2 * 33] * g8[2], s[3 * 33] * g8[3]); o.z = pk2(s[4 * 33] * g8[4], s[5 * 33] * g8[5]); o.w = pk2(s[6 * 33] * g8[6], s[7 * 33] * g8[7]);
        *(GAS v4u*)(J.WT + (size_t)(J.nbase + rowmap(J.mode, ng)) * J.ldk + J.koff + k0 + 8 * c) = o; }
    LDS_WAIT(); asm volatile("" ::: "memory");
}
__device__ __forceinline__ void p0_prologue(const Args& a, LAS unsigned char* lds, int vcu, int G, int wave, int lane) {
    unsigned char* ws = a.ws;
    LAS float* scr = (LAS float*)(lds + wave * 16384);
    const int gw = vcu * NWAVES + wave, NGW = G * NWAVES;
    constexpr int I0 = 16 * 144, I1 = 16 * 64, I2 = 8 * 32, I3 = 16 * 32, I4 = 16 * 32, I5 = 16 * 256, I6 = 16 * 256, I7 = 48 * 256;
    constexpr int NITEMS = I0 + I1 + I2 + I3 + I4 + I5 + I6 + I7;
    for (int it = gw; it < NITEMS; it += NGW) {
        int r = it; TJob J;
        if (r < I0) { J = TJob{a.in[2], 4608, (bf16*)(ws + WS_W1), 1024, 0, 1, 0, nullptr}; }
        else if ((r -= I0) < I1) { J = TJob{a.in[3], 2048, (bf16*)(ws + WS_W1), 1024, 0, 0, 4608, nullptr}; }
        else if ((r -= I1) < I2) { J = TJob{a.in[5], 1024, (bf16*)(ws + WS_WSB), 512, 0, 0, 0, nullptr}; }
        else if ((r -= I2) < I3) { J = TJob{a.in[6], 1024, (bf16*)(ws + WS_WRET), 1024, 0, 0, 0, nullptr}; }
        else if ((r -= I3) < I4) { J = TJob{a.in[8], 1024, (bf16*)(ws + WS_WOUT), 1024, 0, 0, 0, nullptr}; }
        else if ((r -= I4) < I5) { const int e = r >> 8; r &= 255; J = TJob{a.in[14] + (size_t)e * 1024 * 512, 512, (bf16*)(ws + WS_WUP) + (size_t)e * 1024 * 1024, 1024, 0, 2, 0, a.in[9]}; }
        else if ((r -= I5) < I6) { const int e = r >> 8; r &= 255; J = TJob{a.in[15] + (size_t)e * 1024 * 512, 512, (bf16*)(ws + WS_WUP) + (size_t)e * 1024 * 1024, 1024, 0, 3, 0, a.in[9]}; }
        else { r -= I6; const int cs = r >> 8; r &= 255; const int cls = cs >> 1, slot = cs & 1, g = cls / 6, p = cls % 6;
            const int pa = p < 3 ? 0 : (p < 5 ? 1 : 2), pb = p == 0 ? 1 : (p == 1 ? 2 : (p == 2 ? 3 : (p == 3 ? 2 : 3)));
            const int e = 4 * g + (slot ? pb : pa);
            J = TJob{a.in[16] + (size_t)e * 512 * 1024, 1024, (bf16*)(ws + WS_WDN) + (size_t)cls * 1024 * 1024, 1024, slot * 512, 0, 0, nullptr}; }
        p0_transpose_item(J, scr, r, lane);
    }
    const float* x = a.in[0]; const float* g = a.in[1]; bf16* xn = (bf16*)(ws + WS_R1);
    f32x4 gv[4];
#pragma unroll
    for (int j = 0; j < 4; ++j) gv[j] = ((const f32x4*)g)[lane + 64 * j];
    for (int m = gw; m < T; m += NGW) {
        const GAS f32x4* xr = (const GAS f32x4*)(x + (size_t)m * DM) + lane;
        f32x4 v[4]; float s = 0.f;
#pragma unroll
        for (int j = 0; j < 4; ++j) { v[j] = xr[64 * j]; s += (v[j].x * v[j].x + v[j].y * v[j].y) + (v[j].z * v[j].z + v[j].w * v[j].w); }
        const float rstd = 1.f / sqrtf(wave_sum(s) * (1.f / DM) + EPS);
        GAS unsigned long long* o8 = (GAS unsigned long long*)(xn + (size_t)m * DM) + lane;
#pragma unroll
        for (int j = 0; j < 4; ++j) { const f32x4 y = v[j] * rstd * gv[j]; o8[64 * j] = (unsigned long long)pk2(y.x, y.y) | ((unsigned long long)pk2(y.z, y.w) << 32); }
    }
    float* rot = (float*)(ws + WS_ROT);
    for (int idx = gw * 64 + lane; idx < SEQ * 32; idx += NGW * 64) {
        const int pos = idx >> 5, i = idx & 31;
        const float inv = (float)exp(-(double)i * (9.210340371976184 / 32.0));
        const float ang = (float)pos * inv;
        rot[idx] = (float)cos((double)ang); rot[SEQ * 32 + idx] = (float)sin((double)ang);
    }
    bf16* wrt = (bf16*)(ws + WS_WRT);
    for (int idx = gw * 64 + lane; idx < 32 * 1024; idx += NGW * 64) {
        const int o = idx >> 10, k = idx & 1023;
        float v = 0.f; if (o < 8) v = a.in[10][k * 4 + (o & 3)]; else if (o < 24) v = a.in[12][k * 16 + (o - 8)];
        v *= a.in[9][k];
        const unsigned hb_ = f2bf(v); const float lo = v - __builtin_bit_cast(float, hb_ << 16);
        wrt[idx] = (bf16)hb_; wrt[32 * 1024 + idx] = (bf16)f2bf(lo);
    }
}

typedef pg8::Unit Unit;
using pg8::cvt_pk_bf16;
__device__ __forceinline__ v4u pack8(const f32x4 a, const f32x4 b) { v4u w; w.x = cvt_pk_bf16(a[0], a[1]); w.y = cvt_pk_bf16(a[2], a[3]); w.z = cvt_pk_bf16(b[0], b[1]); w.w = cvt_pk_bf16(b[2], b[3]); return w; }
__device__ __forceinline__ float sigm(float x) { return 1.f / (1.f + __expf(-x)); }

struct Epi1 {
    static constexpr bool PERM = true, AFTER_DRAIN = false, INPLACE = false;
    bf16 *sbq, *sbk, *sbv, *rq, *rk, *rv, *rg, *gates; const float* bgate; const float* rot; int nostore;
    __device__ __forceinline__ void operator()(const f32x4 (&acc)[2][2][4][2], const Unit& u, int wr, int wc, int fr, int fq) const {
        const int pn = u.tag, rowb = u.row0 + wr * 64 + fr, cw = wc * 32 + 8 * fq;
        if (pn >= 6 && pn < 10) {
            bf16* base = (pn < 8 ? rq : rk) + ((pn & 1) * 4 + wc) * 64 + 8 * fq;
            const int hh_ = (pn & 1) * 4 + wc; const float lg2h = hh_ == 0 ? -4.5803689613e-02f : (hh_ == 1 ? -2.2720076500e-02f : (hh_ == 2 ? -1.1315313228e-02f : (hh_ == 3 ? -5.6465631411e-03f : (hh_ == 4 ? -2.8205190624e-03f : (hh_ == 5 ? -1.4095702547e-03f : (hh_ == 6 ? -7.0461297659e-04f : (-3.5226347163e-04f)))))));
#pragma unroll
            for (int ai = 0; ai < 2; ++ai)
#pragma unroll
                for (int m = 0; m < 4; ++m) { const int row = rowb + ai * 128 + m * 16, pos = row & (SEQ - 1);
                    const f32x4 c0 = *(const f32x4*)(rot + pos * 32 + 8 * fq), c1 = *(const f32x4*)(rot + pos * 32 + 8 * fq + 4);
                    const f32x4 s0 = *(const f32x4*)(rot + SEQ * 32 + pos * 32 + 8 * fq), s1 = *(const f32x4*)(rot + SEQ * 32 + pos * 32 + 8 * fq + 4);
                    const f32x4 x10 = acc[ai][0][m][0], x11 = acc[ai][0][m][1], x20 = acc[ai][1][m][0], x21 = acc[ai][1][m][1];
                    f32x4 o10 = x10 * c0 - x20 * s0, o11 = x11 * c1 - x21 * s1, o20 = x20 * c0 + x10 * s0, o21 = x21 * c1 + x11 * s1;
                    if (pn >= 8) { const float kd = __builtin_amdgcn_exp2f(lg2h * (float)(64 - (pos & 63))); o10 *= kd; o11 *= kd; o20 *= kd; o21 *= kd; }
                    bf16* rowp = base + (size_t)row * 512;
                    const v4u w0 = pack8(o10, o11), w1 = pack8(o20, o21); if (!nostore) { *(v4u*)rowp = w0; *(v4u*)(rowp + 32) = w1; } else asm volatile("" :: "v"(w0), "v"(w1)); }
            return;
        }
        bf16* base; int ld, colt, act = 0;
        if (pn < 2) { base = sbq; ld = 512; colt = pn * 256; } else if (pn < 4) { base = sbk; ld = 512; colt = (pn - 2) * 256; }
        else if (pn < 6) { base = sbv; ld = 512; colt = (pn - 4) * 256; } else if (pn < 14) { base = rv; ld = 1024; colt = (pn - 10) * 256; }
        else if (pn < 18) { base = rg; ld = 1024; colt = (pn - 14) * 256; act = 1; } else { base = gates; ld = 2048; colt = (pn - 18) * 256; act = 2; }
        f32x4 bv[2][2];
#pragma unroll
        for (int bj = 0; bj < 2; ++bj)
#pragma unroll
            for (int n = 0; n < 2; ++n) bv[bj][n] = act == 2 ? *(const f32x4*)(bgate + colt + bj * 128 + cw + 4 * n) : (f32x4){0.f, 0.f, 0.f, 0.f};
#pragma unroll
        for (int ai = 0; ai < 2; ++ai)
#pragma unroll
            for (int m = 0; m < 4; ++m) { bf16* rowp = base + (size_t)(rowb + ai * 128 + m * 16) * ld + colt + cw;
#pragma unroll
                for (int bj = 0; bj < 2; ++bj) { f32x4 v0 = acc[ai][bj][m][0] + bv[bj][0], v1 = acc[ai][bj][m][1] + bv[bj][1];
                    if (act == 1) {
#pragma unroll
                        for (int j = 0; j < 4; ++j) { v0[j] = v0[j] * sigm(v0[j]); v1[j] = v1[j] * sigm(v1[j]); } }
                    else if (act == 2) {
#pragma unroll
                        for (int j = 0; j < 4; ++j) { v0[j] = sigm(v0[j]); v1[j] = sigm(v1[j]); } }
                    const v4u w0 = pack8(v0, v1); if (!nostore) *(v4u*)(rowp + bj * 128) = w0; else asm volatile("" :: "v"(w0)); } }
    }
};
template <bool ADD> struct EpiMix {
    static constexpr bool PERM = true, AFTER_DRAIN = false, INPLACE = false;
    const bf16* gates; int goff; const bf16* prev; bf16* out;
    __device__ __forceinline__ void operator()(const f32x4 (&acc)[2][2][4][2], const Unit& u, int wr, int wc, int fr, int fq) const {
        const int rowb = u.row0 + wr * 64 + fr, colb = u.col0 + wc * 32 + 8 * fq;
#pragma unroll
        for (int ai = 0; ai < 2; ++ai)
#pragma unroll
            for (int m = 0; m < 4; ++m) { const size_t row = rowb + ai * 128 + m * 16;
#pragma unroll
                for (int bj = 0; bj < 2; ++bj) { const int col = colb + bj * 128;
                    const v4u g = *(const v4u*)(gates + row * 2048 + goff + col);
                    f32x4 v0 = acc[ai][bj][m][0], v1 = acc[ai][bj][m][1];
                    v0[0] *= bflo(g.x); v0[1] *= bfhi(g.x); v0[2] *= bflo(g.y); v0[3] *= bfhi(g.y); v1[0] *= bflo(g.z); v1[1] *= bfhi(g.z); v1[2] *= bflo(g.w); v1[3] *= bfhi(g.w);
                    if (ADD) { const v4u p = *(const v4u*)(prev + row * 1024 + col);
                        v0[0] += bflo(p.x); v0[1] += bfhi(p.x); v0[2] += bflo(p.y); v0[3] += bfhi(p.y); v1[0] += bflo(p.z); v1[1] += bfhi(p.z); v1[2] += bflo(p.w); v1[3] += bfhi(p.w); }
                    *(v4u*)(out + row * 1024 + col) = pack8(v0, v1); } }
    }
};
struct EpiOut {
    static constexpr bool PERM = true, AFTER_DRAIN = false, INPLACE = false;
    const float* x; float* out; bf16* hb;
    __device__ __forceinline__ void operator()(const f32x4 (&acc)[2][2][4][2], const Unit& u, int wr, int wc, int fr, int fq) const {
        const int rowb = u.row0 + wr * 64 + fr, colb = u.col0 + wc * 32 + 8 * fq;
#pragma unroll
        for (int ai = 0; ai < 2; ++ai)
#pragma unroll
            for (int m = 0; m < 4; ++m) { const size_t off = (size_t)(rowb + ai * 128 + m * 16) * 1024 + colb;
#pragma unroll
                for (int bj = 0; bj < 2; ++bj)
                { const f32x4 v0 = *(const f32x4*)(x + off + bj * 128) + acc[ai][bj][m][0], v1 = *(const f32x4*)(x + off + bj * 128 + 4) + acc[ai][bj][m][1];
                    *(f32x4*)(out + off + bj * 128) = v0; *(f32x4*)(out + off + bj * 128 + 4) = v1; *(v4u*)(hb + off + bj * 128) = pack8(v0, v1); } }
    }
};
struct EpiUp {
    static constexpr bool PERM = true, AFTER_DRAIN = false, INPLACE = false;
    const TokInfo* tinfo; const volatile LAS int* rowtok; bf16* hid;
    __device__ __forceinline__ void operator()(const f32x4 (&acc)[2][2][4][2], const Unit& u, int wr, int wc, int fr, int fq) const {
        const int ct = u.tag, lrb = wr * 64 + fr, col = ct * 128 + wc * 32 + 8 * fq;
#pragma unroll
        for (int ai = 0; ai < 2; ++ai)
#pragma unroll
            for (int m = 0; m < 4; ++m) { const int lr = lrb + ai * 128 + m * 16, tok = rowtok[u.idx * 256 + lr];
                if (tok >= 0) { const TokInfo ti = tinfo[tok]; const float gw = ct < 4 ? ti.ga : ti.gb, rs = ti.rstd;
                    f32x4 v0, v1;
#pragma unroll
                    for (int j = 0; j < 4; ++j) { const float g0 = acc[ai][0][m][0][j] * rs, g1 = acc[ai][0][m][1][j] * rs;
                        v0[j] = g0 * sigm(g0) * acc[ai][1][m][0][j] * (rs * gw); v1[j] = g1 * sigm(g1) * acc[ai][1][m][1][j] * (rs * gw); }
                    *(v4u*)(hid + (size_t)(u.row0 + lr) * 1024 + col) = pack8(v0, v1); } }
    }
};
struct EpiDown {
    static constexpr bool PERM = true, AFTER_DRAIN = false, INPLACE = true;
    const volatile LAS int* rowtok; float* out; const float* gfin; float* xbuf; unsigned* cnt; LAS unsigned char* xl;
    __device__ __forceinline__ void inplace(f32x4 (&acc)[2][2][4][2], const Unit& u, int wr, int wc, int fr, int fq, int wid, int lane) const {
        LAS float* P = (LAS float*)xl; LAS float* S = (LAS float*)(xl + 4096); volatile LAS unsigned* flag = (volatile LAS unsigned*)(xl + 5120);
        const int lrb = wr * 64 + fr, colb = u.col0 + wc * 32 + 8 * fq, rt = u.row0 >> 8, ct = u.tag;
#pragma unroll
        for (int ai = 0; ai < 2; ++ai)
#pragma unroll
            for (int m = 0; m < 4; ++m) { const int lr = lrb + ai * 128 + m * 16, tok = rowtok[u.idx * 256 + lr]; float s = 0.f;
                if (tok >= 0) { const float* p = out + (size_t)tok * 1024 + colb;
#pragma unroll
                    for (int bj = 0; bj < 2; ++bj)
#pragma unroll
                        for (int n = 0; n < 2; ++n) { const f32x4 y = *(const f32x4*)(p + bj * 128 + n * 4) + acc[ai][bj][m][n]; acc[ai][bj][m][n] = y; s += (y[0] * y[0] + y[1] * y[1]) + (y[2] * y[2] + y[3] * y[3]); } }
                s += __shfl_xor(s, 16); s += __shfl_xor(s, 32);
                if (fq == 0) P[lr * 4 + wc] = s; }
        asm volatile("s_waitcnt lgkmcnt(0)" ::: "memory"); __builtin_amdgcn_s_barrier(); asm volatile("" ::: "memory");
        const int row = wid * 32 + (lane & 31);
        if (lane < 32) { const float s = (P[row * 4 + 0] + P[row * 4 + 1]) + (P[row * 4 + 2] + P[row * 4 + 3]);
            __hip_atomic_store(xbuf + ((size_t)rt * 256 + row) * 4 + ct, s, __ATOMIC_RELAXED, __HIP_MEMORY_SCOPE_AGENT); }
        asm volatile("s_waitcnt vmcnt(0)" ::: "memory");
        if (lane == 0) __hip_atomic_fetch_add(cnt + 64 * rt, 1u, __ATOMIC_RELAXED, __HIP_MEMORY_SCOPE_AGENT);
        if (wid == 0) { unsigned sp = 0;
            while ((unsigned)__builtin_amdgcn_readfirstlane(__hip_atomic_load(cnt + 64 * rt, __ATOMIC_RELAXED, __HIP_MEMORY_SCOPE_AGENT)) < 32u) { __builtin_amdgcn_s_sleep(2); if (++sp > (1u << 22)) break; }
            __builtin_amdgcn_fence(__ATOMIC_ACQUIRE, "agent");
            if (lane == 0) flag[0] = 1u; }
        asm volatile("s_waitcnt vmcnt(0) lgkmcnt(0)" ::: "memory"); __builtin_amdgcn_s_barrier(); asm volatile("" ::: "memory");
        if (lane < 32) { const float* sl = xbuf + ((size_t)rt * 256 + row) * 4; float t = 0.f;
#pragma unroll
            for (int k = 0; k < 4; ++k) t += __hip_atomic_load(sl + k, __ATOMIC_RELAXED, __HIP_MEMORY_SCOPE_AGENT);
            S[row] = 1.f / sqrtf(t * (1.f / 1024.f) + EPS); }
        asm volatile("s_waitcnt vmcnt(0) lgkmcnt(0)" ::: "memory"); __builtin_amdgcn_s_barrier(); asm volatile("" ::: "memory");
        f32x4 gv[2][2];
#pragma unroll
        for (int bj = 0; bj < 2; ++bj)
#pragma unroll
            for (int n = 0; n < 2; ++n) gv[bj][n] = *(const f32x4*)(gfin + colb + bj * 128 + n * 4);
#pragma unroll
        for (int ai = 0; ai < 2; ++ai)
#pragma unroll
            for (int m = 0; m < 4; ++m) { const int lr = lrb + ai * 128 + m * 16, tok = rowtok[u.idx * 256 + lr]; const float rs = S[lr];
                if (tok >= 0) { float* p = out + (size_t)tok * 1024 + colb;
#pragma unroll
                    for (int bj = 0; bj < 2; ++bj)
#pragma unroll
                        for (int n = 0; n < 2; ++n) *(f32x4*)(p + bj * 128 + n * 4) = acc[ai][bj][m][n] * rs * gv[bj][n]; } }
        asm volatile("s_waitcnt lgkmcnt(0)" ::: "memory"); __builtin_amdgcn_s_barrier(); asm volatile("" ::: "memory");
    }
};
struct MoeOrder {
    const char* A; const char* B; const volatile LAS int* tstart; volatile LAS int* rowtok; int nct, up, G, c;
    __device__ __forceinline__ void locate(int L, int& rt, int& ct, int& cls) const {
        rt = L / nct; ct = L % nct; cls = 0;
        for (int k = 1; k < NCLS; ++k) cls += (rt >= __builtin_amdgcn_readfirstlane(tstart[k])) ? 1 : 0;
    }
    __device__ bool next(int i, Unit& u) const {
        const int L = i * G + c; const int ntile = __builtin_amdgcn_readfirstlane(tstart[NCLS]);
        if (L >= ntile * nct) return false;
        int rt, ct, cls; locate(L, rt, ct, cls);
        const int g = cls / 6, p = cls % 6, pa = p < 3 ? 0 : (p < 5 ? 1 : 2), pb = p == 0 ? 1 : (p == 1 ? 2 : (p == 2 ? 3 : (p == 3 ? 2 : 3)));
        u.row0 = rt * 256; u.tag = ct; u.idx = i;
        if (up) { const int e = 4 * g + (ct < 4 ? pa : pb); u.a = A; u.b = B + ((size_t)e * 1024 + (ct & 3) * 256) * 1024 * 2; u.col0 = ct * 128; }
        else { u.a = A + (size_t)rt * 256 * 1024 * 2; u.b = B + ((size_t)cls * 1024 + ct * 256) * 1024 * 2; u.col0 = ct * 256; }
        return true;
    }
    __device__ __forceinline__ int arow(int ui, int r) const { const int t = rowtok[ui * 256 + r]; return t < 0 ? 0 : t; }
    __device__ __forceinline__ void build(const int* perm, int tid) const {
        const int ntile = tstart[NCLS];
        for (int i = 0; i * G + c < ntile * nct; ++i) { int rt, ct, cls; locate(i * G + c, rt, ct, cls);
            for (int r = tid; r < 256; r += NTHR) { const int idx = (rt - tstart[cls]) * 256 + r; rowtok[i * 256 + r] = idx < tstart[32 + cls] ? perm[(size_t)cls * T + idx] : -1; } }
        __syncthreads();
    }
    __device__ __forceinline__ void a_ready(const Unit&) const {}
    __device__ __forceinline__ void done(const Unit&) const {}
};

typedef float f32x16 __attribute__((ext_vector_type(16)));
typedef short s16x4 __attribute__((ext_vector_type(4)));
typedef float f32x2_t __attribute__((ext_vector_type(2))); typedef __bf16 bf16x2_t __attribute__((ext_vector_type(2)));
__device__ __forceinline__ unsigned cvtpk_s(float lo, float hi) { f32x2_t v = {lo, hi}; bf16x2_t b = __builtin_convertvector(v, bf16x2_t); return __builtin_bit_cast(unsigned, b); }
__device__ __forceinline__ s16x4 vtr(const LAS unsigned char* p) { return __builtin_bit_cast(s16x4, __builtin_amdgcn_ds_read_tr16_b64_v4i16((LAS s16x4*)p)); }
__device__ __forceinline__ int crow(int r, int hi) { return (r & 3) + 8 * (r >> 2) + 4 * hi; }
#define MFMA32(a, b, c) __builtin_amdgcn_mfma_f32_32x32x16_bf16((a), (b), (c), 0, 0, 0)
__device__ __forceinline__ bf16x8 packfrag(const f32x16& p, int s) {
    v4u w; w.x = cvtpk_s(p[8 * s], p[8 * s + 1]); w.y = cvtpk_s(p[8 * s + 2], p[8 * s + 3]); w.z = cvtpk_s(p[8 * s + 4], p[8 * s + 5]); w.w = cvtpk_s(p[8 * s + 6], p[8 * s + 7]);
    return __builtin_bit_cast(bf16x8, w);
}
__device__ __forceinline__ bf16x8 vfrag(const LAS unsigned char* p, int rowbytes) {
    const s16x4 lo = vtr(p), hi_ = vtr(p + 8 * rowbytes);
    return (bf16x8){lo[0], lo[1], lo[2], lo[3], hi_[0], hi_[1], hi_[2], hi_[3]};
}
__device__ __forceinline__ void glds16(const void* gsrc, unsigned lds_dst) { unsigned keep;
    asm volatile("s_mov_b32 %0, m0\n\ts_mov_b32 m0, %2\n\ts_nop 0\n\tglobal_load_lds_dwordx4 %1, off\n\ts_mov_b32 m0, %0" : "=&s"(keep) : "v"(gsrc), "s"(lds_dst) : "memory"); }
#define WAIT_BAR(N) asm volatile("s_waitcnt vmcnt(" #N ") lgkmcnt(0)\n\ts_barrier" ::: "memory")
constexpr float SB_THR2 = -40.f;

template <bool MASK>
__device__ __forceinline__ void sb_tile(const LAS unsigned char* Kt, const LAS unsigned char* Vt, const bf16x8 (&qf)[4], const bf16x8 tri0, const bf16x8 tri1, const bf16x8 ones,
                                        f32x16& o0, f32x16& o1, float& R, int kt, int t, int hi, int kbase, int kx, int v0, int v1) {
    f32x16 p0 = {}, p1 = {};
#pragma unroll
    for (int ks = 0; ks < 4; ++ks) {
        const int co = kbase + (((2 * ks + hi) ^ kx) << 4);
        const bf16x8 a0 = *(const LAS bf16x8*)(Kt + co), a1 = *(const LAS bf16x8*)(Kt + 4096 + co);
        p0 = MFMA32(a0, qf[ks], p0); p1 = MFMA32(a1, qf[ks], p1);
    }
    f32x16 l0, l1; float cs = 0.f;
#pragma unroll
    for (int r = 0; r < 16; ++r) {
        const float z0 = p0[r], z1 = p1[r];
        float k0 = -(fmaxf(z0, 0.f) + __builtin_amdgcn_logf(1.f + __builtin_amdgcn_exp2f(-fabsf(z0))));
        float k1 = -(fmaxf(z1, 0.f) + __builtin_amdgcn_logf(1.f + __builtin_amdgcn_exp2f(-fabsf(z1))));
        if (MASK) { const int key = kt * 64 + crow(r, hi); k0 = key < t ? k0 : 0.f; k1 = key + 32 < t ? k1 : 0.f; }
        l0[r] = k0; l1[r] = k1; cs += k0 + k1;
    }
    cs += __shfl_xor(cs, 32);
    const bf16x8 lb00 = packfrag(l0, 0), lb01 = packfrag(l0, 1), lb10 = packfrag(l1, 0), lb11 = packfrag(l1, 1);
    f32x16 y0 = {}, y1 = {};
    y0 = MFMA32(tri0, lb00, y0); y0 = MFMA32(tri1, lb01, y0); y0 = MFMA32(ones, lb10, y0); y0 = MFMA32(ones, lb11, y0);
    y1 = MFMA32(tri0, lb10, y1); y1 = MFMA32(tri1, lb11, y1);
#pragma unroll
    for (int r = 0; r < 16; ++r) {
        float w0 = __builtin_amdgcn_exp2f(p0[r] + y0[r] + R), w1 = __builtin_amdgcn_exp2f(p1[r] + y1[r] + R);
        if (MASK) { const int key = kt * 64 + crow(r, hi); w0 = key < t ? w0 : 0.f; w1 = key + 32 < t ? w1 : 0.f; }
        p0[r] = w0; p1[r] = w1;
    }
    R += cs;
    const bf16x8 wb00 = packfrag(p0, 0), wb01 = packfrag(p0, 1), wb10 = packfrag(p1, 0), wb11 = packfrag(p1, 1);
    o0 = MFMA32(vfrag(Vt + 0 * 2048 + v0, 128), wb00, o0); o1 = MFMA32(vfrag(Vt + 0 * 2048 + v1, 128), wb00, o1);
    o0 = MFMA32(vfrag(Vt + 1 * 2048 + v0, 128), wb01, o0); o1 = MFMA32(vfrag(Vt + 1 * 2048 + v1, 128), wb01, o1);
    o0 = MFMA32(vfrag(Vt + 2 * 2048 + v0, 128), wb10, o0); o1 = MFMA32(vfrag(Vt + 2 * 2048 + v1, 128), wb10, o1);
    o0 = MFMA32(vfrag(Vt + 3 * 2048 + v0, 128), wb11, o0); o1 = MFMA32(vfrag(Vt + 3 * 2048 + v1, 128), wb11, o1);
}
__device__ __forceinline__ void unit_map(int u, int G, int& bh, int& qb) {
    if (G == 256) { const int bx = u & 255, i = u >> 8, xcd = bx & 7, slot = bx >> 3, gi = slot >> 2, j = slot & 3;
        bh = (xcd * 8 + gi) * 2 + (i >> 1); qb = (i & 1) ? 7 - j : j; }
    else { bh = u >> 3; qb = u & 7; }
}
__device__ __forceinline__ void sb_phase(const bf16* Q, const bf16* Kg, const bf16* Vg, bf16* O, LAS unsigned char* lds, int bx, int G, int tid, int wave, int lane, bool nostore = false) {
    const int r32 = lane & 31, hi = lane >> 5;
    bf16x8 tri0, tri1, ones;
#pragma unroll
    for (int j = 0; j < 8; ++j) { const int kk = 8 * (j >> 2) + 4 * hi + (j & 3); tri0[j] = kk >= r32 ? (short)0x3F80 : (short)0; tri1[j] = 16 + kk >= r32 ? (short)0x3F80 : (short)0; ones[j] = (short)0x3F80; }
    const int skey = wave * 8 + (lane >> 3), sc = (lane & 7) ^ (lane >> 3), svc = (lane & 7) ^ (((lane >> 4) & 1) << 2);
    const unsigned lds0 = (unsigned)(size_t)lds + (unsigned)wave * 1024u;
#define SB_STAGE(kt_, st_) do { const unsigned d_ = (unsigned)__builtin_amdgcn_readfirstlane(lds0 + (unsigned)(st_) * 16384u); \
        glds16(Kg + (rbase + (size_t)(kt_) * 64 + skey) * 512 + h * 64 + sc * 8, d_); glds16(Vg + (rbase + (size_t)(kt_) * 64 + skey) * 512 + h * 64 + svc * 8, d_ + 8192u); } while (0)
    const int kbase = r32 * 128, kx = r32 & 7;
    const int q4 = (lane & 15) >> 2, v0 = ((4 * hi + q4) * 128 + 32 * ((lane >> 4) & 1) + 8 * (lane & 3)) ^ (((q4 >> 1) & 1) << 6), v1 = v0 ^ 64;
    volatile LAS int* flags = (volatile LAS int*)(lds + 49152);
    for (int u = bx; u < 1024; u += G) {
        const int bh = u >> 3, qb = u & 7;
        const int b = bh >> 3, h = bh & 7, q0w = qb * 256 + 32 * wave, my_kt = q0w >> 6, kt_hi = qb * 4 + 3, t = q0w + r32;
        const size_t rbase = (size_t)b * SEQ;
        SB_STAGE(kt_hi, 0);
        if (kt_hi > 0) SB_STAGE(kt_hi - 1, 1);
        bf16x8 qf[4];
#pragma unroll
        for (int ks = 0; ks < 4; ++ks) qf[ks] = *(const bf16x8*)(Q + (rbase + t) * 512 + h * 64 + 16 * ks + 8 * hi);
        f32x16 o0 = {}, o1 = {}; float R = 0.f;
        if (kt_hi > 0) WAIT_BAR(2); else WAIT_BAR(0);
        bool mydone = false; int st = 0, it = 0;
        for (int kt = kt_hi; kt >= 0; --kt, ++it) {
            int st2 = st + 2; if (st2 >= 3) st2 -= 3;
            if (kt >= 2) SB_STAGE(kt - 2, st2);
            if (kt <= my_kt && !mydone) {
                const LAS unsigned char* Kt = lds + st * 16384; const LAS unsigned char* Vt = Kt + 8192;
                if (kt == my_kt) sb_tile<true>(Kt, Vt, qf, tri0, tri1, ones, o0, o1, R, kt, t, hi, kbase, kx, v0, v1);
                else sb_tile<false>(Kt, Vt, qf, tri0, tri1, ones, o0, o1, R, kt, t, hi, kbase, kx, v0, v1);
                mydone = __all(R < SB_THR2) != 0;
            }
            if (lane == 0) flags[(it & 1) * 8 + wave] = mydone ? 1 : 0;
            if (kt >= 2) WAIT_BAR(2); else WAIT_BAR(0);
            int alld = 1;
#pragma unroll
            for (int w = 0; w < 8; ++w) alld &= flags[(it & 1) * 8 + w];
            if (alld) break;
            st = st + 1; if (st >= 3) st = 0;
        }
        { LAS unsigned char* ep = lds + 53248 + wave * 4608;
#pragma unroll
          for (int g4 = 0; g4 < 4; ++g4) {
            *(LAS unsigned long long*)(ep + r32 * 144 + (8 * g4 + 4 * hi) * 2) = (unsigned long long)cvtpk_s(o0[4 * g4], o0[4 * g4 + 1]) | ((unsigned long long)cvtpk_s(o0[4 * g4 + 2], o0[4 * g4 + 3]) << 32);
            *(LAS unsigned long long*)(ep + r32 * 144 + (32 + 8 * g4 + 4 * hi) * 2) = (unsigned long long)cvtpk_s(o1[4 * g4], o1[4 * g4 + 1]) | ((unsigned long long)cvtpk_s(o1[4 * g4 + 2], o1[4 * g4 + 3]) << 32); }
#pragma unroll
          for (int i = 0; i < 4; ++i) { const int row = (lane >> 3) + 8 * i;
            const v4u ov = *(const LAS v4u*)(ep + row * 144 + (lane & 7) * 16); if (!nostore) *(v4u*)(O + (rbase + q0w + row) * 512 + h * 64 + (lane & 7) * 8) = ov; else asm volatile("" :: "v"(ov)); } }
        WAIT_BAR(0);
    }
#undef SB_STAGE
}
template <bool EDGE>
__device__ __forceinline__ void ret_tile(const LAS unsigned char* Kt, const LAS unsigned char* Vt, const bf16x8 (&qf)[4], f32x16 (&o)[4], float lg2, int kt, int my_kt, int n, int hi, int kbase, int kx, int vb) {
    f32x16 p0 = {}, p1 = {};
#pragma unroll
    for (int ks = 0; ks < 4; ++ks) {
        const int co = kbase + (((2 * ks + hi) ^ kx) << 4);
        const bf16x8 a0 = *(const LAS bf16x8*)(Kt + co), a1 = *(const LAS bf16x8*)(Kt + 4096 + co);
        p0 = MFMA32(a0, qf[ks], p0); p1 = MFMA32(a1, qf[ks], p1);
    }
    const int e_off = n - 64 * (kt + 1);
    if (EDGE) {
        const bool diag = kt == my_kt; float fnn = (float)(n & 63); asm volatile("" : "+v"(fnn));
        const float base = diag ? fnn - 64.f : (float)e_off, two = diag ? 2.f : 0.f, h4 = (float)(4 * hi);
#pragma unroll
        for (int r = 0; r < 16; ++r) {
            const float m0 = (float)((r & 3) + 8 * (r >> 2)) + h4;
            p0[r] *= __builtin_amdgcn_exp2f(lg2 * (base + two * fmaxf(m0 - fnn, 0.f))); p1[r] *= __builtin_amdgcn_exp2f(lg2 * (base + two * fmaxf(m0 + 32.f - fnn, 0.f)));
            if ((r & 3) == 3) __builtin_amdgcn_sched_barrier(0);
        }
    } else {
        const float f = __builtin_amdgcn_exp2f(lg2 * (float)e_off);
#pragma unroll
        for (int r = 0; r < 16; ++r) { p0[r] *= f; p1[r] *= f; }
    }
    const bf16x8 wb00 = packfrag(p0, 0), wb01 = packfrag(p0, 1), wb10 = packfrag(p1, 0), wb11 = packfrag(p1, 1);
#pragma unroll
    for (int dt = 0; dt < 4; ++dt) { const LAS unsigned char* vp = Vt + (vb ^ (dt << 6));
        o[dt] = MFMA32(vfrag(vp + 0 * 4096, 256), wb00, o[dt]); o[dt] = MFMA32(vfrag(vp + 1 * 4096, 256), wb01, o[dt]);
        o[dt] = MFMA32(vfrag(vp + 2 * 4096, 256), wb10, o[dt]); o[dt] = MFMA32(vfrag(vp + 3 * 4096, 256), wb11, o[dt]); }
}
__device__ __forceinline__ void kv_chain(const bf16* Kg, const bf16* Vg, bf16* STg, LAS unsigned char* lds, int bh0, int bhs, int tid, int wave, int lane) {
    const int r32 = lane & 31, hi = lane >> 5, q4 = (lane & 15) >> 2, g1 = (lane >> 4) & 1, p = lane & 3, dh = wave >> 2, eq = wave & 3;
    const int skey = wave * 8 + (lane >> 3), sc = (lane & 7) ^ (lane >> 3);
    const int vkey = wave * 8 + (lane >> 4), vc = (lane & 15) ^ (((lane >> 4) & 3) << 2);
    const unsigned ldsk = (unsigned)(size_t)lds + (unsigned)wave * 1024u, ldsv = (unsigned)(size_t)lds + 8192u + (unsigned)wave * 2048u;
#define RET_STAGE(kt_, st_) do { const unsigned so_ = (unsigned)(st_) * 24576u; \
        glds16(Kg + (rbase + (size_t)(kt_) * 64 + skey) * 512 + h * 64 + sc * 8, (unsigned)__builtin_amdgcn_readfirstlane(ldsk + so_)); \
        glds16(Vg + (rbase + (size_t)(kt_) * 64 + vkey) * 1024 + h * 128 + vc * 8, (unsigned)__builtin_amdgcn_readfirstlane(ldsv + so_)); \
        glds16(Vg + (rbase + (size_t)(kt_) * 64 + vkey + 4) * 1024 + h * 128 + vc * 8, (unsigned)__builtin_amdgcn_readfirstlane(ldsv + so_ + 1024u)); } while (0)
    int aoff[2], boff[2];
#pragma unroll
    for (int e = 0; e < 2; ++e) { const int m = 8 * hi + q4 + 4 * e;
        aoff[e] = m * 128 + (((4 * dh + 2 * g1 + (p >> 1)) ^ (m & 7)) << 4) + (p & 1) * 8;
        boff[e] = m * 256 + ((64 * eq + 32 * g1 + 8 * p) ^ ((m & 3) << 6)); }
    for (int bh = bh0; bh < 128; bh += bhs) {
        const int b = bh >> 3, h = bh & 7;
        const size_t rbase = (size_t)b * SEQ;
        const float lg2 = log2f(1.f - exp2f(-5.f - (float)h)), g64 = exp2f(64.f * lg2), g256 = exp2f(256.f * lg2), ginv = exp2f(-lg2);
        RET_STAGE(0, 0); RET_STAGE(1, 1);
        f32x16 S = {}, kv = {};
        WAIT_BAR(3);
        int st = 0;
        for (int kt = 0; kt < 28; ++kt) {
            int st2 = st + 2; if (st2 >= 3) st2 -= 3;
            if (kt + 2 < 28) RET_STAGE(kt + 2, st2);
            const LAS unsigned char* Kt = lds + st * 24576; const LAS unsigned char* Vt = Kt + 8192;
#pragma unroll
            for (int r = 0; r < 16; ++r) kv[r] *= g64;
#pragma unroll
            for (int ks = 0; ks < 4; ++ks) {
                const s16x4 a0 = vtr(Kt + aoff[0] + ks * 2048), a1 = vtr(Kt + aoff[1] + ks * 2048), b0 = vtr(Vt + boff[0] + ks * 4096), b1 = vtr(Vt + boff[1] + ks * 4096);
                kv = MFMA32(((bf16x8){a0[0], a0[1], a0[2], a0[3], a1[0], a1[1], a1[2], a1[3]}), ((bf16x8){b0[0], b0[1], b0[2], b0[3], b1[0], b1[1], b1[2], b1[3]}), kv);
            }
            if ((kt & 3) == 3) {
                bf16* sp = STg + ((size_t)(bh * 8 + (kt >> 2) + 1) * 64 + 32 * dh) * 128 + 32 * eq + r32;
#pragma unroll
                for (int r = 0; r < 16; ++r) { S[r] = S[r] * g256 + kv[r] * ginv; kv[r] = 0.f; sp[crow(r, hi) * 128] = (bf16)(cvtpk_s(S[r], 0.f) & 0xffffu); }
            }
            if (kt + 2 < 28) WAIT_BAR(3); else WAIT_BAR(0);
            st = st + 1; if (st >= 3) st = 0;
        }
    }
#undef RET_STAGE
}
__device__ __forceinline__ void ret_phase(const bf16* Q, const bf16* Kg, const bf16* Vg, const bf16* RG, const float* gn, const bf16* STg, bf16* Y, LAS unsigned char* lds, int bx, int G, int tid, int wave, int lane) {
    const int r32 = lane & 31, hi = lane >> 5;
    const int skey = wave * 8 + (lane >> 3), sc = (lane & 7) ^ (lane >> 3);
    const int vkey = wave * 8 + (lane >> 4), vc = (lane & 15) ^ (((lane >> 4) & 3) << 2);
    const unsigned ldsk = (unsigned)(size_t)lds + (unsigned)wave * 1024u, ldsv = (unsigned)(size_t)lds + 8192u + (unsigned)wave * 2048u, ldss = (unsigned)(size_t)lds + 73728u + (unsigned)wave * 2048u;
#define RET_STAGE(kt_, st_) do { const unsigned so_ = (unsigned)(st_) * 24576u; \
        glds16(Kg + (rbase + (size_t)(kt_) * 64 + skey) * 512 + h * 64 + sc * 8, (unsigned)__builtin_amdgcn_readfirstlane(ldsk + so_)); \
        glds16(Vg + (rbase + (size_t)(kt_) * 64 + vkey) * 1024 + h * 128 + vc * 8, (unsigned)__builtin_amdgcn_readfirstlane(ldsv + so_)); \
        glds16(Vg + (rbase + (size_t)(kt_) * 64 + vkey + 4) * 1024 + h * 128 + vc * 8, (unsigned)__builtin_amdgcn_readfirstlane(ldsv + so_ + 1024u)); } while (0)
#define RET_STAGES(qb_) do { const bf16* s_ = STg + ((size_t)(bh * 8 + (qb_)) * 64 + vkey) * 128 + vc * 8; \
        glds16(s_, (unsigned)__builtin_amdgcn_readfirstlane(ldss)); glds16(s_ + 4 * 128, (unsigned)__builtin_amdgcn_readfirstlane(ldss + 1024u)); } while (0)
    const int kbase = r32 * 128, kx = r32 & 7;
    const int q4 = (lane & 15) >> 2, vb = ((4 * hi + q4) * 256 + 32 * ((lane >> 4) & 1) + 8 * (lane & 3)) ^ (q4 << 6);
    const int sb_ = ((8 * hi + q4) * 256 + 32 * ((lane >> 4) & 1) + 8 * (lane & 3)) ^ (q4 << 6);
    const LAS unsigned char* St = lds + 73728;
    LAS unsigned char* ep = lds + 90112 + wave * 4608;
    const int nper = (2 * 128 + G - 1) / G;
    for (int it = bx * nper; it < (bx + 1) * nper && it < 256; ++it) {
        const int bh = it >> 1, qb0 = 4 * (it & 1), b = bh >> 3, h = bh & 7, kt_end = 4 * qb0 + 15;
        const size_t rbase = (size_t)b * SEQ;
        const float lg2 = log2f(1.f - exp2f(-5.f - (float)h));
        if (qb0 > 0) RET_STAGES(qb0);
        RET_STAGE(4 * qb0, 0); RET_STAGE(4 * qb0 + 1, 1);
        int st = 0;
        WAIT_BAR(3);
        for (int qb = qb0; qb < qb0 + 4; ++qb) {
            const int q0w = qb * 256 + 32 * wave, my_kt = q0w >> 6, n = q0w + r32;
            bf16x8 qf[4];
#pragma unroll
            for (int ks = 0; ks < 4; ++ks) qf[ks] = *(const bf16x8*)(Q + (rbase + n) * 512 + h * 64 + 16 * ks + 8 * hi);
            f32x16 o[4] = {{}, {}, {}, {}};
            if (qb > 0) {
#pragma unroll
                for (int ks = 0; ks < 4; ++ks) {
#pragma unroll
                    for (int dt = 0; dt < 4; ++dt) { const LAS unsigned char* sp = St + (sb_ ^ (dt << 6)) + ks * 4096;
                        const s16x4 a0 = vtr(sp), a1 = vtr(sp + 4 * 256);
                        o[dt] = MFMA32(((bf16x8){a0[0], a0[1], a0[2], a0[3], a1[0], a1[1], a1[2], a1[3]}), qf[ks], o[dt]); }
                    __builtin_amdgcn_sched_barrier(0);
                }
                const float qs = exp2f(lg2 * (float)(32 * wave + r32 + 1));
#pragma unroll
                for (int dt = 0; dt < 4; ++dt)
#pragma unroll
                    for (int r = 0; r < 16; ++r) o[dt][r] *= qs;
            }
#define RET_STEP(BODY) do { const int kt = 4 * qb + t; \
                int st2 = st + 2; if (st2 >= 3) st2 -= 3; \
                if (t == 3 && qb + 1 < qb0 + 4) RET_STAGES(qb + 1);     \
                if (kt + 2 <= kt_end) RET_STAGE(kt + 2, st2); \
                BODY; \
                if (kt + 2 <= kt_end) WAIT_BAR(3); else WAIT_BAR(0); \
                st = st + 1; if (st >= 3) st = 0; } while (0)
            { const int cw = wave >> 1; int t = 0;
              for (; t < cw; ++t) RET_STEP(ret_tile<false>(lds + st * 24576, lds + st * 24576 + 8192, qf, o, lg2, kt, my_kt, n, hi, kbase, kx, vb));
              RET_STEP(ret_tile<true>(lds + st * 24576, lds + st * 24576 + 8192, qf, o, lg2, kt, my_kt, n, hi, kbase, kx, vb)); ++t;
              for (; t < 4; ++t) RET_STEP((void)0); }
#undef RET_STEP
            float ss = 0.f;
#pragma unroll
            for (int dt = 0; dt < 4; ++dt)
#pragma unroll
                for (int r = 0; r < 16; ++r) ss += o[dt][r] * o[dt][r];
            ss += __shfl_xor(ss, 32);
            const float rstd = 1.f / sqrtf(ss * (1.f / 128.f) + EPS);
#pragma unroll
            for (int half = 0; half < 2; ++half) {
#pragma unroll
                for (int dtl = 0; dtl < 2; ++dtl)
#pragma unroll
                    for (int g4 = 0; g4 < 4; ++g4) { const f32x16& od = o[2 * half + dtl];
                        *(LAS unsigned long long*)(ep + r32 * 144 + (32 * dtl + 8 * g4 + 4 * hi) * 2) =
                            (unsigned long long)cvtpk_s(od[4 * g4] * rstd, od[4 * g4 + 1] * rstd) | ((unsigned long long)cvtpk_s(od[4 * g4 + 2] * rstd, od[4 * g4 + 3] * rstd) << 32); }
#pragma unroll
                for (int i = 0; i < 4; ++i) { const int row = (lane >> 3) + 8 * i, e = 64 * half + (lane & 7) * 8;
                    const v4u y = *(const LAS v4u*)(ep + row * 144 + (lane & 7) * 16);
                    const size_t go = (rbase + q0w + row) * 1024 + h * 128 + e;
                    const v4u rg = *(const v4u*)(RG + go); const f32x4 g0 = *(const f32x4*)(gn + h * 128 + e), g1 = *(const f32x4*)(gn + h * 128 + e + 4);
                    f32x4 v0, v1;
                    v0[0] = bflo(y.x) * g0[0] * bflo(rg.x); v0[1] = bfhi(y.x) * g0[1] * bfhi(rg.x); v0[2] = bflo(y.y) * g0[2] * bflo(rg.y); v0[3] = bfhi(y.y) * g0[3] * bfhi(rg.y);
                    v1[0] = bflo(y.z) * g1[0] * bflo(rg.z); v1[1] = bfhi(y.z) * g1[1] * bfhi(rg.z); v1[2] = bflo(y.w) * g1[2] * bflo(rg.w); v1[3] = bfhi(y.w) * g1[3] * bfhi(rg.w);
                    *(v4u*)(Y + go) = pack8(v0, v1); }
            }
        }
    }
#undef RET_STAGE
#undef RET_STAGES
}

__device__ __forceinline__ void p_route(const Args& a, LAS unsigned char* lds, int vcu, int G, int wave, int lane, int tid) {
    const float* h = a.out; const bf16* wrt = (const bf16*)(a.ws + WS_WRT); const float* bg = a.in[11]; const float* be = a.in[13];
    TokInfo* tinfo = (TokInfo*)(a.ws + (a.rep ? WS_PROBE : WS_TOK)); int* perm = (int*)(a.ws + (a.rep ? WS_PROBE + 4 * MiB : WS_PERM));
    unsigned* cnt = (unsigned*)(a.ws + WS_CTL) + (a.rep ? CW_CNT + 4096 : CW_CNT);
    const int r32 = lane & 31, hi = lane >> 5, kh = wave & 1, pair = wave >> 1;
    LAS float* xch = (LAS float*)lds + pair * 64 * 17;
    const int ntask = T / 32, tstride = G * 4, nround = (ntask + tstride - 1) / tstride;
    for (int rd = 0; rd < nround; ++rd) {
        const int task = rd * tstride + vcu * 4 + pair; const bool valid = task < ntask;
        const int t0 = (valid ? task : 0) * 32;
        const float* xp = h + (size_t)(t0 + r32) * DM + kh * 512 + 8 * hi;
        const bf16* ahp = wrt + r32 * 1024 + kh * 512 + 8 * hi;
        f32x16 acc = {}; float ss = 0.f;
#pragma unroll 4
        for (int ks = 0; ks < 32; ++ks) {
            const f32x4 x0 = *(const f32x4*)(xp + 16 * ks), x1 = *(const f32x4*)(xp + 16 * ks + 4);
            ss += (x0[0] * x0[0] + x0[1] * x0[1]) + (x0[2] * x0[2] + x0[3] * x0[3]) + (x1[0] * x1[0] + x1[1] * x1[1]) + (x1[2] * x1[2] + x1[3] * x1[3]);
            v4u wh, wl;
            wh.x = cvtpk_s(x0[0], x0[1]); wh.y = cvtpk_s(x0[2], x0[3]); wh.z = cvtpk_s(x1[0], x1[1]); wh.w = cvtpk_s(x1[2], x1[3]);
            wl.x = cvtpk_s(x0[0] - bflo(wh.x), x0[1] - bfhi(wh.x)); wl.y = cvtpk_s(x0[2] - bflo(wh.y), x0[3] - bfhi(wh.y));
            wl.z = cvtpk_s(x1[0] - bflo(wh.z), x1[1] - bfhi(wh.z)); wl.w = cvtpk_s(x1[2] - bflo(wh.w), x1[3] - bfhi(wh.w));
            const bf16x8 bh_ = __builtin_bit_cast(bf16x8, wh), bl_ = __builtin_bit_cast(bf16x8, wl);
            const bf16x8 ah = *(const bf16x8*)(ahp + 16 * ks), al = *(const bf16x8*)(ahp + 32 * 1024 + 16 * ks);
            acc = MFMA32(ah, bh_, acc); acc = MFMA32(ah, bl_, acc); acc = MFMA32(al, bh_, acc);
        }
        if (kh == 1) {
#pragma unroll
            for (int r = 0; r < 16; ++r) xch[lane * 17 + r] = acc[r];
            xch[lane * 17 + 16] = ss; }
        __syncthreads();
        if (kh == 0) {
#pragma unroll
            for (int r = 0; r < 16; ++r) acc[r] += xch[lane * 17 + r];
            ss += xch[lane * 17 + 16];
            ss += __shfl_xor(ss, 32);
            const float rstd = 1.f / sqrtf(ss * (1.f / DM) + EPS);
            float gl[4];
#pragma unroll
            for (int o = 0; o < 4; ++o) gl[o] = acc[o] * rstd + bg[o];
            int gi = 0; float gm = gl[0];
#pragma unroll
            for (int o = 1; o < 4; ++o) if (gl[o] > gm) { gm = gl[o]; gi = o; }
            float gs = 0.f;
#pragma unroll
            for (int o = 0; o < 4; ++o) gs += __expf(gl[o] - gm);
            const float pgrp = 1.f / gs;
            const bool owner = valid && (hi == (gi & 1));
            float el[4];
#pragma unroll
            for (int e = 0; e < 4; ++e) el[e] = ((gi >> 1) ? acc[8 + e] : acc[4 + e]) * rstd + be[4 * gi + e];
            int i1 = 0; float m1 = el[0];
#pragma unroll
            for (int e = 1; e < 4; ++e) if (el[e] > m1) { m1 = el[e]; i1 = e; }
            int i2 = -1; float m2 = -3.0e38f;
#pragma unroll
            for (int e = 0; e < 4; ++e) if (e != i1 && el[e] > m2) { m2 = el[e]; i2 = e; }
            const float s1 = 1.f / (1.f + __expf(m2 - m1)), g1 = s1 * pgrp, g2 = (1.f - s1) * pgrp;
            const int pa = i1 < i2 ? i1 : i2, pb = i1 < i2 ? i2 : i1;
            const float ga = i1 < i2 ? g1 : g2, gb = i1 < i2 ? g2 : g1;
            const int pidx = pa == 0 ? pb - 1 : (pa == 1 ? pb + 1 : 5);
            const int my_cls = owner ? gi * 6 + pidx : -1;
            int my_pos = 0;
            for (int c = 0; c < NCLS; ++c) {
                const unsigned long long mask = __ballot(my_cls == c);
                if (mask) { const int nn = __popcll(mask), leader = __ffsll((long long)mask) - 1; unsigned bse = 0;
                    if (lane == leader) bse = __hip_atomic_fetch_add(cnt + 64 * c, (unsigned)nn, __ATOMIC_RELAXED, __HIP_MEMORY_SCOPE_AGENT);
                    bse = __shfl(bse, leader);
                    if (my_cls == c) my_pos = (int)bse + __popcll(mask & ((1ull << lane) - 1ull)); }
            }
            if (owner) { const int t = t0 + r32; tinfo[t] = TokInfo{ga, gb, rstd, my_cls}; perm[(size_t)my_cls * T + my_pos] = t; }
        }
        __syncthreads();
    }
}
__device__ __forceinline__ void build_class_table(const Args& a, volatile LAS int* tab, int tid) {
    if (tid == 0) { const unsigned* cnt = (const unsigned*)(a.ws + WS_CTL) + CW_CNT; int acc_ = 0;
        for (int c = 0; c < NCLS; ++c) { tab[c] = acc_; const int n = (int)__hip_atomic_load(cnt + 64 * c, __ATOMIC_RELAXED, __HIP_MEMORY_SCOPE_AGENT); tab[32 + c] = n; acc_ += (n + 255) >> 8; }
        tab[NCLS] = acc_; }
    __syncthreads();
}
__device__ __forceinline__ void p_final(const Args& a, int vcu, int G, int wave, int lane) {
    float* h = a.out; const float* gf = a.in[17];
    const int gw = vcu * NWAVES + wave, NGW = G * NWAVES;
    f32x4 gv[4];
#pragma unroll
    for (int j = 0; j < 4; ++j) gv[j] = ((const f32x4*)gf)[lane + 64 * j];
    for (int t = gw; t < T; t += NGW) {
        GAS f32x4* xr = (GAS f32x4*)(h + (size_t)t * DM) + lane;
        f32x4 v[4]; float s = 0.f;
#pragma unroll
        for (int j = 0; j < 4; ++j) { v[j] = xr[64 * j]; s += (v[j].x * v[j].x + v[j].y * v[j].y) + (v[j].z * v[j].z + v[j].w * v[j].w); }
        const float rstd = 1.f / sqrtf(wave_sum(s) * (1.f / DM) + EPS);
#pragma unroll
        for (int j = 0; j < 4; ++j) xr[64 * j] = v[j] * rstd * gv[j];
    }
}

#ifndef PROBE_MASK
#define PROBE_MASK 0
#endif
#ifndef MK_ONE_LAUNCH
#if PROBE_MASK
#define MK_ONE_LAUNCH 0
#else
#define MK_ONE_LAUNCH 1
#endif
#endif
constexpr int NPHASE = 10;
__global__ void __launch_bounds__(NTHR, 2) fwd_kernel(Args args) {
    extern __shared__ __attribute__((aligned(16))) unsigned char lds_raw[];
    LAS unsigned char* lds = (LAS unsigned char*)lds_raw;
    volatile LAS unsigned* MISC = (volatile LAS unsigned*)(lds + MISC_OFF);
    volatile LAS int* tab = (volatile LAS int*)(lds + TAB_OFF);
    const int tid = threadIdx.x, lane = tid & 63, wave = __builtin_amdgcn_readfirstlane(tid >> 6);
    const int G = gridDim.x; const int bx = blockIdx.x; const int vcu = (G % 8 == 0) ? (bx % 8) * (G / 8) + bx / 8 : bx;
    unsigned char* ws = args.ws;
    for (int u = tid; u < (LDS_BYTES - LDSCTL_OFF) / 4; u += NTHR) ((LAS unsigned*)(lds + LDSCTL_OFF))[u] = 0u;
    __syncthreads();
    XcdBarrier bar; bar.bar = (unsigned*)(ws + WS_CTL) + CW_BAR; bar.x = 0; bar.st = nullptr;
    if (MK_ONE_LAUNCH) bar = xcd_barrier_post((unsigned*)(ws + WS_CTL) + CW_BAR, MISC + 8);
    const int lo = args.ph_lo, hi = args.ph_hi;
#define IN(k) (lo <= (k) && (k) < hi)
#define SEAM(k) do { if (MK_ONE_LAUNCH && IN(k) && IN((k) + 1)) xcd_barrier(bar); } while (0)
    bf16* W1 = (bf16*)(ws + WS_W1); bf16* XN = (bf16*)(ws + WS_R1); bf16* YRET = (bf16*)(ws + WS_R1); bf16* HIDS = (bf16*)(ws + WS_R1);
    bf16* SBQ = (bf16*)(ws + WS_SBQ); bf16* SBK = (bf16*)(ws + WS_SBK); bf16* SBV = (bf16*)(ws + WS_SBV); bf16* RQ = (bf16*)(ws + WS_RQ); bf16* RK = (bf16*)(ws + WS_RK);
    bf16* RV = (bf16*)(ws + WS_RV); bf16* RG = (bf16*)(ws + WS_RG); bf16* YSB = (bf16*)(ws + WS_YSB); bf16* GATES = (bf16*)args.out;
    bf16* TMP = (bf16*)(ws + WS_TMP); bf16* MIX = (bf16*)(ws + WS_MIX); bf16* HB = (bf16*)(ws + WS_HB);
    volatile LAS int* rowtok = (volatile LAS int*)(lds + 131072);

    if (IN(0)) { p0_prologue(args, lds, vcu, G, wave, lane); }
    SEAM(0);
    if (IN(1)) {
        pg8::StaticOrder S; S.init(XN, W1, T, N1, 1024, G, bx);
        Epi1 E{SBQ, SBK, SBV, RQ, RK, RV, RG, GATES, args.in[4], (const float*)(ws + WS_ROT), args.rep};
        pg8::gemm_phase<Epi1, pg8::StaticOrder, true, true>(lds, 1024, S, E);
    }
    SEAM(1);
    if (IN(2)) {
        const int nret = G >> 1;
#ifdef PROBE_ABL
        if (args.rep) { if (PROBE_ABL == 1) { if (bx < nret) kv_chain(RK, RV, (bf16*)(ws + WS_KV), lds, bx, nret, tid, wave, lane); }
                        else { sb_phase(SBQ, SBK, SBV, YSB, lds, bx, G, tid, wave, lane, true); } } else
#endif
        {
        if (bx < nret) kv_chain(RK, RV, (bf16*)(ws + WS_KV), lds, bx, nret, tid, wave, lane);
        if (G == 256) { for (int k = 0; k < (bx < nret ? 3 : 5); ++k) { const int u = bx < nret ? 8 * bx + k : 8 * (bx - nret) + 3 + k; sb_phase(SBQ, SBK, SBV, YSB, lds, u, 1 << 20, tid, wave, lane); } }
        else sb_phase(SBQ, SBK, SBV, YSB, lds, bx, G, tid, wave, lane);
        }
    }
    SEAM(2);
    if (IN(3)) { ret_phase(RQ, RK, RV, RG, args.in[7], (const bf16*)(ws + WS_KV), YRET, lds, bx, G, tid, wave, lane); }
    SEAM(3);
    if (IN(4)) {
        pg8::StaticOrder S; S.init(YSB, ws + WS_WSB, T, 1024, 512, G, bx);
        EpiMix<false> E{GATES, 0, nullptr, TMP};
        pg8::gemm_phase<EpiMix<false>, pg8::StaticOrder, true, true>(lds, 512, S, E);
    }
    SEAM(4);
    if (IN(5)) {
        pg8::StaticOrder S; S.init(YRET, ws + WS_WRET, T, 1024, 1024, G, bx);
        EpiMix<true> E{GATES, 1024, TMP, MIX};
        pg8::gemm_phase<EpiMix<true>, pg8::StaticOrder, true, true>(lds, 1024, S, E);
    }
    SEAM(5);
    if (IN(6)) {
        pg8::StaticOrder S; S.init(MIX, ws + WS_WOUT, T, 1024, 1024, G, bx);
        EpiOut E{args.in[0], args.out, HB};
        pg8::gemm_phase<EpiOut, pg8::StaticOrder, true, true>(lds, 1024, S, E);
    }
    SEAM(6);
    if (IN(7)) { p_route(args, lds, vcu, G, wave, lane, tid); }
    SEAM(7);
    if (IN(8)) {
        build_class_table(args, tab, tid);
        MoeOrder S{(const char*)HB, (const char*)(ws + WS_WUP), tab, rowtok, 8, 1, G, bx};
        S.build((const int*)(ws + WS_PERM), tid);
        EpiUp E{(const TokInfo*)(ws + WS_TOK), rowtok, HIDS};
        pg8::gemm_phase<EpiUp, MoeOrder, true, true, true>(lds, 1024, S, E);
    }
    SEAM(8);
    if (IN(9)) {
        build_class_table(args, tab, tid);
        MoeOrder S{(const char*)HIDS, (const char*)(ws + WS_WDN), tab, rowtok, 4, 0, G, bx};
        S.build((const int*)(ws + WS_PERM), tid);
        EpiDown E{rowtok, args.out, args.in[17], (float*)(ws + WS_XBUF), (unsigned*)(ws + WS_CTL) + CW_ROWT, lds + 131072 + 6144};
        pg8::gemm_phase<EpiDown, MoeOrder, true, true>(lds, 1024, S, E);
    }
#undef IN
#undef SEAM
}

extern "C" void kernel_launch(void* const* d_in, const int* in_sizes, int n_in, void* d_out, int out_size, void* d_ws, size_t ws_size, hipStream_t stream) {
    static int grid = 0;
    if (grid == 0) {
        if (n_in != 18 || in_sizes[0] != T * DM || out_size != T * DM || ws_size < WS_END) { fprintf(stderr, "kernel_launch: unexpected shapes (n_in %d, in0 %d, out %d, ws %zu < %zu)\n", n_in, n_in > 0 ? in_sizes[0] : -1, out_size, ws_size, (size_t)WS_END); grid = -1; return; }
        int dev = 0, cus = 0, per_cu = 0;
        if (hipGetDevice(&dev) != hipSuccess || hipDeviceGetAttribute(&cus, hipDeviceAttributeMultiprocessorCount, dev) != hipSuccess) { grid = -1; return; }
        if (hipFuncSetAttribute((const void*)fwd_kernel, hipFuncAttributeMaxDynamicSharedMemorySize, LDS_BYTES) != hipSuccess) { fprintf(stderr, "kernel_launch: hipFuncSetAttribute failed\n"); grid = -1; return; }
        if (hipOccupancyMaxActiveBlocksPerMultiprocessor(&per_cu, (const void*)fwd_kernel, NTHR, LDS_BYTES) != hipSuccess || per_cu < 1) fprintf(stderr, "kernel_launch: occupancy query reports %d\n", per_cu);
        (void)hipGetLastError();
        grid = cus;
    }
    if (grid < 0) return;
    hipMemsetAsync((char*)d_ws + WS_CTL, 0, CTL_ZERO_BYTES, stream);
    Args a{};
    for (int i = 0; i < 18; ++i) a.in[i] = (const float*)d_in[i];
    a.out = (float*)d_out; a.ws = (unsigned char*)d_ws;
#if MK_ONE_LAUNCH
    a.ph_lo = 0; a.ph_hi = NPHASE;
    hipLaunchKernelGGL(fwd_kernel, dim3(grid), dim3(NTHR), LDS_BYTES, stream, a);
#else
    for (int p = 0; p < NPHASE; ++p) for (int rep = 0; rep < ((PROBE_MASK >> p) & 1) + 1; ++rep) { a.ph_lo = p; a.ph_hi = p + 1; a.rep = rep; hipLaunchKernelGGL(fwd_kernel, dim3(grid), dim3(NTHR), LDS_BYTES, stream, a); }
#endif
}
```

```cpp
#include <hip/hip_runtime.h>
#include <cstdio>
#include <cstdint>
namespace pg8 {
#define PG8_LAS __attribute__((address_space(3)))
typedef unsigned short bf16_t;
typedef short bf16x8 __attribute__((ext_vector_type(8)));
typedef float f32x4 __attribute__((ext_vector_type(4)));
typedef unsigned u32x4 __attribute__((ext_vector_type(4)));
constexpr int BM = 256, BK = 64, HALF = 128, HTB = HALF * BK * 2  , STAGE_BYTES = 8 * HTB, NXCD = 8, WGM = 8;
__host__ __device__ __forceinline__ int lds_byte(int r, int c) { const int st = (r >> 4) * 2 + (c >> 5), rr = r & 15, cc = c & 31, ob = rr * 64 + cc * 2; return st * 1024 + (ob ^ (((ob >> 9) & 1) << 5)); }
__host__ __device__ __forceinline__ void stage_rc(int b, int& R, int& C) { const int st = b / 1024, sb = b % 1024, swz = sb ^ (((sb >> 9) & 1) << 5); R = (st >> 1) * 16 + swz / 64; C = (st & 1) * 32 + (swz % 64) / 2; }
__host__ __device__ __forceinline__ int perm32(int rho) { const int n = rho >> 4, i = rho & 15; return 8 * (i >> 2) + 4 * n + (i & 3); }

struct Unit { const char* a; const char* b; const char* a2; int row0, col0, tag, idx; };
struct StaticOrder {
    const char* A; const char* Bt; int K, nM, nN, nwg, G, c;
    __device__ void init(const void* A_, const void* Bt_, int M, int N, int K_, int G_, int c_) { A = (const char*)A_; Bt = (const char*)Bt_; K = K_; nM = M / BM; nN = N / BM; nwg = nM * nN; G = G_; c = c_; }
    __device__ bool next(int i, Unit& u) const {
        const long L = (long)i * G + c; if (L >= nwg) return false;
        int wgid = (int)L; { const int q = nwg / NXCD, r = nwg % NXCD, xcd = wgid % NXCD, off = wgid / NXCD; wgid = (xcd < r ? xcd * (q + 1) : r * (q + 1) + (xcd - r) * q) + off; }
        const int nig = WGM * nN, gid = wgid / nig, fm = gid * WGM, gsz = (nM - fm) < WGM ? (nM - fm) : WGM;
        const int pm = fm + ((wgid % nig) % gsz), pn = (wgid % nig) / gsz;
        u.a = A + (size_t)pm * BM * K * 2; u.a2 = nullptr; u.b = Bt + (size_t)pn * BM * K * 2; u.row0 = pm * BM; u.col0 = pn * BM; u.tag = pn; u.idx = i; return true;
    }
    __device__ __forceinline__ void a_ready(const Unit&) const {}
    __device__ __forceinline__ void done(const Unit&) const {}
};
__device__ __forceinline__ unsigned cvt_pk_bf16(float lo, float hi) { unsigned r; asm volatile("v_cvt_pk_bf16_f32 %0, %1, %2" : "=v"(r) : "v"(lo), "v"(hi)); return r; }
template <class Epi, class Sched, bool ALIGN_EPI = false, bool SP2 = false, bool GATHER = false, int KSPLIT = 0>
__device__ __forceinline__ void gemm_phase(PG8_LAS unsigned char* lds, const int K, const Sched& S, const Epi& E, const int ka1 = 0, const int ka2 = 0) {
    const int tid = threadIdx.x, wid = __builtin_amdgcn_readfirstlane(tid >> 6), lane = tid & 63, wr = wid >> 2, wc = wid & 3, fr = lane & 15, fq = lane >> 4;
    const int nt = K / BK;
    static_assert(!GATHER || SP2, "GATHER is implemented on the SP2 loop only");
    unsigned voffA[2], voffA1[2], voffB[2], voffAn[2] = {0u, 0u}, voffA1n[2] = {0u, 0u}; int Rr[2], Cc[2];
#pragma unroll
    for (int i = 0; i < 2; ++i) { int R, C; stage_rc(tid * 16 + i * 8192, R, C); const int Rb = Epi::PERM ? ((R & ~31) + perm32(R & 31)) : R; Rr[i] = R; Cc[i] = C;
        const int KA = KSPLIT ? ka1 : K;
        voffA[i] = (unsigned)(R * KA + C) * 2u; voffA1[i] = 0u; voffB[i] = (unsigned)(Rb * K + C) * 2u; }
    unsigned voffAs[2] = {0u, 0u};
    if constexpr (KSPLIT != 0) {
#pragma unroll
        for (int i = 0; i < 2; ++i) voffAs[i] = (unsigned)(Rr[i] * ka2 + Cc[i]) * 2u; }
    const size_t hs1 = GATHER ? 0 : (size_t)HALF * (KSPLIT ? ka1 : K) * 2, hs2 = (size_t)HALF * ka2 * 2;
#define PG8_AROWS(ui_, v0_, v1_) do { _Pragma("unroll") for (int i_ = 0; i_ < 2; ++i_) { \
        v0_[i_] = (unsigned)(S.arow((ui_), Rr[i_]) * K + Cc[i_]) * 2u; v1_[i_] = (unsigned)(S.arow((ui_), Rr[i_] + HALF) * K + Cc[i_]) * 2u; } } while (0)
    const size_t kstep = (size_t)(BK * 2);
    const size_t hstep = (size_t)HALF * K * 2;
    const size_t tstep = 2 * hstep;
    const unsigned ldsw = (unsigned)wid * 1024u;
    const int aoff = lds_byte(wr * 64 + fr, fq * 8), boff = lds_byte(wc * 32 + fr, fq * 8);
#define PG8_SA(b, h) (((b) * 2 + (h)) * HTB)
#define PG8_SB(b, h) ((4 + (b) * 2 + (h)) * HTB)
#define PG8_STAGE(bufoff, gbase, voff) do { _Pragma("unroll") for (int _i = 0; _i < 2; ++_i) \
        __builtin_amdgcn_global_load_lds((const unsigned*)((const char*)(gbase) + (voff)[_i]), (PG8_LAS unsigned*)(lds + (bufoff) + ldsw + _i * 8192), 16, 0, 0); } while (0)
#define PG8_LDA(dst, b, h) do { _Pragma("unroll") for (int m = 0; m < 4; ++m) _Pragma("unroll") for (int k = 0; k < 2; ++k) dst[m][k] = *(const PG8_LAS bf16x8*)(lds + PG8_SA(b, h) + aoff + m * 2048 + k * 1024); } while (0)
#define PG8_LDB(dst, b, h) do { _Pragma("unroll") for (int n = 0; n < 2; ++n) _Pragma("unroll") for (int k = 0; k < 2; ++k) dst[n][k] = *(const PG8_LAS bf16x8*)(lds + PG8_SB(b, h) + boff + n * 2048 + k * 1024); } while (0)
#define PG8_MMA(ai, bj, At, Bt) do { __builtin_amdgcn_s_setprio(1); _Pragma("unroll") for (int m = 0; m < 4; ++m) _Pragma("unroll") for (int n = 0; n < 2; ++n) _Pragma("unroll") for (int k = 0; k < 2; ++k) \
        acc[ai][bj][m][n] = __builtin_amdgcn_mfma_f32_16x16x32_bf16(Bt[n][k], At[m][k], acc[ai][bj][m][n], 0, 0, 0); __builtin_amdgcn_s_setprio(0); } while (0)
#define PG8_WAIT_V(n) asm volatile("s_waitcnt vmcnt(" #n ")" ::: "memory")
#define PG8_WAIT_L(n) asm volatile("s_waitcnt lgkmcnt(" #n ")" ::: "memory")
#define PG8_BAR __builtin_amdgcn_s_barrier()
#define PG8_SCHED __builtin_amdgcn_sched_barrier(0)
    Unit cur, nxt; int ui = 0;
    if (!S.next(0, cur)) return;
    f32x4 acc[2][2][4][2];
#pragma unroll
    for (int a = 0; a < 2; ++a)
#pragma unroll
        for (int b = 0; b < 2; ++b)
#pragma unroll
            for (int m = 0; m < 4; ++m)
#pragma unroll
                for (int n = 0; n < 2; ++n) acc[a][b][m][n] = (f32x4){0.f, 0.f, 0.f, 0.f};
    bf16x8 At[4][2], B0[2][2], B1[2][2];
    const char* cA = cur.a; const char* cB = cur.b;
    S.a_ready(cur);
    if constexpr (SP2) {
        if constexpr (GATHER) PG8_AROWS(0, voffA, voffA1);
        PG8_STAGE(PG8_SB(0, 0), cB, voffB); PG8_STAGE(PG8_SB(0, 1), cB + hstep, voffB); PG8_STAGE(PG8_SA(0, 0), cA, voffA); if constexpr (GATHER) PG8_STAGE(PG8_SA(0, 1), cA, voffA1); else PG8_STAGE(PG8_SA(0, 1), cA + hs1, voffA);
        if (wr == 1) PG8_BAR;
        PG8_WAIT_V(2); PG8_BAR;
        PG8_STAGE(PG8_SB(1, 0), cB + kstep, voffB); PG8_STAGE(PG8_SA(1, 0), cA + kstep, voffA); PG8_STAGE(PG8_SB(1, 1), cB + hstep + kstep, voffB);
        PG8_WAIT_V(6); PG8_BAR;
    } else {
        PG8_STAGE(PG8_SB(0, 0), cB, voffB); PG8_STAGE(PG8_SA(0, 0), cA, voffA); PG8_STAGE(PG8_SB(0, 1), cB + hstep, voffB); PG8_STAGE(PG8_SA(0, 1), cA + hstep, voffA);
        if (wr == 1) PG8_BAR;
        PG8_WAIT_V(4); PG8_BAR;
        PG8_STAGE(PG8_SB(1, 0), cB + kstep, voffB); PG8_STAGE(PG8_SA(1, 0), cA + kstep, voffA); PG8_STAGE(PG8_SB(1, 1), cB + hstep + kstep, voffB);
        PG8_WAIT_V(6); PG8_BAR;
    }
    for (;;) {
        const bool has_next = S.next(ui + 1, nxt);
        if constexpr (GATHER) { if (has_next) PG8_AROWS(ui + 1, voffAn, voffA1n); }
        const char* nA = has_next ? nxt.a : cA; const char* nB = has_next ? nxt.b : cB;
        for (int t = 0; t < nt; t += 2) {
            const bool last = (t == nt - 2);
            const bool s1 = KSPLIT != 0 && t + 1 >= KSPLIT, s2 = KSPLIT != 0 && !last && t + 2 >= KSPLIT;
            if constexpr (KSPLIT != 0) { if (t == KSPLIT) E.mid(acc, cur, wr, wc, fr, fq); }
            const char* a1 = s1 ? cur.a2 + (size_t)(t + 1 - KSPLIT) * kstep : cA + (size_t)(t + 1) * kstep;
            const char* a2 = last ? nA : (s2 ? cur.a2 + (size_t)(t + 2 - KSPLIT) * kstep : cA + (size_t)(t + 2) * kstep); const char* b2 = last ? nB : cB + (size_t)(t + 2) * kstep;
            const char* a3 = a2 + kstep; const char* b3 = b2 + kstep;
            if (last && has_next) S.a_ready(nxt);
            unsigned vx0[2], vx1[2], vy1[2];
#pragma unroll
            for (int i = 0; i < 2; ++i) { vx0[i] = (GATHER && last && has_next) ? voffAn[i] : (s2 ? voffAs[i] : voffA[i]);
                vx1[i] = GATHER ? ((last && has_next) ? voffA1n[i] : voffA1[i]) : vx0[i]; vy1[i] = GATHER ? voffA1[i] : (s1 ? voffAs[i] : voffA[i]); }
            const size_t hy1 = s1 ? hs2 : hs1, hx1 = s2 ? hs2 : hs1;
            if constexpr (SP2) {
            PG8_LDB(B0, 0, 0); PG8_LDB(B1, 0, 1); PG8_SCHED; PG8_LDA(At, 0, 0); PG8_STAGE(PG8_SA(1, 1), a1 + hy1, vy1);
            PG8_WAIT_V(8); PG8_WAIT_L(0); PG8_BAR; PG8_MMA(0, 0, At, B0); PG8_MMA(0, 1, At, B1); PG8_BAR; PG8_SCHED;
            PG8_LDA(At, 0, 1); PG8_STAGE(PG8_SB(0, 0), b2, voffB); PG8_STAGE(PG8_SB(0, 1), b2 + hstep, voffB); PG8_STAGE(PG8_SA(0, 0), a2, vx0);
            PG8_WAIT_V(8); PG8_WAIT_L(0); PG8_BAR; PG8_MMA(1, 0, At, B0); PG8_MMA(1, 1, At, B1); PG8_BAR; PG8_SCHED;
            PG8_LDB(B0, 1, 0); PG8_LDB(B1, 1, 1); PG8_SCHED; PG8_LDA(At, 1, 0); PG8_STAGE(PG8_SA(0, 1), a2 + hx1, vx1);
            PG8_WAIT_V(8); PG8_WAIT_L(0); PG8_BAR; PG8_MMA(0, 0, At, B0); PG8_MMA(0, 1, At, B1); PG8_BAR; PG8_SCHED;
            PG8_LDA(At, 1, 1); PG8_STAGE(PG8_SB(1, 0), b3, voffB); PG8_STAGE(PG8_SB(1, 1), b3 + hstep, voffB); PG8_STAGE(PG8_SA(1, 0), a3, vx0);
            PG8_WAIT_V(8); PG8_WAIT_L(0); PG8_BAR; PG8_MMA(1, 0, At, B0); PG8_MMA(1, 1, At, B1); PG8_BAR; PG8_SCHED;
            } else {
            PG8_LDB(B0, 0, 0); PG8_SCHED; PG8_LDA(At, 0, 0); PG8_STAGE(PG8_SA(1, 1), a1 + hstep, voffA);
            PG8_WAIT_L(8); PG8_BAR; PG8_WAIT_L(0); PG8_MMA(0, 0, At, B0); PG8_BAR; PG8_SCHED;
            PG8_LDB(B1, 0, 1); PG8_STAGE(PG8_SB(0, 0), b2, voffB);
            PG8_BAR; PG8_WAIT_L(0); PG8_MMA(0, 1, At, B1); PG8_BAR;
            PG8_LDA(At, 0, 1); PG8_STAGE(PG8_SA(0, 0), a2, voffA);
            PG8_BAR; PG8_WAIT_L(0); PG8_MMA(1, 0, At, B0); PG8_BAR; PG8_SCHED;
            PG8_STAGE(PG8_SB(0, 1), b2 + hstep, voffB);
            PG8_WAIT_V(6); PG8_BAR; PG8_MMA(1, 1, At, B1); PG8_BAR;
            PG8_LDB(B0, 1, 0); PG8_SCHED; PG8_LDA(At, 1, 0); PG8_STAGE(PG8_SA(0, 1), a2 + hstep, voffA);
            PG8_WAIT_L(8); PG8_BAR; PG8_WAIT_L(0); PG8_MMA(0, 0, At, B0); PG8_BAR; PG8_SCHED;
            PG8_LDB(B1, 1, 1); PG8_STAGE(PG8_SB(1, 0), b3, voffB);
            PG8_BAR; PG8_WAIT_L(0); PG8_MMA(0, 1, At, B1); PG8_BAR;
            PG8_LDA(At, 1, 1); PG8_STAGE(PG8_SA(1, 0), a3, voffA);
            PG8_BAR; PG8_WAIT_L(0); PG8_MMA(1, 0, At, B0); PG8_BAR; PG8_SCHED;
            PG8_STAGE(PG8_SB(1, 1), b3 + hstep, voffB);
            PG8_WAIT_V(6); PG8_BAR; PG8_MMA(1, 1, At, B1); PG8_BAR;
            }
        }
        if constexpr (ALIGN_EPI) { if (wr == 0) PG8_BAR; }
        if constexpr (!Epi::AFTER_DRAIN) { if constexpr (Epi::INPLACE) E.inplace(acc, cur, wr, wc, fr, fq, wid, lane); else E(acc, cur, wr, wc, fr, fq); S.done(cur); }
        if (!has_next) break;
#pragma unroll
        for (int a = 0; a < 2; ++a)
#pragma unroll
            for (int b = 0; b < 2; ++b)
#pragma unroll
                for (int m = 0; m < 4; ++m)
#pragma unroll
                    for (int n = 0; n < 2; ++n) acc[a][b][m][n] = (f32x4){0.f, 0.f, 0.f, 0.f};
        cur = nxt; cA = nA; cB = nB; ++ui;
        if constexpr (GATHER) {
#pragma unroll
            for (int i = 0; i < 2; ++i) { voffA[i] = voffAn[i]; voffA1[i] = voffA1n[i]; } }
        if constexpr (ALIGN_EPI) { if (wr == 1) PG8_BAR; }
    }
    PG8_WAIT_V(0);
    if constexpr (!ALIGN_EPI) { if (wr == 0) PG8_BAR; }
    PG8_BAR;
    if constexpr (Epi::AFTER_DRAIN) { E.fused(acc, cur, wr, wc, fr, fq, lds, wid, lane); S.done(cur); }
#undef PG8_AROWS
#undef PG8_SA
#undef PG8_SB
#undef PG8_STAGE
#undef PG8_LDA
#undef PG8_LDB
#undef PG8_MMA
#undef PG8_WAIT_V
#undef PG8_WAIT_L
#undef PG8_BAR
#undef PG8_SCHED
}
}
#define GAS __attribute__((address_space(1)))
#define LAS __attribute__((address_space(3)))
typedef unsigned short bf16;
typedef unsigned v4u __attribute__((ext_vector_type(4)));
typedef float f32x4 __attribute__((ext_vector_type(4)));
typedef short bf16x8 __attribute__((ext_vector_type(8)));
typedef GAS unsigned gu32;
typedef GAS unsigned long long gu64;
#define RLX_AGENT __ATOMIC_RELAXED, __HIP_MEMORY_SCOPE_AGENT
#define LDS_WAIT() asm volatile("s_waitcnt lgkmcnt(0)" ::: "memory")
#define VM_WAIT() asm volatile("s_waitcnt vmcnt(0)" ::: "memory")
__device__ __forceinline__ unsigned long long rt() { return __builtin_amdgcn_s_memrealtime(); }
__device__ __forceinline__ unsigned f2bf(float f) { unsigned u = __builtin_bit_cast(unsigned, f); return (u + 0x7fffu + ((u >> 16) & 1u)) >> 16; }
__device__ __forceinline__ unsigned pk2(float lo, float hi) { return f2bf(lo) | (f2bf(hi) << 16); }

#define XB_TMO      128
#define XB_XCNT(j)  (256  + 64 * (j))
#define XB_XSUB(j)  (1280 + 64 * (j))
#define XB_XGEN(j)  (2304 + 64 * (j))
#define XB_TOP      3328
#define XB_TOPGEN   3392
#define XCD_BAR_WORDS 3456
#define XB_SPIN_CAP (1u << 18)

__device__ __forceinline__ unsigned xb_ld(unsigned* p)              { return __hip_atomic_load(p, __ATOMIC_RELAXED, __HIP_MEMORY_SCOPE_AGENT); }
__device__ __forceinline__ unsigned xb_add(unsigned* p, unsigned v) { return __hip_atomic_fetch_add(p, v, __ATOMIC_RELAXED, __HIP_MEMORY_SCOPE_AGENT); }
__device__ __forceinline__ unsigned xb_xcc_id() { return (unsigned)__builtin_amdgcn_s_getreg((3 << 11) | 20) & 0xFu; }
#define XB_SPIN(cond, bar) do { unsigned _sp = 0; while (cond) { __builtin_amdgcn_s_sleep(1); \
    if ((++_sp & 255u) == 0u) { if (xb_ld(&(bar)[XB_TMO])) break; if (_sp > XB_SPIN_CAP) { atomicAdd(&(bar)[XB_TMO], 1u); break; } } } } while (0)

struct XcdBarrier {
    unsigned* bar; unsigned x;
    volatile LAS unsigned* st;
};

__device__ __forceinline__ XcdBarrier xcd_barrier_post(unsigned* bar, volatile LAS unsigned* st) {
    XcdBarrier b; b.bar = bar; b.x = xb_xcc_id(); b.st = st;
    if (threadIdx.x == 0) (void)xb_add(&bar[XB_XCNT(b.x)], 1u);
    return b;
}
__device__ __forceinline__ void xcd_barrier_complete(unsigned* bar, unsigned x, unsigned& nloc, unsigned& nx) {
    const unsigned G = gridDim.x * gridDim.y * gridDim.z;
    unsigned sum, cnt, mine, sp = 0u;
    for (;;) {
        sum = 0u; cnt = 0u; mine = 0u;
#pragma unroll
        for (unsigned j = 0; j < 16; ++j) { const unsigned c = xb_ld(&bar[XB_XCNT(j)]); sum += c; cnt += (c > 0u) ? 1u : 0u; mine = (j == x) ? c : mine; }
        if (sum == G) break;
        __builtin_amdgcn_s_sleep(1);
        if ((++sp & 255u) == 0u) { if (xb_ld(&bar[XB_TMO])) break; if (sp > XB_SPIN_CAP) { atomicAdd(&bar[XB_TMO], 1u); break; } }
    }
    nloc = mine > 0u ? mine : 1u; nx = cnt > 0u ? cnt : 1u;
}

__device__ __forceinline__ void xcd_barrier(const XcdBarrier& b) {
    asm volatile("s_waitcnt vmcnt(0)" ::: "memory");
    __syncthreads();
    if (threadIdx.x == 0) {
        unsigned* bar = b.bar;
        __builtin_amdgcn_s_waitcnt(0);
        unsigned nloc = b.st[0], nx = b.st[1];
        if (nloc == 0u) { xcd_barrier_complete(bar, b.x, nloc, nx); b.st[0] = nloc; b.st[1] = nx; }
        const unsigned old = xb_add(&bar[XB_XSUB(b.x)], 1u);
        const unsigned gen = old / nloc;
        if (old + 1u == (gen + 1u) * nloc) {
            __builtin_amdgcn_fence(__ATOMIC_RELEASE, "agent");
            asm volatile("s_waitcnt vmcnt(0)" ::: "memory");
            const unsigned og = xb_add(&bar[XB_TOP], 1u);
            const unsigned tg = og / nx;
            if (og + 1u == (tg + 1u) * nx) xb_add(&bar[XB_TOPGEN], 1u);
            else XB_SPIN(xb_ld(&bar[XB_TOPGEN]) == tg, bar);
            __builtin_amdgcn_fence(__ATOMIC_ACQUIRE, "agent");
            xb_add(&bar[XB_XGEN(b.x)], 1u);
            asm volatile("s_waitcnt vmcnt(0)" ::: "memory");
        } else {
            XB_SPIN(xb_ld(&bar[XB_XGEN(b.x)]) == gen, bar);
            __builtin_amdgcn_fence(__ATOMIC_ACQUIRE, "agent");
            asm volatile("s_waitcnt vmcnt(0)" ::: "memory");
        }
    }
    __syncthreads();
}


constexpr int NWAVES = 8, NTHR = NWAVES * 64;
constexpr int DM = 1024, NB = 16, SEQ = 2048, T = NB * SEQ;
constexpr int N1 = 6656;
constexpr int NCLS = 24, SROWS = T + NCLS * 256;
constexpr float EPS = 1e-6f;
constexpr size_t MiB = 1u << 20;
constexpr size_t WS_CTL = 0, CTL_ZERO_BYTES = 1 * MiB;
constexpr size_t WS_ROT = 1 * MiB;
constexpr size_t WS_WRT = 1 * MiB + 512 * 1024;
constexpr size_t WS_TOK = 2 * MiB;
constexpr size_t WS_RSTD = 2 * MiB + 512 * 1024;
constexpr size_t WS_XBUF = 3 * MiB;
constexpr size_t WS_W1 = 4 * MiB, WS_WCAT = 18 * MiB  , WS_WOUT = 21 * MiB, WS_WUP = 23 * MiB, WS_WDN = 55 * MiB;
constexpr size_t WS_R1 = 104 * MiB;
constexpr size_t WS_SBQ = 168 * MiB, WS_SBK = 200 * MiB, WS_SBV = 232 * MiB, WS_RQ = 264 * MiB, WS_RK = 296 * MiB, WS_RV = 328 * MiB, WS_RG = 392 * MiB, WS_YSB = WS_SBQ;
constexpr size_t WS_MIX = WS_SBV, WS_HB = WS_RG;
constexpr size_t WS_PERM = WS_W1;
constexpr size_t WS_KV = 456 * MiB;
constexpr size_t WS_END = 488 * MiB;
constexpr size_t WS_PROBE = 200 * MiB;
constexpr int CW_BAR = 4096, CW_CNT = 8192, CW_ROWT = 16384;
constexpr int LDS_BYTES = 147456;
constexpr int LDSCTL_OFF = LDS_BYTES - 2048, MISC_OFF = LDSCTL_OFF + 320, TAB_OFF = LDSCTL_OFF + 1024;

struct TokInfo { float ga, gb, rstd; int cls; };

__device__ __forceinline__ float wave_sum(float v) {
#pragma unroll
    for (int o = 1; o < 64; o <<= 1) v += __shfl_xor(v, o);
    return v;
}
__device__ __forceinline__ float bf2f(unsigned short b) { return __builtin_bit_cast(float, (unsigned)b << 16); }
__device__ __forceinline__ float bflo(unsigned w) { return __builtin_bit_cast(float, w << 16); }
__device__ __forceinline__ float bfhi(unsigned w) { return __builtin_bit_cast(float, w & 0xffff0000u); }

struct Args { const float* in[18]; float* out; unsigned char* ws; int ph_lo, ph_hi, rep, pad; };

struct TJob { const float* W; int N; bf16* WT; int ldk, koff, mode, nbase; const float* gk; };
__device__ __forceinline__ int rowmap(int mode, int n) {
    if (mode == 1) {
        if (n >= 1536 && n < 2560) { const int seg = n < 2048 ? 1536 : 2048, c = n - seg, hh = c >> 6, i = c & 63; return seg + (hh >> 2) * 256 + (i >> 5) * 128 + (hh & 3) * 32 + (i & 31); }
        return n;
    }
    if (mode == 2) return (n >> 7) * 256 + (n & 127);
    if (mode == 3) return (n >> 7) * 256 + 128 + (n & 127);
    return n;
}
__device__ __forceinline__ void p0_transpose_item(const TJob& J, LAS float* scr, int item, int lane) {
    const int nblk = J.N / 32, kb = item / nblk, nb = item % nblk, k0 = 64 * kb, n0 = 32 * nb;
#pragma unroll 8
    for (int i = 0; i < 32; ++i) { const int kk = 2 * i + (lane >> 5); scr[kk * 33 + (lane & 31)] = J.W[(size_t)(k0 + kk) * J.N + n0 + (lane & 31)]; }
    LDS_WAIT(); asm volatile("" ::: "memory");
    const int c = lane & 7;
#pragma unroll
    for (int j = 0; j < 4; ++j) { const int n = (lane >> 3) + 8 * j; const LAS float* s = scr + (8 * c) * 33 + n;
        const int ng = n0 + n; float sc = 1.f; if (J.mode == 1) { if (ng < 512) sc = 0.125f * 1.4426950408889634f; else if (ng >= 2048 && ng < 2560) sc = 0.125f; }
        float g8[8];
#pragma unroll
        for (int q = 0; q < 8; ++q) g8[q] = J.gk ? J.gk[k0 + 8 * c + q] * sc : sc;
        v4u o; o.x = pk2(s[0 * 33] * g8[0], s[1 * 33] * g8[1]); o.y = pk2(s[2 * 33] * g8[2], s[3 * 33] * g8[3]); o.z = pk2(s[4 * 33] * g8[4], s[5 * 33] * g8[5]); o.w = pk2(s[6 * 33] * g8[6], s[7 * 33] * g8[7]);
        *(GAS v4u*)(J.WT + (size_t)(J.nbase + rowmap(J.mode, ng)) * J.ldk + J.koff + k0 + 8 * c) = o; }
    LDS_WAIT(); asm volatile("" ::: "memory");
}
__device__ __forceinline__ void p0_prologue(const Args& a, LAS unsigned char* lds, int vcu, int G, int wave, int lane) {
    unsigned char* ws = a.ws;
    LAS float* scr = (LAS float*)(lds + wave * 16384);
    const int gw = vcu * NWAVES + wave, NGW = G * NWAVES;
    constexpr int I0 = 16 * 144, I1 = 16 * 64, I2 = 8 * 32, I3 = 16 * 32, I4 = 16 * 32, I5 = 16 * 256, I6 = 16 * 256, I7 = 48 * 256;
    constexpr int NITEMS = I0 + I1 + I2 + I3 + I4 + I5 + I6 + I7;
    for (int it = gw; it < NITEMS; it += NGW) {
        int r = it; TJob J;
        if (r < I0) { J = TJob{a.in[2], 4608, (bf16*)(ws + WS_W1), 1024, 0, 1, 0, nullptr}; }
        else if ((r -= I0) < I1) { J = TJob{a.in[3], 2048, (bf16*)(ws + WS_W1), 1024, 0, 0, 4608, nullptr}; }
        else if ((r -= I1) < I2) { J = TJob{a.in[5], 1024, (bf16*)(ws + WS_WCAT), 1536, 0, 0, 0, nullptr}; }
        else if ((r -= I2) < I3) { J = TJob{a.in[6], 1024, (bf16*)(ws + WS_WCAT), 1536, 512, 0, 0, nullptr}; }
        else if ((r -= I3) < I4) { J = TJob{a.in[8], 1024, (bf16*)(ws + WS_WOUT), 1024, 0, 0, 0, nullptr}; }
        else if ((r -= I4) < I5) { const int e = r >> 8; r &= 255; J = TJob{a.in[14] + (size_t)e * 1024 * 512, 512, (bf16*)(ws + WS_WUP) + (size_t)e * 1024 * 1024, 1024, 0, 2, 0, a.in[9]}; }
        else if ((r -= I5) < I6) { const int e = r >> 8; r &= 255; J = TJob{a.in[15] + (size_t)e * 1024 * 512, 512, (bf16*)(ws + WS_WUP) + (size_t)e * 1024 * 1024, 1024, 0, 3, 0, a.in[9]}; }
        else { r -= I6; const int cs = r >> 8; r &= 255; const int cls = cs >> 1, slot = cs & 1, g = cls / 6, p = cls % 6;
            const int pa = p < 3 ? 0 : (p < 5 ? 1 : 2), pb = p == 0 ? 1 : (p == 1 ? 2 : (p == 2 ? 3 : (p == 3 ? 2 : 3)));
            const int e = 4 * g + (slot ? pb : pa);
            J = TJob{a.in[16] + (size_t)e * 512 * 1024, 1024, (bf16*)(ws + WS_WDN) + (size_t)cls * 1024 * 1024, 1024, slot * 512, 0, 0, nullptr}; }
        p0_transpose_item(J, scr, r, lane);
    }
    const float* x = a.in[0]; const float* g = a.in[1]; bf16* xn = (bf16*)(ws + WS_R1);
    f32x4 gv[4];
#pragma unroll
    for (int j = 0; j < 4; ++j) gv[j] = ((const f32x4*)g)[lane + 64 * j];
    for (int m = gw; m < T; m += NGW) {
        const GAS f32x4* xr = (const GAS f32x4*)(x + (size_t)m * DM) + lane;
        f32x4 v[4]; float s = 0.f;
#pragma unroll
        for (int j = 0; j < 4; ++j) { v[j] = xr[64 * j]; s += (v[j].x * v[j].x + v[j].y * v[j].y) + (v[j].z * v[j].z + v[j].w * v[j].w); }
        const float rstd = 1.f / sqrtf(wave_sum(s) * (1.f / DM) + EPS);
        GAS unsigned long long* o8 = (GAS unsigned long long*)(xn + (size_t)m * DM) + lane;
#pragma unroll
        for (int j = 0; j < 4; ++j) { const f32x4 y = v[j] * rstd * gv[j]; o8[64 * j] = (unsigned long long)pk2(y.x, y.y) | ((unsigned long long)pk2(y.z, y.w) << 32); }
    }
    float* rot = (float*)(ws + WS_ROT);
    for (int idx = gw * 64 + lane; idx < SEQ * 32; idx += NGW * 64) {
        const int pos = idx >> 5, i = idx & 31;
        const float inv = (float)exp(-(double)i * (9.210340371976184 / 32.0));
        const float ang = (float)pos * inv;
        rot[idx] = (float)cos((double)ang); rot[SEQ * 32 + idx] = (float)sin((double)ang);
    }
    bf16* wrt = (bf16*)(ws + WS_WRT);
    for (int idx = gw * 64 + lane; idx < 32 * 1024; idx += NGW * 64) {
        const int o = idx >> 10, k = idx & 1023;
        float v = 0.f; if (o < 8) v = a.in[10][k * 4 + (o & 3)]; else if (o < 24) v = a.in[12][k * 16 + (o - 8)];
        v *= a.in[9][k];
        const unsigned hb_ = f2bf(v); const float lo = v - __builtin_bit_cast(float, hb_ << 16);
        wrt[idx] = (bf16)hb_; wrt[32 * 1024 + idx] = (bf16)f2bf(lo);
    }
}

typedef pg8::Unit Unit;
using pg8::cvt_pk_bf16;
__device__ __forceinline__ v4u pack8(const f32x4 a, const f32x4 b) { v4u w; w.x = cvt_pk_bf16(a[0], a[1]); w.y = cvt_pk_bf16(a[2], a[3]); w.z = cvt_pk_bf16(b[0], b[1]); w.w = cvt_pk_bf16(b[2], b[3]); return w; }
__device__ __forceinline__ float sigm(float x) { return 1.f / (1.f + __expf(-x)); }

struct Epi1 {
    static constexpr bool PERM = true, AFTER_DRAIN = false, INPLACE = false;
    bf16 *sbq, *sbk, *sbv, *rq, *rk, *rv, *rg, *gates; const float* bgate; const float* rot; int nostore;
    __device__ __forceinline__ void operator()(const f32x4 (&acc)[2][2][4][2], const Unit& u, int wr, int wc, int fr, int fq) const {
        const int pn = u.tag, rowb = u.row0 + wr * 64 + fr, cw = wc * 32 + 8 * fq;
        if (pn >= 6 && pn < 10) {
            bf16* base = (pn < 8 ? rq : rk) + ((pn & 1) * 4 + wc) * 64 + 8 * fq;
            const int hh_ = (pn & 1) * 4 + wc; const float lg2h = hh_ == 0 ? -4.5803689613e-02f : (hh_ == 1 ? -2.2720076500e-02f : (hh_ == 2 ? -1.1315313228e-02f : (hh_ == 3 ? -5.6465631411e-03f : (hh_ == 4 ? -2.8205190624e-03f : (hh_ == 5 ? -1.4095702547e-03f : (hh_ == 6 ? -7.0461297659e-04f : (-3.5226347163e-04f)))))));
#pragma unroll
            for (int ai = 0; ai < 2; ++ai)
#pragma unroll
                for (int m = 0; m < 4; ++m) { const int row = rowb + ai * 128 + m * 16, pos = row & (SEQ - 1);
                    const f32x4 c0 = *(const f32x4*)(rot + pos * 32 + 8 * fq), c1 = *(const f32x4*)(rot + pos * 32 + 8 * fq + 4);
                    const f32x4 s0 = *(const f32x4*)(rot + SEQ * 32 + pos * 32 + 8 * fq), s1 = *(const f32x4*)(rot + SEQ * 32 + pos * 32 + 8 * fq + 4);
                    const f32x4 x10 = acc[ai][0][m][0], x11 = acc[ai][0][m][1], x20 = acc[ai][1][m][0], x21 = acc[ai][1][m][1];
                    f32x4 o10 = x10 * c0 - x20 * s0, o11 = x11 * c1 - x21 * s1, o20 = x20 * c0 + x10 * s0, o21 = x21 * c1 + x11 * s1;
                    if (pn >= 8) { const float kd = __builtin_amdgcn_exp2f(lg2h * (float)(64 - (pos & 63))); o10 *= kd; o11 *= kd; o20 *= kd; o21 *= kd; }
                    bf16* rowp = base + (size_t)row * 512;
                    const v4u w0 = pack8(o10, o11), w1 = pack8(o20, o21); if (!nostore) { *(v4u*)rowp = w0; *(v4u*)(rowp + 32) = w1; } else asm volatile("" :: "v"(w0), "v"(w1)); }
            return;
        }
        bf16* base; int ld, colt, act = 0;
        if (pn < 2) { base = sbq; ld = 512; colt = pn * 256; } else if (pn < 4) { base = sbk; ld = 512; colt = (pn - 2) * 256; }
        else if (pn < 6) { base = sbv; ld = 512; colt = (pn - 4) * 256; } else if (pn < 14) { base = rv; ld = 1024; colt = (pn - 10) * 256; }
        else if (pn < 18) { base = rg; ld = 1024; colt = (pn - 14) * 256; act = 1; } else { base = gates; ld = 2048; colt = (pn - 18) * 256; act = 2; }
        f32x4 bv[2][2];
#pragma unroll
        for (int bj = 0; bj < 2; ++bj)
#pragma unroll
            for (int n = 0; n < 2; ++n) bv[bj][n] = act == 2 ? *(const f32x4*)(bgate + colt + bj * 128 + cw + 4 * n) : (f32x4){0.f, 0.f, 0.f, 0.f};
#pragma unroll
        for (int ai = 0; ai < 2; ++ai)
#pragma unroll
            for (int m = 0; m < 4; ++m) { bf16* rowp = base + (size_t)(rowb + ai * 128 + m * 16) * ld + colt + cw;
#pragma unroll
                for (int bj = 0; bj < 2; ++bj) { f32x4 v0 = acc[ai][bj][m][0] + bv[bj][0], v1 = acc[ai][bj][m][1] + bv[bj][1];
                    if (act == 1) {
#pragma unroll
                        for (int j = 0; j < 4; ++j) { v0[j] = v0[j] * sigm(v0[j]); v1[j] = v1[j] * sigm(v1[j]); } }
                    else if (act == 2) {
#pragma unroll
                        for (int j = 0; j < 4; ++j) { v0[j] = sigm(v0[j]); v1[j] = sigm(v1[j]); } }
                    const v4u w0 = pack8(v0, v1); if (!nostore) *(v4u*)(rowp + bj * 128) = w0; else asm volatile("" :: "v"(w0)); } }
    }
};
struct EpiMixCat {
    static constexpr bool PERM = true, AFTER_DRAIN = false, INPLACE = false;
    const bf16* gates; bf16* out;
    __device__ __forceinline__ void mid(f32x4 (&acc)[2][2][4][2], const Unit& u, int wr, int wc, int fr, int fq) const {
        const int rowb = u.row0 + wr * 64 + fr, colb = u.col0 + wc * 32 + 8 * fq;
#pragma unroll
        for (int ai = 0; ai < 2; ++ai)
#pragma unroll
            for (int m = 0; m < 4; ++m) { const size_t row = rowb + ai * 128 + m * 16;
#pragma unroll
                for (int bj = 0; bj < 2; ++bj) { const int col = colb + bj * 128;
                    const v4u gs = *(const v4u*)(gates + row * 2048 + col), gr = *(const v4u*)(gates + row * 2048 + 1024 + col);
                    f32x4& v0 = acc[ai][bj][m][0]; f32x4& v1 = acc[ai][bj][m][1];
#define RAT(s_, r_) ((s_) * __builtin_amdgcn_rcpf(fmaxf((r_), 1e-20f)))
                    v0[0] *= RAT(bflo(gs.x), bflo(gr.x)); v0[1] *= RAT(bfhi(gs.x), bfhi(gr.x)); v0[2] *= RAT(bflo(gs.y), bflo(gr.y)); v0[3] *= RAT(bfhi(gs.y), bfhi(gr.y));
                    v1[0] *= RAT(bflo(gs.z), bflo(gr.z)); v1[1] *= RAT(bfhi(gs.z), bfhi(gr.z)); v1[2] *= RAT(bflo(gs.w), bflo(gr.w)); v1[3] *= RAT(bfhi(gs.w), bfhi(gr.w));
#undef RAT
                }
                asm volatile("" ::: "memory"); }
    }
    __device__ __forceinline__ void operator()(const f32x4 (&acc)[2][2][4][2], const Unit& u, int wr, int wc, int fr, int fq) const {
        const int rowb = u.row0 + wr * 64 + fr, colb = u.col0 + wc * 32 + 8 * fq;
#pragma unroll
        for (int ai = 0; ai < 2; ++ai)
#pragma unroll
            for (int m = 0; m < 4; ++m) { const size_t row = rowb + ai * 128 + m * 16;
#pragma unroll
                for (int bj = 0; bj < 2; ++bj) { const int col = colb + bj * 128;
                    const v4u g = *(const v4u*)(gates + row * 2048 + 1024 + col);
                    f32x4 v0 = acc[ai][bj][m][0], v1 = acc[ai][bj][m][1];
                    v0[0] *= bflo(g.x); v0[1] *= bfhi(g.x); v0[2] *= bflo(g.y); v0[3] *= bfhi(g.y); v1[0] *= bflo(g.z); v1[1] *= bfhi(g.z); v1[2] *= bflo(g.w); v1[3] *= bfhi(g.w);
                    *(v4u*)(out + row * 1024 + col) = pack8(v0, v1); } }
    }
};
struct CatOrder : pg8::StaticOrder {
    const char* A2; int K1, K2;
    __device__ bool next(int i, Unit& u) const {
        if (!pg8::StaticOrder::next(i, u)) return false;
        const int pm = u.row0 / pg8::BM;
        u.a = A + (size_t)pm * pg8::BM * K1 * 2; u.a2 = A2 + (size_t)pm * pg8::BM * K2 * 2; return true;
    }
};
struct EpiOut {
    static constexpr bool PERM = true, AFTER_DRAIN = false, INPLACE = false;
    const float* x; float* out; bf16* hb;
    __device__ __forceinline__ void operator()(const f32x4 (&acc)[2][2][4][2], const Unit& u, int wr, int wc, int fr, int fq) const {
        const int rowb = u.row0 + wr * 64 + fr, colb = u.col0 + wc * 32 + 8 * fq;
#pragma unroll
        for (int ai = 0; ai < 2; ++ai)
#pragma unroll
            for (int m = 0; m < 4; ++m) { const size_t off = (size_t)(rowb + ai * 128 + m * 16) * 1024 + colb;
#pragma unroll
                for (int bj = 0; bj < 2; ++bj)
                { const f32x4 v0 = *(const f32x4*)(x + off + bj * 128) + acc[ai][bj][m][0], v1 = *(const f32x4*)(x + off + bj * 128 + 4) + acc[ai][bj][m][1];
                    *(f32x4*)(out + off + bj * 128) = v0; *(f32x4*)(out + off + bj * 128 + 4) = v1; *(v4u*)(hb + off + bj * 128) = pack8(v0, v1); } }
    }
};
struct EpiUp {
    static constexpr bool PERM = true, AFTER_DRAIN = false, INPLACE = false;
    const TokInfo* tinfo; const volatile LAS int* rowtok; bf16* hid;
    __device__ __forceinline__ void operator()(const f32x4 (&acc)[2][2][4][2], const Unit& u, int wr, int wc, int fr, int fq) const {
        const int ct = u.tag, lrb = wr * 64 + fr, col = ct * 128 + wc * 32 + 8 * fq;
#pragma unroll
        for (int ai = 0; ai < 2; ++ai)
#pragma unroll
            for (int m = 0; m < 4; ++m) { const int lr = lrb + ai * 128 + m * 16, tok = rowtok[u.idx * 256 + lr];
                if (tok >= 0) { const TokInfo ti = tinfo[tok]; const float gw = ct < 4 ? ti.ga : ti.gb, rs = ti.rstd;
                    f32x4 v0, v1;
#pragma unroll
                    for (int j = 0; j < 4; ++j) { const float g0 = acc[ai][0][m][0][j] * rs, g1 = acc[ai][0][m][1][j] * rs;
                        v0[j] = g0 * sigm(g0) * acc[ai][1][m][0][j] * (rs * gw); v1[j] = g1 * sigm(g1) * acc[ai][1][m][1][j] * (rs * gw); }
                    *(v4u*)(hid + (size_t)(u.row0 + lr) * 1024 + col) = pack8(v0, v1); } }
    }
};
struct EpiDown {
    static constexpr bool PERM = true, AFTER_DRAIN = false, INPLACE = true;
    const volatile LAS int* rowtok; float* out; const float* gfin; float* xbuf; unsigned* cnt; LAS unsigned char* xl;
    __device__ __forceinline__ void inplace(f32x4 (&acc)[2][2][4][2], const Unit& u, int wr, int wc, int fr, int fq, int wid, int lane) const {
        LAS float* P = (LAS float*)xl; LAS float* S = (LAS float*)(xl + 4096); volatile LAS unsigned* flag = (volatile LAS unsigned*)(xl + 5120);
        const int lrb = wr * 64 + fr, colb = u.col0 + wc * 32 + 8 * fq, rt = u.row0 >> 8, ct = u.tag;
#pragma unroll
        for (int ai = 0; ai < 2; ++ai)
#pragma unroll
            for (int m = 0; m < 4; ++m) { const int lr = lrb + ai * 128 + m * 16, tok = rowtok[u.idx * 256 + lr]; float s = 0.f;
                if (tok >= 0) { const float* p = out + (size_t)tok * 1024 + colb;
#pragma unroll
                    for (int bj = 0; bj < 2; ++bj)
#pragma unroll
                        for (int n = 0; n < 2; ++n) { const f32x4 y = *(const f32x4*)(p + bj * 128 + n * 4) + acc[ai][bj][m][n]; acc[ai][bj][m][n] = y; s += (y[0] * y[0] + y[1] * y[1]) + (y[2] * y[2] + y[3] * y[3]); } }
                s += __shfl_xor(s, 16); s += __shfl_xor(s, 32);
                if (fq == 0) P[lr * 4 + wc] = s; }
        asm volatile("s_waitcnt lgkmcnt(0)" ::: "memory"); __builtin_amdgcn_s_barrier(); asm volatile("" ::: "memory");
        const int row = wid * 32 + (lane & 31);
        if (lane < 32) { const float s = (P[row * 4 + 0] + P[row * 4 + 1]) + (P[row * 4 + 2] + P[row * 4 + 3]);
            __hip_atomic_store(xbuf + ((size_t)rt * 256 + row) * 4 + ct, s, __ATOMIC_RELAXED, __HIP_MEMORY_SCOPE_AGENT); }
        asm volatile("s_waitcnt vmcnt(0)" ::: "memory");
        if (lane == 0) __hip_atomic_fetch_add(cnt + 64 * rt, 1u, __ATOMIC_RELAXED, __HIP_MEMORY_SCOPE_AGENT);
        if (wid == 0) { unsigned sp = 0;
            while ((unsigned)__builtin_amdgcn_readfirstlane(__hip_atomic_load(cnt + 64 * rt, __ATOMIC_RELAXED, __HIP_MEMORY_SCOPE_AGENT)) < 32u) { __builtin_amdgcn_s_sleep(2); if (++sp > (1u << 22)) break; }
            __builtin_amdgcn_fence(__ATOMIC_ACQUIRE, "agent");
            if (lane == 0) flag[0] = 1u; }
        asm volatile("s_waitcnt vmcnt(0) lgkmcnt(0)" ::: "memory"); __builtin_amdgcn_s_barrier(); asm volatile("" ::: "memory");
        if (lane < 32) { const float* sl = xbuf + ((size_t)rt * 256 + row) * 4; float t = 0.f;
#pragma unroll
            for (int k = 0; k < 4; ++k) t += __hip_atomic_load(sl + k, __ATOMIC_RELAXED, __HIP_MEMORY_SCOPE_AGENT);
            S[row] = 1.f / sqrtf(t * (1.f / 1024.f) + EPS); }
        asm volatile("s_waitcnt vmcnt(0) lgkmcnt(0)" ::: "memory"); __builtin_amdgcn_s_barrier(); asm volatile("" ::: "memory");
        f32x4 gv[2][2];
#pragma unroll
        for (int bj = 0; bj < 2; ++bj)
#pragma unroll
            for (int n = 0; n < 2; ++n) gv[bj][n] = *(const f32x4*)(gfin + colb + bj * 128 + n * 4);
#pragma unroll
        for (int ai = 0; ai < 2; ++ai)
#pragma unroll
            for (int m = 0; m < 4; ++m) { const int lr = lrb + ai * 128 + m * 16, tok = rowtok[u.idx * 256 + lr]; const float rs = S[lr];
                if (tok >= 0) { float* p = out + (size_t)tok * 1024 + colb;
#pragma unroll
                    for (int bj = 0; bj < 2; ++bj)
#pragma unroll
                        for (int n = 0; n < 2; ++n) *(f32x4*)(p + bj * 128 + n * 4) = acc[ai][bj][m][n] * rs * gv[bj][n]; } }
        asm volatile("s_waitcnt lgkmcnt(0)" ::: "memory"); __builtin_amdgcn_s_barrier(); asm volatile("" ::: "memory");
    }
};
struct MoeOrder {
    const char* A; const char* B; const volatile LAS int* tstart; volatile LAS int* rowtok; int nct, up, G, c;
    __device__ __forceinline__ void locate(int L, int& rt, int& ct, int& cls) const {
        rt = L / nct; ct = L % nct; cls = 0;
        for (int k = 1; k < NCLS; ++k) cls += (rt >= __builtin_amdgcn_readfirstlane(tstart[k])) ? 1 : 0;
    }
    __device__ bool next(int i, Unit& u) const {
        const int L = i * G + c; const int ntile = __builtin_amdgcn_readfirstlane(tstart[NCLS]);
        if (L >= ntile * nct) return false;
        int rt, ct, cls; locate(L, rt, ct, cls);
        const int g = cls / 6, p = cls % 6, pa = p < 3 ? 0 : (p < 5 ? 1 : 2), pb = p == 0 ? 1 : (p == 1 ? 2 : (p == 2 ? 3 : (p == 3 ? 2 : 3)));
        u.row0 = rt * 256; u.tag = ct; u.idx = i; u.a2 = nullptr;
        if (up) { const int e = 4 * g + (ct < 4 ? pa : pb); u.a = A; u.b = B + ((size_t)e * 1024 + (ct & 3) * 256) * 1024 * 2; u.col0 = ct * 128; }
        else { u.a = A + (size_t)rt * 256 * 1024 * 2; u.b = B + ((size_t)cls * 1024 + ct * 256) * 1024 * 2; u.col0 = ct * 256; }
        return true;
    }
    __device__ __forceinline__ int arow(int ui, int r) const { const int t = rowtok[ui * 256 + r]; return t < 0 ? 0 : t; }
    __device__ __forceinline__ void build(const int* perm, int tid) const {
        const int ntile = tstart[NCLS];
        for (int i = 0; i * G + c < ntile * nct; ++i) { int rt, ct, cls; locate(i * G + c, rt, ct, cls);
            for (int r = tid; r < 256; r += NTHR) { const int idx = (rt - tstart[cls]) * 256 + r; rowtok[i * 256 + r] = idx < tstart[32 + cls] ? perm[(size_t)cls * T + idx] : -1; } }
        __syncthreads();
    }
    __device__ __forceinline__ void a_ready(const Unit&) const {}
    __device__ __forceinline__ void done(const Unit&) const {}
};

typedef float f32x16 __attribute__((ext_vector_type(16)));
typedef short s16x4 __attribute__((ext_vector_type(4)));
typedef float f32x2_t __attribute__((ext_vector_type(2))); typedef __bf16 bf16x2_t __attribute__((ext_vector_type(2)));
__device__ __forceinline__ unsigned cvtpk_s(float lo, float hi) { f32x2_t v = {lo, hi}; bf16x2_t b = __builtin_convertvector(v, bf16x2_t); return __builtin_bit_cast(unsigned, b); }
__device__ __forceinline__ s16x4 vtr(const LAS unsigned char* p) { return __builtin_bit_cast(s16x4, __builtin_amdgcn_ds_read_tr16_b64_v4i16((LAS s16x4*)p)); }
__device__ __forceinline__ int crow(int r, int hi) { return (r & 3) + 8 * (r >> 2) + 4 * hi; }
#define MFMA32(a, b, c) __builtin_amdgcn_mfma_f32_32x32x16_bf16((a), (b), (c), 0, 0, 0)
__device__ __forceinline__ bf16x8 packfrag(const f32x16& p, int s) {
    v4u w; w.x = cvtpk_s(p[8 * s], p[8 * s + 1]); w.y = cvtpk_s(p[8 * s + 2], p[8 * s + 3]); w.z = cvtpk_s(p[8 * s + 4], p[8 * s + 5]); w.w = cvtpk_s(p[8 * s + 6], p[8 * s + 7]);
    return __builtin_bit_cast(bf16x8, w);
}
__device__ __forceinline__ bf16x8 vfrag(const LAS unsigned char* p, int rowbytes) {
    const s16x4 lo = vtr(p), hi_ = vtr(p + 8 * rowbytes);
    return (bf16x8){lo[0], lo[1], lo[2], lo[3], hi_[0], hi_[1], hi_[2], hi_[3]};
}
__device__ __forceinline__ void glds16(const void* gsrc, unsigned lds_dst) { unsigned keep;
    asm volatile("s_mov_b32 %0, m0\n\ts_mov_b32 m0, %2\n\ts_nop 0\n\tglobal_load_lds_dwordx4 %1, off\n\ts_mov_b32 m0, %0" : "=&s"(keep) : "v"(gsrc), "s"(lds_dst) : "memory"); }
#define WAIT_BAR(N) asm volatile("s_waitcnt vmcnt(" #N ") lgkmcnt(0)\n\ts_barrier" ::: "memory")
constexpr float SB_THR2 = -40.f;

template <bool MASK>
__device__ __forceinline__ void sb_tile(const LAS unsigned char* Kt, const LAS unsigned char* Vt, const bf16x8 (&qf)[4], const bf16x8 tri0, const bf16x8 tri1, const bf16x8 ones,
                                        f32x16& o0, f32x16& o1, float& R, int kt, int t, int hi, int kbase, int kx, int v0, int v1) {
    f32x16 p0 = {}, p1 = {};
#pragma unroll
    for (int ks = 0; ks < 4; ++ks) {
        const int co = kbase + (((2 * ks + hi) ^ kx) << 4);
        const bf16x8 a0 = *(const LAS bf16x8*)(Kt + co), a1 = *(const LAS bf16x8*)(Kt + 4096 + co);
        p0 = MFMA32(a0, qf[ks], p0); p1 = MFMA32(a1, qf[ks], p1);
    }
    f32x16 l0, l1; float cs = 0.f;
#pragma unroll
    for (int r = 0; r < 16; ++r) {
        const float z0 = p0[r], z1 = p1[r];
        float k0 = -(fmaxf(z0, 0.f) + __builtin_amdgcn_logf(1.f + __builtin_amdgcn_exp2f(-fabsf(z0))));
        float k1 = -(fmaxf(z1, 0.f) + __builtin_amdgcn_logf(1.f + __builtin_amdgcn_exp2f(-fabsf(z1))));
        if (MASK) { const int key = kt * 64 + crow(r, hi); k0 = key < t ? k0 : 0.f; k1 = key + 32 < t ? k1 : 0.f; }
        l0[r] = k0; l1[r] = k1; cs += k0 + k1;
    }
    cs += __shfl_xor(cs, 32);
    const bf16x8 lb00 = packfrag(l0, 0), lb01 = packfrag(l0, 1), lb10 = packfrag(l1, 0), lb11 = packfrag(l1, 1);
    f32x16 y0 = {}, y1 = {};
    y0 = MFMA32(tri0, lb00, y0); y0 = MFMA32(tri1, lb01, y0); y0 = MFMA32(ones, lb10, y0); y0 = MFMA32(ones, lb11, y0);
    y1 = MFMA32(tri0, lb10, y1); y1 = MFMA32(tri1, lb11, y1);
#pragma unroll
    for (int r = 0; r < 16; ++r) {
        float w0 = __builtin_amdgcn_exp2f(p0[r] + y0[r] + R), w1 = __builtin_amdgcn_exp2f(p1[r] + y1[r] + R);
        if (MASK) { const int key = kt * 64 + crow(r, hi); w0 = key < t ? w0 : 0.f; w1 = key + 32 < t ? w1 : 0.f; }
        p0[r] = w0; p1[r] = w1;
    }
    R += cs;
    const bf16x8 wb00 = packfrag(p0, 0), wb01 = packfrag(p0, 1), wb10 = packfrag(p1, 0), wb11 = packfrag(p1, 1);
    o0 = MFMA32(vfrag(Vt + 0 * 2048 + v0, 128), wb00, o0); o1 = MFMA32(vfrag(Vt + 0 * 2048 + v1, 128), wb00, o1);
    o0 = MFMA32(vfrag(Vt + 1 * 2048 + v0, 128), wb01, o0); o1 = MFMA32(vfrag(Vt + 1 * 2048 + v1, 128), wb01, o1);
    o0 = MFMA32(vfrag(Vt + 2 * 2048 + v0, 128), wb10, o0); o1 = MFMA32(vfrag(Vt + 2 * 2048 + v1, 128), wb10, o1);
    o0 = MFMA32(vfrag(Vt + 3 * 2048 + v0, 128), wb11, o0); o1 = MFMA32(vfrag(Vt + 3 * 2048 + v1, 128), wb11, o1);
}
__device__ __forceinline__ void unit_map(int u, int G, int& bh, int& qb) {
    if (G == 256) { const int bx = u & 255, i = u >> 8, xcd = bx & 7, slot = bx >> 3, gi = slot >> 2, j = slot & 3;
        bh = (xcd * 8 + gi) * 2 + (i >> 1); qb = (i & 1) ? 7 - j : j; }
    else { bh = u >> 3; qb = u & 7; }
}
__device__ __forceinline__ void sb_phase(const bf16* Q, const bf16* Kg, const bf16* Vg, bf16* O, LAS unsigned char* lds, int bx, int G, int tid, int wave, int lane, bool nostore = false) {
    const int r32 = lane & 31, hi = lane >> 5;
    bf16x8 tri0, tri1, ones;
#pragma unroll
    for (int j = 0; j < 8; ++j) { const int kk = 8 * (j >> 2) + 4 * hi + (j & 3); tri0[j] = kk >= r32 ? (short)0x3F80 : (short)0; tri1[j] = 16 + kk >= r32 ? (short)0x3F80 : (short)0; ones[j] = (short)0x3F80; }
    const int skey = wave * 8 + (lane >> 3), sc = (lane & 7) ^ (lane >> 3), svc = (lane & 7) ^ (((lane >> 4) & 1) << 2);
    const unsigned lds0 = (unsigned)(size_t)lds + (unsigned)wave * 1024u;
#define SB_STAGE(kt_, st_) do { const unsigned d_ = (unsigned)__builtin_amdgcn_readfirstlane(lds0 + (unsigned)(st_) * 16384u); \
        glds16(Kg + (rbase + (size_t)(kt_) * 64 + skey) * 512 + h * 64 + sc * 8, d_); glds16(Vg + (rbase + (size_t)(kt_) * 64 + skey) * 512 + h * 64 + svc * 8, d_ + 8192u); } while (0)
    const int kbase = r32 * 128, kx = r32 & 7;
    const int q4 = (lane & 15) >> 2, v0 = ((4 * hi + q4) * 128 + 32 * ((lane >> 4) & 1) + 8 * (lane & 3)) ^ (((q4 >> 1) & 1) << 6), v1 = v0 ^ 64;
    volatile LAS int* flags = (volatile LAS int*)(lds + 49152);
    for (int u = bx; u < 1024; u += G) {
        const int bh = u >> 3, qb = u & 7;
        const int b = bh >> 3, h = bh & 7, q0w = qb * 256 + 32 * wave, my_kt = q0w >> 6, kt_hi = qb * 4 + 3, t = q0w + r32;
        const size_t rbase = (size_t)b * SEQ;
        SB_STAGE(kt_hi, 0);
        if (kt_hi > 0) SB_STAGE(kt_hi - 1, 1);
        bf16x8 qf[4];
#pragma unroll
        for (int ks = 0; ks < 4; ++ks) qf[ks] = *(const bf16x8*)(Q + (rbase + t) * 512 + h * 64 + 16 * ks + 8 * hi);
        f32x16 o0 = {}, o1 = {}; float R = 0.f;
        if (kt_hi > 0) WAIT_BAR(2); else WAIT_BAR(0);
        bool mydone = false; int st = 0, it = 0;
        for (int kt = kt_hi; kt >= 0; --kt, ++it) {
            int st2 = st + 2; if (st2 >= 3) st2 -= 3;
            if (kt >= 2) SB_STAGE(kt - 2, st2);
            if (kt <= my_kt && !mydone) {
                const LAS unsigned char* Kt = lds + st * 16384; const LAS unsigned char* Vt = Kt + 8192;
                if (kt == my_kt) sb_tile<true>(Kt, Vt, qf, tri0, tri1, ones, o0, o1, R, kt, t, hi, kbase, kx, v0, v1);
                else sb_tile<false>(Kt, Vt, qf, tri0, tri1, ones, o0, o1, R, kt, t, hi, kbase, kx, v0, v1);
                mydone = __all(R < SB_THR2) != 0;
            }
            if (lane == 0) flags[(it & 1) * 8 + wave] = mydone ? 1 : 0;
            if (kt >= 2) WAIT_BAR(2); else WAIT_BAR(0);
            int alld = 1;
#pragma unroll
            for (int w = 0; w < 8; ++w) alld &= flags[(it & 1) * 8 + w];
            if (alld) break;
            st = st + 1; if (st >= 3) st = 0;
        }
        { LAS unsigned char* ep = lds + 53248 + wave * 4608;
#pragma unroll
          for (int g4 = 0; g4 < 4; ++g4) {
            *(LAS unsigned long long*)(ep + r32 * 144 + (8 * g4 + 4 * hi) * 2) = (unsigned long long)cvtpk_s(o0[4 * g4], o0[4 * g4 + 1]) | ((unsigned long long)cvtpk_s(o0[4 * g4 + 2], o0[4 * g4 + 3]) << 32);
            *(LAS unsigned long long*)(ep + r32 * 144 + (32 + 8 * g4 + 4 * hi) * 2) = (unsigned long long)cvtpk_s(o1[4 * g4], o1[4 * g4 + 1]) | ((unsigned long long)cvtpk_s(o1[4 * g4 + 2], o1[4 * g4 + 3]) << 32); }
#pragma unroll
          for (int i = 0; i < 4; ++i) { const int row = (lane >> 3) + 8 * i;
            const v4u ov = *(const LAS v4u*)(ep + row * 144 + (lane & 7) * 16); if (!nostore) *(v4u*)(O + (rbase + q0w + row) * 512 + h * 64 + (lane & 7) * 8) = ov; else asm volatile("" :: "v"(ov)); } }
        WAIT_BAR(0);
    }
#undef SB_STAGE
}
template <bool EDGE>
__device__ __forceinline__ void ret_tile(const LAS unsigned char* Kt, const LAS unsigned char* Vt, const bf16x8 (&qf)[4], f32x16 (&o)[4], float lg2, int kt, int my_kt, int n, int hi, int kbase, int kx, int vb) {
    f32x16 p0 = {}, p1 = {};
#pragma unroll
    for (int ks = 0; ks < 4; ++ks) {
        const int co = kbase + (((2 * ks + hi) ^ kx) << 4);
        const bf16x8 a0 = *(const LAS bf16x8*)(Kt + co), a1 = *(const LAS bf16x8*)(Kt + 4096 + co);
        p0 = MFMA32(a0, qf[ks], p0); p1 = MFMA32(a1, qf[ks], p1);
    }
    const int e_off = n - 64 * (kt + 1);
    if (EDGE) {
        const bool diag = kt == my_kt; float fnn = (float)(n & 63); asm volatile("" : "+v"(fnn));
        const float base = diag ? fnn - 64.f : (float)e_off, two = diag ? 2.f : 0.f, h4 = (float)(4 * hi);
#pragma unroll
        for (int r = 0; r < 16; ++r) {
            const float m0 = (float)((r & 3) + 8 * (r >> 2)) + h4;
            p0[r] *= __builtin_amdgcn_exp2f(lg2 * (base + two * fmaxf(m0 - fnn, 0.f))); p1[r] *= __builtin_amdgcn_exp2f(lg2 * (base + two * fmaxf(m0 + 32.f - fnn, 0.f)));
            if ((r & 3) == 3) __builtin_amdgcn_sched_barrier(0);
        }
    } else {
        const float f = __builtin_amdgcn_exp2f(lg2 * (float)e_off);
#pragma unroll
        for (int r = 0; r < 16; ++r) { p0[r] *= f; p1[r] *= f; }
    }
    const bf16x8 wb00 = packfrag(p0, 0), wb01 = packfrag(p0, 1), wb10 = packfrag(p1, 0), wb11 = packfrag(p1, 1);
#pragma unroll
    for (int dt = 0; dt < 4; ++dt) { const LAS unsigned char* vp = Vt + (vb ^ (dt << 6));
        o[dt] = MFMA32(vfrag(vp + 0 * 4096, 256), wb00, o[dt]); o[dt] = MFMA32(vfrag(vp + 1 * 4096, 256), wb01, o[dt]);
        o[dt] = MFMA32(vfrag(vp + 2 * 4096, 256), wb10, o[dt]); o[dt] = MFMA32(vfrag(vp + 3 * 4096, 256), wb11, o[dt]); }
}
__device__ __forceinline__ void kv_chain(const bf16* Kg, const bf16* Vg, bf16* STg, LAS unsigned char* lds, int bh0, int bhs, int tid, int wave, int lane) {
    const int r32 = lane & 31, hi = lane >> 5, q4 = (lane & 15) >> 2, g1 = (lane >> 4) & 1, p = lane & 3, dh = wave >> 2, eq = wave & 3;
    const int skey = wave * 8 + (lane >> 3), sc = (lane & 7) ^ (lane >> 3);
    const int vkey = wave * 8 + (lane >> 4), vc = (lane & 15) ^ (((lane >> 4) & 3) << 2);
    const unsigned ldsk = (unsigned)(size_t)lds + (unsigned)wave * 1024u, ldsv = (unsigned)(size_t)lds + 8192u + (unsigned)wave * 2048u;
#define RET_STAGE(kt_, st_) do { const unsigned so_ = (unsigned)(st_) * 24576u; \
        glds16(Kg + (rbase + (size_t)(kt_) * 64 + skey) * 512 + h * 64 + sc * 8, (unsigned)__builtin_amdgcn_readfirstlane(ldsk + so_)); \
        glds16(Vg + (rbase + (size_t)(kt_) * 64 + vkey) * 1024 + h * 128 + vc * 8, (unsigned)__builtin_amdgcn_readfirstlane(ldsv + so_)); \
        glds16(Vg + (rbase + (size_t)(kt_) * 64 + vkey + 4) * 1024 + h * 128 + vc * 8, (unsigned)__builtin_amdgcn_readfirstlane(ldsv + so_ + 1024u)); } while (0)
    int aoff[2], boff[2];
#pragma unroll
    for (int e = 0; e < 2; ++e) { const int m = 8 * hi + q4 + 4 * e;
        aoff[e] = m * 128 + (((4 * dh + 2 * g1 + (p >> 1)) ^ (m & 7)) << 4) + (p & 1) * 8;
        boff[e] = m * 256 + ((64 * eq + 32 * g1 + 8 * p) ^ ((m & 3) << 6)); }
    for (int bh = bh0; bh < 128; bh += bhs) {
        const int b = bh >> 3, h = bh & 7;
        const size_t rbase = (size_t)b * SEQ;
        const float lg2 = log2f(1.f - exp2f(-5.f - (float)h)), g64 = exp2f(64.f * lg2), g256 = exp2f(256.f * lg2), ginv = exp2f(-lg2);
        RET_STAGE(0, 0); RET_STAGE(1, 1);
        f32x16 S = {}, kv = {};
        WAIT_BAR(3);
        int st = 0;
        for (int kt = 0; kt < 28; ++kt) {
            int st2 = st + 2; if (st2 >= 3) st2 -= 3;
            if (kt + 2 < 28) RET_STAGE(kt + 2, st2);
            const LAS unsigned char* Kt = lds + st * 24576; const LAS unsigned char* Vt = Kt + 8192;
#pragma unroll
            for (int r = 0; r < 16; ++r) kv[r] *= g64;
#pragma unroll
            for (int ks = 0; ks < 4; ++ks) {
                const s16x4 a0 = vtr(Kt + aoff[0] + ks * 2048), a1 = vtr(Kt + aoff[1] + ks * 2048), b0 = vtr(Vt + boff[0] + ks * 4096), b1 = vtr(Vt + boff[1] + ks * 4096);
                kv = MFMA32(((bf16x8){a0[0], a0[1], a0[2], a0[3], a1[0], a1[1], a1[2], a1[3]}), ((bf16x8){b0[0], b0[1], b0[2], b0[3], b1[0], b1[1], b1[2], b1[3]}), kv);
            }
            if ((kt & 3) == 3) {
                bf16* sp = STg + ((size_t)(bh * 8 + (kt >> 2) + 1) * 64 + 32 * dh) * 128 + 32 * eq + r32;
#pragma unroll
                for (int r = 0; r < 16; ++r) { S[r] = S[r] * g256 + kv[r] * ginv; kv[r] = 0.f; sp[crow(r, hi) * 128] = (bf16)(cvtpk_s(S[r], 0.f) & 0xffffu); }
            }
            if (kt + 2 < 28) WAIT_BAR(3); else WAIT_BAR(0);
            st = st + 1; if (st >= 3) st = 0;
        }
    }
#undef RET_STAGE
}
__device__ __forceinline__ void ret_phase(const bf16* Q, const bf16* Kg, const bf16* Vg, const bf16* RG, const float* gn, const bf16* STg, bf16* Y, LAS unsigned char* lds, int bx, int G, int tid, int wave, int lane) {
    const int r32 = lane & 31, hi = lane >> 5;
    const int skey = wave * 8 + (lane >> 3), sc = (lane & 7) ^ (lane >> 3);
    const int vkey = wave * 8 + (lane >> 4), vc = (lane & 15) ^ (((lane >> 4) & 3) << 2);
    const unsigned ldsk = (unsigned)(size_t)lds + (unsigned)wave * 1024u, ldsv = (unsigned)(size_t)lds + 8192u + (unsigned)wave * 2048u, ldss = (unsigned)(size_t)lds + 73728u + (unsigned)wave * 2048u;
#define RET_STAGE(kt_, st_) do { const unsigned so_ = (unsigned)(st_) * 24576u; \
        glds16(Kg + (rbase + (size_t)(kt_) * 64 + skey) * 512 + h * 64 + sc * 8, (unsigned)__builtin_amdgcn_readfirstlane(ldsk + so_)); \
        glds16(Vg + (rbase + (size_t)(kt_) * 64 + vkey) * 1024 + h * 128 + vc * 8, (unsigned)__builtin_amdgcn_readfirstlane(ldsv + so_)); \
        glds16(Vg + (rbase + (size_t)(kt_) * 64 + vkey + 4) * 1024 + h * 128 + vc * 8, (unsigned)__builtin_amdgcn_readfirstlane(ldsv + so_ + 1024u)); } while (0)
#define RET_STAGES(qb_) do { const bf16* s_ = STg + ((size_t)(bh * 8 + (qb_)) * 64 + vkey) * 128 + vc * 8; \
        glds16(s_, (unsigned)__builtin_amdgcn_readfirstlane(ldss)); glds16(s_ + 4 * 128, (unsigned)__builtin_amdgcn_readfirstlane(ldss + 1024u)); } while (0)
    const int kbase = r32 * 128, kx = r32 & 7;
    const int q4 = (lane & 15) >> 2, vb = ((4 * hi + q4) * 256 + 32 * ((lane >> 4) & 1) + 8 * (lane & 3)) ^ (q4 << 6);
    const int sb_ = ((8 * hi + q4) * 256 + 32 * ((lane >> 4) & 1) + 8 * (lane & 3)) ^ (q4 << 6);
    const LAS unsigned char* St = lds + 73728;
    LAS unsigned char* ep = lds + 90112 + wave * 4608;
    const int nper = (2 * 128 + G - 1) / G;
    for (int it = bx * nper; it < (bx + 1) * nper && it < 256; ++it) {
        const int bh = it >> 1, qb0 = 4 * (it & 1), b = bh >> 3, h = bh & 7, kt_end = 4 * qb0 + 15;
        const size_t rbase = (size_t)b * SEQ;
        const float lg2 = log2f(1.f - exp2f(-5.f - (float)h));
        if (qb0 > 0) RET_STAGES(qb0);
        RET_STAGE(4 * qb0, 0); RET_STAGE(4 * qb0 + 1, 1);
        int st = 0;
        WAIT_BAR(3);
        for (int qb = qb0; qb < qb0 + 4; ++qb) {
            const int q0w = qb * 256 + 32 * wave, my_kt = q0w >> 6, n = q0w + r32;
            bf16x8 qf[4];
#pragma unroll
            for (int ks = 0; ks < 4; ++ks) qf[ks] = *(const bf16x8*)(Q + (rbase + n) * 512 + h * 64 + 16 * ks + 8 * hi);
            f32x16 o[4] = {{}, {}, {}, {}};
            if (qb > 0) {
#pragma unroll
                for (int ks = 0; ks < 4; ++ks) {
#pragma unroll
                    for (int dt = 0; dt < 4; ++dt) { const LAS unsigned char* sp = St + (sb_ ^ (dt << 6)) + ks * 4096;
                        const s16x4 a0 = vtr(sp), a1 = vtr(sp + 4 * 256);
                        o[dt] = MFMA32(((bf16x8){a0[0], a0[1], a0[2], a0[3], a1[0], a1[1], a1[2], a1[3]}), qf[ks], o[dt]); }
                    __builtin_amdgcn_sched_barrier(0);
                }
                const float qs = exp2f(lg2 * (float)(32 * wave + r32 + 1));
#pragma unroll
                for (int dt = 0; dt < 4; ++dt)
#pragma unroll
                    for (int r = 0; r < 16; ++r) o[dt][r] *= qs;
            }
#define RET_STEP(BODY) do { const int kt = 4 * qb + t; \
                int st2 = st + 2; if (st2 >= 3) st2 -= 3; \
                if (t == 3 && qb + 1 < qb0 + 4) RET_STAGES(qb + 1);     \
                if (kt + 2 <= kt_end) RET_STAGE(kt + 2, st2); \
                BODY; \
                if (kt + 2 <= kt_end) WAIT_BAR(3); else WAIT_BAR(0); \
                st = st + 1; if (st >= 3) st = 0; } while (0)
            { const int cw = wave >> 1; int t = 0;
              for (; t < cw; ++t) RET_STEP(ret_tile<false>(lds + st * 24576, lds + st * 24576 + 8192, qf, o, lg2, kt, my_kt, n, hi, kbase, kx, vb));
              RET_STEP(ret_tile<true>(lds + st * 24576, lds + st * 24576 + 8192, qf, o, lg2, kt, my_kt, n, hi, kbase, kx, vb)); ++t;
              for (; t < 4; ++t) RET_STEP((void)0); }
#undef RET_STEP
            float ss = 0.f;
#pragma unroll
            for (int dt = 0; dt < 4; ++dt)
#pragma unroll
                for (int r = 0; r < 16; ++r) ss += o[dt][r] * o[dt][r];
            ss += __shfl_xor(ss, 32);
            const float rstd = 1.f / sqrtf(ss * (1.f / 128.f) + EPS);
#pragma unroll
            for (int half = 0; half < 2; ++half) {
#pragma unroll
                for (int dtl = 0; dtl < 2; ++dtl)
#pragma unroll
                    for (int g4 = 0; g4 < 4; ++g4) { const f32x16& od = o[2 * half + dtl];
                        *(LAS unsigned long long*)(ep + r32 * 144 + (32 * dtl + 8 * g4 + 4 * hi) * 2) =
                            (unsigned long long)cvtpk_s(od[4 * g4] * rstd, od[4 * g4 + 1] * rstd) | ((unsigned long long)cvtpk_s(od[4 * g4 + 2] * rstd, od[4 * g4 + 3] * rstd) << 32); }
#pragma unroll
                for (int i = 0; i < 4; ++i) { const int row = (lane >> 3) + 8 * i, e = 64 * half + (lane & 7) * 8;
                    const v4u y = *(const LAS v4u*)(ep + row * 144 + (lane & 7) * 16);
                    const size_t go = (rbase + q0w + row) * 1024 + h * 128 + e;
                    const v4u rg = *(const v4u*)(RG + go); const f32x4 g0 = *(const f32x4*)(gn + h * 128 + e), g1 = *(const f32x4*)(gn + h * 128 + e + 4);
                    f32x4 v0, v1;
                    v0[0] = bflo(y.x) * g0[0] * bflo(rg.x); v0[1] = bfhi(y.x) * g0[1] * bfhi(rg.x); v0[2] = bflo(y.y) * g0[2] * bflo(rg.y); v0[3] = bfhi(y.y) * g0[3] * bfhi(rg.y);
                    v1[0] = bflo(y.z) * g1[0] * bflo(rg.z); v1[1] = bfhi(y.z) * g1[1] * bfhi(rg.z); v1[2] = bflo(y.w) * g1[2] * bflo(rg.w); v1[3] = bfhi(y.w) * g1[3] * bfhi(rg.w);
                    *(v4u*)(Y + go) = pack8(v0, v1); }
            }
        }
    }
#undef RET_STAGE
#undef RET_STAGES
}

__device__ __forceinline__ void p_route(const Args& a, LAS unsigned char* lds, int vcu, int G, int wave, int lane, int tid) {
    const float* h = a.out; const bf16* wrt = (const bf16*)(a.ws + WS_WRT); const float* bg = a.in[11]; const float* be = a.in[13];
    TokInfo* tinfo = (TokInfo*)(a.ws + (a.rep ? WS_PROBE : WS_TOK)); int* perm = (int*)(a.ws + (a.rep ? WS_PROBE + 4 * MiB : WS_PERM));
    unsigned* cnt = (unsigned*)(a.ws + WS_CTL) + (a.rep ? CW_CNT + 4096 : CW_CNT);
    const int r32 = lane & 31, hi = lane >> 5, kh = wave & 1, pair = wave >> 1;
    LAS float* xch = (LAS float*)lds + pair * 64 * 17;
    const int ntask = T / 32, tstride = G * 4, nround = (ntask + tstride - 1) / tstride;
    for (int rd = 0; rd < nround; ++rd) {
        const int task = rd * tstride + vcu * 4 + pair; const bool valid = task < ntask;
        const int t0 = (valid ? task : 0) * 32;
        const float* xp = h + (size_t)(t0 + r32) * DM + kh * 512 + 8 * hi;
        const bf16* ahp = wrt + r32 * 1024 + kh * 512 + 8 * hi;
        f32x16 acc = {}; float ss = 0.f;
#pragma unroll 4
        for (int ks = 0; ks < 32; ++ks) {
            const f32x4 x0 = *(const f32x4*)(xp + 16 * ks), x1 = *(const f32x4*)(xp + 16 * ks + 4);
            ss += (x0[0] * x0[0] + x0[1] * x0[1]) + (x0[2] * x0[2] + x0[3] * x0[3]) + (x1[0] * x1[0] + x1[1] * x1[1]) + (x1[2] * x1[2] + x1[3] * x1[3]);
            v4u wh, wl;
            wh.x = cvtpk_s(x0[0], x0[1]); wh.y = cvtpk_s(x0[2], x0[3]); wh.z = cvtpk_s(x1[0], x1[1]); wh.w = cvtpk_s(x1[2], x1[3]);
            wl.x = cvtpk_s(x0[0] - bflo(wh.x), x0[1] - bfhi(wh.x)); wl.y = cvtpk_s(x0[2] - bflo(wh.y), x0[3] - bfhi(wh.y));
            wl.z = cvtpk_s(x1[0] - bflo(wh.z), x1[1] - bfhi(wh.z)); wl.w = cvtpk_s(x1[2] - bflo(wh.w), x1[3] - bfhi(wh.w));
            const bf16x8 bh_ = __builtin_bit_cast(bf16x8, wh), bl_ = __builtin_bit_cast(bf16x8, wl);
            const bf16x8 ah = *(const bf16x8*)(ahp + 16 * ks), al = *(const bf16x8*)(ahp + 32 * 1024 + 16 * ks);
            acc = MFMA32(ah, bh_, acc); acc = MFMA32(ah, bl_, acc); acc = MFMA32(al, bh_, acc);
        }
        if (kh == 1) {
#pragma unroll
            for (int r = 0; r < 16; ++r) xch[lane * 17 + r] = acc[r];
            xch[lane * 17 + 16] = ss; }
        __syncthreads();
        if (kh == 0) {
#pragma unroll
            for (int r = 0; r < 16; ++r) acc[r] += xch[lane * 17 + r];
            ss += xch[lane * 17 + 16];
            ss += __shfl_xor(ss, 32);
            const float rstd = 1.f / sqrtf(ss * (1.f / DM) + EPS);
            float gl[4];
#pragma unroll
            for (int o = 0; o < 4; ++o) gl[o] = acc[o] * rstd + bg[o];
            int gi = 0; float gm = gl[0];
#pragma unroll
            for (int o = 1; o < 4; ++o) if (gl[o] > gm) { gm = gl[o]; gi = o; }
            float gs = 0.f;
#pragma unroll
            for (int o = 0; o < 4; ++o) gs += __expf(gl[o] - gm);
            const float pgrp = 1.f / gs;
            const bool owner = valid && (hi == (gi & 1));
            float el[4];
#pragma unroll
            for (int e = 0; e < 4; ++e) el[e] = ((gi >> 1) ? acc[8 + e] : acc[4 + e]) * rstd + be[4 * gi + e];
            int i1 = 0; float m1 = el[0];
#pragma unroll
            for (int e = 1; e < 4; ++e) if (el[e] > m1) { m1 = el[e]; i1 = e; }
            int i2 = -1; float m2 = -3.0e38f;
#pragma unroll
            for (int e = 0; e < 4; ++e) if (e != i1 && el[e] > m2) { m2 = el[e]; i2 = e; }
            const float s1 = 1.f / (1.f + __expf(m2 - m1)), g1 = s1 * pgrp, g2 = (1.f - s1) * pgrp;
            const int pa = i1 < i2 ? i1 : i2, pb = i1 < i2 ? i2 : i1;
            const float ga = i1 < i2 ? g1 : g2, gb = i1 < i2 ? g2 : g1;
            const int pidx = pa == 0 ? pb - 1 : (pa == 1 ? pb + 1 : 5);
            const int my_cls = owner ? gi * 6 + pidx : -1;
            int my_pos = 0;
            for (int c = 0; c < NCLS; ++c) {
                const unsigned long long mask = __ballot(my_cls == c);
                if (mask) { const int nn = __popcll(mask), leader = __ffsll((long long)mask) - 1; unsigned bse = 0;
                    if (lane == leader) bse = __hip_atomic_fetch_add(cnt + 64 * c, (unsigned)nn, __ATOMIC_RELAXED, __HIP_MEMORY_SCOPE_AGENT);
                    bse = __shfl(bse, leader);
                    if (my_cls == c) my_pos = (int)bse + __popcll(mask & ((1ull << lane) - 1ull)); }
            }
            if (owner) { const int t = t0 + r32; tinfo[t] = TokInfo{ga, gb, rstd, my_cls}; perm[(size_t)my_cls * T + my_pos] = t; }
        }
        __syncthreads();
    }
}
__device__ __forceinline__ void build_class_table(const Args& a, volatile LAS int* tab, int tid) {
    if (tid == 0) { const unsigned* cnt = (const unsigned*)(a.ws + WS_CTL) + CW_CNT; int acc_ = 0;
        for (int c = 0; c < NCLS; ++c) { tab[c] = acc_; const int n = (int)__hip_atomic_load(cnt + 64 * c, __ATOMIC_RELAXED, __HIP_MEMORY_SCOPE_AGENT); tab[32 + c] = n; acc_ += (n + 255) >> 8; }
        tab[NCLS] = acc_; }
    __syncthreads();
}
__device__ __forceinline__ void p_final(const Args& a, int vcu, int G, int wave, int lane) {
    float* h = a.out; const float* gf = a.in[17];
    const int gw = vcu * NWAVES + wave, NGW = G * NWAVES;
    f32x4 gv[4];
#pragma unroll
    for (int j = 0; j < 4; ++j) gv[j] = ((const f32x4*)gf)[lane + 64 * j];
    for (int t = gw; t < T; t += NGW) {
        GAS f32x4* xr = (GAS f32x4*)(h + (size_t)t * DM) + lane;
        f32x4 v[4]; float s = 0.f;
#pragma unroll
        for (int j = 0; j < 4; ++j) { v[j] = xr[64 * j]; s += (v[j].x * v[j].x + v[j].y * v[j].y) + (v[j].z * v[j].z + v[j].w * v[j].w); }
        const float rstd = 1.f / sqrtf(wave_sum(s) * (1.f / DM) + EPS);
#pragma unroll
        for (int j = 0; j < 4; ++j) xr[64 * j] = v[j] * rstd * gv[j];
    }
}

#ifndef PROBE_MASK
#define PROBE_MASK 0
#endif
#ifndef MK_ONE_LAUNCH
#if PROBE_MASK
#define MK_ONE_LAUNCH 0
#else
#define MK_ONE_LAUNCH 1
#endif
#endif
constexpr int NPHASE = 9;
__global__ void __launch_bounds__(NTHR, 2) fwd_kernel(Args args) {
    extern __shared__ __attribute__((aligned(16))) unsigned char lds_raw[];
    LAS unsigned char* lds = (LAS unsigned char*)lds_raw;
    volatile LAS unsigned* MISC = (volatile LAS unsigned*)(lds + MISC_OFF);
    volatile LAS int* tab = (volatile LAS int*)(lds + TAB_OFF);
    const int tid = threadIdx.x, lane = tid & 63, wave = __builtin_amdgcn_readfirstlane(tid >> 6);
    const int G = gridDim.x; const int bx = blockIdx.x; const int vcu = (G % 8 == 0) ? (bx % 8) * (G / 8) + bx / 8 : bx;
    unsigned char* ws = args.ws;
    for (int u = tid; u < (LDS_BYTES - LDSCTL_OFF) / 4; u += NTHR) ((LAS unsigned*)(lds + LDSCTL_OFF))[u] = 0u;
    __syncthreads();
    XcdBarrier bar; bar.bar = (unsigned*)(ws + WS_CTL) + CW_BAR; bar.x = 0; bar.st = nullptr;
    if (MK_ONE_LAUNCH) bar = xcd_barrier_post((unsigned*)(ws + WS_CTL) + CW_BAR, MISC + 8);
    const int lo = args.ph_lo, hi = args.ph_hi;
#define IN(k) (lo <= (k) && (k) < hi)
#define SEAM(k) do { if (MK_ONE_LAUNCH && IN(k) && IN((k) + 1)) xcd_barrier(bar); } while (0)
    bf16* W1 = (bf16*)(ws + WS_W1); bf16* XN = (bf16*)(ws + WS_R1); bf16* YRET = (bf16*)(ws + WS_R1); bf16* HIDS = (bf16*)(ws + WS_R1);
    bf16* SBQ = (bf16*)(ws + WS_SBQ); bf16* SBK = (bf16*)(ws + WS_SBK); bf16* SBV = (bf16*)(ws + WS_SBV); bf16* RQ = (bf16*)(ws + WS_RQ); bf16* RK = (bf16*)(ws + WS_RK);
    bf16* RV = (bf16*)(ws + WS_RV); bf16* RG = (bf16*)(ws + WS_RG); bf16* YSB = (bf16*)(ws + WS_YSB); bf16* GATES = (bf16*)args.out;
    bf16* MIX = (bf16*)(ws + WS_MIX); bf16* HB = (bf16*)(ws + WS_HB);
    volatile LAS int* rowtok = (volatile LAS int*)(lds + 131072);

    if (IN(0)) { p0_prologue(args, lds, vcu, G, wave, lane); }
    SEAM(0);
    if (IN(1)) {
        pg8::StaticOrder S; S.init(XN, W1, T, N1, 1024, G, bx);
        Epi1 E{SBQ, SBK, SBV, RQ, RK, RV, RG, GATES, args.in[4], (const float*)(ws + WS_ROT), args.rep};
        pg8::gemm_phase<Epi1, pg8::StaticOrder, true, true>(lds, 1024, S, E);
    }
    SEAM(1);
    if (IN(2)) {
        const int nret = G >> 1;
#ifdef PROBE_ABL
        if (args.rep) { if (PROBE_ABL == 1) { if (bx < nret) kv_chain(RK, RV, (bf16*)(ws + WS_KV), lds, bx, nret, tid, wave, lane); }
                        else { sb_phase(SBQ, SBK, SBV, YSB, lds, bx, G, tid, wave, lane, true); } } else
#endif
        {
        if (bx < nret) kv_chain(RK, RV, (bf16*)(ws + WS_KV), lds, bx, nret, tid, wave, lane);
        if (G == 256) { for (int k = 0; k < (bx < nret ? 3 : 5); ++k) { const int u = bx < nret ? 8 * bx + k : 8 * (bx - nret) + 3 + k; sb_phase(SBQ, SBK, SBV, YSB, lds, u, 1 << 20, tid, wave, lane); } }
        else sb_phase(SBQ, SBK, SBV, YSB, lds, bx, G, tid, wave, lane);
        }
    }
    SEAM(2);
    if (IN(3)) { ret_phase(RQ, RK, RV, RG, args.in[7], (const bf16*)(ws + WS_KV), YRET, lds, bx, G, tid, wave, lane); }
    SEAM(3);
    if (IN(4)) {
        CatOrder S; S.init(YSB, ws + WS_WCAT, T, 1024, 1536, G, bx); S.A2 = (const char*)YRET; S.K1 = 512; S.K2 = 1024;
        EpiMixCat E{GATES, MIX};
        pg8::gemm_phase<EpiMixCat, CatOrder, true, true, false, 8>(lds, 1536, S, E, 512, 1024);
    }
    SEAM(4);
    if (IN(5)) {
        pg8::StaticOrder S; S.init(MIX, ws + WS_WOUT, T, 1024, 1024, G, bx);
        EpiOut E{args.in[0], args.out, HB};
        pg8::gemm_phase<EpiOut, pg8::StaticOrder, true, true>(lds, 1024, S, E);
    }
    SEAM(5);
    if (IN(6)) { p_route(args, lds, vcu, G, wave, lane, tid); }
    SEAM(6);
    if (IN(7)) {
        build_class_table(args, tab, tid);
        MoeOrder S{(const char*)HB, (const char*)(ws + WS_WUP), tab, rowtok, 8, 1, G, bx};
        S.build((const int*)(ws + WS_PERM), tid);
        EpiUp E{(const TokInfo*)(ws + WS_TOK), rowtok, HIDS};
        pg8::gemm_phase<EpiUp, MoeOrder, true, true, true>(lds, 1024, S, E);
    }
    SEAM(7);
    if (IN(8)) {
        build_class_table(args, tab, tid);
        MoeOrder S{(const char*)HIDS, (const char*)(ws + WS_WDN), tab, rowtok, 4, 0, G, bx};
        S.build((const int*)(ws + WS_PERM), tid);
        EpiDown E{rowtok, args.out, args.in[17], (float*)(ws + WS_XBUF), (unsigned*)(ws + WS_CTL) + CW_ROWT, lds + 131072 + 6144};
        pg8::gemm_phase<EpiDown, MoeOrder, true, true>(lds, 1024, S, E);
    }
#undef IN
#undef SEAM
}

extern "C" void kernel_launch(void* const* d_in, const int* in_sizes, int n_in, void* d_out, int out_size, void* d_ws, size_t ws_size, hipStream_t stream) {
    static int grid = 0;
    if (grid == 0) {
        if (n_in != 18 || in_sizes[0] != T * DM || out_size != T * DM || ws_size < WS_END) { fprintf(stderr, "kernel_launch: unexpected shapes (n_in %d, in0 %d, out %d, ws %zu < %zu)\n", n_in, n_in > 0 ? in_sizes[0] : -1, out_size, ws_size, (size_t)WS_END); grid = -1; return; }
        int dev = 0, cus = 0, per_cu = 0;
        if (hipGetDevice(&dev) != hipSuccess || hipDeviceGetAttribute(&cus, hipDeviceAttributeMultiprocessorCount, dev) != hipSuccess) { grid = -1; return; }
        if (hipFuncSetAttribute((const void*)fwd_kernel, hipFuncAttributeMaxDynamicSharedMemorySize, LDS_BYTES) != hipSuccess) { fprintf(stderr, "kernel_launch: hipFuncSetAttribute failed\n"); grid = -1; return; }
        if (hipOccupancyMaxActiveBlocksPerMultiprocessor(&per_cu, (const void*)fwd_kernel, NTHR, LDS_BYTES) != hipSuccess || per_cu < 1) fprintf(stderr, "kernel_launch: occupancy query reports %d\n", per_cu);
        (void)hipGetLastError();
        grid = cus;
    }
    if (grid < 0) return;
    hipMemsetAsync((char*)d_ws + WS_CTL, 0, CTL_ZERO_BYTES, stream);
    Args a{};
    for (int i = 0; i < 18; ++i) a.in[i] = (const float*)d_in[i];
    a.out = (float*)d_out; a.ws = (unsigned char*)d_ws;
#if MK_ONE_LAUNCH
    a.ph_lo = 0; a.ph_hi = NPHASE;
    hipLaunchKernelGGL(fwd_kernel, dim3(grid), dim3(NTHR), LDS_BYTES, stream, a);
#else
    for (int p = 0; p < NPHASE; ++p) for (int rep = 0; rep < ((PROBE_MASK >> p) & 1) + 1; ++rep) { a.ph_lo = p; a.ph_hi = p + 1; a.rep = rep; hipLaunchKernelGGL(fwd_kernel, dim3(grid), dim3(NTHR), LDS_BYTES, stream, a); }
#endif
}
```

```cpp
#include <hip/hip_runtime.h>
#include <cstdio>
#include <cstdint>
namespace pg8 {
#define PG8_LAS __attribute__((address_space(3)))
typedef unsigned short bf16_t;
typedef short bf16x8 __attribute__((ext_vector_type(8)));
typedef float f32x4 __attribute__((ext_vector_type(4)));
typedef unsigned u32x4 __attribute__((ext_vector_type(4)));
constexpr int BM = 256, BK = 64, HALF = 128, HTB = HALF * BK * 2  , STAGE_BYTES = 8 * HTB, NXCD = 8, WGM = 8;
__host__ __device__ __forceinline__ int lds_byte(int r, int c) { const int st = (r >> 4) * 2 + (c >> 5), rr = r & 15, cc = c & 31, ob = rr * 64 + cc * 2; return st * 1024 + (ob ^ (((ob >> 9) & 1) << 5)); }
__host__ __device__ __forceinline__ void stage_rc(int b, int& R, int& C) { const int st = b / 1024, sb = b % 1024, swz = sb ^ (((sb >> 9) & 1) << 5); R = (st >> 1) * 16 + swz / 64; C = (st & 1) * 32 + (swz % 64) / 2; }
__host__ __device__ __forceinline__ int perm32(int rho) { const int n = rho >> 4, i = rho & 15; return 8 * (i >> 2) + 4 * n + (i & 3); }

struct Unit { const char* a; const char* b; const char* a2; int row0, col0, tag, idx; };
struct StaticOrder {
    const char* A; const char* Bt; int K, nM, nN, nwg, G, c;
    __device__ void init(const void* A_, const void* Bt_, int M, int N, int K_, int G_, int c_) { A = (const char*)A_; Bt = (const char*)Bt_; K = K_; nM = M / BM; nN = N / BM; nwg = nM * nN; G = G_; c = c_; }
    __device__ bool next(int i, Unit& u) const {
        const long L = (long)i * G + c; if (L >= nwg) return false;
        int wgid = (int)L; { const int q = nwg / NXCD, r = nwg % NXCD, xcd = wgid % NXCD, off = wgid / NXCD; wgid = (xcd < r ? xcd * (q + 1) : r * (q + 1) + (xcd - r) * q) + off; }
        const int nig = WGM * nN, gid = wgid / nig, fm = gid * WGM, gsz = (nM - fm) < WGM ? (nM - fm) : WGM;
        const int pm = fm + ((wgid % nig) % gsz), pn = (wgid % nig) / gsz;
        u.a = A + (size_t)pm * BM * K * 2; u.a2 = nullptr; u.b = Bt + (size_t)pn * BM * K * 2; u.row0 = pm * BM; u.col0 = pn * BM; u.tag = pn; u.idx = i; return true;
    }
    __device__ __forceinline__ void a_ready(const Unit&) const {}
    __device__ __forceinline__ void done(const Unit&) const {}
};
__device__ __forceinline__ unsigned cvt_pk_bf16(float lo, float hi) { unsigned r; asm volatile("v_cvt_pk_bf16_f32 %0, %1, %2" : "=v"(r) : "v"(lo), "v"(hi)); return r; }
template <class Epi, class Sched, bool ALIGN_EPI = false, bool SP2 = false, bool GATHER = false, int KSPLIT = 0, bool HALFSKIP = false>
__device__ __forceinline__ void gemm_phase(PG8_LAS unsigned char* lds, const int K, const Sched& S, const Epi& E, const int ka1 = 0, const int ka2 = 0) {
    const int tid = threadIdx.x, wid = __builtin_amdgcn_readfirstlane(tid >> 6), lane = tid & 63, wr = wid >> 2, wc = wid & 3, fr = lane & 15, fq = lane >> 4;
    const int nt = K / BK;
    static_assert(!GATHER || SP2, "GATHER is implemented on the SP2 loop only");
    unsigned voffA[2], voffA1[2], voffB[2]; int Rr[2], Cc[2];
#pragma unroll
    for (int i = 0; i < 2; ++i) { int R, C; stage_rc(tid * 16 + i * 8192, R, C); const int Rb = Epi::PERM ? ((R & ~31) + perm32(R & 31)) : R; Rr[i] = R; Cc[i] = C;
        const int KA = KSPLIT ? ka1 : K;
        voffA[i] = (unsigned)(R * KA + C) * 2u; voffA1[i] = 0u; voffB[i] = (unsigned)(Rb * K + C) * 2u; }
    unsigned voffAs[2] = {0u, 0u};
    if constexpr (KSPLIT != 0) {
#pragma unroll
        for (int i = 0; i < 2; ++i) voffAs[i] = (unsigned)(Rr[i] * ka2 + Cc[i]) * 2u; }
    const size_t hs1 = GATHER ? 0 : (size_t)HALF * (KSPLIT ? ka1 : K) * 2, hs2 = (size_t)HALF * ka2 * 2;
#define PG8_AROWS(ui_, v0_, v1_) do { _Pragma("unroll") for (int i_ = 0; i_ < 2; ++i_) { \
        v0_[i_] = (unsigned)(S.arow((ui_), Rr[i_]) * K + Cc[i_]) * 2u; v1_[i_] = (unsigned)(S.arow((ui_), Rr[i_] + HALF) * K + Cc[i_]) * 2u; } } while (0)
    const size_t kstep = (size_t)(BK * 2);
    const size_t hstep = (size_t)HALF * K * 2;
    const size_t tstep = 2 * hstep;
    const unsigned ldsw = (unsigned)wid * 1024u;
    const int aoff = lds_byte(wr * 64 + fr, fq * 8), boff = lds_byte(wc * 32 + fr, fq * 8);
#define PG8_SA(b, h) (((b) * 2 + (h)) * HTB)
#define PG8_SB(b, h) ((4 + (b) * 2 + (h)) * HTB)
#define PG8_STAGE(bufoff, gbase, voff) do { _Pragma("unroll") for (int _i = 0; _i < 2; ++_i) \
        __builtin_amdgcn_global_load_lds((const unsigned*)((const char*)(gbase) + (voff)[_i]), (PG8_LAS unsigned*)(lds + (bufoff) + ldsw + _i * 8192), 16, 0, 0); } while (0)
#define PG8_LDA(dst, b, h) do { _Pragma("unroll") for (int m = 0; m < 4; ++m) _Pragma("unroll") for (int k = 0; k < 2; ++k) dst[m][k] = *(const PG8_LAS bf16x8*)(lds + PG8_SA(b, h) + aoff + m * 2048 + k * 1024); } while (0)
#define PG8_LDB(dst, b, h) do { _Pragma("unroll") for (int n = 0; n < 2; ++n) _Pragma("unroll") for (int k = 0; k < 2; ++k) dst[n][k] = *(const PG8_LAS bf16x8*)(lds + PG8_SB(b, h) + boff + n * 2048 + k * 1024); } while (0)
#define PG8_MMA(ai, bj, At, Bt) do { __builtin_amdgcn_s_setprio(1); _Pragma("unroll") for (int m = 0; m < 4; ++m) _Pragma("unroll") for (int n = 0; n < 2; ++n) _Pragma("unroll") for (int k = 0; k < 2; ++k) \
        acc[ai][bj][m][n] = __builtin_amdgcn_mfma_f32_16x16x32_bf16(Bt[n][k], At[m][k], acc[ai][bj][m][n], 0, 0, 0); __builtin_amdgcn_s_setprio(0); } while (0)
#define PG8_WAIT_V(n) asm volatile("s_waitcnt vmcnt(" #n ")" ::: "memory")
#define PG8_WAIT_L(n) asm volatile("s_waitcnt lgkmcnt(" #n ")" ::: "memory")
#define PG8_BAR __builtin_amdgcn_s_barrier()
#define PG8_SCHED __builtin_amdgcn_sched_barrier(0)
    Unit cur, nxt; int ui = 0;
    if (!S.next(0, cur)) return;
    f32x4 acc[2][2][4][2];
#pragma unroll
    for (int a = 0; a < 2; ++a)
#pragma unroll
        for (int b = 0; b < 2; ++b)
#pragma unroll
            for (int m = 0; m < 4; ++m)
#pragma unroll
                for (int n = 0; n < 2; ++n) acc[a][b][m][n] = (f32x4){0.f, 0.f, 0.f, 0.f};
    bf16x8 At[4][2], B0[2][2], B1[2][2];
    const char* cA = cur.a; const char* cB = cur.b;
    S.a_ready(cur);
    if constexpr (SP2) {
        if constexpr (GATHER) PG8_AROWS(0, voffA, voffA1);
        PG8_STAGE(PG8_SB(0, 0), cB, voffB); PG8_STAGE(PG8_SB(0, 1), cB + hstep, voffB); PG8_STAGE(PG8_SA(0, 0), cA, voffA); if constexpr (GATHER) PG8_STAGE(PG8_SA(0, 1), cA, voffA1); else PG8_STAGE(PG8_SA(0, 1), cA + hs1, voffA);
        if (wr == 1) PG8_BAR;
        PG8_WAIT_V(2); PG8_BAR;
        PG8_STAGE(PG8_SB(1, 0), cB + kstep, voffB); PG8_STAGE(PG8_SA(1, 0), cA + kstep, voffA); PG8_STAGE(PG8_SB(1, 1), cB + hstep + kstep, voffB);
        PG8_WAIT_V(6); PG8_BAR;
    } else {
        PG8_STAGE(PG8_SB(0, 0), cB, voffB); PG8_STAGE(PG8_SA(0, 0), cA, voffA); PG8_STAGE(PG8_SB(0, 1), cB + hstep, voffB); PG8_STAGE(PG8_SA(0, 1), cA + hstep, voffA);
        if (wr == 1) PG8_BAR;
        PG8_WAIT_V(4); PG8_BAR;
        PG8_STAGE(PG8_SB(1, 0), cB + kstep, voffB); PG8_STAGE(PG8_SA(1, 0), cA + kstep, voffA); PG8_STAGE(PG8_SB(1, 1), cB + hstep + kstep, voffB);
        PG8_WAIT_V(6); PG8_BAR;
    }
    for (;;) {
        const bool has_next = S.next(ui + 1, nxt);
        const char* nA = has_next ? nxt.a : cA; const char* nB = has_next ? nxt.b : cB;
        const bool halfu = HALFSKIP && (cur.tag & 32) != 0;
        for (int t = 0; t < nt; t += 2) {
            const bool last = (t == nt - 2);
            const bool s1 = KSPLIT != 0 && t + 1 >= KSPLIT, s2 = KSPLIT != 0 && !last && t + 2 >= KSPLIT;
            if constexpr (KSPLIT != 0) { if (t == KSPLIT) E.mid(acc, cur, wr, wc, fr, fq); }
            const char* a1 = s1 ? cur.a2 + (size_t)(t + 1 - KSPLIT) * kstep : cA + (size_t)(t + 1) * kstep;
            const char* a2 = last ? nA : (s2 ? cur.a2 + (size_t)(t + 2 - KSPLIT) * kstep : cA + (size_t)(t + 2) * kstep); const char* b2 = last ? nB : cB + (size_t)(t + 2) * kstep;
            const char* a3 = a2 + kstep; const char* b3 = b2 + kstep;
            if (last && has_next) S.a_ready(nxt);
            unsigned vx0[2], vx1[2], vy1[2];
#pragma unroll
            for (int i = 0; i < 2; ++i) { vx0[i] = s2 ? voffAs[i] : voffA[i]; vx1[i] = GATHER ? voffA1[i] : vx0[i]; vy1[i] = GATHER ? voffA1[i] : (s1 ? voffAs[i] : voffA[i]); }
            if constexpr (GATHER) { if (last && has_next) PG8_AROWS(ui + 1, vx0, vx1); }
            const size_t hy1 = s1 ? hs2 : hs1, hx1 = s2 ? hs2 : hs1;
            if constexpr (SP2) {
            PG8_LDB(B0, 0, 0); PG8_LDB(B1, 0, 1); PG8_SCHED; PG8_LDA(At, 0, 0); PG8_STAGE(PG8_SA(1, 1), a1 + hy1, vy1);
            PG8_WAIT_V(8); PG8_WAIT_L(0); PG8_BAR; PG8_MMA(0, 0, At, B0); PG8_MMA(0, 1, At, B1); PG8_BAR; PG8_SCHED;
            PG8_LDA(At, 0, 1); PG8_STAGE(PG8_SB(0, 0), b2, voffB); PG8_STAGE(PG8_SB(0, 1), b2 + hstep, voffB); PG8_STAGE(PG8_SA(0, 0), a2, vx0);
            PG8_WAIT_V(8); PG8_WAIT_L(0); PG8_BAR; if (!halfu) { PG8_MMA(1, 0, At, B0); PG8_MMA(1, 1, At, B1); } PG8_BAR; PG8_SCHED;
            PG8_LDB(B0, 1, 0); PG8_LDB(B1, 1, 1); PG8_SCHED; PG8_LDA(At, 1, 0); PG8_STAGE(PG8_SA(0, 1), a2 + hx1, vx1);
            PG8_WAIT_V(8); PG8_WAIT_L(0); PG8_BAR; PG8_MMA(0, 0, At, B0); PG8_MMA(0, 1, At, B1); PG8_BAR; PG8_SCHED;
            PG8_LDA(At, 1, 1); PG8_STAGE(PG8_SB(1, 0), b3, voffB); PG8_STAGE(PG8_SB(1, 1), b3 + hstep, voffB); PG8_STAGE(PG8_SA(1, 0), a3, vx0);
            PG8_WAIT_V(8); PG8_WAIT_L(0); PG8_BAR; if (!halfu) { PG8_MMA(1, 0, At, B0); PG8_MMA(1, 1, At, B1); } PG8_BAR; PG8_SCHED;
            } else {
            PG8_LDB(B0, 0, 0); PG8_SCHED; PG8_LDA(At, 0, 0); PG8_STAGE(PG8_SA(1, 1), a1 + hstep, voffA);
            PG8_WAIT_L(8); PG8_BAR; PG8_WAIT_L(0); PG8_MMA(0, 0, At, B0); PG8_BAR; PG8_SCHED;
            PG8_LDB(B1, 0, 1); PG8_STAGE(PG8_SB(0, 0), b2, voffB);
            PG8_BAR; PG8_WAIT_L(0); PG8_MMA(0, 1, At, B1); PG8_BAR;
            PG8_LDA(At, 0, 1); PG8_STAGE(PG8_SA(0, 0), a2, voffA);
            PG8_BAR; PG8_WAIT_L(0); PG8_MMA(1, 0, At, B0); PG8_BAR; PG8_SCHED;
            PG8_STAGE(PG8_SB(0, 1), b2 + hstep, voffB);
            PG8_WAIT_V(6); PG8_BAR; PG8_MMA(1, 1, At, B1); PG8_BAR;
            PG8_LDB(B0, 1, 0); PG8_SCHED; PG8_LDA(At, 1, 0); PG8_STAGE(PG8_SA(0, 1), a2 + hstep, voffA);
            PG8_WAIT_L(8); PG8_BAR; PG8_WAIT_L(0); PG8_MMA(0, 0, At, B0); PG8_BAR; PG8_SCHED;
            PG8_LDB(B1, 1, 1); PG8_STAGE(PG8_SB(1, 0), b3, voffB);
            PG8_BAR; PG8_WAIT_L(0); PG8_MMA(0, 1, At, B1); PG8_BAR;
            PG8_LDA(At, 1, 1); PG8_STAGE(PG8_SA(1, 0), a3, voffA);
            PG8_BAR; PG8_WAIT_L(0); PG8_MMA(1, 0, At, B0); PG8_BAR; PG8_SCHED;
            PG8_STAGE(PG8_SB(1, 1), b3 + hstep, voffB);
            PG8_WAIT_V(6); PG8_BAR; PG8_MMA(1, 1, At, B1); PG8_BAR;
            }
        }
        if constexpr (ALIGN_EPI) { if (wr == 0) PG8_BAR; }
        if constexpr (!Epi::AFTER_DRAIN) { if constexpr (Epi::INPLACE) E.inplace(acc, cur, wr, wc, fr, fq, wid, lane); else E(acc, cur, wr, wc, fr, fq); S.done(cur); }
        if (!has_next) break;
#pragma unroll
        for (int a = 0; a < 2; ++a)
#pragma unroll
            for (int b = 0; b < 2; ++b)
#pragma unroll
                for (int m = 0; m < 4; ++m)
#pragma unroll
                    for (int n = 0; n < 2; ++n) acc[a][b][m][n] = (f32x4){0.f, 0.f, 0.f, 0.f};
        cur = nxt; cA = nA; cB = nB; ++ui;
        if constexpr (GATHER) PG8_AROWS(ui, voffA, voffA1);
        if constexpr (ALIGN_EPI) { if (wr == 1) PG8_BAR; }
    }
    PG8_WAIT_V(0);
    if constexpr (!ALIGN_EPI) { if (wr == 0) PG8_BAR; }
    PG8_BAR;
    if constexpr (Epi::AFTER_DRAIN) { E.fused(acc, cur, wr, wc, fr, fq, lds, wid, lane); S.done(cur); }
#undef PG8_AROWS
#undef PG8_SA
#undef PG8_SB
#undef PG8_STAGE
#undef PG8_LDA
#undef PG8_LDB
#undef PG8_MMA
#undef PG8_WAIT_V
#undef PG8_WAIT_L
#undef PG8_BAR
#undef PG8_SCHED
}
}
#define GAS __attribute__((address_space(1)))
#define LAS __attribute__((address_space(3)))
typedef unsigned short bf16;
typedef unsigned v4u __attribute__((ext_vector_type(4)));
typedef float f32x4 __attribute__((ext_vector_type(4)));
typedef short bf16x8 __attribute__((ext_vector_type(8)));
typedef GAS unsigned gu32;
typedef GAS unsigned long long gu64;
#define RLX_AGENT __ATOMIC_RELAXED, __HIP_MEMORY_SCOPE_AGENT
#define LDS_WAIT() asm volatile("s_waitcnt lgkmcnt(0)" ::: "memory")
#define VM_WAIT() asm volatile("s_waitcnt vmcnt(0)" ::: "memory")
__device__ __forceinline__ unsigned long long rt() { return __builtin_amdgcn_s_memrealtime(); }
__device__ __forceinline__ unsigned f2bf(float f) { unsigned u = __builtin_bit_cast(unsigned, f); return (u + 0x7fffu + ((u >> 16) & 1u)) >> 16; }
__device__ __forceinline__ unsigned pk2(float lo, float hi) { return f2bf(lo) | (f2bf(hi) << 16); }

#define XB_TMO      128
#define XB_XCNT(j)  (256  + 64 * (j))
#define XB_XSUB(j)  (1280 + 64 * (j))
#define XB_XGEN(j)  (2304 + 64 * (j))
#define XB_TOP      3328
#define XB_TOPGEN   3392
#define XCD_BAR_WORDS 3456
#define XB_SPIN_CAP (1u << 18)

__device__ __forceinline__ unsigned xb_ld(unsigned* p)              { return __hip_atomic_load(p, __ATOMIC_RELAXED, __HIP_MEMORY_SCOPE_AGENT); }
__device__ __forceinline__ unsigned xb_add(unsigned* p, unsigned v) { return __hip_atomic_fetch_add(p, v, __ATOMIC_RELAXED, __HIP_MEMORY_SCOPE_AGENT); }
__device__ __forceinline__ unsigned xb_xcc_id() { return (unsigned)__builtin_amdgcn_s_getreg((3 << 11) | 20) & 0xFu; }
#define XB_SPIN(cond, bar) do { unsigned _sp = 0; while (cond) { __builtin_amdgcn_s_sleep(1); \
    if ((++_sp & 255u) == 0u) { if (xb_ld(&(bar)[XB_TMO])) break; if (_sp > XB_SPIN_CAP) { atomicAdd(&(bar)[XB_TMO], 1u); break; } } } } while (0)

struct XcdBarrier {
    unsigned* bar; unsigned x;
    volatile LAS unsigned* st;
};

__device__ __forceinline__ XcdBarrier xcd_barrier_post(unsigned* bar, volatile LAS unsigned* st) {
    XcdBarrier b; b.bar = bar; b.x = xb_xcc_id(); b.st = st;
    if (threadIdx.x == 0) (void)xb_add(&bar[XB_XCNT(b.x)], 1u);
    return b;
}
__device__ __forceinline__ void xcd_barrier_complete(unsigned* bar, unsigned x, unsigned& nloc, unsigned& nx) {
    const unsigned G = gridDim.x * gridDim.y * gridDim.z;
    unsigned sum, cnt, mine, sp = 0u;
    for (;;) {
        sum = 0u; cnt = 0u; mine = 0u;
#pragma unroll
        for (unsigned j = 0; j < 16; ++j) { const unsigned c = xb_ld(&bar[XB_XCNT(j)]); sum += c; cnt += (c > 0u) ? 1u : 0u; mine = (j == x) ? c : mine; }
        if (sum == G) break;
        __builtin_amdgcn_s_sleep(1);
        if ((++sp & 255u) == 0u) { if (xb_ld(&bar[XB_TMO])) break; if (sp > XB_SPIN_CAP) { atomicAdd(&bar[XB_TMO], 1u); break; } }
    }
    nloc = mine > 0u ? mine : 1u; nx = cnt > 0u ? cnt : 1u;
}

__device__ __forceinline__ void xcd_barrier(const XcdBarrier& b) {
    asm volatile("s_waitcnt vmcnt(0)" ::: "memory");
    __syncthreads();
    if (threadIdx.x == 0) {
        unsigned* bar = b.bar;
        __builtin_amdgcn_s_waitcnt(0);
        unsigned nloc = b.st[0], nx = b.st[1];
        if (nloc == 0u) { xcd_barrier_complete(bar, b.x, nloc, nx); b.st[0] = nloc; b.st[1] = nx; }
        const unsigned old = xb_add(&bar[XB_XSUB(b.x)], 1u);
        const unsigned gen = old / nloc;
        if (old + 1u == (gen + 1u) * nloc) {
            __builtin_amdgcn_fence(__ATOMIC_RELEASE, "agent");
            asm volatile("s_waitcnt vmcnt(0)" ::: "memory");
            const unsigned og = xb_add(&bar[XB_TOP], 1u);
            const unsigned tg = og / nx;
            if (og + 1u == (tg + 1u) * nx) xb_add(&bar[XB_TOPGEN], 1u);
            else XB_SPIN(xb_ld(&bar[XB_TOPGEN]) == tg, bar);
            __builtin_amdgcn_fence(__ATOMIC_ACQUIRE, "agent");
            xb_add(&bar[XB_XGEN(b.x)], 1u);
            asm volatile("s_waitcnt vmcnt(0)" ::: "memory");
        } else {
            XB_SPIN(xb_ld(&bar[XB_XGEN(b.x)]) == gen, bar);
            __builtin_amdgcn_fence(__ATOMIC_ACQUIRE, "agent");
            asm volatile("s_waitcnt vmcnt(0)" ::: "memory");
        }
    }
    __syncthreads();
}


constexpr int NWAVES = 8, NTHR = NWAVES * 64;
constexpr int DM = 1024, NB = 16, SEQ = 2048, T = NB * SEQ;
constexpr int N1 = 6656;
constexpr int NCLS = 24, SROWS = T + NCLS * 256;
constexpr float EPS = 1e-6f;
constexpr size_t MiB = 1u << 20;
constexpr size_t WS_CTL = 0, CTL_ZERO_BYTES = 1 * MiB;
constexpr size_t WS_ROT = 1 * MiB;
constexpr size_t WS_WRT = 1 * MiB + 512 * 1024;
constexpr size_t WS_TOK = 2 * MiB;
constexpr size_t WS_RSTD = 2 * MiB + 512 * 1024;
constexpr size_t WS_XBUF = 3 * MiB;
constexpr size_t WS_W1 = 4 * MiB, WS_WCAT = 18 * MiB  , WS_WOUT = 21 * MiB, WS_WUP = 23 * MiB, WS_WDN = 55 * MiB;
constexpr size_t WS_R1 = 104 * MiB;
constexpr size_t WS_SBQ = 168 * MiB, WS_SBK = 200 * MiB, WS_SBV = 232 * MiB, WS_RQ = 264 * MiB, WS_RK = 296 * MiB, WS_RV = 328 * MiB, WS_RG = 392 * MiB, WS_YSB = WS_SBQ;
constexpr size_t WS_MIX = WS_SBV, WS_HB = WS_RG;
constexpr size_t WS_PERM = WS_W1;
constexpr size_t WS_KV = 456 * MiB;
constexpr size_t WS_END = 488 * MiB;
constexpr size_t WS_PROBE = 200 * MiB;
constexpr int CW_BAR = 4096, CW_CNT = 8192, CW_ROWT = 16384, CW_UPD = 32768;
constexpr int LDS_BYTES = 147456;
constexpr int LDSCTL_OFF = LDS_BYTES - 1024, MISC_OFF = LDSCTL_OFF + 320, TAB_OFF = LDSCTL_OFF + 512;

struct TokInfo { float ga, gb, rstd; int cls; };

__device__ __forceinline__ float wave_sum(float v) {
#pragma unroll
    for (int o = 1; o < 64; o <<= 1) v += __shfl_xor(v, o);
    return v;
}
__device__ __forceinline__ float bf2f(unsigned short b) { return __builtin_bit_cast(float, (unsigned)b << 16); }
__device__ __forceinline__ float bflo(unsigned w) { return __builtin_bit_cast(float, w << 16); }
__device__ __forceinline__ float bfhi(unsigned w) { return __builtin_bit_cast(float, w & 0xffff0000u); }

struct Args { const float* in[18]; float* out; unsigned char* ws; int ph_lo, ph_hi, rep, pad; };

struct TJob { const float* W; int N; bf16* WT; int ldk, koff, mode, nbase; const float* gk; };
__device__ __forceinline__ int rowmap(int mode, int n) {
    if (mode == 1) {
        if (n >= 1536 && n < 2560) { const int seg = n < 2048 ? 1536 : 2048, c = n - seg, hh = c >> 6, i = c & 63; return seg + (hh >> 2) * 256 + (i >> 5) * 128 + (hh & 3) * 32 + (i & 31); }
        return n;
    }
    if (mode == 2) return (n >> 7) * 256 + (n & 127);
    if (mode == 3) return (n >> 7) * 256 + 128 + (n & 127);
    return n;
}
__device__ __forceinline__ void p0_transpose_item(const TJob& J, LAS float* scr, int item, int lane) {
    const int nblk = J.N / 32, kb = item / nblk, nb = item % nblk, k0 = 64 * kb, n0 = 32 * nb;
#pragma unroll 8
    for (int i = 0; i < 32; ++i) { const int kk = 2 * i + (lane >> 5); scr[kk * 33 + (lane & 31)] = J.W[(size_t)(k0 + kk) * J.N + n0 + (lane & 31)]; }
    LDS_WAIT(); asm volatile("" ::: "memory");
    const int c = lane & 7;
#pragma unroll
    for (int j = 0; j < 4; ++j) { const int n = (lane >> 3) + 8 * j; const LAS float* s = scr + (8 * c) * 33 + n;
        const int ng = n0 + n; float sc = 1.f; if (J.mode == 1) { if (ng < 512) sc = 0.125f * 1.4426950408889634f; else if (ng >= 2048 && ng < 2560) sc = 0.125f; }
        float g8[8];
#pragma unroll
        for (int q = 0; q < 8; ++q) g8[q] = J.gk ? J.gk[k0 + 8 * c + q] * sc : sc;
        v4u o; o.x = pk2(s[0 * 33] * g8[0], s[1 * 33] * g8[1]); o.y = pk2(s[2 * 33] * g8[2], s[3 * 33] * g8[3]); o.z = pk2(s[4 * 33] * g8[4], s[5 * 33] * g8[5]); o.w = pk2(s[6 * 33] * g8[6], s[7 * 33] * g8[7]);
        *(GAS v4u*)(J.WT + (size_t)(J.nbase + rowmap(J.mode, ng)) * J.ldk + J.koff + k0 + 8 * c) = o; }
    LDS_WAIT(); asm volatile("" ::: "memory");
}
__device__ __forceinline__ void p0_prologue(const Args& a, LAS unsigned char* lds, int vcu, int G, int wave, int lane) {
    unsigned char* ws = a.ws;
    LAS float* scr = (LAS float*)(lds + wave * 16384);
    const int gw = vcu * NWAVES + wave, NGW = G * NWAVES;
    constexpr int I0 = 16 * 144, I1 = 16 * 64, I2 = 8 * 32, I3 = 16 * 32, I4 = 16 * 32, I5 = 16 * 256, I6 = 16 * 256, I7 = 48 * 256;
    constexpr int NITEMS = I0 + I1 + I2 + I3 + I4 + I5 + I6 + I7;
    for (int it = gw; it < NITEMS; it += NGW) {
        int r = it; TJob J;
        if (r < I0) { J = TJob{a.in[2], 4608, (bf16*)(ws + WS_W1), 1024, 0, 1, 0, nullptr}; }
        else if ((r -= I0) < I1) { J = TJob{a.in[3], 2048, (bf16*)(ws + WS_W1), 1024, 0, 0, 4608, nullptr}; }
        else if ((r -= I1) < I2) { J = TJob{a.in[5], 1024, (bf16*)(ws + WS_WCAT), 1536, 0, 0, 0, nullptr}; }
        else if ((r -= I2) < I3) { J = TJob{a.in[6], 1024, (bf16*)(ws + WS_WCAT), 1536, 512, 0, 0, nullptr}; }
        else if ((r -= I3) < I4) { J = TJob{a.in[8], 1024, (bf16*)(ws + WS_WOUT), 1024, 0, 0, 0, nullptr}; }
        else if ((r -= I4) < I5) { const int e = r >> 8; r &= 255; J = TJob{a.in[14] + (size_t)e * 1024 * 512, 512, (bf16*)(ws + WS_WUP) + (size_t)e * 1024 * 1024, 1024, 0, 2, 0, a.in[9]}; }
        else if ((r -= I5) < I6) { const int e = r >> 8; r &= 255; J = TJob{a.in[15] + (size_t)e * 1024 * 512, 512, (bf16*)(ws + WS_WUP) + (size_t)e * 1024 * 1024, 1024, 0, 3, 0, a.in[9]}; }
        else { r -= I6; const int cs = r >> 8; r &= 255; const int cls = cs >> 1, slot = cs & 1, g = cls / 6, p = cls % 6;
            const int pa = p < 3 ? 0 : (p < 5 ? 1 : 2), pb = p == 0 ? 1 : (p == 1 ? 2 : (p == 2 ? 3 : (p == 3 ? 2 : 3)));
            const int e = 4 * g + (slot ? pb : pa);
            J = TJob{a.in[16] + (size_t)e * 512 * 1024, 1024, (bf16*)(ws + WS_WDN) + (size_t)cls * 1024 * 1024, 1024, slot * 512, 0, 0, nullptr}; }
        p0_transpose_item(J, scr, r, lane);
    }
    const float* x = a.in[0]; const float* g = a.in[1]; bf16* xn = (bf16*)(ws + WS_R1);
    f32x4 gv[4];
#pragma unroll
    for (int j = 0; j < 4; ++j) gv[j] = ((const f32x4*)g)[lane + 64 * j];
    for (int m = gw; m < T; m += NGW) {
        const GAS f32x4* xr = (const GAS f32x4*)(x + (size_t)m * DM) + lane;
        f32x4 v[4]; float s = 0.f;
#pragma unroll
        for (int j = 0; j < 4; ++j) { v[j] = xr[64 * j]; s += (v[j].x * v[j].x + v[j].y * v[j].y) + (v[j].z * v[j].z + v[j].w * v[j].w); }
        const float rstd = 1.f / sqrtf(wave_sum(s) * (1.f / DM) + EPS);
        GAS unsigned long long* o8 = (GAS unsigned long long*)(xn + (size_t)m * DM) + lane;
#pragma unroll
        for (int j = 0; j < 4; ++j) { const f32x4 y = v[j] * rstd * gv[j]; o8[64 * j] = (unsigned long long)pk2(y.x, y.y) | ((unsigned long long)pk2(y.z, y.w) << 32); }
    }
    float* rot = (float*)(ws + WS_ROT);
    for (int idx = gw * 64 + lane; idx < SEQ * 32; idx += NGW * 64) {
        const int pos = idx >> 5, i = idx & 31;
        const float inv = (float)exp(-(double)i * (9.210340371976184 / 32.0));
        const float ang = (float)pos * inv;
        rot[idx] = (float)cos((double)ang); rot[SEQ * 32 + idx] = (float)sin((double)ang);
    }
    bf16* wrt = (bf16*)(ws + WS_WRT);
    for (int idx = gw * 64 + lane; idx < 32 * 1024; idx += NGW * 64) {
        const int o = idx >> 10, k = idx & 1023;
        float v = 0.f; if (o < 8) v = a.in[10][k * 4 + (o & 3)]; else if (o < 24) v = a.in[12][k * 16 + (o - 8)];
        v *= a.in[9][k];
        const unsigned hb_ = f2bf(v); const float lo = v - __builtin_bit_cast(float, hb_ << 16);
        wrt[idx] = (bf16)hb_; wrt[32 * 1024 + idx] = (bf16)f2bf(lo);
    }
}

typedef pg8::Unit Unit;
using pg8::cvt_pk_bf16;
__device__ __forceinline__ v4u pack8(const f32x4 a, const f32x4 b) { v4u w; w.x = cvt_pk_bf16(a[0], a[1]); w.y = cvt_pk_bf16(a[2], a[3]); w.z = cvt_pk_bf16(b[0], b[1]); w.w = cvt_pk_bf16(b[2], b[3]); return w; }
__device__ __forceinline__ float sigm(float x) { return 1.f / (1.f + __expf(-x)); }

struct Epi1 {
    static constexpr bool PERM = true, AFTER_DRAIN = false, INPLACE = false;
    bf16 *sbq, *sbk, *sbv, *rq, *rk, *rv, *rg, *gates; const float* bgate; const float* rot; int nostore;
    __device__ __forceinline__ void operator()(const f32x4 (&acc)[2][2][4][2], const Unit& u, int wr, int wc, int fr, int fq) const {
        const int pn = u.tag, rowb = u.row0 + wr * 64 + fr, cw = wc * 32 + 8 * fq;
        if (pn >= 6 && pn < 10) {
            bf16* base = (pn < 8 ? rq : rk) + ((pn & 1) * 4 + wc) * 64 + 8 * fq;
            const int hh_ = (pn & 1) * 4 + wc; const float lg2h = hh_ == 0 ? -4.5803689613e-02f : (hh_ == 1 ? -2.2720076500e-02f : (hh_ == 2 ? -1.1315313228e-02f : (hh_ == 3 ? -5.6465631411e-03f : (hh_ == 4 ? -2.8205190624e-03f : (hh_ == 5 ? -1.4095702547e-03f : (hh_ == 6 ? -7.0461297659e-04f : (-3.5226347163e-04f)))))));
#pragma unroll
            for (int ai = 0; ai < 2; ++ai)
#pragma unroll
                for (int m = 0; m < 4; ++m) { const int row = rowb + ai * 128 + m * 16, pos = row & (SEQ - 1);
                    const f32x4 c0 = *(const f32x4*)(rot + pos * 32 + 8 * fq), c1 = *(const f32x4*)(rot + pos * 32 + 8 * fq + 4);
                    const f32x4 s0 = *(const f32x4*)(rot + SEQ * 32 + pos * 32 + 8 * fq), s1 = *(const f32x4*)(rot + SEQ * 32 + pos * 32 + 8 * fq + 4);
                    const f32x4 x10 = acc[ai][0][m][0], x11 = acc[ai][0][m][1], x20 = acc[ai][1][m][0], x21 = acc[ai][1][m][1];
                    f32x4 o10 = x10 * c0 - x20 * s0, o11 = x11 * c1 - x21 * s1, o20 = x20 * c0 + x10 * s0, o21 = x21 * c1 + x11 * s1;
                    if (pn >= 8) { const float kd = __builtin_amdgcn_exp2f(lg2h * (float)(64 - (pos & 63))); o10 *= kd; o11 *= kd; o20 *= kd; o21 *= kd; }
                    bf16* rowp = base + (size_t)row * 512;
                    const v4u w0 = pack8(o10, o11), w1 = pack8(o20, o21); if (!nostore) { *(v4u*)rowp = w0; *(v4u*)(rowp + 32) = w1; } else asm volatile("" :: "v"(w0), "v"(w1)); }
            return;
        }
        bf16* base; int ld, colt, act = 0;
        if (pn < 2) { base = sbq; ld = 512; colt = pn * 256; } else if (pn < 4) { base = sbk; ld = 512; colt = (pn - 2) * 256; }
        else if (pn < 6) { base = sbv; ld = 512; colt = (pn - 4) * 256; } else if (pn < 14) { base = rv; ld = 1024; colt = (pn - 10) * 256; }
        else if (pn < 18) { base = rg; ld = 1024; colt = (pn - 14) * 256; act = 1; } else { base = gates; ld = 2048; colt = (pn - 18) * 256; act = 2; }
        f32x4 bv[2][2];
#pragma unroll
        for (int bj = 0; bj < 2; ++bj)
#pragma unroll
            for (int n = 0; n < 2; ++n) bv[bj][n] = act == 2 ? *(const f32x4*)(bgate + colt + bj * 128 + cw + 4 * n) : (f32x4){0.f, 0.f, 0.f, 0.f};
#pragma unroll
        for (int ai = 0; ai < 2; ++ai)
#pragma unroll
            for (int m = 0; m < 4; ++m) { bf16* rowp = base + (size_t)(rowb + ai * 128 + m * 16) * ld + colt + cw;
#pragma unroll
                for (int bj = 0; bj < 2; ++bj) { f32x4 v0 = acc[ai][bj][m][0] + bv[bj][0], v1 = acc[ai][bj][m][1] + bv[bj][1];
                    if (act == 1) {
#pragma unroll
                        for (int j = 0; j < 4; ++j) { v0[j] = v0[j] * sigm(v0[j]); v1[j] = v1[j] * sigm(v1[j]); } }
                    else if (act == 2) {
#pragma unroll
                        for (int j = 0; j < 4; ++j) { v0[j] = sigm(v0[j]); v1[j] = sigm(v1[j]); } }
                    const v4u w0 = pack8(v0, v1); if (!nostore) *(v4u*)(rowp + bj * 128) = w0; else asm volatile("" :: "v"(w0)); } }
    }
};
struct EpiMixCat {
    static constexpr bool PERM = true, AFTER_DRAIN = false, INPLACE = false;
    const bf16* gates; bf16* out;
    __device__ __forceinline__ void mid(f32x4 (&acc)[2][2][4][2], const Unit& u, int wr, int wc, int fr, int fq) const {
        const int rowb = u.row0 + wr * 64 + fr, colb = u.col0 + wc * 32 + 8 * fq;
#pragma unroll
        for (int ai = 0; ai < 2; ++ai)
#pragma unroll
            for (int m = 0; m < 4; ++m) { const size_t row = rowb + ai * 128 + m * 16;
#pragma unroll
                for (int bj = 0; bj < 2; ++bj) { const int col = colb + bj * 128;
                    const v4u gs = *(const v4u*)(gates + row * 2048 + col), gr = *(const v4u*)(gates + row * 2048 + 1024 + col);
                    f32x4& v0 = acc[ai][bj][m][0]; f32x4& v1 = acc[ai][bj][m][1];
#define RAT(s_, r_) ((s_) * __builtin_amdgcn_rcpf(fmaxf((r_), 1e-20f)))
                    v0[0] *= RAT(bflo(gs.x), bflo(gr.x)); v0[1] *= RAT(bfhi(gs.x), bfhi(gr.x)); v0[2] *= RAT(bflo(gs.y), bflo(gr.y)); v0[3] *= RAT(bfhi(gs.y), bfhi(gr.y));
                    v1[0] *= RAT(bflo(gs.z), bflo(gr.z)); v1[1] *= RAT(bfhi(gs.z), bfhi(gr.z)); v1[2] *= RAT(bflo(gs.w), bflo(gr.w)); v1[3] *= RAT(bfhi(gs.w), bfhi(gr.w));
#undef RAT
                }
                asm volatile("" ::: "memory"); }
    }
    __device__ __forceinline__ void operator()(const f32x4 (&acc)[2][2][4][2], const Unit& u, int wr, int wc, int fr, int fq) const {
        const int rowb = u.row0 + wr * 64 + fr, colb = u.col0 + wc * 32 + 8 * fq;
#pragma unroll
        for (int ai = 0; ai < 2; ++ai)
#pragma unroll
            for (int m = 0; m < 4; ++m) { const size_t row = rowb + ai * 128 + m * 16;
#pragma unroll
                for (int bj = 0; bj < 2; ++bj) { const int col = colb + bj * 128;
                    const v4u g = *(const v4u*)(gates + row * 2048 + 1024 + col);
                    f32x4 v0 = acc[ai][bj][m][0], v1 = acc[ai][bj][m][1];
                    v0[0] *= bflo(g.x); v0[1] *= bfhi(g.x); v0[2] *= bflo(g.y); v0[3] *= bfhi(g.y); v1[0] *= bflo(g.z); v1[1] *= bfhi(g.z); v1[2] *= bflo(g.w); v1[3] *= bfhi(g.w);
                    *(v4u*)(out + row * 1024 + col) = pack8(v0, v1); } }
    }
};
struct CatOrder : pg8::StaticOrder {
    const char* A2; int K1, K2;
    __device__ bool next(int i, Unit& u) const {
        if (!pg8::StaticOrder::next(i, u)) return false;
        const int pm = u.row0 / pg8::BM;
        u.a = A + (size_t)pm * pg8::BM * K1 * 2; u.a2 = A2 + (size_t)pm * pg8::BM * K2 * 2; return true;
    }
};
struct EpiOut {
    static constexpr bool PERM = true, AFTER_DRAIN = false, INPLACE = false;
    const float* x; float* out; bf16* hb;
    __device__ __forceinline__ void operator()(const f32x4 (&acc)[2][2][4][2], const Unit& u, int wr, int wc, int fr, int fq) const {
        const int rowb = u.row0 + wr * 64 + fr, colb = u.col0 + wc * 32 + 8 * fq;
#pragma unroll
        for (int ai = 0; ai < 2; ++ai)
#pragma unroll
            for (int m = 0; m < 4; ++m) { const size_t off = (size_t)(rowb + ai * 128 + m * 16) * 1024 + colb;
#pragma unroll
                for (int bj = 0; bj < 2; ++bj)
                { const f32x4 v0 = *(const f32x4*)(x + off + bj * 128) + acc[ai][bj][m][0], v1 = *(const f32x4*)(x + off + bj * 128 + 4) + acc[ai][bj][m][1];
                    *(f32x4*)(out + off + bj * 128) = v0; *(f32x4*)(out + off + bj * 128 + 4) = v1; *(v4u*)(hb + off + bj * 128) = pack8(v0, v1); } }
    }
};
struct EpiUp {
    static constexpr bool PERM = true, AFTER_DRAIN = false, INPLACE = false;
    const TokInfo* tinfo; const volatile LAS int* rowtok; bf16* hid;
    __device__ __forceinline__ void operator()(const f32x4 (&acc)[2][2][4][2], const Unit& u, int wr, int wc, int fr, int fq) const {
        const int ct = u.tag, lrb = wr * 64 + fr, col = ct * 128 + wc * 32 + 8 * fq;
#pragma unroll
        for (int ai = 0; ai < 2; ++ai)
#pragma unroll
            for (int m = 0; m < 4; ++m) { const int lr = lrb + ai * 128 + m * 16, tok = rowtok[u.idx * 256 + lr];
                if (tok >= 0) { const TokInfo ti = tinfo[tok]; const float gw = ct < 4 ? ti.ga : ti.gb, rs = ti.rstd;
                    f32x4 v0, v1;
#pragma unroll
                    for (int j = 0; j < 4; ++j) { const float g0 = acc[ai][0][m][0][j] * rs, g1 = acc[ai][0][m][1][j] * rs;
                        v0[j] = g0 * sigm(g0) * acc[ai][1][m][0][j] * (rs * gw); v1[j] = g1 * sigm(g1) * acc[ai][1][m][1][j] * (rs * gw); }
                    *(v4u*)(hid + (size_t)(u.row0 + lr) * 1024 + col) = pack8(v0, v1); } }
    }
};
struct EpiDown {
    static constexpr bool PERM = true, AFTER_DRAIN = false, INPLACE = true;
    const volatile LAS int* rowtok; float* out; const float* gfin; float* xbuf; unsigned* cnt; LAS unsigned char* xl;
    __device__ __forceinline__ void inplace(f32x4 (&acc)[2][2][4][2], const Unit& u, int wr, int wc, int fr, int fq, int wid, int lane) const {
        LAS float* P = (LAS float*)xl; LAS float* S = (LAS float*)(xl + 4096); volatile LAS unsigned* flag = (volatile LAS unsigned*)(xl + 5120);
        const int lrb = wr * 64 + fr, colb = u.col0 + wc * 32 + 8 * fq, rt = u.row0 >> 8, ct = u.tag;
#pragma unroll
        for (int ai = 0; ai < 2; ++ai)
#pragma unroll
            for (int m = 0; m < 4; ++m) { const int lr = lrb + ai * 128 + m * 16, tok = rowtok[u.idx * 256 + lr]; float s = 0.f;
                if (tok >= 0) { const float* p = out + (size_t)tok * 1024 + colb;
#pragma unroll
                    for (int bj = 0; bj < 2; ++bj)
#pragma unroll
                        for (int n = 0; n < 2; ++n) { const f32x4 y = *(const f32x4*)(p + bj * 128 + n * 4) + acc[ai][bj][m][n]; acc[ai][bj][m][n] = y; s += (y[0] * y[0] + y[1] * y[1]) + (y[2] * y[2] + y[3] * y[3]); } }
                s += __shfl_xor(s, 16); s += __shfl_xor(s, 32);
                if (fq == 0) P[lr * 4 + wc] = s; }
        asm volatile("s_waitcnt lgkmcnt(0)" ::: "memory"); __builtin_amdgcn_s_barrier(); asm volatile("" ::: "memory");
        const int row = wid * 32 + (lane & 31);
        if (lane < 32) { const float s = (P[row * 4 + 0] + P[row * 4 + 1]) + (P[row * 4 + 2] + P[row * 4 + 3]);
            __hip_atomic_store(xbuf + ((size_t)rt * 256 + row) * 4 + ct, s, __ATOMIC_RELAXED, __HIP_MEMORY_SCOPE_AGENT); }
        asm volatile("s_waitcnt vmcnt(0)" ::: "memory");
        if (lane == 0) __hip_atomic_fetch_add(cnt + 64 * rt, 1u, __ATOMIC_RELAXED, __HIP_MEMORY_SCOPE_AGENT);
        if (wid == 0) { unsigned sp = 0;
            while ((unsigned)__builtin_amdgcn_readfirstlane(__hip_atomic_load(cnt + 64 * rt, __ATOMIC_RELAXED, __HIP_MEMORY_SCOPE_AGENT)) < 32u) { __builtin_amdgcn_s_sleep(2); if (++sp > (1u << 22)) break; }
            __builtin_amdgcn_fence(__ATOMIC_ACQUIRE, "agent");
            if (lane == 0) flag[0] = 1u; }
        asm volatile("s_waitcnt vmcnt(0) lgkmcnt(0)" ::: "memory"); __builtin_amdgcn_s_barrier(); asm volatile("" ::: "memory");
        if (lane < 32) { const float* sl = xbuf + ((size_t)rt * 256 + row) * 4; float t = 0.f;
#pragma unroll
            for (int k = 0; k < 4; ++k) t += __hip_atomic_load(sl + k, __ATOMIC_RELAXED, __HIP_MEMORY_SCOPE_AGENT);
            S[row] = 1.f / sqrtf(t * (1.f / 1024.f) + EPS); }
        asm volatile("s_waitcnt vmcnt(0) lgkmcnt(0)" ::: "memory"); __builtin_amdgcn_s_barrier(); asm volatile("" ::: "memory");
        f32x4 gv[2][2];
#pragma unroll
        for (int bj = 0; bj < 2; ++bj)
#pragma unroll
            for (int n = 0; n < 2; ++n) gv[bj][n] = *(const f32x4*)(gfin + colb + bj * 128 + n * 4);
#pragma unroll
        for (int ai = 0; ai < 2; ++ai)
#pragma unroll
            for (int m = 0; m < 4; ++m) { const int lr = lrb + ai * 128 + m * 16, tok = rowtok[u.idx * 256 + lr]; const float rs = S[lr];
                if (tok >= 0) { float* p = out + (size_t)tok * 1024 + colb;
#pragma unroll
                    for (int bj = 0; bj < 2; ++bj)
#pragma unroll
                        for (int n = 0; n < 2; ++n) *(f32x4*)(p + bj * 128 + n * 4) = acc[ai][bj][m][n] * rs * gv[bj][n]; } }
        asm volatile("s_waitcnt lgkmcnt(0)" ::: "memory"); __builtin_amdgcn_s_barrier(); asm volatile("" ::: "memory");
    }
};
struct MoeOrder {
    const char* A; const char* B; const volatile LAS int* tstart; volatile LAS int* rowtok; int nct, up, G, c;
    __device__ __forceinline__ void locate(int L, int& rt, int& ct, int& cls) const {
        rt = L / nct; ct = L % nct; cls = 0;
        for (int k = 1; k < NCLS; ++k) cls += (rt >= __builtin_amdgcn_readfirstlane(tstart[k])) ? 1 : 0;
    }
    __device__ bool next(int i, Unit& u) const {
        const int L = i * G + c; const int ntile = __builtin_amdgcn_readfirstlane(tstart[NCLS]);
        if (L >= ntile * nct) return false;
        int rt, ct, cls; locate(L, rt, ct, cls);
        const int g = cls / 6, p = cls % 6, pa = p < 3 ? 0 : (p < 5 ? 1 : 2), pb = p == 0 ? 1 : (p == 1 ? 2 : (p == 2 ? 3 : (p == 3 ? 2 : 3)));
        u.row0 = rt * 256; u.tag = ct; u.idx = i; u.a2 = nullptr;
        if (up) { const int e = 4 * g + (ct < 4 ? pa : pb); u.a = A; u.b = B + ((size_t)e * 1024 + (ct & 3) * 256) * 1024 * 2; u.col0 = ct * 128; }
        else { u.a = A + (size_t)rt * 256 * 1024 * 2; u.b = B + ((size_t)cls * 1024 + ct * 256) * 1024 * 2; u.col0 = ct * 256; }
        return true;
    }
    __device__ __forceinline__ int arow(int ui, int r) const { const int t = rowtok[ui * 256 + r]; return t < 0 ? 0 : t; }
    __device__ __forceinline__ void build(const int* perm, int tid) const {
        const int ntile = tstart[NCLS];
        for (int i = 0; i * G + c < ntile * nct; ++i) { int rt, ct, cls; locate(i * G + c, rt, ct, cls);
            for (int r = tid; r < 256; r += NTHR) { const int idx = (rt - tstart[cls]) * 256 + r; rowtok[i * 256 + r] = idx < tstart[32 + cls] ? perm[(size_t)cls * T + idx] : -1; } }
        __syncthreads();
    }
    __device__ __forceinline__ void a_ready(const Unit&) const {}
    __device__ __forceinline__ void done(const Unit&) const {}
};

typedef float f32x16 __attribute__((ext_vector_type(16)));
typedef short s16x4 __attribute__((ext_vector_type(4)));
typedef float f32x2_t __attribute__((ext_vector_type(2))); typedef __bf16 bf16x2_t __attribute__((ext_vector_type(2)));
__device__ __forceinline__ unsigned cvtpk_s(float lo, float hi) { f32x2_t v = {lo, hi}; bf16x2_t b = __builtin_convertvector(v, bf16x2_t); return __builtin_bit_cast(unsigned, b); }
__device__ __forceinline__ s16x4 vtr(const LAS unsigned char* p) { return __builtin_bit_cast(s16x4, __builtin_amdgcn_ds_read_tr16_b64_v4i16((LAS s16x4*)p)); }
__device__ __forceinline__ int crow(int r, int hi) { return (r & 3) + 8 * (r >> 2) + 4 * hi; }
#define MFMA32(a, b, c) __builtin_amdgcn_mfma_f32_32x32x16_bf16((a), (b), (c), 0, 0, 0)
__device__ __forceinline__ bf16x8 packfrag(const f32x16& p, int s) {
    v4u w; w.x = cvtpk_s(p[8 * s], p[8 * s + 1]); w.y = cvtpk_s(p[8 * s + 2], p[8 * s + 3]); w.z = cvtpk_s(p[8 * s + 4], p[8 * s + 5]); w.w = cvtpk_s(p[8 * s + 6], p[8 * s + 7]);
    return __builtin_bit_cast(bf16x8, w);
}
__device__ __forceinline__ bf16x8 vfrag(const LAS unsigned char* p, int rowbytes) {
    const s16x4 lo = vtr(p), hi_ = vtr(p + 8 * rowbytes);
    return (bf16x8){lo[0], lo[1], lo[2], lo[3], hi_[0], hi_[1], hi_[2], hi_[3]};
}
__device__ __forceinline__ void glds16(const void* gsrc, unsigned lds_dst) { unsigned keep;
    asm volatile("s_mov_b32 %0, m0\n\ts_mov_b32 m0, %2\n\ts_nop 0\n\tglobal_load_lds_dwordx4 %1, off\n\ts_mov_b32 m0, %0" : "=&s"(keep) : "v"(gsrc), "s"(lds_dst) : "memory"); }
#define WAIT_BAR(N) asm volatile("s_waitcnt vmcnt(" #N ") lgkmcnt(0)\n\ts_barrier" ::: "memory")
constexpr float SB_THR2 = -40.f;

template <bool MASK>
__device__ __forceinline__ void sb_tile(const LAS unsigned char* Kt, const LAS unsigned char* Vt, const bf16x8 (&qf)[4], const bf16x8 tri0, const bf16x8 tri1, const bf16x8 ones,
                                        f32x16& o0, f32x16& o1, float& R, int kt, int t, int hi, int kbase, int kx, int v0, int v1) {
    f32x16 p0 = {}, p1 = {};
#pragma unroll
    for (int ks = 0; ks < 4; ++ks) {
        const int co = kbase + (((2 * ks + hi) ^ kx) << 4);
        const bf16x8 a0 = *(const LAS bf16x8*)(Kt + co), a1 = *(const LAS bf16x8*)(Kt + 4096 + co);
        p0 = MFMA32(a0, qf[ks], p0); p1 = MFMA32(a1, qf[ks], p1);
    }
    f32x16 l0, l1; float cs = 0.f;
#pragma unroll
    for (int r = 0; r < 16; ++r) {
        const float z0 = p0[r], z1 = p1[r];
        float k0 = -(fmaxf(z0, 0.f) + __builtin_amdgcn_logf(1.f + __builtin_amdgcn_exp2f(-fabsf(z0))));
        float k1 = -(fmaxf(z1, 0.f) + __builtin_amdgcn_logf(1.f + __builtin_amdgcn_exp2f(-fabsf(z1))));
        if (MASK) { const int key = kt * 64 + crow(r, hi); k0 = key < t ? k0 : 0.f; k1 = key + 32 < t ? k1 : 0.f; }
        l0[r] = k0; l1[r] = k1; cs += k0 + k1;
    }
    cs += __shfl_xor(cs, 32);
    const bf16x8 lb00 = packfrag(l0, 0), lb01 = packfrag(l0, 1), lb10 = packfrag(l1, 0), lb11 = packfrag(l1, 1);
    f32x16 y0 = {}, y1 = {};
    y0 = MFMA32(tri0, lb00, y0); y0 = MFMA32(tri1, lb01, y0); y0 = MFMA32(ones, lb10, y0); y0 = MFMA32(ones, lb11, y0);
    y1 = MFMA32(tri0, lb10, y1); y1 = MFMA32(tri1, lb11, y1);
#pragma unroll
    for (int r = 0; r < 16; ++r) {
        float w0 = __builtin_amdgcn_exp2f(p0[r] + y0[r] + R), w1 = __builtin_amdgcn_exp2f(p1[r] + y1[r] + R);
        if (MASK) { const int key = kt * 64 + crow(r, hi); w0 = key < t ? w0 : 0.f; w1 = key + 32 < t ? w1 : 0.f; }
        p0[r] = w0; p1[r] = w1;
    }
    R += cs;
    const bf16x8 wb00 = packfrag(p0, 0), wb01 = packfrag(p0, 1), wb10 = packfrag(p1, 0), wb11 = packfrag(p1, 1);
    o0 = MFMA32(vfrag(Vt + 0 * 2048 + v0, 128), wb00, o0); o1 = MFMA32(vfrag(Vt + 0 * 2048 + v1, 128), wb00, o1);
    o0 = MFMA32(vfrag(Vt + 1 * 2048 + v0, 128), wb01, o0); o1 = MFMA32(vfrag(Vt + 1 * 2048 + v1, 128), wb01, o1);
    o0 = MFMA32(vfrag(Vt + 2 * 2048 + v0, 128), wb10, o0); o1 = MFMA32(vfrag(Vt + 2 * 2048 + v1, 128), wb10, o1);
    o0 = MFMA32(vfrag(Vt + 3 * 2048 + v0, 128), wb11, o0); o1 = MFMA32(vfrag(Vt + 3 * 2048 + v1, 128), wb11, o1);
}
__device__ __forceinline__ void unit_map(int u, int G, int& bh, int& qb) {
    if (G == 256) { const int bx = u & 255, i = u >> 8, xcd = bx & 7, slot = bx >> 3, gi = slot >> 2, j = slot & 3;
        bh = (xcd * 8 + gi) * 2 + (i >> 1); qb = (i & 1) ? 7 - j : j; }
    else { bh = u >> 3; qb = u & 7; }
}
__device__ __forceinline__ void sb_phase(const bf16* Q, const bf16* Kg, const bf16* Vg, bf16* O, LAS unsigned char* lds, int bx, int G, int tid, int wave, int lane, bool nostore = false) {
    const int r32 = lane & 31, hi = lane >> 5;
    bf16x8 tri0, tri1, ones;
#pragma unroll
    for (int j = 0; j < 8; ++j) { const int kk = 8 * (j >> 2) + 4 * hi + (j & 3); tri0[j] = kk >= r32 ? (short)0x3F80 : (short)0; tri1[j] = 16 + kk >= r32 ? (short)0x3F80 : (short)0; ones[j] = (short)0x3F80; }
    const int skey = wave * 8 + (lane >> 3), sc = (lane & 7) ^ (lane >> 3), svc = (lane & 7) ^ (((lane >> 4) & 1) << 2);
    const unsigned lds0 = (unsigned)(size_t)lds + (unsigned)wave * 1024u;
#define SB_STAGE(kt_, st_) do { const unsigned d_ = (unsigned)__builtin_amdgcn_readfirstlane(lds0 + (unsigned)(st_) * 16384u); \
        glds16(Kg + (rbase + (size_t)(kt_) * 64 + skey) * 512 + h * 64 + sc * 8, d_); glds16(Vg + (rbase + (size_t)(kt_) * 64 + skey) * 512 + h * 64 + svc * 8, d_ + 8192u); } while (0)
    const int kbase = r32 * 128, kx = r32 & 7;
    const int q4 = (lane & 15) >> 2, v0 = ((4 * hi + q4) * 128 + 32 * ((lane >> 4) & 1) + 8 * (lane & 3)) ^ (((q4 >> 1) & 1) << 6), v1 = v0 ^ 64;
    volatile LAS int* flags = (volatile LAS int*)(lds + 49152);
    for (int u = bx; u < 1024; u += G) {
        const int bh = u >> 3, qb = u & 7;
        const int b = bh >> 3, h = bh & 7, q0w = qb * 256 + 32 * wave, my_kt = q0w >> 6, kt_hi = qb * 4 + 3, t = q0w + r32;
        const size_t rbase = (size_t)b * SEQ;
        SB_STAGE(kt_hi, 0);
        if (kt_hi > 0) SB_STAGE(kt_hi - 1, 1);
        bf16x8 qf[4];
#pragma unroll
        for (int ks = 0; ks < 4; ++ks) qf[ks] = *(const bf16x8*)(Q + (rbase + t) * 512 + h * 64 + 16 * ks + 8 * hi);
        f32x16 o0 = {}, o1 = {}; float R = 0.f;
        if (kt_hi > 0) WAIT_BAR(2); else WAIT_BAR(0);
        bool mydone = false; int st = 0, it = 0;
        for (int kt = kt_hi; kt >= 0; --kt, ++it) {
            int st2 = st + 2; if (st2 >= 3) st2 -= 3;
            if (kt >= 2) SB_STAGE(kt - 2, st2);
            if (kt <= my_kt && !mydone) {
                const LAS unsigned char* Kt = lds + st * 16384; const LAS unsigned char* Vt = Kt + 8192;
                if (kt == my_kt) sb_tile<true>(Kt, Vt, qf, tri0, tri1, ones, o0, o1, R, kt, t, hi, kbase, kx, v0, v1);
                else sb_tile<false>(Kt, Vt, qf, tri0, tri1, ones, o0, o1, R, kt, t, hi, kbase, kx, v0, v1);
                mydone = __all(R < SB_THR2) != 0;
            }
            if (lane == 0) flags[(it & 1) * 8 + wave] = mydone ? 1 : 0;
            if (kt >= 2) WAIT_BAR(2); else WAIT_BAR(0);
            int alld = 1;
#pragma unroll
            for (int w = 0; w < 8; ++w) alld &= flags[(it & 1) * 8 + w];
            if (alld) break;
            st = st + 1; if (st >= 3) st = 0;
        }
        { LAS unsigned char* ep = lds + 53248 + wave * 4608;
#pragma unroll
          for (int g4 = 0; g4 < 4; ++g4) {
            *(LAS unsigned long long*)(ep + r32 * 144 + (8 * g4 + 4 * hi) * 2) = (unsigned long long)cvtpk_s(o0[4 * g4], o0[4 * g4 + 1]) | ((unsigned long long)cvtpk_s(o0[4 * g4 + 2], o0[4 * g4 + 3]) << 32);
            *(LAS unsigned long long*)(ep + r32 * 144 + (32 + 8 * g4 + 4 * hi) * 2) = (unsigned long long)cvtpk_s(o1[4 * g4], o1[4 * g4 + 1]) | ((unsigned long long)cvtpk_s(o1[4 * g4 + 2], o1[4 * g4 + 3]) << 32); }
#pragma unroll
          for (int i = 0; i < 4; ++i) { const int row = (lane >> 3) + 8 * i;
            const v4u ov = *(const LAS v4u*)(ep + row * 144 + (lane & 7) * 16); if (!nostore) *(v4u*)(O + (rbase + q0w + row) * 512 + h * 64 + (lane & 7) * 8) = ov; else asm volatile("" :: "v"(ov)); } }
        WAIT_BAR(0);
    }
#undef SB_STAGE
}
template <bool EDGE>
__device__ __forceinline__ void ret_tile(const LAS unsigned char* Kt, const LAS unsigned char* Vt, const bf16x8 (&qf)[4], f32x16 (&o)[4], float lg2, int kt, int my_kt, int n, int hi, int kbase, int kx, int vb) {
    f32x16 p0 = {}, p1 = {};
#pragma unroll
    for (int ks = 0; ks < 4; ++ks) {
        const int co = kbase + (((2 * ks + hi) ^ kx) << 4);
        const bf16x8 a0 = *(const LAS bf16x8*)(Kt + co), a1 = *(const LAS bf16x8*)(Kt + 4096 + co);
        p0 = MFMA32(a0, qf[ks], p0); p1 = MFMA32(a1, qf[ks], p1);
    }
    const int e_off = n - 64 * (kt + 1);
    if (EDGE) {
        const bool diag = kt == my_kt; float fnn = (float)(n & 63); asm volatile("" : "+v"(fnn));
        const float base = diag ? fnn - 64.f : (float)e_off, two = diag ? 2.f : 0.f, h4 = (float)(4 * hi);
#pragma unroll
        for (int r = 0; r < 16; ++r) {
            const float m0 = (float)((r & 3) + 8 * (r >> 2)) + h4;
            p0[r] *= __builtin_amdgcn_exp2f(lg2 * (base + two * fmaxf(m0 - fnn, 0.f))); p1[r] *= __builtin_amdgcn_exp2f(lg2 * (base + two * fmaxf(m0 + 32.f - fnn, 0.f)));
            if ((r & 3) == 3) __builtin_amdgcn_sched_barrier(0);
        }
    } else {
        const float f = __builtin_amdgcn_exp2f(lg2 * (float)e_off);
#pragma unroll
        for (int r = 0; r < 16; ++r) { p0[r] *= f; p1[r] *= f; }
    }
    const bf16x8 wb00 = packfrag(p0, 0), wb01 = packfrag(p0, 1), wb10 = packfrag(p1, 0), wb11 = packfrag(p1, 1);
#pragma unroll
    for (int dt = 0; dt < 4; ++dt) { const LAS unsigned char* vp = Vt + (vb ^ (dt << 6));
        o[dt] = MFMA32(vfrag(vp + 0 * 4096, 256), wb00, o[dt]); o[dt] = MFMA32(vfrag(vp + 1 * 4096, 256), wb01, o[dt]);
        o[dt] = MFMA32(vfrag(vp + 2 * 4096, 256), wb10, o[dt]); o[dt] = MFMA32(vfrag(vp + 3 * 4096, 256), wb11, o[dt]); }
}
__device__ __forceinline__ void kv_chain(const bf16* Kg, const bf16* Vg, bf16* STg, LAS unsigned char* lds, int bh0, int bhs, int tid, int wave, int lane) {
    const int r32 = lane & 31, hi = lane >> 5, q4 = (lane & 15) >> 2, g1 = (lane >> 4) & 1, p = lane & 3, dh = wave >> 2, eq = wave & 3;
    const int skey = wave * 8 + (lane >> 3), sc = (lane & 7) ^ (lane >> 3);
    const int vkey = wave * 8 + (lane >> 4), vc = (lane & 15) ^ (((lane >> 4) & 3) << 2);
    const unsigned ldsk = (unsigned)(size_t)lds + (unsigned)wave * 1024u, ldsv = (unsigned)(size_t)lds + 8192u + (unsigned)wave * 2048u;
#define RET_STAGE(kt_, st_) do { const unsigned so_ = (unsigned)(st_) * 24576u; \
        glds16(Kg + (rbase + (size_t)(kt_) * 64 + skey) * 512 + h * 64 + sc * 8, (unsigned)__builtin_amdgcn_readfirstlane(ldsk + so_)); \
        glds16(Vg + (rbase + (size_t)(kt_) * 64 + vkey) * 1024 + h * 128 + vc * 8, (unsigned)__builtin_amdgcn_readfirstlane(ldsv + so_)); \
        glds16(Vg + (rbase + (size_t)(kt_) * 64 + vkey + 4) * 1024 + h * 128 + vc * 8, (unsigned)__builtin_amdgcn_readfirstlane(ldsv + so_ + 1024u)); } while (0)
    int aoff[2], boff[2];
#pragma unroll
    for (int e = 0; e < 2; ++e) { const int m = 8 * hi + q4 + 4 * e;
        aoff[e] = m * 128 + (((4 * dh + 2 * g1 + (p >> 1)) ^ (m & 7)) << 4) + (p & 1) * 8;
        boff[e] = m * 256 + ((64 * eq + 32 * g1 + 8 * p) ^ ((m & 3) << 6)); }
    for (int bh = bh0; bh < 128; bh += bhs) {
        const int b = bh >> 3, h = bh & 7;
        const size_t rbase = (size_t)b * SEQ;
        const float lg2 = log2f(1.f - exp2f(-5.f - (float)h)), g64 = exp2f(64.f * lg2), g256 = exp2f(256.f * lg2), ginv = exp2f(-lg2);
        RET_STAGE(0, 0); RET_STAGE(1, 1);
        f32x16 S = {}, kv = {};
        WAIT_BAR(3);
        int st = 0;
        for (int kt = 0; kt < 28; ++kt) {
            int st2 = st + 2; if (st2 >= 3) st2 -= 3;
            if (kt + 2 < 28) RET_STAGE(kt + 2, st2);
            const LAS unsigned char* Kt = lds + st * 24576; const LAS unsigned char* Vt = Kt + 8192;
#pragma unroll
            for (int r = 0; r < 16; ++r) kv[r] *= g64;
#pragma unroll
            for (int ks = 0; ks < 4; ++ks) {
                const s16x4 a0 = vtr(Kt + aoff[0] + ks * 2048), a1 = vtr(Kt + aoff[1] + ks * 2048), b0 = vtr(Vt + boff[0] + ks * 4096), b1 = vtr(Vt + boff[1] + ks * 4096);
                kv = MFMA32(((bf16x8){a0[0], a0[1], a0[2], a0[3], a1[0], a1[1], a1[2], a1[3]}), ((bf16x8){b0[0], b0[1], b0[2], b0[3], b1[0], b1[1], b1[2], b1[3]}), kv);
            }
            if ((kt & 3) == 3) {
                bf16* sp = STg + ((size_t)(bh * 8 + (kt >> 2) + 1) * 64 + 32 * dh) * 128 + 32 * eq + r32;
#pragma unroll
                for (int r = 0; r < 16; ++r) { S[r] = S[r] * g256 + kv[r] * ginv; kv[r] = 0.f; sp[crow(r, hi) * 128] = (bf16)(cvtpk_s(S[r], 0.f) & 0xffffu); }
            }
            if (kt + 2 < 28) WAIT_BAR(3); else WAIT_BAR(0);
            st = st + 1; if (st >= 3) st = 0;
        }
    }
#undef RET_STAGE
}
__device__ __forceinline__ void ret_phase(const bf16* Q, const bf16* Kg, const bf16* Vg, const bf16* RG, const float* gn, const bf16* STg, bf16* Y, LAS unsigned char* lds, int bx, int G, int tid, int wave, int lane) {
    const int r32 = lane & 31, hi = lane >> 5;
    const int skey = wave * 8 + (lane >> 3), sc = (lane & 7) ^ (lane >> 3);
    const int vkey = wave * 8 + (lane >> 4), vc = (lane & 15) ^ (((lane >> 4) & 3) << 2);
    const unsigned ldsk = (unsigned)(size_t)lds + (unsigned)wave * 1024u, ldsv = (unsigned)(size_t)lds + 8192u + (unsigned)wave * 2048u, ldss = (unsigned)(size_t)lds + 73728u + (unsigned)wave * 2048u;
#define RET_STAGE(kt_, st_) do { const unsigned so_ = (unsigned)(st_) * 24576u; \
        glds16(Kg + (rbase + (size_t)(kt_) * 64 + skey) * 512 + h * 64 + sc * 8, (unsigned)__builtin_amdgcn_readfirstlane(ldsk + so_)); \
        glds16(Vg + (rbase + (size_t)(kt_) * 64 + vkey) * 1024 + h * 128 + vc * 8, (unsigned)__builtin_amdgcn_readfirstlane(ldsv + so_)); \
        glds16(Vg + (rbase + (size_t)(kt_) * 64 + vkey + 4) * 1024 + h * 128 + vc * 8, (unsigned)__builtin_amdgcn_readfirstlane(ldsv + so_ + 1024u)); } while (0)
#define RET_STAGES(qb_) do { const bf16* s_ = STg + ((size_t)(bh * 8 + (qb_)) * 64 + vkey) * 128 + vc * 8; \
        glds16(s_, (unsigned)__builtin_amdgcn_readfirstlane(ldss)); glds16(s_ + 4 * 128, (unsigned)__builtin_amdgcn_readfirstlane(ldss + 1024u)); } while (0)
    const int kbase = r32 * 128, kx = r32 & 7;
    const int q4 = (lane & 15) >> 2, vb = ((4 * hi + q4) * 256 + 32 * ((lane >> 4) & 1) + 8 * (lane & 3)) ^ (q4 << 6);
    const int sb_ = ((8 * hi + q4) * 256 + 32 * ((lane >> 4) & 1) + 8 * (lane & 3)) ^ (q4 << 6);
    const LAS unsigned char* St = lds + 73728;
    LAS unsigned char* ep = lds + 90112 + wave * 4608;
    const int nper = (2 * 128 + G - 1) / G;
    for (int it = bx * nper; it < (bx + 1) * nper && it < 256; ++it) {
        const int bh = it >> 1, qb0 = 4 * (it & 1), b = bh >> 3, h = bh & 7, kt_end = 4 * qb0 + 15;
        const size_t rbase = (size_t)b * SEQ;
        const float lg2 = log2f(1.f - exp2f(-5.f - (float)h));
        if (qb0 > 0) RET_STAGES(qb0);
        RET_STAGE(4 * qb0, 0); RET_STAGE(4 * qb0 + 1, 1);
        int st = 0;
        WAIT_BAR(3);
        for (int qb = qb0; qb < qb0 + 4; ++qb) {
            const int q0w = qb * 256 + 32 * wave, my_kt = q0w >> 6, n = q0w + r32;
            bf16x8 qf[4];
#pragma unroll
            for (int ks = 0; ks < 4; ++ks) qf[ks] = *(const bf16x8*)(Q + (rbase + n) * 512 + h * 64 + 16 * ks + 8 * hi);
            f32x16 o[4] = {{}, {}, {}, {}};
            if (qb > 0) {
#pragma unroll
                for (int ks = 0; ks < 4; ++ks) {
#pragma unroll
                    for (int dt = 0; dt < 4; ++dt) { const LAS unsigned char* sp = St + (sb_ ^ (dt << 6)) + ks * 4096;
                        const s16x4 a0 = vtr(sp), a1 = vtr(sp + 4 * 256);
                        o[dt] = MFMA32(((bf16x8){a0[0], a0[1], a0[2], a0[3], a1[0], a1[1], a1[2], a1[3]}), qf[ks], o[dt]); }
                    __builtin_amdgcn_sched_barrier(0);
                }
                const float qs = exp2f(lg2 * (float)(32 * wave + r32 + 1));
#pragma unroll
                for (int dt = 0; dt < 4; ++dt)
#pragma unroll
                    for (int r = 0; r < 16; ++r) o[dt][r] *= qs;
            }
#define RET_STEP(BODY) do { const int kt = 4 * qb + t; \
                int st2 = st + 2; if (st2 >= 3) st2 -= 3; \
                if (t == 3 && qb + 1 < qb0 + 4) RET_STAGES(qb + 1);     \
                if (kt + 2 <= kt_end) RET_STAGE(kt + 2, st2); \
                BODY; \
                if (kt + 2 <= kt_end) WAIT_BAR(3); else WAIT_BAR(0); \
                st = st + 1; if (st >= 3) st = 0; } while (0)
            { const int cw = wave >> 1; int t = 0;
              for (; t < cw; ++t) RET_STEP(ret_tile<false>(lds + st * 24576, lds + st * 24576 + 8192, qf, o, lg2, kt, my_kt, n, hi, kbase, kx, vb));
              RET_STEP(ret_tile<true>(lds + st * 24576, lds + st * 24576 + 8192, qf, o, lg2, kt, my_kt, n, hi, kbase, kx, vb)); ++t;
              for (; t < 4; ++t) RET_STEP((void)0); }
#undef RET_STEP
            float ss = 0.f;
#pragma unroll
            for (int dt = 0; dt < 4; ++dt)
#pragma unroll
                for (int r = 0; r < 16; ++r) ss += o[dt][r] * o[dt][r];
            ss += __shfl_xor(ss, 32);
            const float rstd = 1.f / sqrtf(ss * (1.f / 128.f) + EPS);
#pragma unroll
            for (int half = 0; half < 2; ++half) {
#pragma unroll
                for (int dtl = 0; dtl < 2; ++dtl)
#pragma unroll
                    for (int g4 = 0; g4 < 4; ++g4) { const f32x16& od = o[2 * half + dtl];
                        *(LAS unsigned long long*)(ep + r32 * 144 + (32 * dtl + 8 * g4 + 4 * hi) * 2) =
                            (unsigned long long)cvtpk_s(od[4 * g4] * rstd, od[4 * g4 + 1] * rstd) | ((unsigned long long)cvtpk_s(od[4 * g4 + 2] * rstd, od[4 * g4 + 3] * rstd) << 32); }
#pragma unroll
                for (int i = 0; i < 4; ++i) { const int row = (lane >> 3) + 8 * i, e = 64 * half + (lane & 7) * 8;
                    const v4u y = *(const LAS v4u*)(ep + row * 144 + (lane & 7) * 16);
                    const size_t go = (rbase + q0w + row) * 1024 + h * 128 + e;
                    const v4u rg = *(const v4u*)(RG + go); const f32x4 g0 = *(const f32x4*)(gn + h * 128 + e), g1 = *(const f32x4*)(gn + h * 128 + e + 4);
                    f32x4 v0, v1;
                    v0[0] = bflo(y.x) * g0[0] * bflo(rg.x); v0[1] = bfhi(y.x) * g0[1] * bfhi(rg.x); v0[2] = bflo(y.y) * g0[2] * bflo(rg.y); v0[3] = bfhi(y.y) * g0[3] * bfhi(rg.y);
                    v1[0] = bflo(y.z) * g1[0] * bflo(rg.z); v1[1] = bfhi(y.z) * g1[1] * bfhi(rg.z); v1[2] = bflo(y.w) * g1[2] * bflo(rg.w); v1[3] = bfhi(y.w) * g1[3] * bfhi(rg.w);
                    *(v4u*)(Y + go) = pack8(v0, v1); }
            }
        }
    }
#undef RET_STAGE
#undef RET_STAGES
}

__device__ __forceinline__ void p_route(const Args& a, LAS unsigned char* lds, int vcu, int G, int wave, int lane, int tid) {
    const float* h = a.out; const bf16* wrt = (const bf16*)(a.ws + WS_WRT); const float* bg = a.in[11]; const float* be = a.in[13];
    TokInfo* tinfo = (TokInfo*)(a.ws + (a.rep ? WS_PROBE : WS_TOK)); int* perm = (int*)(a.ws + (a.rep ? WS_PROBE + 4 * MiB : WS_PERM));
    unsigned* cnt = (unsigned*)(a.ws + WS_CTL) + (a.rep ? CW_CNT + 4096 : CW_CNT);
    const int r32 = lane & 31, hi = lane >> 5, kh = wave & 1, pair = wave >> 1;
    LAS float* xch = (LAS float*)lds + pair * 64 * 17;
    const int ntask = T / 32, tstride = G * 4, nround = (ntask + tstride - 1) / tstride;
    for (int rd = 0; rd < nround; ++rd) {
        const int task = rd * tstride + vcu * 4 + pair; const bool valid = task < ntask;
        const int t0 = (valid ? task : 0) * 32;
        const float* xp = h + (size_t)(t0 + r32) * DM + kh * 512 + 8 * hi;
        const bf16* ahp = wrt + r32 * 1024 + kh * 512 + 8 * hi;
        f32x16 acc = {}; float ss = 0.f;
#pragma unroll 4
        for (int ks = 0; ks < 32; ++ks) {
            const f32x4 x0 = *(const f32x4*)(xp + 16 * ks), x1 = *(const f32x4*)(xp + 16 * ks + 4);
            ss += (x0[0] * x0[0] + x0[1] * x0[1]) + (x0[2] * x0[2] + x0[3] * x0[3]) + (x1[0] * x1[0] + x1[1] * x1[1]) + (x1[2] * x1[2] + x1[3] * x1[3]);
            v4u wh, wl;
            wh.x = cvtpk_s(x0[0], x0[1]); wh.y = cvtpk_s(x0[2], x0[3]); wh.z = cvtpk_s(x1[0], x1[1]); wh.w = cvtpk_s(x1[2], x1[3]);
            wl.x = cvtpk_s(x0[0] - bflo(wh.x), x0[1] - bfhi(wh.x)); wl.y = cvtpk_s(x0[2] - bflo(wh.y), x0[3] - bfhi(wh.y));
            wl.z = cvtpk_s(x1[0] - bflo(wh.z), x1[1] - bfhi(wh.z)); wl.w = cvtpk_s(x1[2] - bflo(wh.w), x1[3] - bfhi(wh.w));
            const bf16x8 bh_ = __builtin_bit_cast(bf16x8, wh), bl_ = __builtin_bit_cast(bf16x8, wl);
            const bf16x8 ah = *(const bf16x8*)(ahp + 16 * ks), al = *(const bf16x8*)(ahp + 32 * 1024 + 16 * ks);
            acc = MFMA32(ah, bh_, acc); acc = MFMA32(ah, bl_, acc); acc = MFMA32(al, bh_, acc);
        }
        if (kh == 1) {
#pragma unroll
            for (int r = 0; r < 16; ++r) xch[lane * 17 + r] = acc[r];
            xch[lane * 17 + 16] = ss; }
        __syncthreads();
        if (kh == 0) {
#pragma unroll
            for (int r = 0; r < 16; ++r) acc[r] += xch[lane * 17 + r];
            ss += xch[lane * 17 + 16];
            ss += __shfl_xor(ss, 32);
            const float rstd = 1.f / sqrtf(ss * (1.f / DM) + EPS);
            float gl[4];
#pragma unroll
            for (int o = 0; o < 4; ++o) gl[o] = acc[o] * rstd + bg[o];
            int gi = 0; float gm = gl[0];
#pragma unroll
            for (int o = 1; o < 4; ++o) if (gl[o] > gm) { gm = gl[o]; gi = o; }
            float gs = 0.f;
#pragma unroll
            for (int o = 0; o < 4; ++o) gs += __expf(gl[o] - gm);
            const float pgrp = 1.f / gs;
            const bool owner = valid && (hi == (gi & 1));
            float el[4];
#pragma unroll
            for (int e = 0; e < 4; ++e) el[e] = ((gi >> 1) ? acc[8 + e] : acc[4 + e]) * rstd + be[4 * gi + e];
            int i1 = 0; float m1 = el[0];
#pragma unroll
            for (int e = 1; e < 4; ++e) if (el[e] > m1) { m1 = el[e]; i1 = e; }
            int i2 = -1; float m2 = -3.0e38f;
#pragma unroll
            for (int e = 0; e < 4; ++e) if (e != i1 && el[e] > m2) { m2 = el[e]; i2 = e; }
            const float s1 = 1.f / (1.f + __expf(m2 - m1)), g1 = s1 * pgrp, g2 = (1.f - s1) * pgrp;
            const int pa = i1 < i2 ? i1 : i2, pb = i1 < i2 ? i2 : i1;
            const float ga = i1 < i2 ? g1 : g2, gb = i1 < i2 ? g2 : g1;
            const int pidx = pa == 0 ? pb - 1 : (pa == 1 ? pb + 1 : 5);
            const int my_cls = owner ? gi * 6 + pidx : -1;
            int my_pos = 0;
            for (int c = 0; c < NCLS; ++c) {
                const unsigned long long mask = __ballot(my_cls == c);
                if (mask) { const int nn = __popcll(mask), leader = __ffsll((long long)mask) - 1; unsigned bse = 0;
                    if (lane == leader) bse = __hip_atomic_fetch_add(cnt + 64 * c, (unsigned)nn, __ATOMIC_RELAXED, __HIP_MEMORY_SCOPE_AGENT);
                    bse = __shfl(bse, leader);
                    if (my_cls == c) my_pos = (int)bse + __popcll(mask & ((1ull << lane) - 1ull)); }
            }
            if (owner) { const int t = t0 + r32; tinfo[t] = TokInfo{ga, gb, rstd, my_cls}; perm[(size_t)my_cls * T + my_pos] = t; }
        }
        __syncthreads();
    }
}
__device__ __forceinline__ void build_class_table(const Args& a, volatile LAS int* tab, int tid) {
    if (tid == 0) { const unsigned* cnt = (const unsigned*)(a.ws + WS_CTL) + CW_CNT; int acc_ = 0;
        for (int c = 0; c < NCLS; ++c) { tab[c] = acc_; const int n = (int)__hip_atomic_load(cnt + 64 * c, __ATOMIC_RELAXED, __HIP_MEMORY_SCOPE_AGENT); tab[32 + c] = n; acc_ += (n + 255) >> 8; }
        tab[NCLS] = acc_; }
    __syncthreads();
}
__device__ __forceinline__ void p_final(const Args& a, int vcu, int G, int wave, int lane) {
    float* h = a.out; const float* gf = a.in[17];
    const int gw = vcu * NWAVES + wave, NGW = G * NWAVES;
    f32x4 gv[4];
#pragma unroll
    for (int j = 0; j < 4; ++j) gv[j] = ((const f32x4*)gf)[lane + 64 * j];
    for (int t = gw; t < T; t += NGW) {
        GAS f32x4* xr = (GAS f32x4*)(h + (size_t)t * DM) + lane;
        f32x4 v[4]; float s = 0.f;
#pragma unroll
        for (int j = 0; j < 4; ++j) { v[j] = xr[64 * j]; s += (v[j].x * v[j].x + v[j].y * v[j].y) + (v[j].z * v[j].z + v[j].w * v[j].w); }
        const float rstd = 1.f / sqrtf(wave_sum(s) * (1.f / DM) + EPS);
#pragma unroll
        for (int j = 0; j < 4; ++j) xr[64 * j] = v[j] * rstd * gv[j];
    }
}

#ifndef PROBE_MASK
#define PROBE_MASK 0
#endif
#ifndef MK_ONE_LAUNCH
#if PROBE_MASK
#define MK_ONE_LAUNCH 0
#else
#define MK_ONE_LAUNCH 1
#endif
#endif
constexpr int NPHASE = 9;
__global__ void __launch_bounds__(NTHR, 2) fwd_kernel(Args args) {
    extern __shared__ __attribute__((aligned(16))) unsigned char lds_raw[];
    LAS unsigned char* lds = (LAS unsigned char*)lds_raw;
    volatile LAS unsigned* MISC = (volatile LAS unsigned*)(lds + MISC_OFF);
    volatile LAS int* tab = (volatile LAS int*)(lds + TAB_OFF);
    const int tid = threadIdx.x, lane = tid & 63, wave = __builtin_amdgcn_readfirstlane(tid >> 6);
    const int G = gridDim.x; const int bx = blockIdx.x; const int vcu = (G % 8 == 0) ? (bx % 8) * (G / 8) + bx / 8 : bx;
    unsigned char* ws = args.ws;
    for (int u = tid; u < (LDS_BYTES - LDSCTL_OFF) / 4; u += NTHR) ((LAS unsigned*)(lds + LDSCTL_OFF))[u] = 0u;
    __syncthreads();
    XcdBarrier bar; bar.bar = (unsigned*)(ws + WS_CTL) + CW_BAR; bar.x = 0; bar.st = nullptr;
    if (MK_ONE_LAUNCH) bar = xcd_barrier_post((unsigned*)(ws + WS_CTL) + CW_BAR, MISC + 8);
    const int lo = args.ph_lo, hi = args.ph_hi;
#define IN(k) (lo <= (k) && (k) < hi)
#define SEAM(k) do { if (MK_ONE_LAUNCH && IN(k) && IN((k) + 1)) xcd_barrier(bar); } while (0)
    bf16* W1 = (bf16*)(ws + WS_W1); bf16* XN = (bf16*)(ws + WS_R1); bf16* YRET = (bf16*)(ws + WS_R1); bf16* HIDS = (bf16*)(ws + WS_R1);
    bf16* SBQ = (bf16*)(ws + WS_SBQ); bf16* SBK = (bf16*)(ws + WS_SBK); bf16* SBV = (bf16*)(ws + WS_SBV); bf16* RQ = (bf16*)(ws + WS_RQ); bf16* RK = (bf16*)(ws + WS_RK);
    bf16* RV = (bf16*)(ws + WS_RV); bf16* RG = (bf16*)(ws + WS_RG); bf16* YSB = (bf16*)(ws + WS_YSB); bf16* GATES = (bf16*)args.out;
    bf16* MIX = (bf16*)(ws + WS_MIX); bf16* HB = (bf16*)(ws + WS_HB);
    volatile LAS int* rowtok = (volatile LAS int*)(lds + 131072);

    if (IN(0)) { p0_prologue(args, lds, vcu, G, wave, lane); }
    SEAM(0);
    if (IN(1)) {
        pg8::StaticOrder S; S.init(XN, W1, T, N1, 1024, G, bx);
        Epi1 E{SBQ, SBK, SBV, RQ, RK, RV, RG, GATES, args.in[4], (const float*)(ws + WS_ROT), args.rep};
        pg8::gemm_phase<Epi1, pg8::StaticOrder, true, true>(lds, 1024, S, E);
    }
    SEAM(1);
    if (IN(2)) {
        const int nret = G >> 1;
#ifdef PROBE_ABL
        if (args.rep) { if (PROBE_ABL == 1) { if (bx < nret) kv_chain(RK, RV, (bf16*)(ws + WS_KV), lds, bx, nret, tid, wave, lane); }
                        else { sb_phase(SBQ, SBK, SBV, YSB, lds, bx, G, tid, wave, lane, true); } } else
#endif
        {
        if (bx < nret) kv_chain(RK, RV, (bf16*)(ws + WS_KV), lds, bx, nret, tid, wave, lane);
        if (G == 256) { for (int k = 0; k < (bx < nret ? 3 : 5); ++k) { const int u = bx < nret ? 8 * bx + k : 8 * (bx - nret) + 3 + k; sb_phase(SBQ, SBK, SBV, YSB, lds, u, 1 << 20, tid, wave, lane); } }
        else sb_phase(SBQ, SBK, SBV, YSB, lds, bx, G, tid, wave, lane);
        }
    }
    SEAM(2);
    if (IN(3)) { ret_phase(RQ, RK, RV, RG, args.in[7], (const bf16*)(ws + WS_KV), YRET, lds, bx, G, tid, wave, lane); }
    SEAM(3);
    if (IN(4)) {
        CatOrder S; S.init(YSB, ws + WS_WCAT, T, 1024, 1536, G, bx); S.A2 = (const char*)YRET; S.K1 = 512; S.K2 = 1024;
        EpiMixCat E{GATES, MIX};
        pg8::gemm_phase<EpiMixCat, CatOrder, true, true, false, 8>(lds, 1536, S, E, 512, 1024);
    }
    SEAM(4);
    if (IN(5)) {
        pg8::StaticOrder S; S.init(MIX, ws + WS_WOUT, T, 1024, 1024, G, bx);
        EpiOut E{args.in[0], args.out, HB};
        pg8::gemm_phase<EpiOut, pg8::StaticOrder, true, true>(lds, 1024, S, E);
    }
    SEAM(5);
    if (IN(6)) { p_route(args, lds, vcu, G, wave, lane, tid); }
    SEAM(6);
    if (IN(7)) {
        build_class_table(args, tab, tid);
        MoeOrder S{(const char*)HB, (const char*)(ws + WS_WUP), tab, rowtok, 8, 1, G, bx};
        S.build((const int*)(ws + WS_PERM), tid);
        EpiUp E{(const TokInfo*)(ws + WS_TOK), rowtok, HIDS};
        pg8::gemm_phase<EpiUp, MoeOrder, true, true, true>(lds, 1024, S, E);
    }
    SEAM(7);
    if (IN(8)) {
        build_class_table(args, tab, tid);
        MoeOrder S{(const char*)HIDS, (const char*)(ws + WS_WDN), tab, rowtok, 4, 0, G, bx};
        S.build((const int*)(ws + WS_PERM), tid);
        EpiDown E{rowtok, args.out, args.in[17], (float*)(ws + WS_XBUF), (unsigned*)(ws + WS_CTL) + CW_ROWT, lds + 131072 + 6144};
        pg8::gemm_phase<EpiDown, MoeOrder, true, true>(lds, 1024, S, E);
    }
#undef IN
#undef SEAM
}

extern "C" void kernel_launch(void* const* d_in, const int* in_sizes, int n_in, void* d_out, int out_size, void* d_ws, size_t ws_size, hipStream_t stream) {
    static int grid = 0;
    if (grid == 0) {
        if (n_in != 18 || in_sizes[0] != T * DM || out_size != T * DM || ws_size < WS_END) { fprintf(stderr, "kernel_launch: unexpected shapes (n_in %d, in0 %d, out %d, ws %zu < %zu)\n", n_in, n_in > 0 ? in_sizes[0] : -1, out_size, ws_size, (size_t)WS_END); grid = -1; return; }
        int dev = 0, cus = 0, per_cu = 0;
        if (hipGetDevice(&dev) != hipSuccess || hipDeviceGetAttribute(&cus, hipDeviceAttributeMultiprocessorCount, dev) != hipSuccess) { grid = -1; return; }
        if (hipFuncSetAttribute((const void*)fwd_kernel, hipFuncAttributeMaxDynamicSharedMemorySize, LDS_BYTES) != hipSuccess) { fprintf(stderr, "kernel_launch: hipFuncSetAttribute failed\n"); grid = -1; return; }
        if (hipOccupancyMaxActiveBlocksPerMultiprocessor(&per_cu, (const void*)fwd_kernel, NTHR, LDS_BYTES) != hipSuccess || per_cu < 1) fprintf(stderr, "kernel_launch: occupancy query reports %d\n", per_cu);
        (void)hipGetLastError();
        grid = cus;
    }
    if (grid < 0) return;
    hipMemsetAsync((char*)d_ws + WS_CTL, 0, CTL_ZERO_BYTES, stream);
    Args a{};
    for (int i = 0; i < 18; ++i) a.in[i] = (const float*)d_in[i];
    a.out = (float*)d_out; a.ws = (unsigned char*)d_ws;
#if MK_ONE_LAUNCH
    a.ph_lo = 0; a.ph_hi = NPHASE;
    hipLaunchKernelGGL(fwd_kernel, dim3(grid), dim3(NTHR), LDS_BYTES, stream, a);
#else
    for (int p = 0; p < NPHASE; ++p) for (int rep = 0; rep < ((PROBE_MASK >> p) & 1) + 1; ++rep) { a.ph_lo = p; a.ph_hi = p + 1; a.rep = rep; hipLaunchKernelGGL(fwd_kernel, dim3(grid), dim3(NTHR), LDS_BYTES, stream, a); }
#endif
}
```

```cpp
#include <hip/hip_runtime.h>
#include <cstdio>
#include <cstdint>
namespace pg8 {
#define PG8_LAS __attribute__((address_space(3)))
typedef unsigned short bf16_t;
typedef short bf16x8 __attribute__((ext_vector_type(8)));
typedef float f32x4 __attribute__((ext_vector_type(4)));
typedef unsigned u32x4 __attribute__((ext_vector_type(4)));
constexpr int BM = 256, BK = 64, HALF = 128, HTB = HALF * BK * 2  , STAGE_BYTES = 8 * HTB, NXCD = 8, WGM = 8;
__host__ __device__ __forceinline__ int lds_byte(int r, int c) { const int st = (r >> 4) * 2 + (c >> 5), rr = r & 15, cc = c & 31, ob = rr * 64 + cc * 2; return st * 1024 + (ob ^ (((ob >> 9) & 1) << 5)); }
__host__ __device__ __forceinline__ void stage_rc(int b, int& R, int& C) { const int st = b / 1024, sb = b % 1024, swz = sb ^ (((sb >> 9) & 1) << 5); R = (st >> 1) * 16 + swz / 64; C = (st & 1) * 32 + (swz % 64) / 2; }
__host__ __device__ __forceinline__ int perm32(int rho) { const int n = rho >> 4, i = rho & 15; return 8 * (i >> 2) + 4 * n + (i & 3); }

struct Unit { const char* a; const char* b; const char* a2; int row0, col0, tag, idx; };
struct StaticOrder {
    const char* A; const char* Bt; int K, nM, nN, nwg, G, c;
    __device__ void init(const void* A_, const void* Bt_, int M, int N, int K_, int G_, int c_) { A = (const char*)A_; Bt = (const char*)Bt_; K = K_; nM = M / BM; nN = N / BM; nwg = nM * nN; G = G_; c = c_; }
    __device__ bool next(int i, Unit& u) const {
        const long L = (long)i * G + c; if (L >= nwg) return false;
        int wgid = (int)L; { const int q = nwg / NXCD, r = nwg % NXCD, xcd = wgid % NXCD, off = wgid / NXCD; wgid = (xcd < r ? xcd * (q + 1) : r * (q + 1) + (xcd - r) * q) + off; }
        const int nig = WGM * nN, gid = wgid / nig, fm = gid * WGM, gsz = (nM - fm) < WGM ? (nM - fm) : WGM;
        const int pm = fm + ((wgid % nig) % gsz), pn = (wgid % nig) / gsz;
        u.a = A + (size_t)pm * BM * K * 2; u.a2 = nullptr; u.b = Bt + (size_t)pn * BM * K * 2; u.row0 = pm * BM; u.col0 = pn * BM; u.tag = pn; u.idx = i; return true;
    }
    __device__ __forceinline__ void a_ready(const Unit&) const {}
    __device__ __forceinline__ void done(const Unit&) const {}
};
__device__ __forceinline__ unsigned cvt_pk_bf16(float lo, float hi) { unsigned r; asm volatile("v_cvt_pk_bf16_f32 %0, %1, %2" : "=v"(r) : "v"(lo), "v"(hi)); return r; }
template <class Epi, class Sched, bool ALIGN_EPI = false, bool SP2 = false, bool GATHER = false, int KSPLIT = 0, bool HALFSKIP = false>
__device__ __forceinline__ void gemm_phase(PG8_LAS unsigned char* lds, const int K, const Sched& S, const Epi& E, const int ka1 = 0, const int ka2 = 0) {
    const int tid = threadIdx.x, wid = __builtin_amdgcn_readfirstlane(tid >> 6), lane = tid & 63, wr = wid >> 2, wc = wid & 3, fr = lane & 15, fq = lane >> 4;
    const int nt = K / BK;
    static_assert(!GATHER || SP2, "GATHER is implemented on the SP2 loop only");
    unsigned voffA[2], voffA1[2], voffB[2]; int Rr[2], Cc[2];
#pragma unroll
    for (int i = 0; i < 2; ++i) { int R, C; stage_rc(tid * 16 + i * 8192, R, C); const int Rb = Epi::PERM ? ((R & ~31) + perm32(R & 31)) : R; Rr[i] = R; Cc[i] = C;
        const int KA = KSPLIT ? ka1 : K;
        voffA[i] = (unsigned)(R * KA + C) * 2u; voffA1[i] = 0u; voffB[i] = (unsigned)(Rb * K + C) * 2u; }
    unsigned voffAs[2] = {0u, 0u};
    if constexpr (KSPLIT != 0) {
#pragma unroll
        for (int i = 0; i < 2; ++i) voffAs[i] = (unsigned)(Rr[i] * ka2 + Cc[i]) * 2u; }
    const size_t hs1 = GATHER ? 0 : (size_t)HALF * (KSPLIT ? ka1 : K) * 2, hs2 = (size_t)HALF * ka2 * 2;
#define PG8_AROWS(ui_, v0_, v1_) do { _Pragma("unroll") for (int i_ = 0; i_ < 2; ++i_) { \
        v0_[i_] = (unsigned)(S.arow((ui_), Rr[i_]) * K + Cc[i_]) * 2u; v1_[i_] = (unsigned)(S.arow((ui_), Rr[i_] + HALF) * K + Cc[i_]) * 2u; } } while (0)
    const size_t kstep = (size_t)(BK * 2);
    const size_t hstep = (size_t)HALF * K * 2;
    const size_t tstep = 2 * hstep;
    const unsigned ldsw = (unsigned)wid * 1024u;
    const int aoff = lds_byte(wr * 64 + fr, fq * 8), boff = lds_byte(wc * 32 + fr, fq * 8);
#define PG8_SA(b, h) (((b) * 2 + (h)) * HTB)
#define PG8_SB(b, h) ((4 + (b) * 2 + (h)) * HTB)
#define PG8_STAGE(bufoff, gbase, voff) do { _Pragma("unroll") for (int _i = 0; _i < 2; ++_i) \
        __builtin_amdgcn_global_load_lds((const unsigned*)((const char*)(gbase) + (voff)[_i]), (PG8_LAS unsigned*)(lds + (bufoff) + ldsw + _i * 8192), 16, 0, 0); } while (0)
#define PG8_LDA(dst, b, h) do { _Pragma("unroll") for (int m = 0; m < 4; ++m) _Pragma("unroll") for (int k = 0; k < 2; ++k) dst[m][k] = *(const PG8_LAS bf16x8*)(lds + PG8_SA(b, h) + aoff + m * 2048 + k * 1024); } while (0)
#define PG8_LDB(dst, b, h) do { _Pragma("unroll") for (int n = 0; n < 2; ++n) _Pragma("unroll") for (int k = 0; k < 2; ++k) dst[n][k] = *(const PG8_LAS bf16x8*)(lds + PG8_SB(b, h) + boff + n * 2048 + k * 1024); } while (0)
#define PG8_MMA(ai, bj, At, Bt) do { __builtin_amdgcn_s_setprio(1); _Pragma("unroll") for (int m = 0; m < 4; ++m) _Pragma("unroll") for (int n = 0; n < 2; ++n) _Pragma("unroll") for (int k = 0; k < 2; ++k) \
        acc[ai][bj][m][n] = __builtin_amdgcn_mfma_f32_16x16x32_bf16(Bt[n][k], At[m][k], acc[ai][bj][m][n], 0, 0, 0); __builtin_amdgcn_s_setprio(0); } while (0)
#define PG8_WAIT_V(n) asm volatile("s_waitcnt vmcnt(" #n ")" ::: "memory")
#define PG8_WAIT_L(n) asm volatile("s_waitcnt lgkmcnt(" #n ")" ::: "memory")
#define PG8_BAR __builtin_amdgcn_s_barrier()
#define PG8_SCHED __builtin_amdgcn_sched_barrier(0)
    Unit cur, nxt; int ui = 0;
    if (!S.next(0, cur)) return;
    f32x4 acc[2][2][4][2];
#pragma unroll
    for (int a = 0; a < 2; ++a)
#pragma unroll
        for (int b = 0; b < 2; ++b)
#pragma unroll
            for (int m = 0; m < 4; ++m)
#pragma unroll
                for (int n = 0; n < 2; ++n) acc[a][b][m][n] = (f32x4){0.f, 0.f, 0.f, 0.f};
    bf16x8 At[4][2], B0[2][2], B1[2][2];
    const char* cA = cur.a; const char* cB = cur.b;
    S.a_ready(cur);
    if constexpr (SP2) {
        if constexpr (GATHER) PG8_AROWS(0, voffA, voffA1);
        PG8_STAGE(PG8_SB(0, 0), cB, voffB); PG8_STAGE(PG8_SB(0, 1), cB + hstep, voffB); PG8_STAGE(PG8_SA(0, 0), cA, voffA); if constexpr (GATHER) PG8_STAGE(PG8_SA(0, 1), cA, voffA1); else PG8_STAGE(PG8_SA(0, 1), cA + hs1, voffA);
        if (wr == 1) PG8_BAR;
        PG8_WAIT_V(2); PG8_BAR;
        PG8_STAGE(PG8_SB(1, 0), cB + kstep, voffB); PG8_STAGE(PG8_SA(1, 0), cA + kstep, voffA); PG8_STAGE(PG8_SB(1, 1), cB + hstep + kstep, voffB);
        PG8_WAIT_V(6); PG8_BAR;
    } else {
        PG8_STAGE(PG8_SB(0, 0), cB, voffB); PG8_STAGE(PG8_SA(0, 0), cA, voffA); PG8_STAGE(PG8_SB(0, 1), cB + hstep, voffB); PG8_STAGE(PG8_SA(0, 1), cA + hstep, voffA);
        if (wr == 1) PG8_BAR;
        PG8_WAIT_V(4); PG8_BAR;
        PG8_STAGE(PG8_SB(1, 0), cB + kstep, voffB); PG8_STAGE(PG8_SA(1, 0), cA + kstep, voffA); PG8_STAGE(PG8_SB(1, 1), cB + hstep + kstep, voffB);
        PG8_WAIT_V(6); PG8_BAR;
    }
    for (;;) {
        const bool has_next = S.next(ui + 1, nxt);
        const char* nA = has_next ? nxt.a : cA; const char* nB = has_next ? nxt.b : cB;
        const bool halfu = HALFSKIP && (cur.tag & 32) != 0;
        for (int t = 0; t < nt; t += 2) {
            const bool last = (t == nt - 2);
            const bool s1 = KSPLIT != 0 && t + 1 >= KSPLIT, s2 = KSPLIT != 0 && !last && t + 2 >= KSPLIT;
            if constexpr (KSPLIT != 0) { if (t == KSPLIT) E.mid(acc, cur, wr, wc, fr, fq); }
            const char* a1 = s1 ? cur.a2 + (size_t)(t + 1 - KSPLIT) * kstep : cA + (size_t)(t + 1) * kstep;
            const char* a2 = last ? nA : (s2 ? cur.a2 + (size_t)(t + 2 - KSPLIT) * kstep : cA + (size_t)(t + 2) * kstep); const char* b2 = last ? nB : cB + (size_t)(t + 2) * kstep;
            const char* a3 = a2 + kstep; const char* b3 = b2 + kstep;
            if (last && has_next) S.a_ready(nxt);
            unsigned vx0[2], vx1[2], vy1[2];
#pragma unroll
            for (int i = 0; i < 2; ++i) { vx0[i] = s2 ? voffAs[i] : voffA[i]; vx1[i] = GATHER ? voffA1[i] : vx0[i]; vy1[i] = GATHER ? voffA1[i] : (s1 ? voffAs[i] : voffA[i]); }
            if constexpr (GATHER) { if (last && has_next) PG8_AROWS(ui + 1, vx0, vx1); }
            const size_t hy1 = s1 ? hs2 : hs1, hx1 = s2 ? hs2 : hs1;
            if constexpr (SP2) {
            PG8_LDB(B0, 0, 0); PG8_LDB(B1, 0, 1); PG8_SCHED; PG8_LDA(At, 0, 0); PG8_STAGE(PG8_SA(1, 1), a1 + hy1, vy1);
            PG8_WAIT_V(8); PG8_WAIT_L(0); PG8_BAR; PG8_MMA(0, 0, At, B0); PG8_MMA(0, 1, At, B1); PG8_BAR; PG8_SCHED;
            PG8_LDA(At, 0, 1); PG8_STAGE(PG8_SB(0, 0), b2, voffB); PG8_STAGE(PG8_SB(0, 1), b2 + hstep, voffB); PG8_STAGE(PG8_SA(0, 0), a2, vx0);
            PG8_WAIT_V(8); PG8_WAIT_L(0); PG8_BAR; if (!halfu) { PG8_MMA(1, 0, At, B0); PG8_MMA(1, 1, At, B1); } PG8_BAR; PG8_SCHED;
            PG8_LDB(B0, 1, 0); PG8_LDB(B1, 1, 1); PG8_SCHED; PG8_LDA(At, 1, 0); PG8_STAGE(PG8_SA(0, 1), a2 + hx1, vx1);
            PG8_WAIT_V(8); PG8_WAIT_L(0); PG8_BAR; PG8_MMA(0, 0, At, B0); PG8_MMA(0, 1, At, B1); PG8_BAR; PG8_SCHED;
            PG8_LDA(At, 1, 1); PG8_STAGE(PG8_SB(1, 0), b3, voffB); PG8_STAGE(PG8_SB(1, 1), b3 + hstep, voffB); PG8_STAGE(PG8_SA(1, 0), a3, vx0);
            PG8_WAIT_V(8); PG8_WAIT_L(0); PG8_BAR; if (!halfu) { PG8_MMA(1, 0, At, B0); PG8_MMA(1, 1, At, B1); } PG8_BAR; PG8_SCHED;
            } else {
            PG8_LDB(B0, 0, 0); PG8_SCHED; PG8_LDA(At, 0, 0); PG8_STAGE(PG8_SA(1, 1), a1 + hstep, voffA);
            PG8_WAIT_L(8); PG8_BAR; PG8_WAIT_L(0); PG8_MMA(0, 0, At, B0); PG8_BAR; PG8_SCHED;
            PG8_LDB(B1, 0, 1); PG8_STAGE(PG8_SB(0, 0), b2, voffB);
            PG8_BAR; PG8_WAIT_L(0); PG8_MMA(0, 1, At, B1); PG8_BAR;
            PG8_LDA(At, 0, 1); PG8_STAGE(PG8_SA(0, 0), a2, voffA);
            PG8_BAR; PG8_WAIT_L(0); PG8_MMA(1, 0, At, B0); PG8_BAR; PG8_SCHED;
            PG8_STAGE(PG8_SB(0, 1), b2 + hstep, voffB);
            PG8_WAIT_V(6); PG8_BAR; PG8_MMA(1, 1, At, B1); PG8_BAR;
            PG8_LDB(B0, 1, 0); PG8_SCHED; PG8_LDA(At, 1, 0); PG8_STAGE(PG8_SA(0, 1), a2 + hstep, voffA);
            PG8_WAIT_L(8); PG8_BAR; PG8_WAIT_L(0); PG8_MMA(0, 0, At, B0); PG8_BAR; PG8_SCHED;
            PG8_LDB(B1, 1, 1); PG8_STAGE(PG8_SB(1, 0), b3, voffB);
            PG8_BAR; PG8_WAIT_L(0); PG8_MMA(0, 1, At, B1); PG8_BAR;
            PG8_LDA(At, 1, 1); PG8_STAGE(PG8_SA(1, 0), a3, voffA);
            PG8_BAR; PG8_WAIT_L(0); PG8_MMA(1, 0, At, B0); PG8_BAR; PG8_SCHED;
            PG8_STAGE(PG8_SB(1, 1), b3 + hstep, voffB);
            PG8_WAIT_V(6); PG8_BAR; PG8_MMA(1, 1, At, B1); PG8_BAR;
            }
        }
        if constexpr (ALIGN_EPI) { if (wr == 0) PG8_BAR; }
        if constexpr (!Epi::AFTER_DRAIN) { if constexpr (Epi::INPLACE) E.inplace(acc, cur, wr, wc, fr, fq, wid, lane); else E(acc, cur, wr, wc, fr, fq); S.done(cur); }
        if (!has_next) break;
#pragma unroll
        for (int a = 0; a < 2; ++a)
#pragma unroll
            for (int b = 0; b < 2; ++b)
#pragma unroll
                for (int m = 0; m < 4; ++m)
#pragma unroll
                    for (int n = 0; n < 2; ++n) acc[a][b][m][n] = (f32x4){0.f, 0.f, 0.f, 0.f};
        cur = nxt; cA = nA; cB = nB; ++ui;
        if constexpr (GATHER) PG8_AROWS(ui, voffA, voffA1);
        if constexpr (ALIGN_EPI) { if (wr == 1) PG8_BAR; }
    }
    PG8_WAIT_V(0);
    if constexpr (!ALIGN_EPI) { if (wr == 0) PG8_BAR; }
    PG8_BAR;
    if constexpr (Epi::AFTER_DRAIN) { E.fused(acc, cur, wr, wc, fr, fq, lds, wid, lane); S.done(cur); }
#undef PG8_AROWS
#undef PG8_SA
#undef PG8_SB
#undef PG8_STAGE
#undef PG8_LDA
#undef PG8_LDB
#undef PG8_MMA
#undef PG8_WAIT_V
#undef PG8_WAIT_L
#undef PG8_BAR
#undef PG8_SCHED
}
}
#define GAS __attribute__((address_space(1)))
#define LAS __attribute__((address_space(3)))
typedef unsigned short bf16;
typedef unsigned v4u __attribute__((ext_vector_type(4)));
typedef float f32x4 __attribute__((ext_vector_type(4)));
typedef short bf16x8 __attribute__((ext_vector_type(8)));
typedef GAS unsigned gu32;
typedef GAS unsigned long long gu64;
#define RLX_AGENT __ATOMIC_RELAXED, __HIP_MEMORY_SCOPE_AGENT
#define LDS_WAIT() asm volatile("s_waitcnt lgkmcnt(0)" ::: "memory")
#define VM_WAIT() asm volatile("s_waitcnt vmcnt(0)" ::: "memory")
__device__ __forceinline__ unsigned long long rt() { return __builtin_amdgcn_s_memrealtime(); }
__device__ __forceinline__ unsigned f2bf(float f) { unsigned u = __builtin_bit_cast(unsigned, f); return (u + 0x7fffu + ((u >> 16) & 1u)) >> 16; }
__device__ __forceinline__ unsigned pk2(float lo, float hi) { return f2bf(lo) | (f2bf(hi) << 16); }

#define XB_TMO      128
#define XB_XCNT(j)  (256  + 64 * (j))
#define XB_XSUB(j)  (1280 + 64 * (j))
#define XB_XGEN(j)  (2304 + 64 * (j))
#define XB_TOP      3328
#define XB_TOPGEN   3392
#define XCD_BAR_WORDS 3456
#define XB_SPIN_CAP (1u << 18)

__device__ __forceinline__ unsigned xb_ld(unsigned* p)              { return __hip_atomic_load(p, __ATOMIC_RELAXED, __HIP_MEMORY_SCOPE_AGENT); }
__device__ __forceinline__ unsigned xb_add(unsigned* p, unsigned v) { return __hip_atomic_fetch_add(p, v, __ATOMIC_RELAXED, __HIP_MEMORY_SCOPE_AGENT); }
__device__ __forceinline__ unsigned xb_xcc_id() { return (unsigned)__builtin_amdgcn_s_getreg((3 << 11) | 20) & 0xFu; }
#define XB_SPIN(cond, bar) do { unsigned _sp = 0; while (cond) { __builtin_amdgcn_s_sleep(1); \
    if ((++_sp & 255u) == 0u) { if (xb_ld(&(bar)[XB_TMO])) break; if (_sp > XB_SPIN_CAP) { atomicAdd(&(bar)[XB_TMO], 1u); break; } } } } while (0)

struct XcdBarrier {
    unsigned* bar; unsigned x;
    volatile LAS unsigned* st;
};

__device__ __forceinline__ XcdBarrier xcd_barrier_post(unsigned* bar, volatile LAS unsigned* st) {
    XcdBarrier b; b.bar = bar; b.x = xb_xcc_id(); b.st = st;
    if (threadIdx.x == 0) (void)xb_add(&bar[XB_XCNT(b.x)], 1u);
    return b;
}
__device__ __forceinline__ void xcd_barrier_complete(unsigned* bar, unsigned x, unsigned& nloc, unsigned& nx) {
    const unsigned G = gridDim.x * gridDim.y * gridDim.z;
    unsigned sum, cnt, mine, sp = 0u;
    for (;;) {
        sum = 0u; cnt = 0u; mine = 0u;
#pragma unroll
        for (unsigned j = 0; j < 16; ++j) { const unsigned c = xb_ld(&bar[XB_XCNT(j)]); sum += c; cnt += (c > 0u) ? 1u : 0u; mine = (j == x) ? c : mine; }
        if (sum == G) break;
        __builtin_amdgcn_s_sleep(1);
        if ((++sp & 255u) == 0u) { if (xb_ld(&bar[XB_TMO])) break; if (sp > XB_SPIN_CAP) { atomicAdd(&bar[XB_TMO], 1u); break; } }
    }
    nloc = mine > 0u ? mine : 1u; nx = cnt > 0u ? cnt : 1u;
}

__device__ __forceinline__ void xcd_barrier(const XcdBarrier& b) {
    asm volatile("s_waitcnt vmcnt(0)" ::: "memory");
    __syncthreads();
    if (threadIdx.x == 0) {
        unsigned* bar = b.bar;
        __builtin_amdgcn_s_waitcnt(0);
        unsigned nloc = b.st[0], nx = b.st[1];
        if (nloc == 0u) { xcd_barrier_complete(bar, b.x, nloc, nx); b.st[0] = nloc; b.st[1] = nx; }
        const unsigned old = xb_add(&bar[XB_XSUB(b.x)], 1u);
        const unsigned gen = old / nloc;
        if (old + 1u == (gen + 1u) * nloc) {
            __builtin_amdgcn_fence(__ATOMIC_RELEASE, "agent");
            asm volatile("s_waitcnt vmcnt(0)" ::: "memory");
            const unsigned og = xb_add(&bar[XB_TOP], 1u);
            const unsigned tg = og / nx;
            if (og + 1u == (tg + 1u) * nx) xb_add(&bar[XB_TOPGEN], 1u);
            else XB_SPIN(xb_ld(&bar[XB_TOPGEN]) == tg, bar);
            __builtin_amdgcn_fence(__ATOMIC_ACQUIRE, "agent");
            xb_add(&bar[XB_XGEN(b.x)], 1u);
            asm volatile("s_waitcnt vmcnt(0)" ::: "memory");
        } else {
            XB_SPIN(xb_ld(&bar[XB_XGEN(b.x)]) == gen, bar);
            __builtin_amdgcn_fence(__ATOMIC_ACQUIRE, "agent");
            asm volatile("s_waitcnt vmcnt(0)" ::: "memory");
        }
    }
    __syncthreads();
}


constexpr int NWAVES = 8, NTHR = NWAVES * 64;
constexpr int DM = 1024, NB = 16, SEQ = 2048, T = NB * SEQ;
constexpr int N1 = 6656;
constexpr int NCLS = 24, SROWS = T + NCLS * 256;
constexpr float EPS = 1e-6f;
constexpr size_t MiB = 1u << 20;
constexpr size_t WS_CTL = 0, CTL_ZERO_BYTES = 1 * MiB;
constexpr size_t WS_ROT = 1 * MiB;
constexpr size_t WS_WRT = 1 * MiB + 512 * 1024;
constexpr size_t WS_TOK = 2 * MiB;
constexpr size_t WS_RSTD = 2 * MiB + 512 * 1024;
constexpr size_t WS_XBUF = 3 * MiB;
constexpr size_t WS_W1 = 4 * MiB, WS_WCAT = 18 * MiB  , WS_WOUT = 21 * MiB, WS_WUP = 23 * MiB, WS_WDN = 55 * MiB;
constexpr size_t WS_R1 = 104 * MiB;
constexpr size_t WS_SBQ = 168 * MiB, WS_SBK = 200 * MiB, WS_SBV = 232 * MiB, WS_RQ = 264 * MiB, WS_RK = 296 * MiB, WS_RV = 328 * MiB, WS_RG = 392 * MiB, WS_YSB = WS_SBQ;
constexpr size_t WS_MIX = WS_SBV, WS_HB = WS_RG;
constexpr size_t WS_HLO = WS_RV;
constexpr size_t WS_PERM = WS_W1;
constexpr size_t WS_KV = 456 * MiB;
constexpr size_t WS_END = 488 * MiB;
constexpr size_t WS_PROBE = 200 * MiB;
constexpr int CW_BAR = 4096, CW_CNT = 8192, CW_ROWT = 16384, CW_UPD = 32768, CW_WDN = 2048;
constexpr int LDS_BYTES = 147456;
constexpr int LDSCTL_OFF = LDS_BYTES - 1024, MISC_OFF = LDSCTL_OFF + 320, TAB_OFF = LDSCTL_OFF + 512;

struct TokInfo { float ga, gb, rstd; int cls; };

__device__ __forceinline__ float wave_sum(float v) {
#pragma unroll
    for (int o = 1; o < 64; o <<= 1) v += __shfl_xor(v, o);
    return v;
}
__device__ __forceinline__ float bf2f(unsigned short b) { return __builtin_bit_cast(float, (unsigned)b << 16); }
__device__ __forceinline__ float bflo(unsigned w) { return __builtin_bit_cast(float, w << 16); }
__device__ __forceinline__ float bfhi(unsigned w) { return __builtin_bit_cast(float, w & 0xffff0000u); }

struct Args { const float* in[18]; float* out; unsigned char* ws; int ph_lo, ph_hi, rep, pad; };

struct TJob { const float* W; int N; bf16* WT; int ldk, koff, mode, nbase; const float* gk; };
__device__ __forceinline__ int rowmap(int mode, int n) {
    if (mode == 1) {
        if (n >= 1536 && n < 2560) { const int seg = n < 2048 ? 1536 : 2048, c = n - seg, hh = c >> 6, i = c & 63; return seg + (hh >> 2) * 256 + (i >> 5) * 128 + (hh & 3) * 32 + (i & 31); }
        return n;
    }
    if (mode == 2) return (n >> 7) * 256 + (n & 127);
    if (mode == 3) return (n >> 7) * 256 + 128 + (n & 127);
    return n;
}
__device__ __forceinline__ void p0_transpose_item(const TJob& J, LAS float* scr, int item, int lane) {
    const int nblk = J.N / 32, kb = item / nblk, nb = item % nblk, k0 = 64 * kb, n0 = 32 * nb;
#pragma unroll 8
    for (int i = 0; i < 32; ++i) { const int kk = 2 * i + (lane >> 5); scr[kk * 33 + (lane & 31)] = J.W[(size_t)(k0 + kk) * J.N + n0 + (lane & 31)]; }
    LDS_WAIT(); asm volatile("" ::: "memory");
    const int c = lane & 7;
#pragma unroll
    for (int j = 0; j < 4; ++j) { const int n = (lane >> 3) + 8 * j; const LAS float* s = scr + (8 * c) * 33 + n;
        const int ng = n0 + n; float sc = 1.f; if (J.mode == 1) { if (ng < 512) sc = 0.125f * 1.4426950408889634f; else if (ng >= 2048 && ng < 2560) sc = 0.125f; }
        float g8[8];
#pragma unroll
        for (int q = 0; q < 8; ++q) g8[q] = J.gk ? J.gk[k0 + 8 * c + q] * sc : sc;
        v4u o; o.x = pk2(s[0 * 33] * g8[0], s[1 * 33] * g8[1]); o.y = pk2(s[2 * 33] * g8[2], s[3 * 33] * g8[3]); o.z = pk2(s[4 * 33] * g8[4], s[5 * 33] * g8[5]); o.w = pk2(s[6 * 33] * g8[6], s[7 * 33] * g8[7]);
        *(GAS v4u*)(J.WT + (size_t)(J.nbase + rowmap(J.mode, ng)) * J.ldk + J.koff + k0 + 8 * c) = o; }
    LDS_WAIT(); asm volatile("" ::: "memory");
}
__device__ __forceinline__ void p0_prologue(const Args& a, LAS unsigned char* lds, int vcu, int G, int wave, int lane) {
    unsigned char* ws = a.ws;
    LAS float* scr = (LAS float*)(lds + wave * 16384);
    const int gw = vcu * NWAVES + wave, NGW = G * NWAVES;
    constexpr int I0 = 16 * 144, I1 = 16 * 64, I2 = 8 * 32, I3 = 16 * 32, I4 = 16 * 32, I5 = 16 * 256, I6 = 16 * 256, I7 = 48 * 256;
    constexpr int NITEMS = I0 + I1 + I2 + I3 + I4 + I5 + I6;
    for (int it = gw; it < NITEMS; it += NGW) {
        int r = it; TJob J;
        if (r < I0) { J = TJob{a.in[2], 4608, (bf16*)(ws + WS_W1), 1024, 0, 1, 0, nullptr}; }
        else if ((r -= I0) < I1) { J = TJob{a.in[3], 2048, (bf16*)(ws + WS_W1), 1024, 0, 0, 4608, nullptr}; }
        else if ((r -= I1) < I2) { J = TJob{a.in[5], 1024, (bf16*)(ws + WS_WCAT), 1536, 0, 0, 0, nullptr}; }
        else if ((r -= I2) < I3) { J = TJob{a.in[6], 1024, (bf16*)(ws + WS_WCAT), 1536, 512, 0, 0, nullptr}; }
        else if ((r -= I3) < I4) { J = TJob{a.in[8], 1024, (bf16*)(ws + WS_WOUT), 1024, 0, 0, 0, nullptr}; }
        else if ((r -= I4) < I5) { const int e = r >> 8; r &= 255; J = TJob{a.in[14] + (size_t)e * 1024 * 512, 512, (bf16*)(ws + WS_WUP) + (size_t)e * 1024 * 1024, 1024, 0, 2, 0, a.in[9]}; }
        else { r -= I5; const int e = r >> 8; r &= 255; J = TJob{a.in[15] + (size_t)e * 1024 * 512, 512, (bf16*)(ws + WS_WUP) + (size_t)e * 1024 * 1024, 1024, 0, 3, 0, a.in[9]}; }
        p0_transpose_item(J, scr, r, lane);
    }
    const float* x = a.in[0]; const float* g = a.in[1]; bf16* xn = (bf16*)(ws + WS_R1);
    f32x4 gv[4];
#pragma unroll
    for (int j = 0; j < 4; ++j) gv[j] = ((const f32x4*)g)[lane + 64 * j];
    for (int m = gw; m < T; m += NGW) {
        const GAS f32x4* xr = (const GAS f32x4*)(x + (size_t)m * DM) + lane;
        f32x4 v[4]; float s = 0.f;
#pragma unroll
        for (int j = 0; j < 4; ++j) { v[j] = xr[64 * j]; s += (v[j].x * v[j].x + v[j].y * v[j].y) + (v[j].z * v[j].z + v[j].w * v[j].w); }
        const float rstd = 1.f / sqrtf(wave_sum(s) * (1.f / DM) + EPS);
        GAS unsigned long long* o8 = (GAS unsigned long long*)(xn + (size_t)m * DM) + lane;
#pragma unroll
        for (int j = 0; j < 4; ++j) { const f32x4 y = v[j] * rstd * gv[j]; o8[64 * j] = (unsigned long long)pk2(y.x, y.y) | ((unsigned long long)pk2(y.z, y.w) << 32); }
    }
    float* rot = (float*)(ws + WS_ROT);
    for (int idx = gw * 64 + lane; idx < SEQ * 32; idx += NGW * 64) {
        const int pos = idx >> 5, i = idx & 31;
        const float inv = (float)exp(-(double)i * (9.210340371976184 / 32.0));
        const float ang = (float)pos * inv;
        rot[idx] = (float)cos((double)ang); rot[SEQ * 32 + idx] = (float)sin((double)ang);
    }
    bf16* wrt = (bf16*)(ws + WS_WRT);
    for (int idx = gw * 64 + lane; idx < 32 * 1024; idx += NGW * 64) {
        const int o = idx >> 10, k = idx & 1023;
        float v = 0.f; if (o < 8) v = a.in[10][k * 4 + (o & 3)]; else if (o < 24) v = a.in[12][k * 16 + (o - 8)];
        v *= a.in[9][k];
        const unsigned hb_ = f2bf(v); const float lo = v - __builtin_bit_cast(float, hb_ << 16);
        wrt[idx] = (bf16)hb_; wrt[32 * 1024 + idx] = (bf16)f2bf(lo);
    }
}
__device__ __forceinline__ void wdn_items(const Args& a, LAS unsigned char* lds, int rank, int nshare, int wave, int lane) {
    if (rank < 0) return;
    LAS float* scr = (LAS float*)(lds + wave * 16384);
    for (int it = rank * NWAVES + wave; it < 48 * 256; it += nshare * NWAVES) {
        const int cs = it >> 8, r = it & 255, cls = cs >> 1, slot = cs & 1, g = cls / 6, p = cls % 6;
        const int pa = p < 3 ? 0 : (p < 5 ? 1 : 2), pb = p == 0 ? 1 : (p == 1 ? 2 : (p == 2 ? 3 : (p == 3 ? 2 : 3)));
        const int e = 4 * g + (slot ? pb : pa);
        const TJob J{a.in[16] + (size_t)e * 512 * 1024, 1024, (bf16*)(a.ws + WS_WDN) + (size_t)cls * 1024 * 1024, 1024, slot * 512, 0, 0, nullptr};
        p0_transpose_item(J, scr, r, lane);
    }
}

typedef pg8::Unit Unit;
using pg8::cvt_pk_bf16;
__device__ __forceinline__ v4u pack8(const f32x4 a, const f32x4 b) { v4u w; w.x = cvt_pk_bf16(a[0], a[1]); w.y = cvt_pk_bf16(a[2], a[3]); w.z = cvt_pk_bf16(b[0], b[1]); w.w = cvt_pk_bf16(b[2], b[3]); return w; }
__device__ __forceinline__ float sigm(float x) { return 1.f / (1.f + __expf(-x)); }

struct Epi1 {
    static constexpr bool PERM = true, AFTER_DRAIN = false, INPLACE = false;
    bf16 *sbq, *sbk, *sbv, *rq, *rk, *rv, *rg, *gates; const float* bgate; const float* rot; int nostore;
    __device__ __forceinline__ void operator()(const f32x4 (&acc)[2][2][4][2], const Unit& u, int wr, int wc, int fr, int fq) const {
        const int pn = u.tag, rowb = u.row0 + wr * 64 + fr, cw = wc * 32 + 8 * fq;
        if (pn >= 6 && pn < 10) {
            bf16* base = (pn < 8 ? rq : rk) + ((pn & 1) * 4 + wc) * 64 + 8 * fq;
            const int hh_ = (pn & 1) * 4 + wc; const float lg2h = hh_ == 0 ? -4.5803689613e-02f : (hh_ == 1 ? -2.2720076500e-02f : (hh_ == 2 ? -1.1315313228e-02f : (hh_ == 3 ? -5.6465631411e-03f : (hh_ == 4 ? -2.8205190624e-03f : (hh_ == 5 ? -1.4095702547e-03f : (hh_ == 6 ? -7.0461297659e-04f : (-3.5226347163e-04f)))))));
#pragma unroll
            for (int ai = 0; ai < 2; ++ai)
#pragma unroll
                for (int m = 0; m < 4; ++m) { const int row = rowb + ai * 128 + m * 16, pos = row & (SEQ - 1);
                    const f32x4 c0 = *(const f32x4*)(rot + pos * 32 + 8 * fq), c1 = *(const f32x4*)(rot + pos * 32 + 8 * fq + 4);
                    const f32x4 s0 = *(const f32x4*)(rot + SEQ * 32 + pos * 32 + 8 * fq), s1 = *(const f32x4*)(rot + SEQ * 32 + pos * 32 + 8 * fq + 4);
                    const f32x4 x10 = acc[ai][0][m][0], x11 = acc[ai][0][m][1], x20 = acc[ai][1][m][0], x21 = acc[ai][1][m][1];
                    f32x4 o10 = x10 * c0 - x20 * s0, o11 = x11 * c1 - x21 * s1, o20 = x20 * c0 + x10 * s0, o21 = x21 * c1 + x11 * s1;
                    if (pn >= 8) { const float kd = __builtin_amdgcn_exp2f(lg2h * (float)(64 - (pos & 63))); o10 *= kd; o11 *= kd; o20 *= kd; o21 *= kd; }
                    bf16* rowp = base + (size_t)row * 512;
                    const v4u w0 = pack8(o10, o11), w1 = pack8(o20, o21); if (!nostore) { *(v4u*)rowp = w0; *(v4u*)(rowp + 32) = w1; } else asm volatile("" :: "v"(w0), "v"(w1)); }
            return;
        }
        bf16* base; int ld, colt, act = 0;
        if (pn < 2) { base = sbq; ld = 512; colt = pn * 256; } else if (pn < 4) { base = sbk; ld = 512; colt = (pn - 2) * 256; }
        else if (pn < 6) { base = sbv; ld = 512; colt = (pn - 4) * 256; } else if (pn < 14) { base = rv; ld = 1024; colt = (pn - 10) * 256; }
        else if (pn < 18) { base = rg; ld = 1024; colt = (pn - 14) * 256; act = 1; } else { base = gates; ld = 2048; colt = (pn - 18) * 256; act = 2; }
        f32x4 bv[2][2];
#pragma unroll
        for (int bj = 0; bj < 2; ++bj)
#pragma unroll
            for (int n = 0; n < 2; ++n) bv[bj][n] = act == 2 ? *(const f32x4*)(bgate + colt + bj * 128 + cw + 4 * n) : (f32x4){0.f, 0.f, 0.f, 0.f};
#pragma unroll
        for (int ai = 0; ai < 2; ++ai)
#pragma unroll
            for (int m = 0; m < 4; ++m) { bf16* rowp = base + (size_t)(rowb + ai * 128 + m * 16) * ld + colt + cw;
#pragma unroll
                for (int bj = 0; bj < 2; ++bj) { f32x4 v0 = acc[ai][bj][m][0] + bv[bj][0], v1 = acc[ai][bj][m][1] + bv[bj][1];
                    if (act == 1) {
#pragma unroll
                        for (int j = 0; j < 4; ++j) { v0[j] = v0[j] * sigm(v0[j]); v1[j] = v1[j] * sigm(v1[j]); } }
                    else if (act == 2) {
#pragma unroll
                        for (int j = 0; j < 4; ++j) { v0[j] = sigm(v0[j]); v1[j] = sigm(v1[j]); } }
                    const v4u w0 = pack8(v0, v1); if (!nostore) *(v4u*)(rowp + bj * 128) = w0; else asm volatile("" :: "v"(w0)); } }
    }
};
struct EpiMixCat {
    static constexpr bool PERM = true, AFTER_DRAIN = false, INPLACE = false;
    const bf16* gates; bf16* out;
    __device__ __forceinline__ void mid(f32x4 (&acc)[2][2][4][2], const Unit& u, int wr, int wc, int fr, int fq) const {
        const int rowb = u.row0 + wr * 64 + fr, colb = u.col0 + wc * 32 + 8 * fq;
#pragma unroll
        for (int ai = 0; ai < 2; ++ai)
#pragma unroll
            for (int m = 0; m < 4; ++m) { const size_t row = rowb + ai * 128 + m * 16;
#pragma unroll
                for (int bj = 0; bj < 2; ++bj) { const int col = colb + bj * 128;
                    const v4u gs = *(const v4u*)(gates + row * 2048 + col), gr = *(const v4u*)(gates + row * 2048 + 1024 + col);
                    f32x4& v0 = acc[ai][bj][m][0]; f32x4& v1 = acc[ai][bj][m][1];
#define RAT(s_, r_) ((s_) * __builtin_amdgcn_rcpf(fmaxf((r_), 1e-20f)))
                    v0[0] *= RAT(bflo(gs.x), bflo(gr.x)); v0[1] *= RAT(bfhi(gs.x), bfhi(gr.x)); v0[2] *= RAT(bflo(gs.y), bflo(gr.y)); v0[3] *= RAT(bfhi(gs.y), bfhi(gr.y));
                    v1[0] *= RAT(bflo(gs.z), bflo(gr.z)); v1[1] *= RAT(bfhi(gs.z), bfhi(gr.z)); v1[2] *= RAT(bflo(gs.w), bflo(gr.w)); v1[3] *= RAT(bfhi(gs.w), bfhi(gr.w));
#undef RAT
                }
                asm volatile("" ::: "memory"); }
    }
    __device__ __forceinline__ void operator()(const f32x4 (&acc)[2][2][4][2], const Unit& u, int wr, int wc, int fr, int fq) const {
        const int rowb = u.row0 + wr * 64 + fr, colb = u.col0 + wc * 32 + 8 * fq;
#pragma unroll
        for (int ai = 0; ai < 2; ++ai)
#pragma unroll
            for (int m = 0; m < 4; ++m) { const size_t row = rowb + ai * 128 + m * 16;
#pragma unroll
                for (int bj = 0; bj < 2; ++bj) { const int col = colb + bj * 128;
                    const v4u g = *(const v4u*)(gates + row * 2048 + 1024 + col);
                    f32x4 v0 = acc[ai][bj][m][0], v1 = acc[ai][bj][m][1];
                    v0[0] *= bflo(g.x); v0[1] *= bfhi(g.x); v0[2] *= bflo(g.y); v0[3] *= bfhi(g.y); v1[0] *= bflo(g.z); v1[1] *= bfhi(g.z); v1[2] *= bflo(g.w); v1[3] *= bfhi(g.w);
                    *(v4u*)(out + row * 1024 + col) = pack8(v0, v1); } }
    }
};
struct CatOrder : pg8::StaticOrder {
    const char* A2; int K1, K2;
    __device__ bool next(int i, Unit& u) const {
        if (!pg8::StaticOrder::next(i, u)) return false;
        const int pm = u.row0 / pg8::BM;
        u.a = A + (size_t)pm * pg8::BM * K1 * 2; u.a2 = A2 + (size_t)pm * pg8::BM * K2 * 2; return true;
    }
};
struct EpiOut {
    static constexpr bool PERM = true, AFTER_DRAIN = false, INPLACE = false;
    const float* x; bf16* hhi; bf16* hlo;
    __device__ __forceinline__ void operator()(const f32x4 (&acc)[2][2][4][2], const Unit& u, int wr, int wc, int fr, int fq) const {
        const int rowb = u.row0 + wr * 64 + fr, colb = u.col0 + wc * 32 + 8 * fq;
#pragma unroll
        for (int ai = 0; ai < 2; ++ai)
#pragma unroll
            for (int m = 0; m < 4; ++m) { const size_t off = (size_t)(rowb + ai * 128 + m * 16) * 1024 + colb;
#pragma unroll
                for (int bj = 0; bj < 2; ++bj)
                { const f32x4 v0 = *(const f32x4*)(x + off + bj * 128) + acc[ai][bj][m][0], v1 = *(const f32x4*)(x + off + bj * 128 + 4) + acc[ai][bj][m][1];
                    const v4u hi = pack8(v0, v1); f32x4 l0, l1;
                    l0[0] = v0[0] - bflo(hi.x); l0[1] = v0[1] - bfhi(hi.x); l0[2] = v0[2] - bflo(hi.y); l0[3] = v0[3] - bfhi(hi.y);
                    l1[0] = v1[0] - bflo(hi.z); l1[1] = v1[1] - bfhi(hi.z); l1[2] = v1[2] - bflo(hi.w); l1[3] = v1[3] - bfhi(hi.w);
                    *(v4u*)(hhi + off + bj * 128) = hi; *(v4u*)(hlo + off + bj * 128) = pack8(l0, l1); } }
    }
};
struct EpiUp {
    static constexpr bool PERM = true, AFTER_DRAIN = false, INPLACE = false;
    const TokInfo* tinfo; const volatile LAS int* rowtok; bf16* hid;
    __device__ __forceinline__ void operator()(const f32x4 (&acc)[2][2][4][2], const Unit& u, int wr, int wc, int fr, int fq) const {
        const int ct = u.tag, lrb = wr * 64 + fr, col = ct * 128 + wc * 32 + 8 * fq;
#pragma unroll
        for (int ai = 0; ai < 2; ++ai)
#pragma unroll
            for (int m = 0; m < 4; ++m) { const int lr = lrb + ai * 128 + m * 16, tok = rowtok[u.idx * 256 + lr];
                if (tok >= 0) { const TokInfo ti = tinfo[tok]; const float gw = ct < 4 ? ti.ga : ti.gb, rs = ti.rstd;
                    f32x4 v0, v1;
#pragma unroll
                    for (int j = 0; j < 4; ++j) { const float g0 = acc[ai][0][m][0][j] * rs, g1 = acc[ai][0][m][1][j] * rs;
                        v0[j] = g0 * sigm(g0) * acc[ai][1][m][0][j] * (rs * gw); v1[j] = g1 * sigm(g1) * acc[ai][1][m][1][j] * (rs * gw); }
                    *(v4u*)(hid + (size_t)(u.row0 + lr) * 1024 + col) = pack8(v0, v1); } }
    }
};
struct EpiDown {
    static constexpr bool PERM = true, AFTER_DRAIN = false, INPLACE = true;
    const volatile LAS int* rowtok; const bf16* hhi; const bf16* hlo; float* out; const float* gfin; float* xbuf; unsigned* cnt; LAS unsigned char* xl;
    __device__ __forceinline__ void inplace(f32x4 (&acc)[2][2][4][2], const Unit& u, int wr, int wc, int fr, int fq, int wid, int lane) const {
        LAS float* P = (LAS float*)xl; LAS float* S = (LAS float*)(xl + 4096); volatile LAS unsigned* flag = (volatile LAS unsigned*)(xl + 5120);
        const int lrb = wr * 64 + fr, colb = u.col0 + wc * 32 + 8 * fq, rt = u.row0 >> 8, ct = u.tag;
#pragma unroll
        for (int ai = 0; ai < 2; ++ai)
#pragma unroll
            for (int m = 0; m < 4; ++m) { const int lr = lrb + ai * 128 + m * 16, tok = rowtok[u.idx * 256 + lr]; float s = 0.f;
                if (tok >= 0) { const size_t po = (size_t)tok * 1024 + colb;
#pragma unroll
                    for (int bj = 0; bj < 2; ++bj) { const v4u hi = *(const v4u*)(hhi + po + bj * 128), lo = *(const v4u*)(hlo + po + bj * 128);
                        f32x4 y0 = acc[ai][bj][m][0], y1 = acc[ai][bj][m][1];
                        y0[0] += bflo(hi.x) + bflo(lo.x); y0[1] += bfhi(hi.x) + bfhi(lo.x); y0[2] += bflo(hi.y) + bflo(lo.y); y0[3] += bfhi(hi.y) + bfhi(lo.y);
                        y1[0] += bflo(hi.z) + bflo(lo.z); y1[1] += bfhi(hi.z) + bfhi(lo.z); y1[2] += bflo(hi.w) + bflo(lo.w); y1[3] += bfhi(hi.w) + bfhi(lo.w);
                        acc[ai][bj][m][0] = y0; acc[ai][bj][m][1] = y1;
                        s += (y0[0] * y0[0] + y0[1] * y0[1]) + (y0[2] * y0[2] + y0[3] * y0[3]) + (y1[0] * y1[0] + y1[1] * y1[1]) + (y1[2] * y1[2] + y1[3] * y1[3]); } }
                s += __shfl_xor(s, 16); s += __shfl_xor(s, 32);
                if (fq == 0) P[lr * 4 + wc] = s; }
        asm volatile("s_waitcnt lgkmcnt(0)" ::: "memory"); __builtin_amdgcn_s_barrier(); asm volatile("" ::: "memory");
        const int row = wid * 32 + (lane & 31);
        if (lane < 32) { const float s = (P[row * 4 + 0] + P[row * 4 + 1]) + (P[row * 4 + 2] + P[row * 4 + 3]);
            __hip_atomic_store(xbuf + ((size_t)rt * 256 + row) * 4 + ct, s, __ATOMIC_RELAXED, __HIP_MEMORY_SCOPE_AGENT); }
        asm volatile("s_waitcnt vmcnt(0)" ::: "memory");
        if (lane == 0) __hip_atomic_fetch_add(cnt + 64 * rt, 1u, __ATOMIC_RELAXED, __HIP_MEMORY_SCOPE_AGENT);
        if (wid == 0) { unsigned sp = 0;
            while ((unsigned)__builtin_amdgcn_readfirstlane(__hip_atomic_load(cnt + 64 * rt, __ATOMIC_RELAXED, __HIP_MEMORY_SCOPE_AGENT)) < 32u) { __builtin_amdgcn_s_sleep(2); if (++sp > (1u << 22)) break; }
            __builtin_amdgcn_fence(__ATOMIC_ACQUIRE, "agent");
            if (lane == 0) flag[0] = 1u; }
        asm volatile("s_waitcnt vmcnt(0) lgkmcnt(0)" ::: "memory"); __builtin_amdgcn_s_barrier(); asm volatile("" ::: "memory");
        if (lane < 32) { const float* sl = xbuf + ((size_t)rt * 256 + row) * 4; float t = 0.f;
#pragma unroll
            for (int k = 0; k < 4; ++k) t += __hip_atomic_load(sl + k, __ATOMIC_RELAXED, __HIP_MEMORY_SCOPE_AGENT);
            S[row] = 1.f / sqrtf(t * (1.f / 1024.f) + EPS); }
        asm volatile("s_waitcnt vmcnt(0) lgkmcnt(0)" ::: "memory"); __builtin_amdgcn_s_barrier(); asm volatile("" ::: "memory");
        f32x4 gv[2][2];
#pragma unroll
        for (int bj = 0; bj < 2; ++bj)
#pragma unroll
            for (int n = 0; n < 2; ++n) gv[bj][n] = *(const f32x4*)(gfin + colb + bj * 128 + n * 4);
#pragma unroll
        for (int ai = 0; ai < 2; ++ai)
#pragma unroll
            for (int m = 0; m < 4; ++m) { const int lr = lrb + ai * 128 + m * 16, tok = rowtok[u.idx * 256 + lr]; const float rs = S[lr];
                if (tok >= 0) { float* p = out + (size_t)tok * 1024 + colb;
#pragma unroll
                    for (int bj = 0; bj < 2; ++bj)
#pragma unroll
                        for (int n = 0; n < 2; ++n) *(f32x4*)(p + bj * 128 + n * 4) = acc[ai][bj][m][n] * rs * gv[bj][n]; } }
        asm volatile("s_waitcnt lgkmcnt(0)" ::: "memory"); __builtin_amdgcn_s_barrier(); asm volatile("" ::: "memory");
    }
};
struct MoeOrder {
    const char* A; const char* B; const volatile LAS int* tstart; volatile LAS int* rowtok; int nct, up, G, c;
    __device__ __forceinline__ void locate(int L, int& rt, int& ct, int& cls) const {
        rt = L / nct; ct = L % nct; cls = 0;
        for (int k = 1; k < NCLS; ++k) cls += (rt >= __builtin_amdgcn_readfirstlane(tstart[k])) ? 1 : 0;
    }
    __device__ bool next(int i, Unit& u) const {
        const int L = i * G + c; const int ntile = __builtin_amdgcn_readfirstlane(tstart[NCLS]);
        if (L >= ntile * nct) return false;
        int rt, ct, cls; locate(L, rt, ct, cls);
        const int g = cls / 6, p = cls % 6, pa = p < 3 ? 0 : (p < 5 ? 1 : 2), pb = p == 0 ? 1 : (p == 1 ? 2 : (p == 2 ? 3 : (p == 3 ? 2 : 3)));
        u.row0 = rt * 256; u.tag = ct; u.idx = i; u.a2 = nullptr;
        if (up) { const int e = 4 * g + (ct < 4 ? pa : pb); u.a = A; u.b = B + ((size_t)e * 1024 + (ct & 3) * 256) * 1024 * 2; u.col0 = ct * 128; }
        else { u.a = A + (size_t)rt * 256 * 1024 * 2; u.b = B + ((size_t)cls * 1024 + ct * 256) * 1024 * 2; u.col0 = ct * 256; }
        return true;
    }
    __device__ __forceinline__ int arow(int ui, int r) const { const int t = rowtok[ui * 256 + r]; return t < 0 ? 0 : t; }
    __device__ __forceinline__ void build(const int* perm, int tid) const {
        const int ntile = tstart[NCLS];
        for (int i = 0; i * G + c < ntile * nct; ++i) { int rt, ct, cls; locate(i * G + c, rt, ct, cls);
            for (int r = tid; r < 256; r += NTHR) { const int idx = (rt - tstart[cls]) * 256 + r; rowtok[i * 256 + r] = idx < tstart[32 + cls] ? perm[(size_t)cls * T + idx] : -1; } }
        __syncthreads();
    }
    __device__ __forceinline__ void a_ready(const Unit&) const {}
    __device__ __forceinline__ void done(const Unit&) const {}
};

typedef float f32x16 __attribute__((ext_vector_type(16)));
typedef short s16x4 __attribute__((ext_vector_type(4)));
typedef float f32x2_t __attribute__((ext_vector_type(2))); typedef __bf16 bf16x2_t __attribute__((ext_vector_type(2)));
__device__ __forceinline__ unsigned cvtpk_s(float lo, float hi) { f32x2_t v = {lo, hi}; bf16x2_t b = __builtin_convertvector(v, bf16x2_t); return __builtin_bit_cast(unsigned, b); }
__device__ __forceinline__ s16x4 vtr(const LAS unsigned char* p) { return __builtin_bit_cast(s16x4, __builtin_amdgcn_ds_read_tr16_b64_v4i16((LAS s16x4*)p)); }
__device__ __forceinline__ int crow(int r, int hi) { return (r & 3) + 8 * (r >> 2) + 4 * hi; }
#define MFMA32(a, b, c) __builtin_amdgcn_mfma_f32_32x32x16_bf16((a), (b), (c), 0, 0, 0)
__device__ __forceinline__ bf16x8 packfrag(const f32x16& p, int s) {
    v4u w; w.x = cvtpk_s(p[8 * s], p[8 * s + 1]); w.y = cvtpk_s(p[8 * s + 2], p[8 * s + 3]); w.z = cvtpk_s(p[8 * s + 4], p[8 * s + 5]); w.w = cvtpk_s(p[8 * s + 6], p[8 * s + 7]);
    return __builtin_bit_cast(bf16x8, w);
}
__device__ __forceinline__ bf16x8 vfrag(const LAS unsigned char* p, int rowbytes) {
    const s16x4 lo = vtr(p), hi_ = vtr(p + 8 * rowbytes);
    return (bf16x8){lo[0], lo[1], lo[2], lo[3], hi_[0], hi_[1], hi_[2], hi_[3]};
}
__device__ __forceinline__ void glds16(const void* gsrc, unsigned lds_dst) { unsigned keep;
    asm volatile("s_mov_b32 %0, m0\n\ts_mov_b32 m0, %2\n\ts_nop 0\n\tglobal_load_lds_dwordx4 %1, off\n\ts_mov_b32 m0, %0" : "=&s"(keep) : "v"(gsrc), "s"(lds_dst) : "memory"); }
#define WAIT_BAR(N) asm volatile("s_waitcnt vmcnt(" #N ") lgkmcnt(0)\n\ts_barrier" ::: "memory")
constexpr float SB_THR2 = -40.f;

template <bool MASK>
__device__ __forceinline__ void sb_tile(const LAS unsigned char* Kt, const LAS unsigned char* Vt, const bf16x8 (&qf)[4], const bf16x8 tri0, const bf16x8 tri1, const bf16x8 ones,
                                        f32x16& o0, f32x16& o1, float& R, int kt, int t, int hi, int kbase, int kx, int v0, int v1) {
    f32x16 p0 = {}, p1 = {};
#pragma unroll
    for (int ks = 0; ks < 4; ++ks) {
        const int co = kbase + (((2 * ks + hi) ^ kx) << 4);
        const bf16x8 a0 = *(const LAS bf16x8*)(Kt + co), a1 = *(const LAS bf16x8*)(Kt + 4096 + co);
        p0 = MFMA32(a0, qf[ks], p0); p1 = MFMA32(a1, qf[ks], p1);
    }
    f32x16 l0, l1; float cs = 0.f;
#pragma unroll
    for (int r = 0; r < 16; ++r) {
        const float z0 = p0[r], z1 = p1[r];
        float k0 = -(fmaxf(z0, 0.f) + __builtin_amdgcn_logf(1.f + __builtin_amdgcn_exp2f(-fabsf(z0))));
        float k1 = -(fmaxf(z1, 0.f) + __builtin_amdgcn_logf(1.f + __builtin_amdgcn_exp2f(-fabsf(z1))));
        if (MASK) { const int key = kt * 64 + crow(r, hi); k0 = key < t ? k0 : 0.f; k1 = key + 32 < t ? k1 : 0.f; }
        l0[r] = k0; l1[r] = k1; cs += k0 + k1;
    }
    cs += __shfl_xor(cs, 32);
    const bf16x8 lb00 = packfrag(l0, 0), lb01 = packfrag(l0, 1), lb10 = packfrag(l1, 0), lb11 = packfrag(l1, 1);
    f32x16 y0 = {}, y1 = {};
    y0 = MFMA32(tri0, lb00, y0); y0 = MFMA32(tri1, lb01, y0); y0 = MFMA32(ones, lb10, y0); y0 = MFMA32(ones, lb11, y0);
    y1 = MFMA32(tri0, lb10, y1); y1 = MFMA32(tri1, lb11, y1);
#pragma unroll
    for (int r = 0; r < 16; ++r) {
        float w0 = __builtin_amdgcn_exp2f(p0[r] + y0[r] + R), w1 = __builtin_amdgcn_exp2f(p1[r] + y1[r] + R);
        if (MASK) { const int key = kt * 64 + crow(r, hi); w0 = key < t ? w0 : 0.f; w1 = key + 32 < t ? w1 : 0.f; }
        p0[r] = w0; p1[r] = w1;
    }
    R += cs;
    const bf16x8 wb00 = packfrag(p0, 0), wb01 = packfrag(p0, 1), wb10 = packfrag(p1, 0), wb11 = packfrag(p1, 1);
    o0 = MFMA32(vfrag(Vt + 0 * 2048 + v0, 128), wb00, o0); o1 = MFMA32(vfrag(Vt + 0 * 2048 + v1, 128), wb00, o1);
    o0 = MFMA32(vfrag(Vt + 1 * 2048 + v0, 128), wb01, o0); o1 = MFMA32(vfrag(Vt + 1 * 2048 + v1, 128), wb01, o1);
    o0 = MFMA32(vfrag(Vt + 2 * 2048 + v0, 128), wb10, o0); o1 = MFMA32(vfrag(Vt + 2 * 2048 + v1, 128), wb10, o1);
    o0 = MFMA32(vfrag(Vt + 3 * 2048 + v0, 128), wb11, o0); o1 = MFMA32(vfrag(Vt + 3 * 2048 + v1, 128), wb11, o1);
}
__device__ __forceinline__ void unit_map(int u, int G, int& bh, int& qb) {
    if (G == 256) { const int bx = u & 255, i = u >> 8, xcd = bx & 7, slot = bx >> 3, gi = slot >> 2, j = slot & 3;
        bh = (xcd * 8 + gi) * 2 + (i >> 1); qb = (i & 1) ? 7 - j : j; }
    else { bh = u >> 3; qb = u & 7; }
}
__device__ __forceinline__ void sb_phase(const bf16* Q, const bf16* Kg, const bf16* Vg, bf16* O, LAS unsigned char* lds, int bx, int G, int tid, int wave, int lane, bool nostore = false) {
    const int r32 = lane & 31, hi = lane >> 5;
    bf16x8 tri0, tri1, ones;
#pragma unroll
    for (int j = 0; j < 8; ++j) { const int kk = 8 * (j >> 2) + 4 * hi + (j & 3); tri0[j] = kk >= r32 ? (short)0x3F80 : (short)0; tri1[j] = 16 + kk >= r32 ? (short)0x3F80 : (short)0; ones[j] = (short)0x3F80; }
    const int skey = wave * 8 + (lane >> 3), sc = (lane & 7) ^ (lane >> 3), svc = (lane & 7) ^ (((lane >> 4) & 1) << 2);
    const unsigned lds0 = (unsigned)(size_t)lds + (unsigned)wave * 1024u;
#define SB_STAGE(kt_, st_) do { const unsigned d_ = (unsigned)__builtin_amdgcn_readfirstlane(lds0 + (unsigned)(st_) * 16384u); \
        glds16(Kg + (rbase + (size_t)(kt_) * 64 + skey) * 512 + h * 64 + sc * 8, d_); glds16(Vg + (rbase + (size_t)(kt_) * 64 + skey) * 512 + h * 64 + svc * 8, d_ + 8192u); } while (0)
    const int kbase = r32 * 128, kx = r32 & 7;
    const int q4 = (lane & 15) >> 2, v0 = ((4 * hi + q4) * 128 + 32 * ((lane >> 4) & 1) + 8 * (lane & 3)) ^ (((q4 >> 1) & 1) << 6), v1 = v0 ^ 64;
    volatile LAS int* flags = (volatile LAS int*)(lds + 49152);
    for (int u = bx; u < 1024; u += G) {
        const int bh = u >> 3, qb = u & 7;
        const int b = bh >> 3, h = bh & 7, q0w = qb * 256 + 32 * wave, my_kt = q0w >> 6, kt_hi = qb * 4 + 3, t = q0w + r32;
        const size_t rbase = (size_t)b * SEQ;
        SB_STAGE(kt_hi, 0);
        if (kt_hi > 0) SB_STAGE(kt_hi - 1, 1);
        bf16x8 qf[4];
#pragma unroll
        for (int ks = 0; ks < 4; ++ks) qf[ks] = *(const bf16x8*)(Q + (rbase + t) * 512 + h * 64 + 16 * ks + 8 * hi);
        f32x16 o0 = {}, o1 = {}; float R = 0.f;
        if (kt_hi > 0) WAIT_BAR(2); else WAIT_BAR(0);
        bool mydone = false; int st = 0, it = 0;
        for (int kt = kt_hi; kt >= 0; --kt, ++it) {
            int st2 = st + 2; if (st2 >= 3) st2 -= 3;
            if (kt >= 2) SB_STAGE(kt - 2, st2);
            if (kt <= my_kt && !mydone) {
                const LAS unsigned char* Kt = lds + st * 16384; const LAS unsigned char* Vt = Kt + 8192;
                if (kt == my_kt) sb_tile<true>(Kt, Vt, qf, tri0, tri1, ones, o0, o1, R, kt, t, hi, kbase, kx, v0, v1);
                else sb_tile<false>(Kt, Vt, qf, tri0, tri1, ones, o0, o1, R, kt, t, hi, kbase, kx, v0, v1);
                mydone = __all(R < SB_THR2) != 0;
            }
            if (lane == 0) flags[(it & 1) * 8 + wave] = mydone ? 1 : 0;
            if (kt >= 2) WAIT_BAR(2); else WAIT_BAR(0);
            int alld = 1;
#pragma unroll
            for (int w = 0; w < 8; ++w) alld &= flags[(it & 1) * 8 + w];
            if (alld) break;
            st = st + 1; if (st >= 3) st = 0;
        }
        { LAS unsigned char* ep = lds + 53248 + wave * 4608;
#pragma unroll
          for (int g4 = 0; g4 < 4; ++g4) {
            *(LAS unsigned long long*)(ep + r32 * 144 + (8 * g4 + 4 * hi) * 2) = (unsigned long long)cvtpk_s(o0[4 * g4], o0[4 * g4 + 1]) | ((unsigned long long)cvtpk_s(o0[4 * g4 + 2], o0[4 * g4 + 3]) << 32);
            *(LAS unsigned long long*)(ep + r32 * 144 + (32 + 8 * g4 + 4 * hi) * 2) = (unsigned long long)cvtpk_s(o1[4 * g4], o1[4 * g4 + 1]) | ((unsigned long long)cvtpk_s(o1[4 * g4 + 2], o1[4 * g4 + 3]) << 32); }
#pragma unroll
          for (int i = 0; i < 4; ++i) { const int row = (lane >> 3) + 8 * i;
            const v4u ov = *(const LAS v4u*)(ep + row * 144 + (lane & 7) * 16); if (!nostore) *(v4u*)(O + (rbase + q0w + row) * 512 + h * 64 + (lane & 7) * 8) = ov; else asm volatile("" :: "v"(ov)); } }
        WAIT_BAR(0);
    }
#undef SB_STAGE
}
template <bool EDGE>
__device__ __forceinline__ void ret_tile(const LAS unsigned char* Kt, const LAS unsigned char* Vt, const bf16x8 (&qf)[4], f32x16 (&o)[4], float lg2, int kt, int my_kt, int n, int hi, int kbase, int kx, int vb) {
    f32x16 p0 = {}, p1 = {};
#pragma unroll
    for (int ks = 0; ks < 4; ++ks) {
        const int co = kbase + (((2 * ks + hi) ^ kx) << 4);
        const bf16x8 a0 = *(const LAS bf16x8*)(Kt + co), a1 = *(const LAS bf16x8*)(Kt + 4096 + co);
        p0 = MFMA32(a0, qf[ks], p0); p1 = MFMA32(a1, qf[ks], p1);
    }
    const int e_off = n - 64 * (kt + 1);
    if (EDGE) {
        const bool diag = kt == my_kt; float fnn = (float)(n & 63); asm volatile("" : "+v"(fnn));
        const float base = diag ? fnn - 64.f : (float)e_off, two = diag ? 2.f : 0.f, h4 = (float)(4 * hi);
#pragma unroll
        for (int r = 0; r < 16; ++r) {
            const float m0 = (float)((r & 3) + 8 * (r >> 2)) + h4;
            p0[r] *= __builtin_amdgcn_exp2f(lg2 * (base + two * fmaxf(m0 - fnn, 0.f))); p1[r] *= __builtin_amdgcn_exp2f(lg2 * (base + two * fmaxf(m0 + 32.f - fnn, 0.f)));
            if ((r & 3) == 3) __builtin_amdgcn_sched_barrier(0);
        }
    } else {
        const float f = __builtin_amdgcn_exp2f(lg2 * (float)e_off);
#pragma unroll
        for (int r = 0; r < 16; ++r) { p0[r] *= f; p1[r] *= f; }
    }
    const bf16x8 wb00 = packfrag(p0, 0), wb01 = packfrag(p0, 1), wb10 = packfrag(p1, 0), wb11 = packfrag(p1, 1);
#pragma unroll
    for (int dt = 0; dt < 4; ++dt) { const LAS unsigned char* vp = Vt + (vb ^ (dt << 6));
        o[dt] = MFMA32(vfrag(vp + 0 * 4096, 256), wb00, o[dt]); o[dt] = MFMA32(vfrag(vp + 1 * 4096, 256), wb01, o[dt]);
        o[dt] = MFMA32(vfrag(vp + 2 * 4096, 256), wb10, o[dt]); o[dt] = MFMA32(vfrag(vp + 3 * 4096, 256), wb11, o[dt]); }
}
__device__ __forceinline__ void kv_chain(const bf16* Kg, const bf16* Vg, bf16* STg, LAS unsigned char* lds, int bh0, int bhs, int tid, int wave, int lane) {
    const int r32 = lane & 31, hi = lane >> 5, q4 = (lane & 15) >> 2, g1 = (lane >> 4) & 1, p = lane & 3, dh = wave >> 2, eq = wave & 3;
    const int skey = wave * 8 + (lane >> 3), sc = (lane & 7) ^ (lane >> 3);
    const int vkey = wave * 8 + (lane >> 4), vc = (lane & 15) ^ (((lane >> 4) & 3) << 2);
    const unsigned ldsk = (unsigned)(size_t)lds + (unsigned)wave * 1024u, ldsv = (unsigned)(size_t)lds + 8192u + (unsigned)wave * 2048u;
#define RET_STAGE(kt_, st_) do { const unsigned so_ = (unsigned)(st_) * 24576u; \
        glds16(Kg + (rbase + (size_t)(kt_) * 64 + skey) * 512 + h * 64 + sc * 8, (unsigned)__builtin_amdgcn_readfirstlane(ldsk + so_)); \
        glds16(Vg + (rbase + (size_t)(kt_) * 64 + vkey) * 1024 + h * 128 + vc * 8, (unsigned)__builtin_amdgcn_readfirstlane(ldsv + so_)); \
        glds16(Vg + (rbase + (size_t)(kt_) * 64 + vkey + 4) * 1024 + h * 128 + vc * 8, (unsigned)__builtin_amdgcn_readfirstlane(ldsv + so_ + 1024u)); } while (0)
    int aoff[2], boff[2];
#pragma unroll
    for (int e = 0; e < 2; ++e) { const int m = 8 * hi + q4 + 4 * e;
        aoff[e] = m * 128 + (((4 * dh + 2 * g1 + (p >> 1)) ^ (m & 7)) << 4) + (p & 1) * 8;
        boff[e] = m * 256 + ((64 * eq + 32 * g1 + 8 * p) ^ ((m & 3) << 6)); }
    for (int bh = bh0; bh < 128; bh += bhs) {
        const int b = bh >> 3, h = bh & 7;
        const size_t rbase = (size_t)b * SEQ;
        const float lg2 = log2f(1.f - exp2f(-5.f - (float)h)), g64 = exp2f(64.f * lg2), g256 = exp2f(256.f * lg2), ginv = exp2f(-lg2);
        RET_STAGE(0, 0); RET_STAGE(1, 1);
        f32x16 S = {}, kv = {};
        WAIT_BAR(3);
        int st = 0;
        for (int kt = 0; kt < 28; ++kt) {
            int st2 = st + 2; if (st2 >= 3) st2 -= 3;
            if (kt + 2 < 28) RET_STAGE(kt + 2, st2);
            const LAS unsigned char* Kt = lds + st * 24576; const LAS unsigned char* Vt = Kt + 8192;
#pragma unroll
            for (int r = 0; r < 16; ++r) kv[r] *= g64;
#pragma unroll
            for (int ks = 0; ks < 4; ++ks) {
                const s16x4 a0 = vtr(Kt + aoff[0] + ks * 2048), a1 = vtr(Kt + aoff[1] + ks * 2048), b0 = vtr(Vt + boff[0] + ks * 4096), b1 = vtr(Vt + boff[1] + ks * 4096);
                kv = MFMA32(((bf16x8){a0[0], a0[1], a0[2], a0[3], a1[0], a1[1], a1[2], a1[3]}), ((bf16x8){b0[0], b0[1], b0[2], b0[3], b1[0], b1[1], b1[2], b1[3]}), kv);
            }
            if ((kt & 3) == 3) {
                bf16* sp = STg + ((size_t)(bh * 8 + (kt >> 2) + 1) * 64 + 32 * dh) * 128 + 32 * eq + r32;
#pragma unroll
                for (int r = 0; r < 16; ++r) { S[r] = S[r] * g256 + kv[r] * ginv; kv[r] = 0.f; sp[crow(r, hi) * 128] = (bf16)(cvtpk_s(S[r], 0.f) & 0xffffu); }
            }
            if (kt + 2 < 28) WAIT_BAR(3); else WAIT_BAR(0);
            st = st + 1; if (st >= 3) st = 0;
        }
    }
#undef RET_STAGE
}
__device__ __forceinline__ void ret_phase(const bf16* Q, const bf16* Kg, const bf16* Vg, const bf16* RG, const float* gn, const bf16* STg, bf16* Y, LAS unsigned char* lds, int bx, int G, int tid, int wave, int lane) {
    const int r32 = lane & 31, hi = lane >> 5;
    const int skey = wave * 8 + (lane >> 3), sc = (lane & 7) ^ (lane >> 3);
    const int vkey = wave * 8 + (lane >> 4), vc = (lane & 15) ^ (((lane >> 4) & 3) << 2);
    const unsigned ldsk = (unsigned)(size_t)lds + (unsigned)wave * 1024u, ldsv = (unsigned)(size_t)lds + 8192u + (unsigned)wave * 2048u, ldss = (unsigned)(size_t)lds + 73728u + (unsigned)wave * 2048u;
#define RET_STAGE(kt_, st_) do { const unsigned so_ = (unsigned)(st_) * 24576u; \
        glds16(Kg + (rbase + (size_t)(kt_) * 64 + skey) * 512 + h * 64 + sc * 8, (unsigned)__builtin_amdgcn_readfirstlane(ldsk + so_)); \
        glds16(Vg + (rbase + (size_t)(kt_) * 64 + vkey) * 1024 + h * 128 + vc * 8, (unsigned)__builtin_amdgcn_readfirstlane(ldsv + so_)); \
        glds16(Vg + (rbase + (size_t)(kt_) * 64 + vkey + 4) * 1024 + h * 128 + vc * 8, (unsigned)__builtin_amdgcn_readfirstlane(ldsv + so_ + 1024u)); } while (0)
#define RET_STAGES(qb_) do { const bf16* s_ = STg + ((size_t)(bh * 8 + (qb_)) * 64 + vkey) * 128 + vc * 8; \
        glds16(s_, (unsigned)__builtin_amdgcn_readfirstlane(ldss)); glds16(s_ + 4 * 128, (unsigned)__builtin_amdgcn_readfirstlane(ldss + 1024u)); } while (0)
    const int kbase = r32 * 128, kx = r32 & 7;
    const int q4 = (lane & 15) >> 2, vb = ((4 * hi + q4) * 256 + 32 * ((lane >> 4) & 1) + 8 * (lane & 3)) ^ (q4 << 6);
    const int sb_ = ((8 * hi + q4) * 256 + 32 * ((lane >> 4) & 1) + 8 * (lane & 3)) ^ (q4 << 6);
    const LAS unsigned char* St = lds + 73728;
    LAS unsigned char* ep = lds + 90112 + wave * 4608;
    const int nper = (2 * 128 + G - 1) / G;
    for (int it = bx * nper; it < (bx + 1) * nper && it < 256; ++it) {
        const int bh = it >> 1, qb0 = 4 * (it & 1), b = bh >> 3, h = bh & 7, kt_end = 4 * qb0 + 15;
        const size_t rbase = (size_t)b * SEQ;
        const float lg2 = log2f(1.f - exp2f(-5.f - (float)h));
        if (qb0 > 0) RET_STAGES(qb0);
        RET_STAGE(4 * qb0, 0); RET_STAGE(4 * qb0 + 1, 1);
        int st = 0;
        WAIT_BAR(3);
        for (int qb = qb0; qb < qb0 + 4; ++qb) {
            const int q0w = qb * 256 + 32 * wave, my_kt = q0w >> 6, n = q0w + r32;
            bf16x8 qf[4];
#pragma unroll
            for (int ks = 0; ks < 4; ++ks) qf[ks] = *(const bf16x8*)(Q + (rbase + n) * 512 + h * 64 + 16 * ks + 8 * hi);
            f32x16 o[4] = {{}, {}, {}, {}};
            if (qb > 0) {
#pragma unroll
                for (int ks = 0; ks < 4; ++ks) {
#pragma unroll
                    for (int dt = 0; dt < 4; ++dt) { const LAS unsigned char* sp = St + (sb_ ^ (dt << 6)) + ks * 4096;
                        const s16x4 a0 = vtr(sp), a1 = vtr(sp + 4 * 256);
                        o[dt] = MFMA32(((bf16x8){a0[0], a0[1], a0[2], a0[3], a1[0], a1[1], a1[2], a1[3]}), qf[ks], o[dt]); }
                    __builtin_amdgcn_sched_barrier(0);
                }
                const float qs = exp2f(lg2 * (float)(32 * wave + r32 + 1));
#pragma unroll
                for (int dt = 0; dt < 4; ++dt)
#pragma unroll
                    for (int r = 0; r < 16; ++r) o[dt][r] *= qs;
            }
#define RET_STEP(BODY) do { const int kt = 4 * qb + t; \
                int st2 = st + 2; if (st2 >= 3) st2 -= 3; \
                if (t == 3 && qb + 1 < qb0 + 4) RET_STAGES(qb + 1);     \
                if (kt + 2 <= kt_end) RET_STAGE(kt + 2, st2); \
                BODY; \
                if (kt + 2 <= kt_end) WAIT_BAR(3); else WAIT_BAR(0); \
                st = st + 1; if (st >= 3) st = 0; } while (0)
            { const int cw = wave >> 1; int t = 0;
              for (; t < cw; ++t) RET_STEP(ret_tile<false>(lds + st * 24576, lds + st * 24576 + 8192, qf, o, lg2, kt, my_kt, n, hi, kbase, kx, vb));
              RET_STEP(ret_tile<true>(lds + st * 24576, lds + st * 24576 + 8192, qf, o, lg2, kt, my_kt, n, hi, kbase, kx, vb)); ++t;
              for (; t < 4; ++t) RET_STEP((void)0); }
#undef RET_STEP
            float ss = 0.f;
#pragma unroll
            for (int dt = 0; dt < 4; ++dt)
#pragma unroll
                for (int r = 0; r < 16; ++r) ss += o[dt][r] * o[dt][r];
            ss += __shfl_xor(ss, 32);
            const float rstd = 1.f / sqrtf(ss * (1.f / 128.f) + EPS);
#pragma unroll
            for (int half = 0; half < 2; ++half) {
#pragma unroll
                for (int dtl = 0; dtl < 2; ++dtl)
#pragma unroll
                    for (int g4 = 0; g4 < 4; ++g4) { const f32x16& od = o[2 * half + dtl];
                        *(LAS unsigned long long*)(ep + r32 * 144 + (32 * dtl + 8 * g4 + 4 * hi) * 2) =
                            (unsigned long long)cvtpk_s(od[4 * g4] * rstd, od[4 * g4 + 1] * rstd) | ((unsigned long long)cvtpk_s(od[4 * g4 + 2] * rstd, od[4 * g4 + 3] * rstd) << 32); }
#pragma unroll
                for (int i = 0; i < 4; ++i) { const int row = (lane >> 3) + 8 * i, e = 64 * half + (lane & 7) * 8;
                    const v4u y = *(const LAS v4u*)(ep + row * 144 + (lane & 7) * 16);
                    const size_t go = (rbase + q0w + row) * 1024 + h * 128 + e;
                    const v4u rg = *(const v4u*)(RG + go); const f32x4 g0 = *(const f32x4*)(gn + h * 128 + e), g1 = *(const f32x4*)(gn + h * 128 + e + 4);
                    f32x4 v0, v1;
                    v0[0] = bflo(y.x) * g0[0] * bflo(rg.x); v0[1] = bfhi(y.x) * g0[1] * bfhi(rg.x); v0[2] = bflo(y.y) * g0[2] * bflo(rg.y); v0[3] = bfhi(y.y) * g0[3] * bfhi(rg.y);
                    v1[0] = bflo(y.z) * g1[0] * bflo(rg.z); v1[1] = bfhi(y.z) * g1[1] * bfhi(rg.z); v1[2] = bflo(y.w) * g1[2] * bflo(rg.w); v1[3] = bfhi(y.w) * g1[3] * bfhi(rg.w);
                    *(v4u*)(Y + go) = pack8(v0, v1); }
            }
        }
    }
#undef RET_STAGE
#undef RET_STAGES
}

__device__ __forceinline__ void p_route(const Args& a, LAS unsigned char* lds, int vcu, int G, int wave, int lane, int tid) {
    const bf16* hhi = (const bf16*)(a.ws + WS_HB); const bf16* hlo = (const bf16*)(a.ws + WS_HLO); const bf16* wrt = (const bf16*)(a.ws + WS_WRT); const float* bg = a.in[11]; const float* be = a.in[13];
    TokInfo* tinfo = (TokInfo*)(a.ws + (a.rep ? WS_PROBE : WS_TOK)); int* perm = (int*)(a.ws + (a.rep ? WS_PROBE + 4 * MiB : WS_PERM));
    unsigned* cnt = (unsigned*)(a.ws + WS_CTL) + (a.rep ? CW_CNT + 4096 : CW_CNT);
    const int r32 = lane & 31, hi = lane >> 5, kh = wave & 1, pair = wave >> 1;
    LAS float* xch = (LAS float*)lds + pair * 64 * 17;
    const int ntask = T / 32, tstride = G * 4, nround = (ntask + tstride - 1) / tstride;
    for (int rd = 0; rd < nround; ++rd) {
        const int task = rd * tstride + vcu * 4 + pair; const bool valid = task < ntask;
        const int t0 = (valid ? task : 0) * 32;
        const size_t xo = (size_t)(t0 + r32) * DM + kh * 512 + 8 * hi;
        const bf16* ahp = wrt + r32 * 1024 + kh * 512 + 8 * hi;
        f32x16 acc = {}; float ss = 0.f;
#pragma unroll 4
        for (int ks = 0; ks < 32; ++ks) {
            const v4u wh = *(const v4u*)(hhi + xo + 16 * ks), wl = *(const v4u*)(hlo + xo + 16 * ks);
            { const float a0 = bflo(wh.x) + bflo(wl.x), a1 = bfhi(wh.x) + bfhi(wl.x), a2 = bflo(wh.y) + bflo(wl.y), a3 = bfhi(wh.y) + bfhi(wl.y);
              const float a4 = bflo(wh.z) + bflo(wl.z), a5 = bfhi(wh.z) + bfhi(wl.z), a6 = bflo(wh.w) + bflo(wl.w), a7 = bfhi(wh.w) + bfhi(wl.w);
              ss += (a0 * a0 + a1 * a1) + (a2 * a2 + a3 * a3) + (a4 * a4 + a5 * a5) + (a6 * a6 + a7 * a7); }
            const bf16x8 bh_ = __builtin_bit_cast(bf16x8, wh), bl_ = __builtin_bit_cast(bf16x8, wl);
            const bf16x8 ah = *(const bf16x8*)(ahp + 16 * ks), al = *(const bf16x8*)(ahp + 32 * 1024 + 16 * ks);
            acc = MFMA32(ah, bh_, acc); acc = MFMA32(ah, bl_, acc); acc = MFMA32(al, bh_, acc);
        }
        if (kh == 1) {
#pragma unroll
            for (int r = 0; r < 16; ++r) xch[lane * 17 + r] = acc[r];
            xch[lane * 17 + 16] = ss; }
        __syncthreads();
        if (kh == 0) {
#pragma unroll
            for (int r = 0; r < 16; ++r) acc[r] += xch[lane * 17 + r];
            ss += xch[lane * 17 + 16];
            ss += __shfl_xor(ss, 32);
            const float rstd = 1.f / sqrtf(ss * (1.f / DM) + EPS);
            float gl[4];
#pragma unroll
            for (int o = 0; o < 4; ++o) gl[o] = acc[o] * rstd + bg[o];
            int gi = 0; float gm = gl[0];
#pragma unroll
            for (int o = 1; o < 4; ++o) if (gl[o] > gm) { gm = gl[o]; gi = o; }
            float gs = 0.f;
#pragma unroll
            for (int o = 0; o < 4; ++o) gs += __expf(gl[o] - gm);
            const float pgrp = 1.f / gs;
            const bool owner = valid && (hi == (gi & 1));
            float el[4];
#pragma unroll
            for (int e = 0; e < 4; ++e) el[e] = ((gi >> 1) ? acc[8 + e] : acc[4 + e]) * rstd + be[4 * gi + e];
            int i1 = 0; float m1 = el[0];
#pragma unroll
            for (int e = 1; e < 4; ++e) if (el[e] > m1) { m1 = el[e]; i1 = e; }
            int i2 = -1; float m2 = -3.0e38f;
#pragma unroll
            for (int e = 0; e < 4; ++e) if (e != i1 && el[e] > m2) { m2 = el[e]; i2 = e; }
            const float s1 = 1.f / (1.f + __expf(m2 - m1)), g1 = s1 * pgrp, g2 = (1.f - s1) * pgrp;
            const int pa = i1 < i2 ? i1 : i2, pb = i1 < i2 ? i2 : i1;
            const float ga = i1 < i2 ? g1 : g2, gb = i1 < i2 ? g2 : g1;
            const int pidx = pa == 0 ? pb - 1 : (pa == 1 ? pb + 1 : 5);
            const int my_cls = owner ? gi * 6 + pidx : -1;
            int my_pos = 0;
            for (int c = 0; c < NCLS; ++c) {
                const unsigned long long mask = __ballot(my_cls == c);
                if (mask) { const int nn = __popcll(mask), leader = __ffsll((long long)mask) - 1; unsigned bse = 0;
                    if (lane == leader) bse = __hip_atomic_fetch_add(cnt + 64 * c, (unsigned)nn, __ATOMIC_RELAXED, __HIP_MEMORY_SCOPE_AGENT);
                    bse = __shfl(bse, leader);
                    if (my_cls == c) my_pos = (int)bse + __popcll(mask & ((1ull << lane) - 1ull)); }
            }
            if (owner) { const int t = t0 + r32; tinfo[t] = TokInfo{ga, gb, rstd, my_cls}; perm[(size_t)my_cls * T + my_pos] = t; }
        }
        __syncthreads();
    }
}
__device__ __forceinline__ void build_class_table(const Args& a, volatile LAS int* tab, int tid) {
    if (tid == 0) { const unsigned* cnt = (const unsigned*)(a.ws + WS_CTL) + CW_CNT; int acc_ = 0;
        for (int c = 0; c < NCLS; ++c) { tab[c] = acc_; const int n = (int)__hip_atomic_load(cnt + 64 * c, __ATOMIC_RELAXED, __HIP_MEMORY_SCOPE_AGENT); tab[32 + c] = n; acc_ += (n + 255) >> 8; }
        tab[NCLS] = acc_; }
    __syncthreads();
}
__device__ __forceinline__ void p_final(const Args& a, int vcu, int G, int wave, int lane) {
    float* h = a.out; const float* gf = a.in[17];
    const int gw = vcu * NWAVES + wave, NGW = G * NWAVES;
    f32x4 gv[4];
#pragma unroll
    for (int j = 0; j < 4; ++j) gv[j] = ((const f32x4*)gf)[lane + 64 * j];
    for (int t = gw; t < T; t += NGW) {
        GAS f32x4* xr = (GAS f32x4*)(h + (size_t)t * DM) + lane;
        f32x4 v[4]; float s = 0.f;
#pragma unroll
        for (int j = 0; j < 4; ++j) { v[j] = xr[64 * j]; s += (v[j].x * v[j].x + v[j].y * v[j].y) + (v[j].z * v[j].z + v[j].w * v[j].w); }
        const float rstd = 1.f / sqrtf(wave_sum(s) * (1.f / DM) + EPS);
#pragma unroll
        for (int j = 0; j < 4; ++j) xr[64 * j] = v[j] * rstd * gv[j];
    }
}

#ifndef PROBE_MASK
#define PROBE_MASK 0
#endif
#ifndef MK_ONE_LAUNCH
#if PROBE_MASK
#define MK_ONE_LAUNCH 0
#else
#define MK_ONE_LAUNCH 1
#endif
#endif
constexpr int NPHASE = 9;
__global__ void __launch_bounds__(NTHR, 2) fwd_kernel(Args args) {
    extern __shared__ __attribute__((aligned(16))) unsigned char lds_raw[];
    LAS unsigned char* lds = (LAS unsigned char*)lds_raw;
    volatile LAS unsigned* MISC = (volatile LAS unsigned*)(lds + MISC_OFF);
    volatile LAS int* tab = (volatile LAS int*)(lds + TAB_OFF);
    const int tid = threadIdx.x, lane = tid & 63, wave = __builtin_amdgcn_readfirstlane(tid >> 6);
    const int G = gridDim.x; const int bx = blockIdx.x; const int vcu = (G % 8 == 0) ? (bx % 8) * (G / 8) + bx / 8 : bx;
    unsigned char* ws = args.ws;
    for (int u = tid; u < (LDS_BYTES - LDSCTL_OFF) / 4; u += NTHR) ((LAS unsigned*)(lds + LDSCTL_OFF))[u] = 0u;
    __syncthreads();
    XcdBarrier bar; bar.bar = (unsigned*)(ws + WS_CTL) + CW_BAR; bar.x = 0; bar.st = nullptr;
    if (MK_ONE_LAUNCH) bar = xcd_barrier_post((unsigned*)(ws + WS_CTL) + CW_BAR, MISC + 8);
    const int lo = args.ph_lo, hi = args.ph_hi;
#define IN(k) (lo <= (k) && (k) < hi)
#ifndef PROBE_XBAR
#define PROBE_XBAR 0
#endif
#define SEAM(k) do { if (MK_ONE_LAUNCH && IN(k) && IN((k) + 1)) { xcd_barrier(bar); for (int xb_ = 0; xb_ < PROBE_XBAR; ++xb_) xcd_barrier(bar); } } while (0)
    bf16* W1 = (bf16*)(ws + WS_W1); bf16* XN = (bf16*)(ws + WS_R1); bf16* YRET = (bf16*)(ws + WS_R1); bf16* HIDS = (bf16*)(ws + WS_R1);
    bf16* SBQ = (bf16*)(ws + WS_SBQ); bf16* SBK = (bf16*)(ws + WS_SBK); bf16* SBV = (bf16*)(ws + WS_SBV); bf16* RQ = (bf16*)(ws + WS_RQ); bf16* RK = (bf16*)(ws + WS_RK);
    bf16* RV = (bf16*)(ws + WS_RV); bf16* RG = (bf16*)(ws + WS_RG); bf16* YSB = (bf16*)(ws + WS_YSB); bf16* GATES = (bf16*)args.out;
    bf16* MIX = (bf16*)(ws + WS_MIX); bf16* HB = (bf16*)(ws + WS_HB);
    volatile LAS int* rowtok = (volatile LAS int*)(lds + 131072);

    if (IN(0)) { p0_prologue(args, lds, vcu, G, wave, lane); }
    SEAM(0);
    if (IN(1)) {
        pg8::StaticOrder S; S.init(XN, W1, T, N1, 1024, G, bx);
        Epi1 E{SBQ, SBK, SBV, RQ, RK, RV, RG, GATES, args.in[4], (const float*)(ws + WS_ROT), args.rep};
        pg8::gemm_phase<Epi1, pg8::StaticOrder, true, true>(lds, 1024, S, E);
    }
    SEAM(1);
    if (IN(2)) {
        const int nret = G >> 1;
#ifdef PROBE_ABL
        if (args.rep) { if (PROBE_ABL == 1) { if (bx < nret) kv_chain(RK, RV, (bf16*)(ws + WS_KV), lds, bx, nret, tid, wave, lane); }
                        else { sb_phase(SBQ, SBK, SBV, YSB, lds, bx, G, tid, wave, lane, true); } } else
#endif
        {
        if (bx < nret) kv_chain(RK, RV, (bf16*)(ws + WS_KV), lds, bx, nret, tid, wave, lane);
        if (G == 256) { for (int k = 0; k < (bx < nret ? 3 : 5); ++k) { const int u = bx < nret ? 8 * bx + k : 8 * (bx - nret) + 3 + k; sb_phase(SBQ, SBK, SBV, YSB, lds, u, 1 << 20, tid, wave, lane); } }
        else sb_phase(SBQ, SBK, SBV, YSB, lds, bx, G, tid, wave, lane);
        }
    }
    SEAM(2);
    if (IN(3)) { ret_phase(RQ, RK, RV, RG, args.in[7], (const bf16*)(ws + WS_KV), YRET, lds, bx, G, tid, wave, lane); }
    SEAM(3);
    if (IN(4)) {
        CatOrder S; S.init(YSB, ws + WS_WCAT, T, 1024, 1536, G, bx); S.A2 = (const char*)YRET; S.K1 = 512; S.K2 = 1024;
        EpiMixCat E{GATES, MIX};
        pg8::gemm_phase<EpiMixCat, CatOrder, true, true, false, 8>(lds, 1536, S, E, 512, 1024);
    }
    SEAM(4);
    if (IN(5)) {
        pg8::StaticOrder S; S.init(MIX, ws + WS_WOUT, T, 1024, 1024, G, bx);
        EpiOut E{args.in[0], HB, (bf16*)(ws + WS_HLO)};
        pg8::gemm_phase<EpiOut, pg8::StaticOrder, true, true>(lds, 1024, S, E);
    }
    SEAM(5);
    if (IN(6)) { p_route(args, lds, vcu, G, wave, lane, tid); }
    SEAM(6);
    if (IN(7)) {
        build_class_table(args, tab, tid);
        MoeOrder S{(const char*)HB, (const char*)(ws + WS_WUP), tab, rowtok, 8, 1, G, bx};
        S.build((const int*)(ws + WS_PERM), tid);
        EpiUp E{(const TokInfo*)(ws + WS_TOK), rowtok, HIDS};
        pg8::gemm_phase<EpiUp, MoeOrder, true, true, true>(lds, 1024, S, E);
        { const int total = tab[NCLS] * 8, R = (total + G - 1) / G, first_idle = total - (R - 1) * G;
          if (first_idle < G) wdn_items(args, lds, bx >= first_idle ? bx - first_idle : -1, G - first_idle, wave, lane);
          else wdn_items(args, lds, bx, G, wave, lane); }
    }
    SEAM(7);
    if (IN(8)) {
        build_class_table(args, tab, tid);
        MoeOrder S{(const char*)HIDS, (const char*)(ws + WS_WDN), tab, rowtok, 4, 0, G, bx};
        S.build((const int*)(ws + WS_PERM), tid);
        EpiDown E{rowtok, HB, (const bf16*)(ws + WS_HLO), args.rep ? (float*)(ws + WS_PROBE) : args.out, args.in[17], (float*)(ws + WS_XBUF), (unsigned*)(ws + WS_CTL) + (args.rep ? CW_UPD : CW_ROWT), lds + 131072 + 6144};
        pg8::gemm_phase<EpiDown, MoeOrder, true, true>(lds, 1024, S, E);
    }
#undef IN
#undef SEAM
}

extern "C" void kernel_launch(void* const* d_in, const int* in_sizes, int n_in, void* d_out, int out_size, void* d_ws, size_t ws_size, hipStream_t stream) {
    static int grid = 0;
    if (grid == 0) {
        if (n_in != 18 || in_sizes[0] != T * DM || out_size != T * DM || ws_size < WS_END) { fprintf(stderr, "kernel_launch: unexpected shapes (n_in %d, in0 %d, out %d, ws %zu < %zu)\n", n_in, n_in > 0 ? in_sizes[0] : -1, out_size, ws_size, (size_t)WS_END); grid = -1; return; }
        int dev = 0, cus = 0, per_cu = 0;
        if (hipGetDevice(&dev) != hipSuccess || hipDeviceGetAttribute(&cus, hipDeviceAttributeMultiprocessorCount, dev) != hipSuccess) { grid = -1; return; }
        if (hipFuncSetAttribute((const void*)fwd_kernel, hipFuncAttributeMaxDynamicSharedMemorySize, LDS_BYTES) != hipSuccess) { fprintf(stderr, "kernel_launch: hipFuncSetAttribute failed\n"); grid = -1; return; }
        if (hipOccupancyMaxActiveBlocksPerMultiprocessor(&per_cu, (const void*)fwd_kernel, NTHR, LDS_BYTES) != hipSuccess || per_cu < 1) fprintf(stderr, "kernel_launch: occupancy query reports %d\n", per_cu);
        (void)hipGetLastError();
        grid = cus;
    }
    if (grid < 0) return;
    hipMemsetAsync((char*)d_ws + WS_CTL, 0, CTL_ZERO_BYTES, stream);
    Args a{};
    for (int i = 0; i < 18; ++i) a.in[i] = (const float*)d_in[i];
    a.out = (float*)d_out; a.ws = (unsigned char*)d_ws;
#if MK_ONE_LAUNCH
    a.ph_lo = 0; a.ph_hi = NPHASE;
    hipLaunchKernelGGL(fwd_kernel, dim3(grid), dim3(NTHR), LDS_BYTES, stream, a);
#else
    for (int p = 0; p < NPHASE; ++p) for (int rep = 0; rep < ((PROBE_MASK >> p) & 1) + 1; ++rep) { a.ph_lo = p; a.ph_hi = p + 1; a.rep = rep; hipLaunchKernelGGL(fwd_kernel, dim3(grid), dim3(NTHR), LDS_BYTES, stream, a); }
#endif
}
```
